# Optimizing an MI355X kernel written in HIP

```python
import math
import jax, jax.numpy as jnp
from jax import lax
import numpy as np

D_MODEL = 2048
BATCH = 2
SEQ = 4096
DEPTH = 2

N_Q_HEADS = 16
N_KV_HEADS = 4
HEAD_DIM = 64
Q_PER_KV = N_Q_HEADS // N_KV_HEADS
WINDOW = 128
ATTN_WIDTH = N_Q_HEADS * HEAD_DIM
KV_WIDTH = N_KV_HEADS * HEAD_DIM
SSM_GROUP_CH = 16
SSM_GROUPS = 32
SSM_WIDTH = SSM_GROUPS * SSM_GROUP_CH
SSM_STATE = 64
IN_WIDTH = ATTN_WIDTH + 2 * KV_WIDTH + SSM_WIDTH + 2 * D_MODEL
N_EXPERTS = 64
TOP_K = 8
N_EXPERT_GROUPS = 8
TOPK_GROUPS = 4
EXPERT_DIM = 512
SHARED_DIM = 512
ROUTED_SCALE = 2.5
MOE_BLOCK = 128
NORM_EPS = 1e-6

kernel_name = "hybrid_swa_s5_moe_adaln"


def rmsnorm(x, g):
    xf = x.astype(jnp.float32)
    xf = xf * lax.rsqrt(jnp.mean(xf * xf, axis=-1, keepdims=True) + NORM_EPS)
    return (xf * g.astype(jnp.float32)).astype(x.dtype)


def modulate(h, shift, scale):
    return h * (1.0 + scale[:, None, :]) + shift[:, None, :]


def swiglu(x, wg, wu, wd):
    return (jax.nn.silu(x @ wg) * (x @ wu)) @ wd


def sliding_window_gqa(q, k, v, sinks):
    B, L = q.shape[0], q.shape[1]
    nb = L // WINDOW
    qb = q.reshape(B, nb, WINDOW, N_KV_HEADS, Q_PER_KV, HEAD_DIM)
    kb = k.reshape(B, nb, WINDOW, N_KV_HEADS, HEAD_DIM)
    vb = v.reshape(B, nb, WINDOW, N_KV_HEADS, HEAD_DIM)
    pad = ((0, 0), (1, 0), (0, 0), (0, 0), (0, 0))
    k_cat = jnp.concatenate([jnp.pad(kb, pad)[:, :-1], kb], axis=2)
    v_cat = jnp.concatenate([jnp.pad(vb, pad)[:, :-1], vb], axis=2)
    s = jnp.einsum('bnqhgd,bnkhd->bnhgqk', qb, k_cat).astype(jnp.float32) / math.sqrt(HEAD_DIM)
    i = jnp.arange(WINDOW)[:, None]
    j = jnp.arange(2 * WINDOW)[None, :]
    band = (j > i) & (j <= i + WINDOW)
    not_first = (jnp.arange(nb) > 0)[:, None, None]
    mask = band[None] & (not_first | (j >= WINDOW)[None])
    s = jnp.where(mask[None, :, None, None], s, jnp.finfo(jnp.float32).min)
    sink = jnp.broadcast_to(sinks.astype(jnp.float32).reshape(1, 1, N_KV_HEADS, Q_PER_KV, 1, 1),
                            s.shape[:-1] + (1,))
    p = jax.nn.softmax(jnp.concatenate([s, sink], axis=-1), axis=-1)[..., :-1]
    o = jnp.einsum('bnhgqk,bnkhd->bnqhgd', p.astype(v.dtype), v_cat)
    return o.reshape(B, L, ATTN_WIDTH)


def _complex_affine_combine(earlier, later):
    a1r, a1i, b1r, b1i = earlier
    a2r, a2i, b2r, b2i = later
    return (a2r * a1r - a2i * a1i,
            a2r * a1i + a2i * a1r,
            a2r * b1r - a2i * b1i + b2r,
            a2r * b1i + a2i * b1r + b2i)


def s5_branch(u, a_re, a_im, log_dt, b_re, b_im, c_re, c_im, d_skip, w_glu):
    B, L = u.shape[0], u.shape[1]
    f32 = jnp.float32
    uf = u.astype(f32).reshape(B, L, SSM_GROUPS, SSM_GROUP_CH)
    are, aim = a_re.astype(f32), a_im.astype(f32)
    dt = jnp.exp(log_dt.astype(f32))[:, None]
    mag = jnp.exp(dt * are)
    ab_r, ab_i = mag * jnp.cos(dt * aim), mag * jnp.sin(dt * aim)
    den = are * are + aim * aim
    nr, ni = ab_r - 1.0, ab_i
    f_r = (nr * are + ni * aim) / den
    f_i = (ni * are - nr * aim) / den
    br, bi = b_re.astype(f32), b_im.astype(f32)
    bb_r = f_r[..., None] * br - f_i[..., None] * bi
    bb_i = f_r[..., None] * bi + f_i[..., None] * br
    bu_r = jnp.einsum('blgc,gpc->blgp', uf, bb_r)
    bu_i = jnp.einsum('blgc,gpc->blgp', uf, bb_i)
    a_r = jnp.broadcast_to(ab_r, bu_r.shape)
    a_i = jnp.broadcast_to(ab_i, bu_i.shape)
    _, _, x_r, x_i = lax.associative_scan(_complex_affine_combine, (a_r, a_i, bu_r, bu_i), axis=1)
    y = (jnp.einsum('blgp,gcp->blgc', x_r, c_re.astype(f32))
         - jnp.einsum('blgp,gcp->blgc', x_i, c_im.astype(f32))
         + d_skip.astype(f32).reshape(SSM_GROUPS, SSM_GROUP_CH) * uf)
    y = jax.nn.gelu(y).reshape(B, L, SSM_WIDTH).astype(u.dtype)
    za, zb = jnp.split(y @ w_glu, 2, axis=-1)
    return za * jax.nn.sigmoid(zb)


def hybrid_mixer(h, w_in, b_in, attn_sinks, w_attn_o, a_re, a_im, log_dt, b_re, b_im,
                 c_re, c_im, d_skip, w_glu, w_mix_out):
    B, L = h.shape[0], h.shape[1]
    proj = h @ w_in + b_in
    o1 = ATTN_WIDTH
    o2 = o1 + KV_WIDTH
    o3 = o2 + KV_WIDTH
    o4 = o3 + SSM_WIDTH
    o5 = o4 + D_MODEL
    q, k, v, u, g_attn, g_ssm = jnp.split(proj, [o1, o2, o3, o4, o5], axis=-1)
    attn = sliding_window_gqa(q.reshape(B, L, N_Q_HEADS, HEAD_DIM),
                              k.reshape(B, L, N_KV_HEADS, HEAD_DIM),
                              v.reshape(B, L, N_KV_HEADS, HEAD_DIM), attn_sinks) @ w_attn_o
    ssm = s5_branch(u, a_re, a_im, log_dt, b_re, b_im, c_re, c_im, d_skip, w_glu)
    mixed = jax.nn.sigmoid(g_attn) * attn + jax.nn.sigmoid(g_ssm) * ssm
    return mixed @ w_mix_out


def moe_ffn(h, w_router, b_router, w_exp_gate, w_exp_up, w_exp_down, w_sh_gate, w_sh_up, w_sh_down):
    B, L, D = h.shape
    T = B * L
    xs = h.reshape(T, D)
    scores = jax.nn.sigmoid((xs @ w_router).astype(jnp.float32))
    sel = scores + b_router.astype(jnp.float32)
    grp = sel.reshape(T, N_EXPERT_GROUPS, N_EXPERTS // N_EXPERT_GROUPS)
    gscore = lax.top_k(grp, 2)[0].sum(axis=-1)
    _, gidx = lax.top_k(gscore, TOPK_GROUPS)
    gmask = jnp.any(gidx[:, :, None] == jnp.arange(N_EXPERT_GROUPS)[None, None, :], axis=1)
    emask = jnp.repeat(gmask, N_EXPERTS // N_EXPERT_GROUPS, axis=1)
    _, eidx = lax.top_k(jnp.where(emask, sel, -jnp.inf), TOP_K)
    wts = jnp.take_along_axis(scores, eidx, axis=-1)
    wts = wts / jnp.sum(wts, axis=-1, keepdims=True) * ROUTED_SCALE
    n_assign = T * TOP_K
    e_flat = eidx.reshape(-1)
    w_flat = wts.reshape(-1)
    tok_flat = jnp.arange(n_assign, dtype=jnp.int32) // TOP_K
    order = jnp.argsort(e_flat, stable=True)
    e_sorted = e_flat[order]
    counts = jnp.bincount(e_flat, length=N_EXPERTS)
    padded = (counts + MOE_BLOCK - 1) // MOE_BLOCK * MOE_BLOCK
    start = jnp.cumsum(counts) - counts
    pstart = jnp.cumsum(padded) - padded
    pend = pstart + padded
    dest = pstart[e_sorted] + jnp.arange(n_assign, dtype=jnp.int32) - start[e_sorted]
    n_slots = n_assign + N_EXPERTS * MOE_BLOCK
    n_blocks = n_slots // MOE_BLOCK
    slot_tok = jnp.full((n_slots,), T, dtype=jnp.int32).at[dest].set(tok_flat[order])
    slot_w = jnp.zeros((n_slots,), jnp.float32).at[dest].set(w_flat[order])
    blk_start = jnp.arange(n_blocks, dtype=jnp.int32) * MOE_BLOCK
    blk_e = jnp.minimum(jnp.sum(pend[None, :] <= blk_start[:, None], axis=1), N_EXPERTS - 1)
    xs_pad = jnp.concatenate([xs, jnp.zeros((1, D), xs.dtype)], axis=0)
    xb = xs_pad[slot_tok].reshape(n_blocks, MOE_BLOCK, D)

    def expert_block(args):
        xblk, e = args
        return swiglu(xblk, w_exp_gate[e], w_exp_up[e], w_exp_down[e])

    yb = lax.map(expert_block, (xb, blk_e)).reshape(n_slots, D)
    routed = jnp.zeros((T + 1, D), xs.dtype).at[slot_tok].add(yb * slot_w[:, None].astype(xs.dtype))[:T]
    shared = swiglu(xs, w_sh_gate, w_sh_up, w_sh_down)
    return (routed + shared).reshape(B, L, D)


def setup_inputs(seed: int = 0) -> dict:
    key = jax.random.key(seed)
    ks = jax.random.split(key, 32)
    D = D_MODEL

    def nrm(k, shape, scale):
        return jax.random.normal(k, shape, jnp.float32) * scale

    n_idx = jnp.arange(SSM_STATE, dtype=jnp.float32)
    return {
        "x": nrm(ks[0], (BATCH, SEQ, D), 1.0),
        "c": nrm(ks[1], (BATCH, D), 1.0),
        "w_ada": nrm(ks[2], (DEPTH, D, 6 * D), 0.5 * D ** -0.5),
        "b_ada": nrm(ks[3], (DEPTH, 6 * D), 0.02),
        "norm_mix": 1.0 + nrm(ks[4], (DEPTH, D), 0.01),
        "w_in": nrm(ks[5], (DEPTH, D, IN_WIDTH), D ** -0.5),
        "b_in": nrm(ks[6], (DEPTH, IN_WIDTH), 0.02),
        "attn_sinks": nrm(ks[7], (DEPTH, N_Q_HEADS), 0.5),
        "w_attn_o": nrm(ks[8], (DEPTH, ATTN_WIDTH, D), ATTN_WIDTH ** -0.5),
        "ssm_a_re": -0.5 + nrm(ks[9], (DEPTH, SSM_GROUPS, SSM_STATE), 0.01),
        "ssm_a_im": math.pi * n_idx + nrm(ks[10], (DEPTH, SSM_GROUPS, SSM_STATE), 0.01),
        "ssm_log_dt": jax.random.uniform(ks[11], (DEPTH, SSM_GROUPS), jnp.float32,
                                         math.log(1e-3), math.log(1e-1)),
        "ssm_b_re": nrm(ks[12], (DEPTH, SSM_GROUPS, SSM_STATE, SSM_GROUP_CH), (2 * SSM_GROUP_CH) ** -0.5),
        "ssm_b_im": nrm(ks[13], (DEPTH, SSM_GROUPS, SSM_STATE, SSM_GROUP_CH), (2 * SSM_GROUP_CH) ** -0.5),
        "ssm_c_re": nrm(ks[14], (DEPTH, SSM_GROUPS, SSM_GROUP_CH, SSM_STATE), 1.0),
        "ssm_c_im": nrm(ks[15], (DEPTH, SSM_GROUPS, SSM_GROUP_CH, SSM_STATE), 1.0),
        "ssm_d": nrm(ks[16], (DEPTH, SSM_WIDTH), 0.5),
        "w_glu": nrm(ks[17], (DEPTH, SSM_WIDTH, 2 * D), SSM_WIDTH ** -0.5),
        "w_mix_out": nrm(ks[18], (DEPTH, D, D), D ** -0.5),
        "norm_ffn": 1.0 + nrm(ks[19], (DEPTH, D), 0.01),
        "w_router": nrm(ks[20], (DEPTH, D, N_EXPERTS), D ** -0.5),
        "b_router": nrm(ks[21], (DEPTH, N_EXPERTS), 0.01),
        "w_exp_gate": nrm(ks[22], (DEPTH, N_EXPERTS, D, EXPERT_DIM), D ** -0.5),
        "w_exp_up": nrm(ks[23], (DEPTH, N_EXPERTS, D, EXPERT_DIM), D ** -0.5),
        "w_exp_down": nrm(ks[24], (DEPTH, N_EXPERTS, EXPERT_DIM, D), EXPERT_DIM ** -0.5),
        "w_sh_gate": nrm(ks[25], (DEPTH, D, SHARED_DIM), D ** -0.5),
        "w_sh_up": nrm(ks[26], (DEPTH, D, SHARED_DIM), D ** -0.5),
        "w_sh_down": nrm(ks[27], (DEPTH, SHARED_DIM, D), SHARED_DIM ** -0.5),
        "norm_final": 1.0 + nrm(ks[28], (D,), 0.01),
    }


def reference(x, c, w_ada, b_ada, norm_mix, w_in, b_in, attn_sinks, w_attn_o, ssm_a_re, ssm_a_im,
              ssm_log_dt, ssm_b_re, ssm_b_im, ssm_c_re, ssm_c_im, ssm_d, w_glu, w_mix_out, norm_ffn,
              w_router, b_router, w_exp_gate, w_exp_up, w_exp_down, w_sh_gate, w_sh_up, w_sh_down,
              norm_final):
    c_act = jax.nn.silu(c)
    for l in range(DEPTH):
        mod = c_act @ w_ada[l] + b_ada[l]
        sh1, sc1, gt1, sh2, sc2, gt2 = jnp.split(mod, 6, axis=-1)
        h = modulate(rmsnorm(x, norm_mix[l]), sh1, sc1)
        x = x + gt1[:, None, :] * hybrid_mixer(
            h, w_in[l], b_in[l], attn_sinks[l], w_attn_o[l], ssm_a_re[l], ssm_a_im[l], ssm_log_dt[l],
            ssm_b_re[l], ssm_b_im[l], ssm_c_re[l], ssm_c_im[l], ssm_d[l], w_glu[l], w_mix_out[l])
        h = modulate(rmsnorm(x, norm_ffn[l]), sh2, sc2)
        x = x + gt2[:, None, :] * moe_ffn(
            h, w_router[l], b_router[l], w_exp_gate[l], w_exp_up[l], w_exp_down[l],
            w_sh_gate[l], w_sh_up[l], w_sh_down[l])
    return rmsnorm(x, norm_final)
```

```cpp
#include <hip/hip_runtime.h>
#include <cstdio>
#include <cstdint>

#ifndef N_LAUNCHES
#define N_LAUNCHES 1
#endif
#ifndef GEMM_ALIGN
#define GEMM_ALIGN true
#endif
#ifndef GEMM_SP2
#define GEMM_SP2 true
#endif
#ifndef MOE_XCD
#define MOE_XCD 0
#endif

#define LAS __attribute__((address_space(3)))
#define GAS __attribute__((address_space(1)))
typedef unsigned short bf16_t;
typedef short bf16x8 __attribute__((ext_vector_type(8)));
typedef float f32x4 __attribute__((ext_vector_type(4)));
typedef float f32x2 __attribute__((ext_vector_type(2)));
typedef unsigned u32x4 __attribute__((ext_vector_type(4)));
typedef unsigned u32x2 __attribute__((ext_vector_type(2)));

constexpr int T = 8192, D = 2048, SEQ = 4096, DEPTH = 2;
constexpr int INW = 6144, O_Q = 0, O_K = 1024, O_V = 1280, O_U = 1536, O_GA = 2048, O_GS = 4096;
constexpr int NE = 64, NSLOT = 9;
constexpr float NORM_EPS = 1e-6f;
constexpr float LOG2E = 1.4426950408889634f;

constexpr size_t MiB = 1u << 20;
constexpr size_t WS_CTL = 0, CTL_ZERO_BYTES = 1 * MiB;
constexpr size_t WS_MODP = 1 * MiB;
constexpr size_t WS_MOD = 3 * MiB;
constexpr size_t WS_SSM = 4 * MiB;
constexpr size_t SSM_STRIDE = 640 * 1024, SSM_E = 0, SSM_F = 256 * 1024, SSM_KT = 512 * 1024, SSM_P = 560 * 1024;
constexpr size_t WS_WIN = 44 * MiB;
constexpr size_t WS_WO = 92 * MiB;
constexpr size_t WS_WGLU = 100 * MiB;
constexpr size_t WS_WMIX = 108 * MiB;
constexpr size_t WS_WGU = 124 * MiB;
constexpr size_t WS_WD = 644 * MiB;
constexpr size_t WS_H = 904 * MiB;
constexpr size_t WS_PROJ = 936 * MiB;
constexpr size_t WS_ATTN = 1032 * MiB;
constexpr size_t WS_SLOC = 1048 * MiB;
constexpr size_t WS_Y = 1050 * MiB;
constexpr size_t WS_MIXED = 1058 * MiB;
constexpr size_t WS_HID = 1090 * MiB;
constexpr size_t WS_YSLOT = 1163 * MiB;
constexpr size_t WS_LTOK = 1451 * MiB, WS_LDST = 1453 * MiB, WS_LW = 1455 * MiB;
constexpr size_t WS_MIXED2 = 1457 * MiB;
constexpr size_t WS_WRT = 1489 * MiB;
constexpr size_t WS_XB = 1490 * MiB;
constexpr size_t WS_TOKW = 1522 * MiB;
constexpr size_t WS_END = 1523 * MiB;
constexpr int CW_TMO = 0, CW_BAR = 4096, CW_CNT = 8192;

constexpr int RING_BYTES = 131072, LDSCTL_OFF = RING_BYTES, MISC_OFF = LDSCTL_OFF + 320;
constexpr int SEL_OFF = LDSCTL_OFF + 1024;
constexpr int MOE_OFF = LDSCTL_OFF + 10240;
constexpr int LDS_BYTES = 147456;
constexpr int NWAVES = 8;

__device__ __forceinline__ unsigned cvt_pk_bf16(float lo, float hi) { unsigned r; asm("v_cvt_pk_bf16_f32 %0, %1, %2" : "=v"(r) : "v"(lo), "v"(hi)); return r; }
__device__ __forceinline__ float bf_lo(unsigned w) { return __uint_as_float(w << 16); }
__device__ __forceinline__ float bf_hi(unsigned w) { return __uint_as_float(w & 0xffff0000u); }
__device__ __forceinline__ float bf1(bf16_t h) { return __uint_as_float(((unsigned)h) << 16); }
__device__ __forceinline__ float fast_sigmoid(float x) { return __builtin_amdgcn_rcpf(1.0f + __builtin_amdgcn_exp2f(-x * LOG2E)); }
__device__ __forceinline__ float wave_sum(float v) {
#pragma unroll
    for (int o = 1; o < 64; o <<= 1) v += __shfl_xor(v, o);
    return v;
}
__device__ __forceinline__ int opaque(int v) { asm volatile("" : "+v"(v)); return v; }
#define LDS_WAIT() asm volatile("s_waitcnt lgkmcnt(0)" ::: "memory")
#define VM_WAIT() asm volatile("s_waitcnt vmcnt(0)" ::: "memory")

#define XB_TMO      128
#define XB_XCNT(j)  (256  + 64 * (j))
#define XB_XSUB(j)  (1280 + 64 * (j))
#define XB_XGEN(j)  (2304 + 64 * (j))
#define XB_TOP      3328
#define XB_TOPGEN   3392
#define XCD_BAR_WORDS 3456
#define XB_SPIN_CAP (1u << 18)
__device__ __forceinline__ unsigned xb_ld(unsigned* p)              { return __hip_atomic_load(p, __ATOMIC_RELAXED, __HIP_MEMORY_SCOPE_AGENT); }
__device__ __forceinline__ unsigned xb_add(unsigned* p, unsigned v) { return __hip_atomic_fetch_add(p, v, __ATOMIC_RELAXED, __HIP_MEMORY_SCOPE_AGENT); }
__device__ __forceinline__ unsigned xb_xcc_id() { return (unsigned)__builtin_amdgcn_s_getreg((3 << 11) | 20) & 0xFu; }
#define XB_SPIN(cond, bar) do { unsigned _sp = 0; while (cond) { __builtin_amdgcn_s_sleep(1); \
    if ((++_sp & 255u) == 0u) { if (xb_ld(&(bar)[XB_TMO])) break; if (_sp > XB_SPIN_CAP) { atomicAdd(&(bar)[XB_TMO], 1u); break; } } } } while (0)
struct XcdBarrier { unsigned* bar; unsigned x; volatile LAS unsigned* st; };
__device__ __forceinline__ XcdBarrier xcd_barrier_post(unsigned* bar, volatile LAS unsigned* st) {
    XcdBarrier b; b.bar = bar; b.x = xb_xcc_id(); b.st = st;
    if (threadIdx.x == 0) (void)xb_add(&bar[XB_XCNT(b.x)], 1u);
    return b;
}
__device__ __forceinline__ void xcd_barrier_complete(unsigned* bar, unsigned x, unsigned& nloc, unsigned& nx) {
    const unsigned G = gridDim.x * gridDim.y * gridDim.z;
    unsigned sum, cnt, mine, sp = 0u;
    for (;;) {
        sum = 0u; cnt = 0u; mine = 0u;
#pragma unroll
        for (unsigned j = 0; j < 16; ++j) { const unsigned c = xb_ld(&bar[XB_XCNT(j)]); sum += c; cnt += (c > 0u) ? 1u : 0u; mine = (j == x) ? c : mine; }
        if (sum == G) break;
        __builtin_amdgcn_s_sleep(1);
        if ((++sp & 255u) == 0u) { if (xb_ld(&bar[XB_TMO])) break; if (sp > XB_SPIN_CAP) { atomicAdd(&bar[XB_TMO], 1u); break; } }
    }
    nloc = mine > 0u ? mine : 1u; nx = cnt > 0u ? cnt : 1u;
}
__device__ __forceinline__ void xcd_barrier(const XcdBarrier& b) {
    asm volatile("s_waitcnt vmcnt(0)" ::: "memory");
    __syncthreads();
    if (threadIdx.x == 0) {
        unsigned* bar = b.bar;
        __builtin_amdgcn_s_waitcnt(0);
        unsigned nloc = b.st[0], nx = b.st[1];
        if (nloc == 0u) { xcd_barrier_complete(bar, b.x, nloc, nx); b.st[0] = nloc; b.st[1] = nx; }
        const unsigned old = xb_add(&bar[XB_XSUB(b.x)], 1u);
        const unsigned gen = old / nloc;
        if (old + 1u == (gen + 1u) * nloc) {
            __builtin_amdgcn_fence(__ATOMIC_RELEASE, "agent");
            asm volatile("s_waitcnt vmcnt(0)" ::: "memory");
            const unsigned og = xb_add(&bar[XB_TOP], 1u);
            const unsigned tg = og / nx;
            if (og + 1u == (tg + 1u) * nx) xb_add(&bar[XB_TOPGEN], 1u);
            else XB_SPIN(xb_ld(&bar[XB_TOPGEN]) == tg, bar);
            __builtin_amdgcn_fence(__ATOMIC_ACQUIRE, "agent");
            xb_add(&bar[XB_XGEN(b.x)], 1u);
            asm volatile("s_waitcnt vmcnt(0)" ::: "memory");
        } else {
            XB_SPIN(xb_ld(&bar[XB_XGEN(b.x)]) == gen, bar);
            __builtin_amdgcn_fence(__ATOMIC_ACQUIRE, "agent");
            asm volatile("s_waitcnt vmcnt(0)" ::: "memory");
        }
    }
    __syncthreads();
}

namespace pg8 {
constexpr int BM = 256, BK = 64, HALF = 128, HTB = HALF * BK * 2, STAGE_BYTES = 8 * HTB, NXCD = 8, WGM = 8;
__host__ __device__ __forceinline__ int lds_byte(int r, int c) { const int st = (r >> 4) * 2 + (c >> 5), rr = r & 15, cc = c & 31, ob = rr * 64 + cc * 2; return st * 1024 + (ob ^ (((ob >> 9) & 1) << 5)); }
__host__ __device__ __forceinline__ void stage_rc(int b, int& R, int& C) { const int st = b / 1024, sb = b % 1024, swz = sb ^ (((sb >> 9) & 1) << 5); R = (st >> 1) * 16 + swz / 64; C = (st & 1) * 32 + (swz % 64) / 2; }
__host__ __device__ __forceinline__ int perm32(int rho) { const int n = rho >> 4, i = rho & 15; return 8 * (i >> 2) + 4 * n + (i & 3); }

struct Unit { int pm, pn, e, n, r0, x; };

struct DenseOrder {
    static constexpr bool GATHER = false;
    int nM, nN, nwg, G, c; const char* Bt; size_t tstepB;
    __device__ void init(int M, int N, int K, int G_, int c_, const void* Bt_) { nM = M / BM; nN = N / BM; nwg = nM * nN; G = G_; c = c_; Bt = (const char*)Bt_; tstepB = (size_t)BM * K * 2; }
    __device__ __forceinline__ bool next(int i, Unit& u) const {
        const long L = (long)i * G + c; if (L >= nwg) return false;
        int wgid = (int)L; { const int q = nwg / NXCD, r = nwg % NXCD, xcd = wgid % NXCD, off = wgid / NXCD; wgid = (xcd < r ? xcd * (q + 1) : r * (q + 1) + (xcd - r) * q) + off; }
        const int nig = WGM * nN, gid = wgid / nig, fm = gid * WGM, gsz = (nM - fm) < WGM ? (nM - fm) : WGM;
        u.pm = fm + ((wgid % nig) % gsz); u.pn = (wgid % nig) / gsz; u.e = -1; u.n = 256; u.r0 = u.pm * BM; u.x = u.pm * BM; return true;
    }
    __device__ __forceinline__ int a_row(const Unit& u, int R) const { return u.r0 + R; }
    __device__ __forceinline__ void a_row_issue(const Unit& u, int R, int& out) const { out = u.r0 + R; }
    __device__ __forceinline__ int a_row_fix(const Unit& u, int R, int loaded) const { return loaded; }
    __device__ __forceinline__ const char* b_tile(const Unit& u) const { return Bt + (size_t)u.pn * tstepB; }
};
template <int NPN, bool GATHER_> struct MoeOrder {
    static constexpr bool GATHER = GATHER_;
    const LAS int* utab; const char* Wbase; size_t wstepE, tstepB; const int* ltok;
    __device__ __forceinline__ bool next(int i, Unit& u) const {
        if (i >= 64) return false;
        const LAS int* p = utab + i * 8;
        const int pm = __builtin_amdgcn_readfirstlane(p[0]); if (pm < 0) return false;
        u.pm = pm; u.pn = __builtin_amdgcn_readfirstlane(p[1]); u.e = __builtin_amdgcn_readfirstlane(p[2]); u.n = __builtin_amdgcn_readfirstlane(p[3]);
        u.r0 = __builtin_amdgcn_readfirstlane(p[4]); u.x = __builtin_amdgcn_readfirstlane(p[5]); return true;
    }
    __device__ __forceinline__ int a_row(const Unit& u, int R) const {
        if (!GATHER) return u.r0 + R;
        if (u.e == 64) return u.r0 + R;
        const int rr = R < u.n ? R : u.n - 1; return ((const GAS int*)ltok)[u.r0 + rr];
    }
    __device__ __forceinline__ void a_row_issue(const Unit& u, int R, int& out) const {
        const int rr = R < u.n ? R : u.n - 1; const GAS int* p = (const GAS int*)ltok + (u.e == 64 ? 0 : u.r0 + rr);
        asm volatile("global_load_dword %0, %1, off" : "=v"(out) : "v"(p) : "memory");
    }
    __device__ __forceinline__ int a_row_fix(const Unit& u, int R, int loaded) const { return u.e == 64 ? u.r0 + R : loaded; }
    __device__ __forceinline__ const char* b_tile(const Unit& u) const { return Wbase + (size_t)u.e * wstepE + (size_t)u.pn * tstepB; }
};
template <int NPN, bool GATHER> __device__ __forceinline__ void moe_build(LAS int* tpre, LAS int* ebase, LAS int* ecnt, LAS int* utab, const unsigned* counts, int G, int c, int tid) {
    if (tid < 64) ecnt[tid] = (int)__hip_atomic_load(counts + tid, __ATOMIC_RELAXED, __HIP_MEMORY_SCOPE_AGENT);
    __syncthreads();
    if (tid == 0) { int tp = 0, eb = 0; for (int e = 0; e < 64; ++e) { tpre[e] = tp; ebase[e] = eb; tp += (ecnt[e] + 255) >> 8; eb += ecnt[e]; } tpre[64] = tp; ebase[64] = eb; }
    __syncthreads();
#if MOE_XCD
    if (tid < 64) {
        int pm = -1, pn = 0, e = 64, n = 256;
        const int xc = c & 7; int idx = (c >> 3) + (G >> 3) * tid;
        if (idx < 4 * NPN) { pm = xc + 8 * (idx / NPN); pn = idx % NPN; }
        else { idx -= 4 * NPN;
#pragma unroll 1
            for (int j = 0; j < 8; ++j) { const int ee = xc + 8 * j, nu = ((ecnt[ee] + 255) >> 8) * NPN;
                if (pm < 0) { if (idx < nu) { e = ee; pm = idx / NPN; pn = idx % NPN; } else idx -= nu; } }
            if (pm >= 0) { const int rem = ecnt[e] - pm * BM; n = rem < BM ? rem : BM; } }
        const int hb = (e == 64 ? 65536 : ebase[e]) + pm * BM;
        const int r0 = GATHER ? (e == 64 ? pm * BM : e * 8192 + pm * BM) : hb, x = hb;
#else
    if (tid < 64) {
        int pm = -1, pn = 0, e = 64, n = 256;
        const int vc = ((G & 7) == 0) ? (c & 7) * (G >> 3) + (c >> 3) : c;
        int L = tid * G + vc; const int shared_units = 32 * NPN, tot = shared_units + NPN * tpre[64];
        if (L < tot) {
            if (L < shared_units) { pm = L / NPN; pn = L % NPN; }
            else { L -= shared_units; const int tile = L / NPN; pn = L % NPN; e = 0;
#pragma unroll 1
                for (int j = 1; j <= 64; ++j) e += (tpre[j] <= tile) ? 1 : 0;
                pm = tile - tpre[e]; const int rem = ecnt[e] - pm * BM; n = rem < BM ? rem : BM; } }
        const int hb = (e == 64 ? 65536 : ebase[e]) + pm * BM;
        const int r0 = GATHER ? (e == 64 ? pm * BM : e * 8192 + pm * BM) : hb, x = hb;
#endif
        LAS int* p = utab + tid * 8; p[0] = pm; p[1] = pn; p[2] = e; p[3] = n; p[4] = r0; p[5] = x;
    }
    __syncthreads();
}

template <class Epi, class Sched, bool ALIGN_EPI = false, bool SP2 = GEMM_SP2>
__device__ __forceinline__ void gemm_phase(LAS unsigned char* lds, const char* Abase, const int K, const Sched& S, const Epi& E) {
    int tid = threadIdx.x; asm volatile("" : "+v"(tid));
    const int wid = __builtin_amdgcn_readfirstlane(tid >> 6), lane = tid & 63, wr = wid >> 2, wc = wid & 3, fr = lane & 15, fq = lane >> 4;
    const int nt = K / BK;
    constexpr bool GA = Sched::GATHER;
    unsigned voffA[2], voffB[2];
#pragma unroll
    for (int i = 0; i < 2; ++i) { int R, C; stage_rc(tid * 16 + i * 8192, R, C); const int Rb = Epi::PERM ? ((R & ~31) + perm32(R & 31)) : R; voffA[i] = (unsigned)(R * K + C) * 2u; voffB[i] = (unsigned)(Rb * K + C) * 2u; }
    const size_t kstep = (size_t)(BK * 2);
    const size_t hstep = (size_t)HALF * K * 2;
    const unsigned ldsw = (unsigned)wid * 1024u;
    const int aoff = lds_byte(wr * 64 + fr, fq * 8), boff = lds_byte(wc * 32 + fr, fq * 8);
#define PG8_SA(b, h) (((b) * 2 + (h)) * HTB)
#define PG8_SB(b, h) ((4 + (b) * 2 + (h)) * HTB)
#define PG8_STB(bufoff, gbase) do { _Pragma("unroll") for (int _i = 0; _i < 2; ++_i) \
        __builtin_amdgcn_global_load_lds((const unsigned*)((const char*)(gbase) + voffB[_i]), (LAS unsigned*)(lds + (bufoff) + ldsw + _i * 8192), 16, 0, 0); } while (0)
#define PG8_STA(bufoff, h, kb) do { _Pragma("unroll") for (int _i = 0; _i < 2; ++_i) \
        __builtin_amdgcn_global_load_lds((const unsigned*)(GA ? (Abase + (kb) + offC[h][_i]) : (cA + (kb) + (h) * hstep + voffA[_i])), (LAS unsigned*)(lds + (bufoff) + ldsw + _i * 8192), 16, 0, 0); } while (0)
#define PG8_LDA(dst, b, h) do { _Pragma("unroll") for (int m = 0; m < 4; ++m) _Pragma("unroll") for (int k = 0; k < 2; ++k) dst[m][k] = *(const LAS bf16x8*)(lds + PG8_SA(b, h) + aoff + m * 2048 + k * 1024); } while (0)
#define PG8_LDB(dst, b, h) do { _Pragma("unroll") for (int n = 0; n < 2; ++n) _Pragma("unroll") for (int k = 0; k < 2; ++k) dst[n][k] = *(const LAS bf16x8*)(lds + PG8_SB(b, h) + boff + n * 2048 + k * 1024); } while (0)
#define PG8_MMA(ai, bj, At, Bt) do { __builtin_amdgcn_s_setprio(1); _Pragma("unroll") for (int m = 0; m < 4; ++m) _Pragma("unroll") for (int n = 0; n < 2; ++n) _Pragma("unroll") for (int k = 0; k < 2; ++k) \
        acc[ai][bj][m][n] = __builtin_amdgcn_mfma_f32_16x16x32_bf16(Bt[n][k], At[m][k], acc[ai][bj][m][n], 0, 0, 0); __builtin_amdgcn_s_setprio(0); } while (0)
#define PG8_WAIT_V(n) asm volatile("s_waitcnt vmcnt(" #n ")" ::: "memory")
#define PG8_WAIT_L(n) asm volatile("s_waitcnt lgkmcnt(" #n ")" ::: "memory")
#define PG8_BAR __builtin_amdgcn_s_barrier()
#define PG8_SCHED __builtin_amdgcn_sched_barrier(0)
#define PG8_AOFF(dst, u) do { if constexpr (GA) { _Pragma("unroll") for (int _h = 0; _h < 2; ++_h) _Pragma("unroll") for (int _i = 0; _i < 2; ++_i) { int _R, _C; stage_rc(tid * 16 + _i * 8192, _R, _C); \
        dst[_h][_i] = (unsigned)(S.a_row(u, _h * HALF + _R) * K + _C) * 2u; } } } while (0)
    Unit cur, nxt; int ui = 0;
    if (!S.next(0, cur)) return;
    f32x4 acc[2][2][4][2];
#pragma unroll
    for (int a = 0; a < 2; ++a)
#pragma unroll
        for (int b = 0; b < 2; ++b)
#pragma unroll
            for (int m = 0; m < 4; ++m)
#pragma unroll
                for (int n = 0; n < 2; ++n) acc[a][b][m][n] = (f32x4){0.f, 0.f, 0.f, 0.f};
    bf16x8 At[4][2], B0[2][2], B1[2][2];
    unsigned offC[2][2];
    PG8_AOFF(offC, cur);
    const char* cB = S.b_tile(cur);
    const char* cA = GA ? Abase : Abase + (size_t)S.a_row(cur, 0) * K * 2;
    if constexpr (SP2) {
        PG8_STB(PG8_SB(0, 0), cB); PG8_STB(PG8_SB(0, 1), cB + hstep); PG8_STA(PG8_SA(0, 0), 0, 0); PG8_STA(PG8_SA(0, 1), 1, 0);
        if (wr == 1) PG8_BAR;
        PG8_WAIT_V(2); PG8_BAR;
        PG8_STB(PG8_SB(1, 0), cB + kstep); PG8_STA(PG8_SA(1, 0), 0, kstep); PG8_STB(PG8_SB(1, 1), cB + hstep + kstep);
        PG8_WAIT_V(6); PG8_BAR;
    } else {
    PG8_STB(PG8_SB(0, 0), cB); PG8_STA(PG8_SA(0, 0), 0, 0); PG8_STB(PG8_SB(0, 1), cB + hstep); PG8_STA(PG8_SA(0, 1), 1, 0);
    if (wr == 1) PG8_BAR;
    PG8_WAIT_V(4); PG8_BAR;
    PG8_STB(PG8_SB(1, 0), cB + kstep); PG8_STA(PG8_SA(1, 0), 0, kstep); PG8_STB(PG8_SB(1, 1), cB + hstep + kstep);
    PG8_WAIT_V(6); PG8_BAR;
    }
    for (;;) {
        int pre_v0, pre_v1; if constexpr (Epi::PRE) E.pre_issue(cur, wr, lane, pre_v0, pre_v1);
        const bool has_next = S.next(ui + 1, nxt);
        const char* nB = has_next ? S.b_tile(nxt) : cB;
        const char* nA = (!GA && has_next) ? Abase + (size_t)S.a_row(nxt, 0) * K * 2 : cA;
        int rowN[2][2];
        if constexpr (GA) { const Unit un = has_next ? nxt : cur;
#pragma unroll
            for (int h = 0; h < 2; ++h)
#pragma unroll
                for (int i = 0; i < 2; ++i) { int R_, C_; stage_rc(tid * 16 + i * 8192, R_, C_); S.a_row_issue(un, h * HALF + R_, rowN[h][i]); } }
        for (int t = 0; t < nt; t += 2) {
            const bool last = (t == nt - 2);
            const size_t kb1 = (size_t)(t + 1) * kstep;
            const size_t kb2 = last ? 0 : (size_t)(t + 2) * kstep, kb3 = kb2 + kstep;
            const char* b2 = last ? nB : cB + (size_t)(t + 2) * kstep; const char* b3 = b2 + kstep;
            if constexpr (SP2) {
            PG8_LDB(B0, 0, 0); PG8_LDB(B1, 0, 1); PG8_SCHED; PG8_LDA(At, 0, 0); PG8_STA(PG8_SA(1, 1), 1, kb1);
            if (last) { if constexpr (GA) { if (has_next) {
#pragma unroll
                for (int h = 0; h < 2; ++h)
#pragma unroll
                    for (int i = 0; i < 2; ++i) { int R_, C_; stage_rc(tid * 16 + i * 8192, R_, C_); int rl = rowN[h][i]; asm volatile("" : "+v"(rl));
                        offC[h][i] = (unsigned)(S.a_row_fix(nxt, h * HALF + R_, rl) * K + C_) * 2u; } } } else cA = nA; }
            PG8_WAIT_V(8); PG8_WAIT_L(0); PG8_BAR; PG8_MMA(0, 0, At, B0); PG8_MMA(0, 1, At, B1); PG8_BAR; PG8_SCHED;
            PG8_LDA(At, 0, 1); PG8_STB(PG8_SB(0, 0), b2); PG8_STB(PG8_SB(0, 1), b2 + hstep); PG8_STA(PG8_SA(0, 0), 0, kb2);
            PG8_WAIT_V(8); PG8_WAIT_L(0); PG8_BAR; PG8_MMA(1, 0, At, B0); PG8_MMA(1, 1, At, B1); PG8_BAR; PG8_SCHED;
            PG8_LDB(B0, 1, 0); PG8_LDB(B1, 1, 1); PG8_SCHED; PG8_LDA(At, 1, 0); PG8_STA(PG8_SA(0, 1), 1, kb2);
            PG8_WAIT_V(8); PG8_WAIT_L(0); PG8_BAR; PG8_MMA(0, 0, At, B0); PG8_MMA(0, 1, At, B1); PG8_BAR; PG8_SCHED;
            PG8_LDA(At, 1, 1); PG8_STB(PG8_SB(1, 0), b3); PG8_STB(PG8_SB(1, 1), b3 + hstep); PG8_STA(PG8_SA(1, 0), 0, kb3);
            PG8_WAIT_V(8); PG8_WAIT_L(0); PG8_BAR; PG8_MMA(1, 0, At, B0); PG8_MMA(1, 1, At, B1); PG8_BAR; PG8_SCHED;
            } else {
            PG8_LDB(B0, 0, 0); PG8_SCHED; PG8_LDA(At, 0, 0); PG8_STA(PG8_SA(1, 1), 1, kb1);
            if (last) { if constexpr (GA) { if (has_next) {
#pragma unroll
                for (int h = 0; h < 2; ++h)
#pragma unroll
                    for (int i = 0; i < 2; ++i) { int R_, C_; stage_rc(tid * 16 + i * 8192, R_, C_); int rl = rowN[h][i]; asm volatile("" : "+v"(rl));
                        offC[h][i] = (unsigned)(S.a_row_fix(nxt, h * HALF + R_, rl) * K + C_) * 2u; } } } else cA = nA; }
            PG8_WAIT_L(8); PG8_BAR; PG8_WAIT_L(0); PG8_MMA(0, 0, At, B0); PG8_BAR; PG8_SCHED;
            PG8_LDB(B1, 0, 1); PG8_STB(PG8_SB(0, 0), b2);
            PG8_BAR; PG8_WAIT_L(0); PG8_MMA(0, 1, At, B1); PG8_BAR;
            PG8_LDA(At, 0, 1); PG8_STA(PG8_SA(0, 0), 0, kb2);
            PG8_BAR; PG8_WAIT_L(0); PG8_MMA(1, 0, At, B0); PG8_BAR; PG8_SCHED;
            PG8_STB(PG8_SB(0, 1), b2 + hstep);
            PG8_WAIT_V(6); PG8_BAR; PG8_MMA(1, 1, At, B1); PG8_BAR;
            PG8_LDB(B0, 1, 0); PG8_SCHED; PG8_LDA(At, 1, 0); PG8_STA(PG8_SA(0, 1), 1, kb2);
            PG8_WAIT_L(8); PG8_BAR; PG8_WAIT_L(0); PG8_MMA(0, 0, At, B0); PG8_BAR; PG8_SCHED;
            PG8_LDB(B1, 1, 1); PG8_STB(PG8_SB(1, 0), b3);
            PG8_BAR; PG8_WAIT_L(0); PG8_MMA(0, 1, At, B1); PG8_BAR;
            PG8_LDA(At, 1, 1); PG8_STA(PG8_SA(1, 0), 0, kb3);
            PG8_BAR; PG8_WAIT_L(0); PG8_MMA(1, 0, At, B0); PG8_BAR; PG8_SCHED;
            PG8_STB(PG8_SB(1, 1), b3 + hstep);
            PG8_WAIT_V(6); PG8_BAR; PG8_MMA(1, 1, At, B1); PG8_BAR;
            }
        }
        if constexpr (ALIGN_EPI) { if (wr == 0) PG8_BAR; }
        if constexpr (Epi::PRE) { asm volatile("" : "+v"(pre_v0), "+v"(pre_v1)); E.pre_commit(pre_v0, pre_v1, wid, lane); }
        E(acc, cur, wr, wc, fr, fq);
        if (!has_next) break;
#pragma unroll
        for (int a = 0; a < 2; ++a)
#pragma unroll
            for (int b = 0; b < 2; ++b)
#pragma unroll
                for (int m = 0; m < 4; ++m)
#pragma unroll
                    for (int n = 0; n < 2; ++n) acc[a][b][m][n] = (f32x4){0.f, 0.f, 0.f, 0.f};
        cur = nxt; cB = nB; ++ui;
        if constexpr (ALIGN_EPI) { if (wr == 1) PG8_BAR; }
    }
    PG8_WAIT_V(0);
    if constexpr (!ALIGN_EPI) { if (wr == 0) PG8_BAR; }
    PG8_BAR;
#undef PG8_SA
#undef PG8_SB
#undef PG8_STB
#undef PG8_STA
#undef PG8_LDA
#undef PG8_LDB
#undef PG8_MMA
#undef PG8_WAIT_V
#undef PG8_WAIT_L
#undef PG8_BAR
#undef PG8_SCHED
#undef PG8_AOFF
}

typedef const f32x4 (&AccRef)[2][2][4][2];
__device__ __forceinline__ u32x4 pack8(const f32x4& a, const f32x4& b) { u32x4 w; w.x = cvt_pk_bf16(a[0], a[1]); w.y = cvt_pk_bf16(a[2], a[3]); w.z = cvt_pk_bf16(b[0], b[1]); w.w = cvt_pk_bf16(b[2], b[3]); return w; }
__device__ __forceinline__ void unpack8(const u32x4 w, f32x4& a, f32x4& b) { a = (f32x4){bf_lo(w.x), bf_hi(w.x), bf_lo(w.y), bf_hi(w.y)}; b = (f32x4){bf_lo(w.z), bf_hi(w.z), bf_lo(w.w), bf_hi(w.w)}; }

struct EpiInProj {
    static constexpr bool PERM = true; static constexpr bool PRE = false;
    bf16_t* O; const float* bias; float qscale; int nostore;
    __device__ __forceinline__ void operator()(AccRef acc, const Unit& u, int wr, int wc, int fr, int fq) const {
        if (nostore) return;
        const int row0 = u.pm * BM + wr * 64 + fr, colb = u.pn * BM + wc * 32 + 8 * fq;
        const int mode = u.pn < 4 ? 1 : (u.pn >= 8 ? 2 : 0);
        f32x4 bv[2][2];
#pragma unroll
        for (int bj = 0; bj < 2; ++bj)
#pragma unroll
            for (int n = 0; n < 2; ++n) bv[bj][n] = *(const GAS f32x4*)(bias + colb + bj * HALF + 4 * n);
#pragma unroll
        for (int ai = 0; ai < 2; ++ai)
#pragma unroll
            for (int m = 0; m < 4; ++m) { bf16_t* rowp = O + (size_t)(row0 + ai * HALF + m * 16) * INW + colb;
#pragma unroll
                for (int bj = 0; bj < 2; ++bj) { f32x4 v0 = acc[ai][bj][m][0] + bv[bj][0], v1 = acc[ai][bj][m][1] + bv[bj][1];
                    if (mode == 1) { v0 = v0 * qscale; v1 = v1 * qscale; }
                    if (mode == 2) {
#pragma unroll
                        for (int j = 0; j < 4; ++j) { v0[j] = fast_sigmoid(v0[j]); v1[j] = fast_sigmoid(v1[j]); } }
                    *(GAS u32x4*)(rowp + bj * HALF) = pack8(v0, v1); } }
    }
};
struct EpiAttnProj {
    static constexpr bool PERM = true; static constexpr bool PRE = false;
    const bf16_t* proj; bf16_t* mixed;
    __device__ __forceinline__ void operator()(AccRef acc, const Unit& u, int wr, int wc, int fr, int fq) const {
        const int row0 = u.pm * BM + wr * 64 + fr, colb = u.pn * BM + wc * 32 + 8 * fq;
#pragma unroll
        for (int ai = 0; ai < 2; ++ai) {
            u32x4 gw[4][2];
#pragma unroll
            for (int m = 0; m < 4; ++m)
#pragma unroll
                for (int bj = 0; bj < 2; ++bj) gw[m][bj] = *(const GAS u32x4*)(proj + (size_t)(row0 + ai * HALF + m * 16) * INW + O_GA + colb + bj * HALF);
#pragma unroll
            for (int m = 0; m < 4; ++m) { const size_t row = (size_t)(row0 + ai * HALF + m * 16);
#pragma unroll
                for (int bj = 0; bj < 2; ++bj) { f32x4 g0, g1; unpack8(gw[m][bj], g0, g1);
                    *(GAS u32x4*)(mixed + row * D + colb + bj * HALF) = pack8(g0 * acc[ai][bj][m][0], g1 * acc[ai][bj][m][1]); } } }
    }
};
struct EpiGlu {
    static constexpr bool PERM = true; static constexpr bool PRE = false;
    const bf16_t* proj; const bf16_t* mixed; bf16_t* mixed2;
    __device__ __forceinline__ void operator()(AccRef acc, const Unit& u, int wr, int wc, int fr, int fq) const {
        const int row0 = u.pm * BM + wr * 64 + fr, col = u.pn * HALF + wc * 32 + 8 * fq;
#pragma unroll
        for (int ai = 0; ai < 2; ++ai) {
            u32x4 gw[4], pw[4];
#pragma unroll
            for (int m = 0; m < 4; ++m) { const size_t row = (size_t)(row0 + ai * HALF + m * 16);
                gw[m] = *(const GAS u32x4*)(proj + row * INW + O_GS + col); pw[m] = *(const GAS u32x4*)(mixed + row * D + col); }
#pragma unroll
            for (int m = 0; m < 4; ++m) { const size_t row = (size_t)(row0 + ai * HALF + m * 16);
                f32x4 g0, g1, p0, p1; unpack8(gw[m], g0, g1); unpack8(pw[m], p0, p1);
                const f32x4 za0 = acc[ai][0][m][0], za1 = acc[ai][0][m][1], zb0 = acc[ai][1][m][0], zb1 = acc[ai][1][m][1];
#pragma unroll
                for (int j = 0; j < 4; ++j) { p0[j] += g0[j] * za0[j] * fast_sigmoid(zb0[j]); p1[j] += g1[j] * za1[j] * fast_sigmoid(zb1[j]); }
                *(GAS u32x4*)(mixed2 + row * D + col) = pack8(p0, p1); } }
    }
};
struct EpiMixOut {
    static constexpr bool PERM = true; static constexpr bool PRE = false;
    const float* xin; const bf16_t* xsrc; bf16_t* xdst; const float* gt;
    __device__ __forceinline__ void operator()(AccRef acc, const Unit& u, int wr, int wc, int fr, int fq) const {
        const int row0 = u.pm * BM + wr * 64 + fr, colb = u.pn * BM + wc * 32 + 8 * fq;
        const float* g = gt + (u.pm >= 16 ? 12288 : 0);
        f32x4 gv[2][2];
#pragma unroll
        for (int bj = 0; bj < 2; ++bj)
#pragma unroll
            for (int n = 0; n < 2; ++n) gv[bj][n] = *(const GAS f32x4*)(g + colb + bj * HALF + 4 * n);
        if (xin) {
#pragma unroll
            for (int ai = 0; ai < 2; ++ai)
#pragma unroll
                for (int mp = 0; mp < 2; ++mp) { f32x4 xv[2][2][2];
#pragma unroll
                    for (int mm = 0; mm < 2; ++mm)
#pragma unroll
                        for (int bj = 0; bj < 2; ++bj) { const size_t off = (size_t)(row0 + ai * HALF + (2 * mp + mm) * 16) * D + colb + bj * HALF;
                            xv[mm][bj][0] = *(const GAS f32x4*)(xin + off); xv[mm][bj][1] = *(const GAS f32x4*)(xin + off + 4); }
#pragma unroll
                    for (int mm = 0; mm < 2; ++mm)
#pragma unroll
                        for (int bj = 0; bj < 2; ++bj) { const int m = 2 * mp + mm; const size_t off = (size_t)(row0 + ai * HALF + m * 16) * D + colb + bj * HALF;
                            *(GAS u32x4*)(xdst + off) = pack8(xv[mm][bj][0] + gv[bj][0] * acc[ai][bj][m][0], xv[mm][bj][1] + gv[bj][1] * acc[ai][bj][m][1]); } }
        } else {
#pragma unroll
            for (int ai = 0; ai < 2; ++ai) { u32x4 xw[4][2];
#pragma unroll
                for (int m = 0; m < 4; ++m)
#pragma unroll
                    for (int bj = 0; bj < 2; ++bj) xw[m][bj] = *(const GAS u32x4*)(xsrc + (size_t)(row0 + ai * HALF + m * 16) * D + colb + bj * HALF);
#pragma unroll
                for (int m = 0; m < 4; ++m)
#pragma unroll
                    for (int bj = 0; bj < 2; ++bj) { f32x4 x0, x1; unpack8(xw[m][bj], x0, x1);
                        *(GAS u32x4*)(xdst + (size_t)(row0 + ai * HALF + m * 16) * D + colb + bj * HALF) = pack8(x0 + gv[bj][0] * acc[ai][bj][m][0], x1 + gv[bj][1] * acc[ai][bj][m][1]); } }
        }
    }
};
struct EpiGateUp {
    static constexpr bool PERM = true; static constexpr bool PRE = false;
    bf16_t* hid;
    __device__ __forceinline__ void operator()(AccRef acc, const Unit& u, int wr, int wc, int fr, int fq) const {
        const int r0 = wr * 64 + fr, col = u.pn * HALF + wc * 32 + 8 * fq;
#pragma unroll
        for (int ai = 0; ai < 2; ++ai)
#pragma unroll
            for (int m = 0; m < 4; ++m) { const int r = r0 + ai * HALF + m * 16;
                f32x4 g0 = acc[ai][0][m][0], g1 = acc[ai][0][m][1], u0 = acc[ai][1][m][0], u1 = acc[ai][1][m][1];
#pragma unroll
                for (int j = 0; j < 4; ++j) { g0[j] = g0[j] * fast_sigmoid(g0[j]) * u0[j]; g1[j] = g1[j] * fast_sigmoid(g1[j]) * u1[j]; }
                if (r < u.n) *(GAS u32x4*)(hid + (size_t)(u.x + r) * 512 + col) = pack8(g0, g1); }
    }
};
constexpr float YS_SCALE = 8.0f, YS_INV = 1.0f / 8.0f;
__device__ __forceinline__ unsigned pk_fp8x4(const f32x4& a) {
    int w = 0; w = __builtin_amdgcn_cvt_pk_fp8_f32(a[0], a[1], w, false); w = __builtin_amdgcn_cvt_pk_fp8_f32(a[2], a[3], w, true); return (unsigned)w; }
struct EpiDown {
    static constexpr bool PERM = true; static constexpr bool PRE = true;
    unsigned char* ys; const int* ldst; LAS int* dstl; int nostore;
    __device__ __forceinline__ void pre_issue(const Unit& u, int wr, int lane, int& v0, int& v1) const {
        const int ra = 64 * wr + lane, rb = ra + 128; const GAS int* p = (const GAS int*)ldst + (u.e == 64 ? 0 : u.e * 8192 + u.pm * BM);
        const GAS int* pa = p + ((u.e != 64 && ra < u.n) ? ra : 0); const GAS int* pb = p + ((u.e != 64 && rb < u.n) ? rb : 0);
        asm volatile("global_load_dword %0, %1, off" : "=v"(v0) : "v"(pa) : "memory");
        asm volatile("global_load_dword %0, %1, off" : "=v"(v1) : "v"(pb) : "memory");
    }
    __device__ __forceinline__ void pre_commit(int v0, int v1, int wid, int lane) const { dstl[wid * 128 + lane] = v0; dstl[wid * 128 + 64 + lane] = v1; }
    __device__ __forceinline__ void operator()(AccRef acc, const Unit& u, int wr, int wc, int fr, int fq) const {
        const int r0 = wr * 64 + fr, colb = u.pn * BM + 16 * (4 * wc + fq);
#pragma unroll
        for (int ai = 0; ai < 2; ++ai)
#pragma unroll
            for (int m = 0; m < 4; ++m) { const int r = r0 + ai * HALF + m * 16;
                const int dst = (u.e == 64) ? (u.pm * BM + r) * NSLOT + 8 : dstl[(wr * 4 + wc) * 128 + ai * 64 + m * 16 + fr];
                if (r < u.n && !nostore)
                    *(GAS u32x4*)(ys + (size_t)dst * D + colb) = (u32x4){pk_fp8x4(acc[ai][0][m][0] * YS_SCALE), pk_fp8x4(acc[ai][0][m][1] * YS_SCALE), pk_fp8x4(acc[ai][1][m][0] * YS_SCALE), pk_fp8x4(acc[ai][1][m][1] * YS_SCALE)}; }
    }
};
}

struct Args { const float* in[29]; float* out; unsigned char* ws; int ph_lo, ph_hi; };
enum { I_X = 0, I_C, I_WADA, I_BADA, I_NMIX, I_WIN, I_BIN, I_SINK, I_WO, I_ARE, I_AIM, I_LDT, I_BRE, I_BIM, I_CRE, I_CIM, I_SD, I_WGLU, I_WMIX, I_NFFN, I_WR, I_BR, I_WEG, I_WEU, I_WED, I_WSG, I_WSU, I_WSD, I_NFIN };

struct TDesc { const float* src; bf16_t* dst; int N, K, cc0; };
__device__ __forceinline__ void tr_load(const TDesc& d, int lane, f32x4 (&v)[16]) {
    const int kr = lane >> 4, nq = lane & 15;
    const GAS float* p = (const GAS float*)d.src + (size_t)kr * d.N + 4 * nq; const size_t step = (size_t)4 * d.N;
#pragma unroll
    for (int i = 0; i < 16; ++i) { v[i] = __builtin_nontemporal_load((const GAS f32x4*)p); p += step; }
}
__device__ __forceinline__ void tr_finish(const TDesc& d, int lane, LAS float* scr, const f32x4 (&v)[16]) {
    const int kr = lane >> 4, nq = lane & 15;
#pragma unroll
    for (int i = 0; i < 16; ++i) { const int k = 4 * i + kr;
#pragma unroll
        for (int e = 0; e < 4; ++e) scr[k * 64 + ((4 * nq + e) ^ k)] = v[i][e]; }
    LDS_WAIT();
    const int c = lane & 7;
#pragma unroll
    for (int j = 0; j < 8; ++j) { const int n = (lane >> 3) + 8 * j; float s[8];
#pragma unroll
        for (int i = 0; i < 8; ++i) { const int k = 8 * c + i; s[i] = scr[k * 64 + (n ^ k)]; }
        u32x4 o; o.x = cvt_pk_bf16(s[0], s[1]); o.y = cvt_pk_bf16(s[2], s[3]); o.z = cvt_pk_bf16(s[4], s[5]); o.w = cvt_pk_bf16(s[6], s[7]);
        const int cc = d.cc0 + n, drow = d.cc0 >= 0 ? (128 * ((cc & 15) >> 3) + 8 * (cc >> 4) + (cc & 7)) : n;
        __builtin_nontemporal_store(o, (GAS u32x4*)(d.dst + (size_t)drow * d.K + 8 * c)); }
    LDS_WAIT();
}
constexpr int IT_WIN = 3072, IT_WO = 512, IT_WGLU = 512, IT_WMIX = 1024, IT_EXP = 16384, IT_SH = 256;
constexpr int IT_LAYER = IT_WIN + IT_WO + IT_WGLU + IT_WMIX + 3 * IT_EXP + 3 * IT_SH;
constexpr int IT_MOD = 768;
constexpr int IT_TR = 2 * IT_LAYER;

__device__ __forceinline__ TDesc tr_desc(const float* W, int K, int N, bf16_t* WT, int kb, int nb, int drow0) {
    TDesc d; d.src = W + (size_t)(64 * kb) * N + 64 * nb; d.dst = WT + (size_t)drow0 * K + 64 * kb; d.N = N; d.K = K; d.cc0 = -1; return d;
}
__device__ __forceinline__ TDesc tr_decode(const Args& a, int it) {
    unsigned char* ws = a.ws;
    const int l = 1 - it / IT_LAYER; int r = it % IT_LAYER;
    if (r < IT_WIN) return tr_desc(a.in[I_WIN] + (size_t)l * 2048 * 6144, 2048, 6144, (bf16_t*)(ws + WS_WIN) + (size_t)l * 6144 * 2048, r / 96, r % 96, 64 * (r % 96));
    r -= IT_WIN;
    if (r < IT_WO) return tr_desc(a.in[I_WO] + (size_t)l * 1024 * 2048, 1024, 2048, (bf16_t*)(ws + WS_WO) + (size_t)l * 2048 * 1024, r / 32, r % 32, 64 * (r % 32));
    r -= IT_WO;
    if (r < IT_WGLU) { const int kb = r / 64, nb = r % 64, n0 = 64 * nb; const int drow = n0 < 2048 ? 256 * (n0 / 128) + (n0 % 128) : 256 * ((n0 - 2048) / 128) + 128 + (n0 % 128);
        return tr_desc(a.in[I_WGLU] + (size_t)l * 512 * 4096, 512, 4096, (bf16_t*)(ws + WS_WGLU) + (size_t)l * 4096 * 512, kb, nb, drow); }
    r -= IT_WGLU;
    if (r < IT_WMIX) return tr_desc(a.in[I_WMIX] + (size_t)l * 2048 * 2048, 2048, 2048, (bf16_t*)(ws + WS_WMIX) + (size_t)l * 2048 * 2048, r / 32, r % 32, 64 * (r % 32));
    r -= IT_WMIX;
    bf16_t* wgu = (bf16_t*)(ws + WS_WGU) + (size_t)l * 65 * 1024 * 2048; bf16_t* wd = (bf16_t*)(ws + WS_WD) + (size_t)l * 65 * 2048 * 512;
    if (r < 2 * IT_EXP) { const int up = r >= IT_EXP; r -= up * IT_EXP; const int e = r / 256, q = r % 256, kb = q / 8, nb = q % 8, n0 = 64 * nb;
        return tr_desc(a.in[up ? I_WEU : I_WEG] + ((size_t)l * 64 + e) * 2048 * 512, 2048, 512, wgu + (size_t)e * 1024 * 2048, kb, nb, 256 * (n0 / 128) + (n0 % 128) + 128 * up); }
    r -= 2 * IT_EXP;
    if (r < IT_EXP) { const int e = r / 256, q = r % 256, kb = q / 32, nb = q % 32;
        TDesc d = tr_desc(a.in[I_WED] + ((size_t)l * 64 + e) * 512 * 2048, 512, 2048, wd + (size_t)e * 2048 * 512, kb, nb, 256 * (nb / 4)); d.cc0 = 64 * (nb % 4); return d; }
    r -= IT_EXP;
    if (r < 2 * IT_SH) { const int up = r >= IT_SH; r -= up * IT_SH; const int kb = r / 8, nb = r % 8, n0 = 64 * nb;
        return tr_desc(a.in[up ? I_WSU : I_WSG] + (size_t)l * 2048 * 512, 2048, 512, wgu + (size_t)64 * 1024 * 2048, kb, nb, 256 * (n0 / 128) + (n0 % 128) + 128 * up); }
    r -= 2 * IT_SH;
    { const int kb = r / 32, nb = r % 32; TDesc d = tr_desc(a.in[I_WSD] + (size_t)l * 512 * 2048, 512, 2048, wd + (size_t)64 * 2048 * 512, kb, nb, 256 * (nb / 4)); d.cc0 = 64 * (nb % 4); return d; }
}
__device__ __forceinline__ void mod_item(const Args& a, int it, int tid, LAS unsigned char* lds) {
    const int lane = tid & 63, wave = tid >> 6;
    const int l = it / 384, r = it % 384, ks = r / 48, cc = r % 48;
    const float* W = a.in[I_WADA] + (size_t)l * 2048 * 12288 + (size_t)(256 * ks + 32 * wave) * 12288 + 256 * cc + 4 * lane;
    const float* c0 = a.in[I_C] + 256 * ks + 32 * wave, *c1 = c0 + 2048;
    f32x4 a0 = {0.f, 0.f, 0.f, 0.f}, a1 = {0.f, 0.f, 0.f, 0.f};
#pragma unroll 1
    for (int h = 0; h < 2; ++h) { f32x4 w[16]; const GAS float* wp = (const GAS float*)W + (size_t)(16 * h) * 12288;
#pragma unroll
        for (int i = 0; i < 16; ++i) { w[i] = __builtin_nontemporal_load((const GAS f32x4*)wp); wp += 12288; }
#pragma unroll
        for (int i = 0; i < 16; ++i) { const float x0 = c0[16 * h + i], x1 = c1[16 * h + i]; const float s0 = x0 * fast_sigmoid(x0), s1 = x1 * fast_sigmoid(x1); a0 += w[i] * s0; a1 += w[i] * s1; } }
    LAS f32x4* red = (LAS f32x4*)lds;
    red[(wave * 2 + 0) * 64 + lane] = a0; red[(wave * 2 + 1) * 64 + lane] = a1;
    __syncthreads();
    { const int b = tid >> 8, col = tid & 255; LAS float* rf = (LAS float*)lds; float s = 0.f;
#pragma unroll
        for (int w8 = 0; w8 < 8; ++w8) s += rf[((w8 * 2 + b) * 64) * 4 + col];
        ((float*)(a.ws + WS_MODP))[((size_t)(ks * 2 + l) * 2 + b) * 12288 + 256 * cc + col] = s; }
    __syncthreads();
}
__device__ __forceinline__ void p0_items(const Args& a, int gw, int ngw, LAS float* scr, int lane) {
#pragma unroll 1
    for (int it = gw; it < IT_TR; it += ngw) { f32x4 v[16]; const TDesc d = tr_decode(a, it); tr_load(d, lane, v); tr_finish(d, lane, scr, v); }
}

__device__ __forceinline__ void cpow(float are, float aim, float dt, int n, float& pr, float& pi) {
    const float mag = __builtin_amdgcn_exp2f((float)n * dt * are * LOG2E);
    const double turns = (double)n * ((double)dt * (double)aim * 0.15915494309189535);
    const float fr = (float)(turns - __builtin_rint(turns));
    pr = mag * __builtin_amdgcn_cosf(fr); pi = mag * __builtin_amdgcn_sinf(fr);
}
__device__ __forceinline__ void ssm_tables(const Args& a, int l, int g, LAS unsigned char* lds, int tid) {
    LAS f32x2* Apow = (LAS f32x2*)lds;
    LAS f32x2* Bb = (LAS f32x2*)(lds + 65 * 64 * 8);
    LAS f32x2* Cc = (LAS f32x2*)(lds + 65 * 64 * 8 + 64 * 16 * 8);
    const int lg = l * 32 + g;
    const float* are_p = a.in[I_ARE] + lg * 64; const float* aim_p = a.in[I_AIM] + lg * 64;
    const float dt = __expf(a.in[I_LDT][lg]);
    unsigned char* tb = a.ws + WS_SSM + (size_t)lg * SSM_STRIDE;
    bf16_t* Et = (bf16_t*)(tb + SSM_E); bf16_t* Ft = (bf16_t*)(tb + SSM_F); bf16_t* Kt = (bf16_t*)(tb + SSM_KT); GAS f32x2* Pt = (GAS f32x2*)(tb + SSM_P);
    for (int idx = tid; idx < 65 * 64; idx += 512) { const int n = idx >> 6, p = idx & 63; float pr, pi; cpow(are_p[p], aim_p[p], dt, n, pr, pi); Apow[idx] = (f32x2){pr, pi}; }
    for (int idx = tid; idx < 64 * 64; idx += 512) { const int m = idx >> 6, p = idx & 63; float pr, pi; cpow(are_p[p], aim_p[p], dt, 64 * m, pr, pi); Pt[idx] = (f32x2){pr, pi}; }
    for (int idx = tid; idx < 64 * 16; idx += 512) { const int p = idx >> 4, c = idx & 15;
        const float ar = are_p[p], ai = aim_p[p]; float br, bi; cpow(ar, ai, dt, 1, br, bi);
        const float nr = br - 1.0f, ni = bi, den = ar * ar + ai * ai; const float fr = (nr * ar + ni * ai) / den, fi = (ni * ar - nr * ai) / den;
        const float b_r = a.in[I_BRE][(size_t)lg * 1024 + idx], b_i = a.in[I_BIM][(size_t)lg * 1024 + idx];
        Bb[idx] = (f32x2){fr * b_r - fi * b_i, fr * b_i + fi * b_r}; }
    for (int idx = tid; idx < 16 * 64; idx += 512) Cc[idx] = (f32x2){a.in[I_CRE][(size_t)lg * 1024 + idx], a.in[I_CIM][(size_t)lg * 1024 + idx]};
    __syncthreads();
    for (int idx = tid; idx < 128 * 128; idx += 512) { const int n = idx >> 7, k8 = idx & 127, ri = n >> 6, p = n & 63, s = k8 >> 1, c0 = (k8 & 1) * 8;
        const f32x2 ap = Apow[(63 - s) * 64 + p]; float v[8];
#pragma unroll
        for (int j = 0; j < 8; ++j) { const f32x2 b = Bb[p * 16 + c0 + j]; v[j] = ri ? (ap.x * b.y + ap.y * b.x) : (ap.x * b.x - ap.y * b.y); }
        u32x4 o; o.x = cvt_pk_bf16(v[0], v[1]); o.y = cvt_pk_bf16(v[2], v[3]); o.z = cvt_pk_bf16(v[4], v[5]); o.w = cvt_pk_bf16(v[6], v[7]);
        *(GAS u32x4*)(Et + (size_t)n * 1024 + k8 * 8) = o; }
    for (int idx = tid; idx < 1024 * 16; idx += 512) { const int n = idx >> 4, k8 = idx & 15, t = n >> 4, c = n & 15, ri = k8 >> 3, p0 = (k8 & 7) * 8; float v[8];
#pragma unroll
        for (int j = 0; j < 8; ++j) { const f32x2 ap = Apow[(t + 1) * 64 + p0 + j], cc = Cc[c * 64 + p0 + j]; v[j] = ri ? -(cc.x * ap.y + cc.y * ap.x) : (cc.x * ap.x - cc.y * ap.y); }
        u32x4 o; o.x = cvt_pk_bf16(v[0], v[1]); o.y = cvt_pk_bf16(v[2], v[3]); o.z = cvt_pk_bf16(v[4], v[5]); o.w = cvt_pk_bf16(v[6], v[7]);
        *(GAS u32x4*)(Ft + (size_t)n * 128 + k8 * 8) = o; }
    for (int idx = tid; idx < 65 * 16 * 2; idx += 512) { const int t1 = idx >> 5, c = (idx >> 1) & 15, c0 = (idx & 1) * 8; float v[8];
#pragma unroll
        for (int j = 0; j < 8; ++j) v[j] = 0.f;
        if (t1 > 0) for (int p = 0; p < 64; ++p) { const f32x2 ap = Apow[(t1 - 1) * 64 + p], cc = Cc[c * 64 + p]; const float cr = cc.x * ap.x - cc.y * ap.y, ci = cc.x * ap.y + cc.y * ap.x;
#pragma unroll
            for (int j = 0; j < 8; ++j) { const f32x2 b = Bb[p * 16 + c0 + j]; v[j] += cr * b.x - ci * b.y; } }
        u32x4 o; o.x = cvt_pk_bf16(v[0], v[1]); o.y = cvt_pk_bf16(v[2], v[3]); o.z = cvt_pk_bf16(v[4], v[5]); o.w = cvt_pk_bf16(v[6], v[7]);
        *(GAS u32x4*)(Kt + (size_t)(t1 * 16 + c) * 16 + c0) = o; }
    __syncthreads();
}

__device__ __forceinline__ void attn_unit(const bf16_t* __restrict__ proj, bf16_t* __restrict__ attn, const float* sinks, int unit, LAS unsigned char* lds, int tid_) {
    const int tid = opaque(tid_);
    const int b = unit >> 7, hk = (unit >> 5) & 3, nb = unit & 31;
    const int wave = __builtin_amdgcn_readfirstlane(tid >> 6), lane = tid & 63, r16 = lane & 15, q4 = lane >> 4;
    LAS unsigned char* Kl = lds;
    LAS unsigned char* Vt = lds + 36864;
    const int gh0 = wave >> 1, half0 = wave & 1, qh0 = hk * 4 + gh0;
    bf16x8 qfa[4][2];
#pragma unroll
    for (int pass = 0; pass < 4; ++pass)
#pragma unroll
        for (int s = 0; s < 2; ++s) qfa[pass][s] = *(const GAS bf16x8*)(proj + (size_t)(b * SEQ + nb * 128 + 16 * (half0 * 4 + pass) + r16) * INW + O_Q + qh0 * 64 + 32 * s + 8 * q4);
#pragma unroll
    for (int i = 0; i < 4; ++i) { const int id = tid + 512 * i, key = id >> 3, ch = id & 7; const int tp = nb * 128 - 128 + key;
        u32x4 kv = {0u, 0u, 0u, 0u}, vv = {0u, 0u, 0u, 0u};
        if (tp >= 0) { const bf16_t* src = proj + (size_t)(b * SEQ + tp) * INW + hk * 64 + ch * 8; kv = *(const GAS u32x4*)(src + O_K); vv = *(const GAS u32x4*)(src + O_V); }
        *(LAS u32x4*)(Kl + key * 144 + ch * 16) = kv;
        LAS bf16_t* vd = (LAS bf16_t*)(Vt + (ch * 8) * 528 + key * 2);
        vd[0 * 264] = (bf16_t)(vv.x & 0xffff); vd[1 * 264] = (bf16_t)(vv.x >> 16); vd[2 * 264] = (bf16_t)(vv.y & 0xffff); vd[3 * 264] = (bf16_t)(vv.y >> 16);
        vd[4 * 264] = (bf16_t)(vv.z & 0xffff); vd[5 * 264] = (bf16_t)(vv.z >> 16); vd[6 * 264] = (bf16_t)(vv.w & 0xffff); vd[7 * 264] = (bf16_t)(vv.w >> 16); }
    __syncthreads();
    const int gh = wave >> 1, half = wave & 1, qh = hk * 4 + gh;
    const float sink = sinks[qh] * LOG2E;
#pragma unroll
    for (int pass = 0; pass < 4; ++pass) {
        const int kt0 = half * 4 + pass, i0 = 16 * kt0, iabs = i0 + r16; const size_t qtok = (size_t)(b * SEQ + nb * 128 + iabs);
        bf16x8 qf[2];
#pragma unroll
        for (int s = 0; s < 2; ++s) qf[s] = qfa[pass][s];
        __builtin_amdgcn_sched_barrier(0);
        f32x4 st[10];
        const LAS unsigned char* kbase = Kl + (16 * kt0 + r16) * 144 + (8 * q4) * 2;
#pragma unroll
        for (int i = 0; i < 9; ++i) { st[i] = (f32x4){0.f, 0.f, 0.f, 0.f};
#pragma unroll
            for (int s = 0; s < 2; ++s) { const bf16x8 kf = *(const LAS bf16x8*)(kbase + i * 16 * 144 + s * 64);
                st[i] = __builtin_amdgcn_mfma_f32_16x16x32_bf16(kf, qf[s], st[i], 0, 0, 0); } }
        st[9] = (f32x4){0.f, 0.f, 0.f, 0.f};
        float mx = sink;
#pragma unroll
        for (int i = 0; i < 9; ++i)
#pragma unroll
            for (int r = 0; r < 4; ++r) { const int jj = 16 * i + 4 * q4 + r; const bool ok = (jj > r16) && (jj <= r16 + 128) && (nb > 0 || jj + i0 >= 128);
                st[i][r] = ok ? st[i][r] : -1e30f; mx = fmaxf(mx, st[i][r]); }
        mx = fmaxf(mx, __shfl_xor(mx, 16)); mx = fmaxf(mx, __shfl_xor(mx, 32));
        float sum = 0.f;
#pragma unroll
        for (int i = 0; i < 9; ++i)
#pragma unroll
            for (int r = 0; r < 4; ++r) { const float p = __builtin_amdgcn_exp2f(st[i][r] - mx); st[i][r] = p; sum += p; }
        sum += __shfl_xor(sum, 16); sum += __shfl_xor(sum, 32);
        const float inv = __builtin_amdgcn_rcpf(sum + __builtin_amdgcn_exp2f(sink - mx));
        f32x4 ot[4];
#pragma unroll
        for (int dt = 0; dt < 4; ++dt) ot[dt] = (f32x4){0.f, 0.f, 0.f, 0.f};
#pragma unroll
        for (int kk = 0; kk < 5; ++kk) {
            u32x4 pw; pw.x = cvt_pk_bf16(st[2 * kk][0], st[2 * kk][1]); pw.y = cvt_pk_bf16(st[2 * kk][2], st[2 * kk][3]); pw.z = cvt_pk_bf16(st[2 * kk + 1][0], st[2 * kk + 1][1]); pw.w = cvt_pk_bf16(st[2 * kk + 1][2], st[2 * kk + 1][3]);
            const bf16x8 pf = __builtin_bit_cast(bf16x8, pw);
            const int t0 = kt0 + 2 * kk, t1 = (t0 + 1) < 15 ? (t0 + 1) : 15;
#pragma unroll
            for (int dt = 0; dt < 4; ++dt) { const LAS unsigned char* vp = Vt + (16 * dt + r16) * 528 + (4 * q4) * 2;
                const u32x2 lo = *(const LAS u32x2*)(vp + t0 * 32), hi = *(const LAS u32x2*)(vp + t1 * 32);
                const u32x4 vw = {lo.x, lo.y, hi.x, hi.y};
                ot[dt] = __builtin_amdgcn_mfma_f32_16x16x32_bf16(__builtin_bit_cast(bf16x8, vw), pf, ot[dt], 0, 0, 0); } }
#pragma unroll
        for (int dt = 0; dt < 4; ++dt) { u32x2 o; o.x = cvt_pk_bf16(ot[dt][0] * inv, ot[dt][1] * inv); o.y = cvt_pk_bf16(ot[dt][2] * inv, ot[dt][3] * inv);
            *(GAS u32x2*)(attn + qtok * 1024 + qh * 64 + 16 * dt + 4 * q4) = o; }
    }
    __syncthreads();
}

constexpr int UPITCH = 2064;
__device__ __forceinline__ void stage_u_issue(const bf16_t* __restrict__ proj, int g, int b, int q, int tid, u32x4 (&uu)[4]) {
#pragma unroll
    for (int i = 0; i < 4; ++i) { const int id = tid + 512 * i, tl = id >> 1, half = id & 1, chunk = tl >> 6, s = tl & 63;
        uu[i] = *(const GAS u32x4*)(proj + (size_t)(b * SEQ + (16 * q + chunk) * 64 + s) * INW + O_U + g * 16 + 8 * half); }
}
__device__ __forceinline__ void stage_u_commit(LAS unsigned char* Al, int tid, u32x4 (&uu)[4]) {
    asm volatile("" : "+v"(uu[0]), "+v"(uu[1]), "+v"(uu[2]), "+v"(uu[3]) :: "memory");
#pragma unroll
    for (int i = 0; i < 4; ++i) { const int id = tid + 512 * i, tl = id >> 1, half = id & 1, chunk = tl >> 6, s = tl & 63;
        *(LAS u32x4*)(Al + chunk * UPITCH + (s * 16 + 8 * half) * 2) = uu[i]; }
}
__device__ __forceinline__ void ssm_s1_unit(const bf16_t* __restrict__ proj, const bf16_t* __restrict__ Et, float* __restrict__ sloc, int g, int b, int q, LAS unsigned char* lds, int tid_) {
    const int tid = opaque(tid_);
    const int wave = __builtin_amdgcn_readfirstlane(tid >> 6), lane = tid & 63, r16 = lane & 15, q4 = lane >> 4;
    const bf16_t* eb = Et + (size_t)(16 * wave + r16) * 1024 + 8 * q4;
    u32x4 uu[4]; stage_u_issue(proj, g, b, q, tid, uu);
    bf16x8 bf[32];
#pragma unroll
    for (int ks = 0; ks < 32; ++ks) bf[ks] = *(const GAS bf16x8*)(eb + 32 * ks);
    stage_u_commit(lds, tid, uu);
    __syncthreads();
    f32x4 acc = {0.f, 0.f, 0.f, 0.f};
#pragma unroll
    for (int ks = 0; ks < 32; ++ks) { const bf16x8 af = *(const LAS bf16x8*)(lds + r16 * UPITCH + (32 * ks + 8 * q4) * 2);
        acc = __builtin_amdgcn_mfma_f32_16x16x32_bf16(af, bf[ks], acc, 0, 0, 0); }
#pragma unroll
    for (int r = 0; r < 4; ++r) sloc[((size_t)(b * 64 + 16 * q + 4 * q4 + r) * 32 + g) * 128 + 16 * wave + r16] = acc[r];
    __syncthreads();
}

__device__ __forceinline__ void ssm_s2_unit(const bf16_t* __restrict__ proj, const unsigned char* __restrict__ tb, const float* __restrict__ sloc, const float* __restrict__ dskip, bf16_t* __restrict__ ybuf,
                                            int g, int b, int q, LAS unsigned char* lds, int tid_) {
    const int tid = opaque(tid_);
    const int wave = __builtin_amdgcn_readfirstlane(tid >> 6), lane = tid & 63, r16 = lane & 15, q4 = lane >> 4;
    LAS unsigned char* Ktl = lds;
    LAS bf16_t* x0l = (LAS bf16_t*)(lds + 33280);
    LAS unsigned char* Al = lds + 49152;
    const bf16_t* Ft = (const bf16_t*)(tb + SSM_F); const GAS f32x2* Pt = (const GAS f32x2*)(tb + SSM_P);
    const int p = tid & 63, part = tid >> 6, j0 = 16 * q;
    f32x2 Pp[6]; float srp[6], sip[6];
#pragma unroll
    for (int ii = 0; ii < 6; ++ii) { const int i = part + 8 * ii; const bool ok = i < j0; const int ic = ok ? i : 0, pc = ok ? (j0 - 1 - i) : 0;
        Pp[ii] = Pt[pc * 64 + p]; const GAS float* sp = (const GAS float*)(sloc + ((size_t)(b * 64 + ic) * 32 + g) * 128); srp[ii] = sp[p]; sip[ii] = sp[64 + p]; }
    u32x4 kt[5];
    { const GAS u32x4* src = (const GAS u32x4*)(tb + SSM_KT);
#pragma unroll
      for (int j = 0; j < 5; ++j) { const int i = tid + 512 * j; kt[j] = src[i < 33280 / 16 ? i : 33280 / 16 - 1]; } }
    u32x4 uu[4]; stage_u_issue(proj, g, b, q, tid, uu);
    const f32x2 A64 = Pt[64 + p];
    float sr[15], si[15];
#pragma unroll
    for (int jq = 0; jq < 15; ++jq) { const GAS float* sp = (const GAS float*)(sloc + ((size_t)(b * 64 + j0 + jq) * 32 + g) * 128); sr[jq] = sp[p]; si[jq] = sp[64 + p]; }
    bf16x8 ff[4][8];
#pragma unroll
    for (int k2 = 0; k2 < 4; ++k2)
#pragma unroll
        for (int tt = 0; tt < 8; ++tt) ff[k2][tt] = *(const GAS bf16x8*)(Ft + (size_t)((wave + 8 * tt) * 16 + r16) * 128 + 32 * k2 + 8 * q4);
    {
        LAS f32x2* red = (LAS f32x2*)(lds + 40960);
        asm volatile("" : "+v"(Pp[0]), "+v"(Pp[1]), "+v"(Pp[2]), "+v"(Pp[3]), "+v"(Pp[4]), "+v"(Pp[5]) :: "memory");
        asm volatile("" : "+v"(srp[0]), "+v"(srp[1]), "+v"(srp[2]), "+v"(srp[3]), "+v"(srp[4]), "+v"(srp[5]), "+v"(sip[0]), "+v"(sip[1]), "+v"(sip[2]), "+v"(sip[3]), "+v"(sip[4]), "+v"(sip[5]) :: "memory");
        float xr = 0.f, xi = 0.f;
#pragma unroll
        for (int ii = 0; ii < 6; ++ii) { const bool ok = part + 8 * ii < j0; const float pr = ok ? Pp[ii].x : 0.f, pi = ok ? Pp[ii].y : 0.f;
            xr += pr * srp[ii] - pi * sip[ii]; xi += pr * sip[ii] + pi * srp[ii]; }
        red[part * 64 + p] = (f32x2){xr, xi};
        asm volatile("" : "+v"(kt[0]), "+v"(kt[1]), "+v"(kt[2]), "+v"(kt[3]), "+v"(kt[4]) :: "memory");
#pragma unroll
        for (int j = 0; j < 5; ++j) { const int i = tid + 512 * j; if (i < 33280 / 16) *(LAS u32x4*)(Ktl + i * 16) = kt[j]; }
        stage_u_commit(Al, tid, uu);
        __syncthreads();
        if (part == 0) {
            float ar = 0.f, ai = 0.f;
#pragma unroll
            for (int w8 = 0; w8 < 8; ++w8) { const f32x2 t = red[w8 * 64 + p]; ar += t.x; ai += t.y; }
#pragma unroll
            for (int jq = 0; jq < 16; ++jq) {
                x0l[jq * 136 + p] = (bf16_t)(cvt_pk_bf16(ar, 0.f) & 0xffff); x0l[jq * 136 + 64 + p] = (bf16_t)(cvt_pk_bf16(ai, 0.f) & 0xffff);
                if (jq < 15) { const float nr = A64.x * ar - A64.y * ai + sr[jq], ni = A64.x * ai + A64.y * ar + si[jq]; ar = nr; ai = ni; } }
        }
    }
    __syncthreads();
    f32x4 acc[8];
#pragma unroll
    for (int tt = 0; tt < 8; ++tt) acc[tt] = (f32x4){0.f, 0.f, 0.f, 0.f};
#pragma unroll 2
    for (int ks = 0; ks < 32; ++ks) { const int s = 2 * ks + (q4 >> 1);
        const bf16x8 af = *(const LAS bf16x8*)(Al + r16 * UPITCH + (32 * ks + 8 * q4) * 2);
#pragma unroll
        for (int tt = 0; tt < 8; ++tt) { const int t = wave + 8 * tt;
            const int tau1 = t - s + 1, tc = tau1 > 0 ? tau1 : 0;
            const bf16x8 bf = *(const LAS bf16x8*)(Ktl + ((tc * 16 + r16) * 16 + 8 * (q4 & 1)) * 2);
            acc[tt] = __builtin_amdgcn_mfma_f32_16x16x32_bf16(af, bf, acc[tt], 0, 0, 0); }
        __builtin_amdgcn_sched_barrier(0); }
#pragma unroll
    for (int k2 = 0; k2 < 4; ++k2) { const bf16x8 ax = *(const LAS bf16x8*)(x0l + r16 * 136 + 32 * k2 + 8 * q4);
#pragma unroll
        for (int tt = 0; tt < 8; ++tt) acc[tt] = __builtin_amdgcn_mfma_f32_16x16x32_bf16(ax, ff[k2][tt], acc[tt], 0, 0, 0); }
    const float dsk = dskip[g * 16 + r16];
#pragma unroll
    for (int tt = 0; tt < 8; ++tt) { const int t = wave + 8 * tt;
#pragma unroll
        for (int r = 0; r < 4; ++r) { const int jq = 4 * q4 + r; const size_t tok = (size_t)(b * SEQ + (16 * q + jq) * 64 + t);
            const float uv = bf1(*(const LAS bf16_t*)(Al + jq * UPITCH + (t * 16 + r16) * 2)); const float y = acc[tt][r] + dsk * uv;
            const float z = 0.7978845608028654f * (y + 0.044715f * y * y * y); const float gl = y * fast_sigmoid(2.0f * z);
            ybuf[tok * 512 + g * 16 + r16] = (bf16_t)(cvt_pk_bf16(gl, 0.f) & 0xffff); } }
    __syncthreads();
}

__device__ __forceinline__ unsigned char* opaque_p(unsigned char* p) { asm volatile("" : "+s"(p)); return p; }
#define PH_BEGIN const int tid = opaque((int)threadIdx.x), lane = tid & 63, wave = __builtin_amdgcn_readfirstlane(tid >> 6); unsigned char* const ws = opaque_p(args.ws); (void)lane; (void)wave; \
    bf16_t* const hbuf = (bf16_t*)(ws + WS_H); bf16_t* const proj = (bf16_t*)(ws + WS_PROJ); float* const mod = (float*)(ws + WS_MOD); float* const xbuf = args.out; unsigned* const ctl = (unsigned*)(ws + WS_CTL); \
    (void)hbuf; (void)proj; (void)mod; (void)xbuf; (void)ctl;

__global__ void __launch_bounds__(NWAVES * 64, 2) mega_fwd(Args args) {
    extern __shared__ __attribute__((aligned(16))) unsigned char lds_raw[];
    LAS unsigned char* lds = (LAS unsigned char*)lds_raw;
    const int G = gridDim.x, blk = blockIdx.x;
    XcdBarrier bar;
    {
        volatile LAS unsigned* MISC = (volatile LAS unsigned*)(lds + MISC_OFF);
        unsigned* ctl0 = (unsigned*)(args.ws + WS_CTL);
        for (int u = threadIdx.x; u < (LDS_BYTES - LDSCTL_OFF) / 4; u += NWAVES * 64) ((LAS unsigned*)(lds + LDSCTL_OFF))[u] = 0u;
        __syncthreads();
        bar.bar = ctl0 + CW_BAR; bar.x = 0; bar.st = nullptr;
        if (N_LAUNCHES == 1) bar = xcd_barrier_post(ctl0 + CW_BAR, MISC + 8);
    }
#define GRID_BAR() do { if (N_LAUNCHES == 1) xcd_barrier(bar); } while (0)
    const int lo = args.ph_lo, hi = args.ph_hi;
#ifndef PH_MASK
#define PH_MASK 0x7ff
#endif
#ifndef REP_MASK
#define REP_MASK 0
#endif
#ifndef REP_VARIANT
#define REP_VARIANT 0
#endif
#define REPS(bit) (((REP_MASK) >> (bit)) & 1 ? 2 : 1)
#define IN(k) (lo <= (k) && (k) < hi)
#define BOTH(k) (IN(k) && IN((k) + 1))

    if ((PH_MASK & 1) && IN(0)) {
        PH_BEGIN
            _Pragma("unroll 1") for (int rep = 0; rep < REPS(9); ++rep) {
        if (blk < 64) ssm_tables(args, blk >> 5, blk & 31, lds, tid);
        LAS float* scr = (LAS float*)(lds + wave * 16384);
        for (int idx = blk * 512 + tid; idx < 2 * 64 * 256; idx += G * 512) {
            const int e = idx & 63, kc = (idx >> 6) & 255, l = idx >> 14; const float* wsrc = args.in[I_WR] + (size_t)l * D * NE + (size_t)(8 * kc) * NE + e;
            float w[8], lo[8]; unsigned hi[4];
#pragma unroll
            for (int i = 0; i < 8; ++i) w[i] = wsrc[i * NE];
#pragma unroll
            for (int i = 0; i < 4; ++i) { hi[i] = cvt_pk_bf16(w[2 * i], w[2 * i + 1]); lo[2 * i] = w[2 * i] - bf_lo(hi[i]); lo[2 * i + 1] = w[2 * i + 1] - bf_hi(hi[i]); }
            bf16_t* dsth = (bf16_t*)(ws + WS_WRT) + ((size_t)(l * 2) * 64 + e) * 2048 + 8 * kc;
            *(GAS u32x4*)dsth = (u32x4){hi[0], hi[1], hi[2], hi[3]};
            *(GAS u32x4*)(dsth + 64 * 2048) = (u32x4){cvt_pk_bf16(lo[0], lo[1]), cvt_pk_bf16(lo[2], lo[3]), cvt_pk_bf16(lo[4], lo[5]), cvt_pk_bf16(lo[6], lo[7])}; }
        for (int it = blk; it < IT_MOD; it += G) mod_item(args, it, tid, lds);
        p0_items(args, blk * NWAVES + wave, G * NWAVES, scr, lane);
            if (rep + 1 < REPS(9)) GRID_BAR(); }
        if (BOTH(0)) GRID_BAR();
    }
    if ((PH_MASK & 2) && IN(1)) {
        PH_BEGIN
        const float* modp = (const float*)(ws + WS_MODP);
        for (int idx = blk * 512 + tid; idx < 2 * 2 * 12288; idx += G * 512) { const int l = idx / 24576, c = idx % 12288; float s = args.in[I_BADA][l * 12288 + c];
#pragma unroll
            for (int ks = 0; ks < 8; ++ks) s += modp[(size_t)ks * 49152 + idx];
            mod[idx] = s; }
        for (int rb = blk; rb < T / 32; rb += G) {
            const int bb = (rb * 32) / SEQ;
            LAS float* shl = (LAS float*)lds; LAS float* scl = shl + 2048;
            for (int c = tid; c < 4096; c += 512) { float s = args.in[I_BADA][c];
#pragma unroll
                for (int ks = 0; ks < 8; ++ks) s += modp[(size_t)ks * 49152 + bb * 12288 + c];
                shl[c] = s; }
            __syncthreads();
#pragma unroll 1
            for (int pr = 0; pr < 2; ++pr) {
                f32x4 v[2][4][2]; float ss[2] = {0.f, 0.f};
#pragma unroll
                for (int rr = 0; rr < 2; ++rr) { const float* xr = args.in[I_X] + (size_t)(rb * 32 + wave * 4 + pr * 2 + rr) * D;
#pragma unroll
                    for (int j = 0; j < 4; ++j)
#pragma unroll
                        for (int h = 0; h < 2; ++h) v[rr][j][h] = *(const GAS f32x4*)(xr + 8 * (lane + 64 * j) + 4 * h); }
#pragma unroll
                for (int rr = 0; rr < 2; ++rr)
#pragma unroll
                    for (int j = 0; j < 4; ++j)
#pragma unroll
                        for (int h = 0; h < 2; ++h) ss[rr] += v[rr][j][h][0] * v[rr][j][h][0] + v[rr][j][h][1] * v[rr][j][h][1] + v[rr][j][h][2] * v[rr][j][h][2] + v[rr][j][h][3] * v[rr][j][h][3];
#pragma unroll
                for (int rr = 0; rr < 2; ++rr) { const int row = rb * 32 + wave * 4 + pr * 2 + rr;
                    const float rstd = 1.0f / sqrtf(wave_sum(ss[rr]) * (1.0f / D) + NORM_EPS);
                    bf16_t* hrow = hbuf + (size_t)row * D;
#pragma unroll
                    for (int j = 0; j < 4; ++j) { const int c = 8 * (lane + 64 * j); f32x4 o[2];
#pragma unroll
                        for (int h = 0; h < 2; ++h) { const f32x4 g = *(const GAS f32x4*)(args.in[I_NMIX] + c + 4 * h); const f32x4 s1 = *(const LAS f32x4*)(scl + c + 4 * h), s0 = *(const LAS f32x4*)(shl + c + 4 * h);
                            o[h] = v[rr][j][h] * rstd * g * (s1 + 1.0f) + s0; }
                        *(GAS u32x4*)(hrow + c) = pg8::pack8(o[0], o[1]); } } }
            __syncthreads();
        }
        if (BOTH(1)) GRID_BAR();
    }

#pragma unroll 1
    for (int l = 0; l < DEPTH; ++l) {
        const int pb = 2 + 9 * l;
        if ((PH_MASK & 4) && IN(pb + 0)) {
            PH_BEGIN
            _Pragma("unroll 1") for (int rep = 0; rep < REPS(0); ++rep) {
            pg8::DenseOrder S; S.init(T, INW, D, G, blk, (bf16_t*)(ws + WS_WIN) + (size_t)l * INW * D);
            pg8::EpiInProj E{proj, args.in[I_BIN] + l * INW, 0.125f * LOG2E, (REP_VARIANT && rep == 1) ? 1 : 0};
            pg8::gemm_phase<pg8::EpiInProj, pg8::DenseOrder, GEMM_ALIGN>(lds, (const char*)hbuf, D, S, E);
            if (rep + 1 < REPS(0)) GRID_BAR(); }
            if (BOTH(pb + 0)) GRID_BAR();
        }
        if ((PH_MASK & 8) && IN(pb + 1)) {
            PH_BEGIN
            _Pragma("unroll 1") for (int rep = 0; rep < REPS(1); ++rep) {
            for (int u = blk; u < 256; u += G) attn_unit(proj, (bf16_t*)(ws + WS_ATTN), args.in[I_SINK] + l * 16, u, lds, tid);
            if (!(REP_VARIANT == 1 && rep == 1)) for (int u = blk; u < 256; u += G) { const int g = u >> 3, b = (u >> 2) & 1, q = u & 3;
                ssm_s1_unit(proj, (const bf16_t*)(ws + WS_SSM + (size_t)(l * 32 + g) * SSM_STRIDE + SSM_E), (float*)(ws + WS_SLOC), g, b, q, lds, tid); }
            if (rep + 1 < REPS(1)) GRID_BAR(); }
            if (BOTH(pb + 1)) GRID_BAR();
        }
        if ((PH_MASK & 16) && IN(pb + 2)) {
            PH_BEGIN
            _Pragma("unroll 1") for (int rep = 0; rep < REPS(2); ++rep) {
            if (!(REP_VARIANT == 1 && rep == 1)) for (int u = blk; u < 256; u += G) { const int g = u >> 3, b = (u >> 2) & 1, q = u & 3;
                ssm_s2_unit(proj, ws + WS_SSM + (size_t)(l * 32 + g) * SSM_STRIDE, (const float*)(ws + WS_SLOC), args.in[I_SD] + l * 512, (bf16_t*)(ws + WS_Y), g, b, q, lds, tid); }
            pg8::DenseOrder S; S.init(T, D, 1024, G, blk, (bf16_t*)(ws + WS_WO) + (size_t)l * D * 1024);
            pg8::EpiAttnProj E{proj, (bf16_t*)(ws + WS_MIXED)};
            pg8::gemm_phase<pg8::EpiAttnProj, pg8::DenseOrder>(lds, (const char*)(ws + WS_ATTN), 1024, S, E);
            if (rep + 1 < REPS(2)) GRID_BAR(); }
            if (BOTH(pb + 2)) GRID_BAR();
        }
        if ((PH_MASK & 32) && IN(pb + 3)) {
            PH_BEGIN
            const int nrep = REPS(3);
            _Pragma("unroll 1") for (int rep = 0; rep < nrep; ++rep) {
            pg8::DenseOrder S; S.init(T, 4096, 512, G, blk, (bf16_t*)(ws + WS_WGLU) + (size_t)l * 4096 * 512);
            pg8::EpiGlu E{proj, (const bf16_t*)(ws + WS_MIXED), (bf16_t*)(ws + WS_MIXED2)};
            pg8::gemm_phase<pg8::EpiGlu, pg8::DenseOrder, GEMM_ALIGN>(lds, (const char*)(ws + WS_Y), 512, S, E);
            if (rep + 1 < nrep) GRID_BAR(); }
            if (BOTH(pb + 3)) GRID_BAR();
        }
        if ((PH_MASK & 64) && IN(pb + 4)) {
            PH_BEGIN
            const int nrep = (l == 0 ? REPS(4) : 1);
            _Pragma("unroll 1") for (int rep = 0; rep < nrep; ++rep) {
            pg8::DenseOrder S; S.init(T, D, D, G, blk, (bf16_t*)(ws + WS_WMIX) + (size_t)l * D * D);
            pg8::EpiMixOut E{l == 0 ? args.in[I_X] : (const float*)nullptr, (const bf16_t*)(ws + WS_XB), (bf16_t*)(ws + WS_XB), mod + (size_t)l * 2 * 12288 + 2 * 2048};
            pg8::gemm_phase<pg8::EpiMixOut, pg8::DenseOrder>(lds, (const char*)(ws + WS_MIXED2), D, S, E);
            if (rep + 1 < nrep) GRID_BAR(); }
            if (BOTH(pb + 4)) GRID_BAR();
        }
        if ((PH_MASK & 128) && IN(pb + 5)) {
            PH_BEGIN
            const int nrep = REPS(5);
            _Pragma("unroll 1") for (int rep = 0; rep < nrep; ++rep) {
            const float* modl = mod + (size_t)l * 2 * 12288;
            int* ltok = (int*)(ws + WS_LTOK); int* ldst = (int*)(ws + WS_LDST); float* lw = (float*)(ws + WS_LW);
            LAS unsigned long long* selmask = (LAS unsigned long long*)(lds + SEL_OFF);
            LAS float* selw = (LAS float*)(lds + SEL_OFF + 256);
            const float* wrt = args.in[I_WR] + (size_t)l * D * NE; const float brt = args.in[I_BR][l * NE + lane];
            for (int rb = blk; rb < T / 32; rb += G) {
                const int bb = (rb * 32) / SEQ; const float* sh2 = modl + bb * 12288 + 3 * 2048; const float* sc2 = sh2 + 2048;
#pragma unroll 1
                for (int it = 0; it < 2; ++it) {
                    {
                        f32x4 v[2][4][2]; float ss[2] = {0.f, 0.f};
                        u32x4 xw[2][4]; f32x4 gsc[4][2], gsh[4][2], sc1[4][2];
#pragma unroll
                        for (int rr = 0; rr < 2; ++rr) { const bf16_t* xr = (const bf16_t*)(ws + WS_XB) + (size_t)(rb * 32 + it * 16 + 2 * wave + rr) * D;
#pragma unroll
                            for (int j = 0; j < 4; ++j) xw[rr][j] = *(const GAS u32x4*)(xr + 8 * (lane + 64 * j)); }
#pragma unroll
                        for (int j = 0; j < 4; ++j)
#pragma unroll
                            for (int h = 0; h < 2; ++h) { const int c = 8 * (lane + 64 * j) + 4 * h;
                                gsc[j][h] = *(const GAS f32x4*)(args.in[I_NFFN] + l * D + c); sc1[j][h] = *(const GAS f32x4*)(sc2 + c); gsh[j][h] = *(const GAS f32x4*)(sh2 + c); }
#pragma unroll
                        for (int rr = 0; rr < 2; ++rr) asm volatile("" : "+v"(xw[rr][0]), "+v"(xw[rr][1]), "+v"(xw[rr][2]), "+v"(xw[rr][3]) :: "memory");
#pragma unroll
                        for (int j = 0; j < 4; ++j) asm volatile("" : "+v"(gsc[j][0]), "+v"(gsc[j][1]), "+v"(sc1[j][0]), "+v"(sc1[j][1]), "+v"(gsh[j][0]), "+v"(gsh[j][1]) :: "memory");
#pragma unroll
                        for (int rr = 0; rr < 2; ++rr)
#pragma unroll
                            for (int j = 0; j < 4; ++j) pg8::unpack8(xw[rr][j], v[rr][j][0], v[rr][j][1]);
#pragma unroll
                        for (int j = 0; j < 4; ++j)
#pragma unroll
                            for (int h = 0; h < 2; ++h) gsc[j][h] = gsc[j][h] * (sc1[j][h] + 1.0f);
#pragma unroll
                        for (int rr = 0; rr < 2; ++rr)
#pragma unroll
                            for (int j = 0; j < 4; ++j)
#pragma unroll
                                for (int h = 0; h < 2; ++h) ss[rr] += v[rr][j][h][0] * v[rr][j][h][0] + v[rr][j][h][1] * v[rr][j][h][1] + v[rr][j][h][2] * v[rr][j][h][2] + v[rr][j][h][3] * v[rr][j][h][3];
#pragma unroll
                        for (int rr = 0; rr < 2; ++rr) { const int lr = 2 * wave + rr, row = rb * 32 + it * 16 + lr;
                            const float rstd = 1.0f / sqrtf(wave_sum(ss[rr]) * (1.0f / D) + NORM_EPS);
                            bf16_t* hrow = hbuf + (size_t)row * D;
#pragma unroll
                            for (int j = 0; j < 4; ++j) { const int c = 8 * (lane + 64 * j); f32x4 o[2];
#pragma unroll
                                for (int h = 0; h < 2; ++h) o[h] = v[rr][j][h] * rstd * gsc[j][h] + gsh[j][h];
                                const u32x4 hiw = pg8::pack8(o[0], o[1]); *(GAS u32x4*)(hrow + c) = hiw;
                                f32x4 h0, h1; pg8::unpack8(hiw, h0, h1); const u32x4 low = pg8::pack8(o[0] - h0, o[1] - h1);
                                const int so = lr * 4096 + (((lane + 64 * j) ^ lr) << 4);
                                *(LAS u32x4*)(lds + so) = hiw; *(LAS u32x4*)(lds + 65536 + so) = low; } }
                    }
                    f32x4 racc[4];
                    {
                        const GAS bf16_t* whi = (const GAS bf16_t*)(ws + WS_WRT) + (size_t)(l * 2) * 64 * 2048 + 256 * wave; const GAS bf16_t* wlo = whi + 64 * 2048;
                        const int lop = opaque(lane), r16 = lop & 15, q4 = lop >> 4;
#pragma unroll
                        for (int nt = 0; nt < 4; ++nt) racc[nt] = (f32x4){0.f, 0.f, 0.f, 0.f};
                        auto ldB = [&](int kp, bf16x8 (&bh)[2][4], bf16x8 (&bl)[2][4]) {
#pragma unroll
                            for (int k2 = 0; k2 < 2; ++k2)
#pragma unroll
                                for (int nt = 0; nt < 4; ++nt) { const size_t wo = (size_t)(16 * nt + r16) * 2048 + 32 * (2 * kp + k2) + 8 * q4; bh[k2][nt] = *(const GAS bf16x8*)(whi + wo); bl[k2][nt] = *(const GAS bf16x8*)(wlo + wo); } };
                        auto mm = [&](int kp, const bf16x8 (&bh)[2][4], const bf16x8 (&bl)[2][4]) {
#pragma unroll
                            for (int k2 = 0; k2 < 2; ++k2) { const int chunk = 32 * wave + 4 * (2 * kp + k2) + q4, so = r16 * 4096 + ((chunk ^ r16) << 4);
                                const bf16x8 ah = *(const LAS bf16x8*)(lds + so), al = *(const LAS bf16x8*)(lds + 65536 + so);
#pragma unroll
                                for (int nt = 0; nt < 4; ++nt) {
                                    racc[nt] = __builtin_amdgcn_mfma_f32_16x16x32_bf16(ah, bh[k2][nt], racc[nt], 0, 0, 0);
                                    racc[nt] = __builtin_amdgcn_mfma_f32_16x16x32_bf16(al, bh[k2][nt], racc[nt], 0, 0, 0);
                                    racc[nt] = __builtin_amdgcn_mfma_f32_16x16x32_bf16(ah, bl[k2][nt], racc[nt], 0, 0, 0); } } };
#define RT_FENCE() asm volatile("" ::: "memory")
#define RT_PIN() asm volatile("" : "+v"(racc[0]), "+v"(racc[1]), "+v"(racc[2]), "+v"(racc[3]) :: "memory")
                        bf16x8 bhA[2][4], blA[2][4], bhB[2][4], blB[2][4];
                        RT_FENCE(); ldB(0, bhA, blA); ldB(1, bhB, blB); RT_FENCE();
                        __syncthreads();
                        mm(0, bhA, blA); RT_PIN(); ldB(2, bhA, blA); RT_FENCE();
                        mm(1, bhB, blB); RT_PIN(); ldB(3, bhB, blB); RT_FENCE();
                        mm(2, bhA, blA); mm(3, bhB, blB);
#undef RT_FENCE
#undef RT_PIN
                    }
                    __syncthreads();
                    LAS float* part = (LAS float*)lds;
#pragma unroll
                    for (int nt = 0; nt < 4; ++nt)
#pragma unroll
                        for (int r = 0; r < 4; ++r) part[(wave * 16 + 4 * (lane >> 4) + r) * 64 + 16 * nt + (lane & 15)] = racc[nt][r];
                    __syncthreads();
#pragma unroll 1
                    for (int rr = 0; rr < 2; ++rr) { const int lr = 2 * wave + rr; float logit = 0.f;
#pragma unroll
                        for (int w8 = 0; w8 < 8; ++w8) logit += part[(w8 * 16 + lr) * 64 + lane];
                        const float score = 1.0f / (1.0f + __expf(-logit)); const float sel = score + brt;
                        float m1 = sel; m1 = fmaxf(m1, __shfl_xor(m1, 1)); m1 = fmaxf(m1, __shfl_xor(m1, 2)); m1 = fmaxf(m1, __shfl_xor(m1, 4));
                        const unsigned long long bm = __ballot(sel == m1); const unsigned gb = (unsigned)(bm >> (lane & 56)) & 0xffu; const int first = __builtin_ctz(gb);
                        float v2 = ((lane & 7) == first) ? -3.0e38f : sel; v2 = fmaxf(v2, __shfl_xor(v2, 1)); v2 = fmaxf(v2, __shfl_xor(v2, 2)); v2 = fmaxf(v2, __shfl_xor(v2, 4));
                        const float gs = m1 + v2; int grank = 0; const int mygrp = lane >> 3;
#pragma unroll
                        for (int gg = 0; gg < 8; ++gg) { const float o = __shfl(gs, gg * 8); grank += (o > gs || (o == gs && gg < mygrp)) ? 1 : 0; }
                        float val = grank < 4 ? sel : -3.0e38f; unsigned long long cm = 0ull;
#pragma unroll
                        for (int pick = 0; pick < 8; ++pick) {
                            float mxv = val;
#pragma unroll
                            for (int o = 1; o < 64; o <<= 1) mxv = fmaxf(mxv, __shfl_xor(mxv, o));
                            const unsigned long long bmx = __ballot(val == mxv); const int sl = __builtin_ctzll(bmx);
                            cm |= 1ull << sl; if (lane == sl) val = -3.4e38f; }
                        const bool chosen = (cm >> lane) & 1ull; const float sw = wave_sum(chosen ? score : 0.f);
                        const int gr = it * 16 + lr;
                        selw[gr * 64 + lane] = chosen ? score / sw * 2.5f : 0.f;
                        if (lane == 0) selmask[gr] = cm; }
                    __syncthreads();
                }
                if (wave == 0 && rep + 1 == nrep) {
                    int cntl = 0;
                    for (int r = 0; r < 32; ++r) cntl += (int)((selmask[r] >> lane) & 1ull);
                    int pos = cntl ? (int)atomicAdd(ctl + CW_CNT + l * 64 + lane, (unsigned)cntl) : 0;
                    for (int r = 0; r < 32; ++r) { const unsigned long long m = selmask[r];
                        if ((m >> lane) & 1ull) { const int k = __builtin_popcountll(m & ((1ull << lane) - 1ull)); const int tok = rb * 32 + r; const int li = lane * 8192 + pos;
                            ltok[li] = tok; ldst[li] = tok * NSLOT + k; ((float*)(ws + WS_TOKW))[tok * 8 + k] = selw[r * 64 + lane]; ++pos; } }
                }
                __syncthreads();
            }
            if (rep + 1 < nrep) GRID_BAR(); }
            if (BOTH(pb + 5)) GRID_BAR();
        }
        if ((PH_MASK & 256) && IN(pb + 6)) {
            PH_BEGIN
            _Pragma("unroll 1") for (int rep = 0; rep < REPS(6); ++rep) {
            LAS int* tpre = (LAS int*)(lds + MOE_OFF); LAS int* ebase = tpre + 65; LAS int* ecnt = ebase + 65; LAS int* utab = (LAS int*)(lds + MOE_OFF + 1024);
            pg8::moe_build<4, true>(tpre, ebase, ecnt, utab, ctl + CW_CNT + l * 64, G, blk, tid);
            pg8::MoeOrder<4, true> S{utab, (const char*)((bf16_t*)(ws + WS_WGU) + (size_t)l * 65 * 1024 * 2048), (size_t)1024 * 2048 * 2, (size_t)256 * 2048 * 2, (const int*)(ws + WS_LTOK)};
            pg8::EpiGateUp E{(bf16_t*)(ws + WS_HID)};
            pg8::gemm_phase<pg8::EpiGateUp, pg8::MoeOrder<4, true>, GEMM_ALIGN>(lds, (const char*)hbuf, D, S, E);
            if (rep + 1 < REPS(6)) GRID_BAR(); }
            if (BOTH(pb + 6)) GRID_BAR();
        }
        if ((PH_MASK & 512) && IN(pb + 7)) {
            PH_BEGIN
            _Pragma("unroll 1") for (int rep = 0; rep < REPS(7); ++rep) {
            LAS int* tpre = (LAS int*)(lds + MOE_OFF); LAS int* ebase = tpre + 65; LAS int* ecnt = ebase + 65; LAS int* utab = (LAS int*)(lds + MOE_OFF + 1024);
            pg8::moe_build<8, false>(tpre, ebase, ecnt, utab, ctl + CW_CNT + l * 64, G, blk, tid);
            pg8::MoeOrder<8, false> S{utab, (const char*)((bf16_t*)(ws + WS_WD) + (size_t)l * 65 * 2048 * 512), (size_t)2048 * 512 * 2, (size_t)256 * 512 * 2, (const int*)(ws + WS_LTOK)};
            pg8::EpiDown E{(unsigned char*)(ws + WS_YSLOT), (const int*)(ws + WS_LDST), (LAS int*)(lds + SEL_OFF), (REP_VARIANT && rep == 1) ? 1 : 0};
            pg8::gemm_phase<pg8::EpiDown, pg8::MoeOrder<8, false>, GEMM_ALIGN>(lds, (const char*)(ws + WS_HID), 512, S, E);
            if (rep + 1 < REPS(7)) GRID_BAR(); }
            if (BOTH(pb + 7)) GRID_BAR();
        }
        if ((PH_MASK & 1024) && IN(pb + 8)) {
            PH_BEGIN
            const int nrep = REPS(8);
            _Pragma("unroll 1") for (int rep = 0; rep < nrep; ++rep) {
            const float* modl = mod + (size_t)l * 2 * 12288;
            const unsigned char* yslot = (const unsigned char*)(ws + WS_YSLOT);
            for (int run = blk * NWAVES + wave; run < T / 4; run += G * NWAVES) {
                const int bb = (run * 4) / SEQ; const float* gt2 = modl + bb * 12288 + 5 * 2048;
                const float* m1 = mod + (size_t)2 * 12288 + bb * 12288;
                f32x4 gtv[2][4];
#pragma unroll
                for (int jj = 0; jj < 2; ++jj)
#pragma unroll
                    for (int q = 0; q < 4; ++q) { const int c = 16 * (lane + 64 * jj) + 4 * q; gtv[jj][q] = *(const GAS f32x4*)(gt2 + c) * pg8::YS_INV; }
#pragma unroll 1
                for (int pr = 0; pr < 2; ++pr) {
                    f32x4 v[2][2][4]; float ss[2] = {0.f, 0.f};
                    const int rowb = run * 4 + pr * 2;
                    f32x4 tw[2][2];
#pragma unroll
                    for (int rr = 0; rr < 2; ++rr) { tw[rr][0] = *(const GAS f32x4*)((const float*)(ws + WS_TOKW) + (rowb + rr) * 8); tw[rr][1] = *(const GAS f32x4*)((const float*)(ws + WS_TOKW) + (rowb + rr) * 8 + 4); }
                    auto issue = [&](int rr, int jj, u32x4 (&w)[NSLOT], u32x4 (&xq)[2]) {
                        const int c = 16 * (lane + 64 * jj); const unsigned char* ys = yslot + (size_t)(rowb + rr) * NSLOT * D + c;
#pragma unroll
                        for (int k = 0; k < NSLOT; ++k) w[k] = *(const GAS u32x4*)(ys + (size_t)k * D);
                        const bf16_t* xr = (const bf16_t*)(ws + WS_XB) + (size_t)(rowb + rr) * D + c; xq[0] = *(const GAS u32x4*)xr; xq[1] = *(const GAS u32x4*)(xr + 8); };
                    auto consume = [&](int rr, int jj, const u32x4 (&w)[NSLOT], const u32x4 (&xq)[2]) {
                        f32x4 a[4];
#pragma unroll
                        for (int q = 0; q < 4; ++q) a[q] = (f32x4){0.f, 0.f, 0.f, 0.f};
#pragma unroll
                        for (int k = 0; k < NSLOT; ++k) { const float wk = k < 8 ? tw[rr][k >> 2][k & 3] : 1.0f;
#pragma unroll
                            for (int q = 0; q < 4; ++q) { const f32x2 lo = __builtin_amdgcn_cvt_pk_f32_fp8((int)w[k][q], false), hi = __builtin_amdgcn_cvt_pk_f32_fp8((int)w[k][q], true); a[q] += (f32x4){lo.x, lo.y, hi.x, hi.y} * wk; } }
                        f32x4 xv[4]; pg8::unpack8(xq[0], xv[0], xv[1]); pg8::unpack8(xq[1], xv[2], xv[3]);
#pragma unroll
                        for (int q = 0; q < 4; ++q) { v[rr][jj][q] = xv[q] + gtv[jj][q] * a[q];
                            ss[rr] += v[rr][jj][q][0] * v[rr][jj][q][0] + v[rr][jj][q][1] * v[rr][jj][q][1] + v[rr][jj][q][2] * v[rr][jj][q][2] + v[rr][jj][q][3] * v[rr][jj][q][3]; } };
                    {
                        u32x4 wA[NSLOT], xA[2], wB[NSLOT], xB[2];
#define CMB_FENCE() asm volatile("" ::: "memory")
#define CMB_PIN(x) asm volatile("" : "+v"(x) :: "memory")
                        issue(0, 0, wA, xA); issue(0, 1, wB, xB); CMB_FENCE();
                        consume(0, 0, wA, xA); CMB_PIN(ss[0]); issue(1, 0, wA, xA); CMB_FENCE();
                        consume(0, 1, wB, xB); CMB_PIN(ss[0]); issue(1, 1, wB, xB); CMB_FENCE();
                        consume(1, 0, wA, xA); consume(1, 1, wB, xB); CMB_PIN(ss[1]);
#undef CMB_FENCE
#undef CMB_PIN
                    }
                    f32x4 gs[2][4], gh[2][4];
                    if (l == 0) {
#pragma unroll
                        for (int jj = 0; jj < 2; ++jj)
#pragma unroll
                            for (int q = 0; q < 4; ++q) { const int c = 16 * (lane + 64 * jj) + 4 * q;
                                gs[jj][q] = *(const GAS f32x4*)(args.in[I_NMIX] + D + c) * (*(const GAS f32x4*)(m1 + 2048 + c) + 1.0f); gh[jj][q] = *(const GAS f32x4*)(m1 + c); }
                    } else {
#pragma unroll
                        for (int jj = 0; jj < 2; ++jj)
#pragma unroll
                            for (int q = 0; q < 4; ++q) { const int c = 16 * (lane + 64 * jj) + 4 * q; gs[jj][q] = *(const GAS f32x4*)(args.in[I_NFIN] + c); gh[jj][q] = (f32x4){0.f, 0.f, 0.f, 0.f}; }
                    }
#pragma unroll
                    for (int rr = 0; rr < 2; ++rr) { const int row = rowb + rr;
                        const float rstd = 1.0f / sqrtf(wave_sum(ss[rr]) * (1.0f / D) + NORM_EPS);
                        float* xw = (rep + 1 == nrep) ? xbuf + (size_t)row * D : (float*)(ws + WS_HID) + (size_t)row * D; bf16_t* hw = (rep + 1 == nrep) ? hbuf + (size_t)row * D : (bf16_t*)(ws + WS_MIXED2) + (size_t)row * D;
                        bf16_t* xbw = (rep + 1 == nrep) ? (bf16_t*)(ws + WS_XB) + (size_t)row * D : (bf16_t*)(ws + WS_MIXED) + (size_t)row * D;
                        if (l == 0) {
#pragma unroll
                            for (int jj = 0; jj < 2; ++jj) { const int c = 16 * (lane + 64 * jj); f32x4 o[4];
                                *(GAS u32x4*)(xbw + c) = pg8::pack8(v[rr][jj][0], v[rr][jj][1]); *(GAS u32x4*)(xbw + c + 8) = pg8::pack8(v[rr][jj][2], v[rr][jj][3]);
#pragma unroll
                                for (int q = 0; q < 4; ++q) o[q] = v[rr][jj][q] * rstd * gs[jj][q] + gh[jj][q];
                                *(GAS u32x4*)(hw + c) = pg8::pack8(o[0], o[1]); *(GAS u32x4*)(hw + c + 8) = pg8::pack8(o[2], o[3]); }
                        } else {
#pragma unroll
                            for (int jj = 0; jj < 2; ++jj) { const int c = 16 * (lane + 64 * jj);
#pragma unroll
                                for (int q = 0; q < 4; ++q) *(GAS f32x4*)(xw + c + 4 * q) = v[rr][jj][q] * rstd * gs[jj][q]; }
                        } }
                }
            }
            if (rep + 1 < nrep) GRID_BAR(); }
            if (BOTH(pb + 8)) GRID_BAR();
        }
    }
#undef IN
#undef BOTH
#undef GRID_BAR
}

extern "C" void kernel_launch(void* const* d_in, const int* in_sizes, int n_in, void* d_out, int out_size, void* d_ws, size_t ws_size, hipStream_t stream) {
    static int grid = 0;
    if (grid == 0) {
        if (n_in != 29 || out_size != T * D || ws_size < WS_END) { fprintf(stderr, "kernel_launch: unexpected shapes (n_in %d out %d ws %zu)\n", n_in, out_size, ws_size); grid = -1; return; }
        int dev = 0, cus = 0, per_cu = 0;
        if (hipGetDevice(&dev) != hipSuccess || hipDeviceGetAttribute(&cus, hipDeviceAttributeMultiprocessorCount, dev) != hipSuccess) { grid = -1; return; }
        if (hipFuncSetAttribute((const void*)mega_fwd, hipFuncAttributeMaxDynamicSharedMemorySize, LDS_BYTES) != hipSuccess) { fprintf(stderr, "kernel_launch: hipFuncSetAttribute failed\n"); grid = -1; return; }
        if (hipOccupancyMaxActiveBlocksPerMultiprocessor(&per_cu, (const void*)mega_fwd, NWAVES * 64, LDS_BYTES) != hipSuccess || per_cu < 1) { fprintf(stderr, "kernel_launch: occupancy query says %d\n", per_cu); }
        (void)hipGetLastError();
        grid = cus & ~7;
    }
    if (grid < 0) return;
    (void)hipMemsetAsync((char*)d_ws + WS_CTL, 0, CTL_ZERO_BYTES, stream);
    Args a{};
    for (int i = 0; i < 29; ++i) a.in[i] = (const float*)d_in[i];
    a.out = (float*)d_out; a.ws = (unsigned char*)d_ws;
    if (N_LAUNCHES == 1) { a.ph_lo = 0; a.ph_hi = 20; hipLaunchKernelGGL(mega_fwd, dim3(grid), dim3(NWAVES * 64), LDS_BYTES, stream, a); }
    else { for (int p = 0; p < 20; ++p) { a.ph_lo = p; a.ph_hi = p + 1; hipLaunchKernelGGL(mega_fwd, dim3(grid), dim3(NWAVES * 64), LDS_BYTES, stream, a); } }
}
```

```cpp
#include <hip/hip_runtime.h>
#include <cstdio>
#include <cstdint>

#ifndef N_LAUNCHES
#define N_LAUNCHES 1
#endif
#ifndef GEMM_ALIGN
#define GEMM_ALIGN true
#endif
#ifndef GEMM_SP2
#define GEMM_SP2 true
#endif
#ifndef MOE_XCD
#define MOE_XCD 0
#endif
#ifndef F8_PIN
#define F8_PIN 1
#endif
#if F8_PIN == 1
#define F8_PIN_ASM(x) asm volatile("" : "+v"(x))
#elif F8_PIN == 2
#define F8_PIN_ASM(x) asm volatile("" : "+a"(x))
#else
#define F8_PIN_ASM(x) do {} while (0)
#endif
#ifndef DOWN_PRE
#define DOWN_PRE 1
#endif

#define LAS __attribute__((address_space(3)))
#define GAS __attribute__((address_space(1)))
typedef unsigned short bf16_t;
typedef short bf16x8 __attribute__((ext_vector_type(8)));
typedef float f32x4 __attribute__((ext_vector_type(4)));
typedef float f32x2 __attribute__((ext_vector_type(2)));
typedef unsigned u32x4 __attribute__((ext_vector_type(4)));
typedef unsigned u32x2 __attribute__((ext_vector_type(2)));
typedef int i32x4 __attribute__((ext_vector_type(4)));
typedef int i32x8 __attribute__((ext_vector_type(8)));

constexpr int T = 8192, D = 2048, SEQ = 4096, DEPTH = 2;
constexpr int INW = 6144, O_Q = 0, O_K = 1024, O_V = 1280, O_U = 1536, O_GA = 2048, O_GS = 4096;
constexpr int NE = 64, NSLOT = 9;
constexpr float NORM_EPS = 1e-6f;
constexpr float LOG2E = 1.4426950408889634f;

constexpr size_t MiB = 1u << 20;
constexpr size_t WS_CTL = 0, CTL_ZERO_BYTES = 1 * MiB;
constexpr size_t WS_MODP = 1 * MiB;
constexpr size_t WS_MOD = 3 * MiB;
constexpr size_t WS_SSM = 4 * MiB;
constexpr size_t SSM_STRIDE = 640 * 1024, SSM_E = 0, SSM_F = 256 * 1024, SSM_KT = 512 * 1024, SSM_P = 560 * 1024;
constexpr size_t WS_WIN = 44 * MiB;
constexpr size_t WS_WO = 92 * MiB;
constexpr size_t WS_WGLU = 100 * MiB;
constexpr size_t WS_WMIX = 108 * MiB;
constexpr size_t WS_WGU = 124 * MiB;
constexpr size_t WS_WD = 644 * MiB;
constexpr size_t WS_H = 904 * MiB;
constexpr size_t WS_PROJ = 936 * MiB;
constexpr size_t WS_ATTN = 1032 * MiB;
constexpr size_t WS_SLOC = 1048 * MiB;
constexpr size_t WS_Y = 1050 * MiB;
constexpr size_t WS_MIXED = 1058 * MiB;
constexpr size_t WS_HID = 1090 * MiB;
constexpr size_t WS_YSLOT = 1163 * MiB;
constexpr size_t WS_LTOK = 1451 * MiB, WS_LDST = 1453 * MiB, WS_LW = 1455 * MiB;
constexpr size_t WS_MIXED2 = 1457 * MiB;
constexpr size_t WS_WRT = 1489 * MiB;
constexpr size_t WS_XB = 1490 * MiB;
constexpr size_t WS_TOKW = 1522 * MiB;
constexpr size_t WS_END = 1523 * MiB;
constexpr int CW_TMO = 0, CW_BAR = 4096, CW_CNT = 8192;

constexpr int RING_BYTES = 131072, LDSCTL_OFF = RING_BYTES, MISC_OFF = LDSCTL_OFF + 320;
constexpr int SEL_OFF = LDSCTL_OFF + 1024;
constexpr int MOE_OFF = LDSCTL_OFF + 10240;
constexpr int LDS_BYTES = 147456;
constexpr int NWAVES = 8;

__device__ __forceinline__ unsigned cvt_pk_bf16(float lo, float hi) { unsigned r; asm("v_cvt_pk_bf16_f32 %0, %1, %2" : "=v"(r) : "v"(lo), "v"(hi)); return r; }
__device__ __forceinline__ float bf_lo(unsigned w) { return __uint_as_float(w << 16); }
__device__ __forceinline__ float bf_hi(unsigned w) { return __uint_as_float(w & 0xffff0000u); }
__device__ __forceinline__ float bf1(bf16_t h) { return __uint_as_float(((unsigned)h) << 16); }
__device__ __forceinline__ float fast_sigmoid(float x) { return __builtin_amdgcn_rcpf(1.0f + __builtin_amdgcn_exp2f(-x * LOG2E)); }
__device__ __forceinline__ float wave_sum(float v) {
#pragma unroll
    for (int o = 1; o < 64; o <<= 1) v += __shfl_xor(v, o);
    return v;
}
__device__ __forceinline__ int opaque(int v) { asm volatile("" : "+v"(v)); return v; }
#define LDS_WAIT() asm volatile("s_waitcnt lgkmcnt(0)" ::: "memory")
#define VM_WAIT() asm volatile("s_waitcnt vmcnt(0)" ::: "memory")

#define XB_TMO      128
#define XB_XCNT(j)  (256  + 64 * (j))
#define XB_XSUB(j)  (1280 + 64 * (j))
#define XB_XGEN(j)  (2304 + 64 * (j))
#define XB_TOP      3328
#define XB_TOPGEN   3392
#define XCD_BAR_WORDS 3456
#define XB_SPIN_CAP (1u << 18)
__device__ __forceinline__ unsigned xb_ld(unsigned* p)              { return __hip_atomic_load(p, __ATOMIC_RELAXED, __HIP_MEMORY_SCOPE_AGENT); }
__device__ __forceinline__ unsigned xb_add(unsigned* p, unsigned v) { return __hip_atomic_fetch_add(p, v, __ATOMIC_RELAXED, __HIP_MEMORY_SCOPE_AGENT); }
__device__ __forceinline__ unsigned xb_xcc_id() { return (unsigned)__builtin_amdgcn_s_getreg((3 << 11) | 20) & 0xFu; }
#define XB_SPIN(cond, bar) do { unsigned _sp = 0; while (cond) { __builtin_amdgcn_s_sleep(1); \
    if ((++_sp & 255u) == 0u) { if (xb_ld(&(bar)[XB_TMO])) break; if (_sp > XB_SPIN_CAP) { atomicAdd(&(bar)[XB_TMO], 1u); break; } } } } while (0)
struct XcdBarrier { unsigned* bar; unsigned x; volatile LAS unsigned* st; };
__device__ __forceinline__ XcdBarrier xcd_barrier_post(unsigned* bar, volatile LAS unsigned* st) {
    XcdBarrier b; b.bar = bar; b.x = xb_xcc_id(); b.st = st;
    if (threadIdx.x == 0) (void)xb_add(&bar[XB_XCNT(b.x)], 1u);
    return b;
}
__device__ __forceinline__ void xcd_barrier_complete(unsigned* bar, unsigned x, unsigned& nloc, unsigned& nx) {
    const unsigned G = gridDim.x * gridDim.y * gridDim.z;
    unsigned sum, cnt, mine, sp = 0u;
    for (;;) {
        sum = 0u; cnt = 0u; mine = 0u;
#pragma unroll
        for (unsigned j = 0; j < 16; ++j) { const unsigned c = xb_ld(&bar[XB_XCNT(j)]); sum += c; cnt += (c > 0u) ? 1u : 0u; mine = (j == x) ? c : mine; }
        if (sum == G) break;
        __builtin_amdgcn_s_sleep(1);
        if ((++sp & 255u) == 0u) { if (xb_ld(&bar[XB_TMO])) break; if (sp > XB_SPIN_CAP) { atomicAdd(&bar[XB_TMO], 1u); break; } }
    }
    nloc = mine > 0u ? mine : 1u; nx = cnt > 0u ? cnt : 1u;
}
__device__ __forceinline__ void xcd_barrier(const XcdBarrier& b) {
    asm volatile("s_waitcnt vmcnt(0)" ::: "memory");
    __syncthreads();
    if (threadIdx.x == 0) {
        unsigned* bar = b.bar;
        __builtin_amdgcn_s_waitcnt(0);
        unsigned nloc = b.st[0], nx = b.st[1];
        if (nloc == 0u) { xcd_barrier_complete(bar, b.x, nloc, nx); b.st[0] = nloc; b.st[1] = nx; }
        const unsigned old = xb_add(&bar[XB_XSUB(b.x)], 1u);
        const unsigned gen = old / nloc;
        if (old + 1u == (gen + 1u) * nloc) {
            __builtin_amdgcn_fence(__ATOMIC_RELEASE, "agent");
            asm volatile("s_waitcnt vmcnt(0)" ::: "memory");
            const unsigned og = xb_add(&bar[XB_TOP], 1u);
            const unsigned tg = og / nx;
            if (og + 1u == (tg + 1u) * nx) xb_add(&bar[XB_TOPGEN], 1u);
            else XB_SPIN(xb_ld(&bar[XB_TOPGEN]) == tg, bar);
            __builtin_amdgcn_fence(__ATOMIC_ACQUIRE, "agent");
            xb_add(&bar[XB_XGEN(b.x)], 1u);
            asm volatile("s_waitcnt vmcnt(0)" ::: "memory");
        } else {
            XB_SPIN(xb_ld(&bar[XB_XGEN(b.x)]) == gen, bar);
            __builtin_amdgcn_fence(__ATOMIC_ACQUIRE, "agent");
            asm volatile("s_waitcnt vmcnt(0)" ::: "memory");
        }
    }
    __syncthreads();
}

namespace pg8 {
constexpr int BM = 256, BK = 64, HALF = 128, HTB = HALF * BK * 2, STAGE_BYTES = 8 * HTB, NXCD = 8, WGM = 8;
__host__ __device__ __forceinline__ int lds_byte(int r, int c) { const int st = (r >> 4) * 2 + (c >> 5), rr = r & 15, cc = c & 31, ob = rr * 64 + cc * 2; return st * 1024 + (ob ^ (((ob >> 9) & 1) << 5)); }
__host__ __device__ __forceinline__ void stage_rc(int b, int& R, int& C) { const int st = b / 1024, sb = b % 1024, swz = sb ^ (((sb >> 9) & 1) << 5); R = (st >> 1) * 16 + swz / 64; C = (st & 1) * 32 + (swz % 64) / 2; }
__host__ __device__ __forceinline__ int perm32(int rho) { const int n = rho >> 4, i = rho & 15; return 8 * (i >> 2) + 4 * n + (i & 3); }

struct Unit { int pm, pn, e, n, r0, x; };

struct DenseOrder {
    static constexpr bool GATHER = false;
    int nM, nN, nwg, G, c; const char* Bt; size_t tstepB;
    __device__ void init(int M, int N, int K, int G_, int c_, const void* Bt_) { nM = M / BM; nN = N / BM; nwg = nM * nN; G = G_; c = c_; Bt = (const char*)Bt_; tstepB = (size_t)BM * K * 2; }
    __device__ __forceinline__ bool next(int i, Unit& u) const {
        const long L = (long)i * G + c; if (L >= nwg) return false;
        int wgid = (int)L; { const int q = nwg / NXCD, r = nwg % NXCD, xcd = wgid % NXCD, off = wgid / NXCD; wgid = (xcd < r ? xcd * (q + 1) : r * (q + 1) + (xcd - r) * q) + off; }
        const int nig = WGM * nN, gid = wgid / nig, fm = gid * WGM, gsz = (nM - fm) < WGM ? (nM - fm) : WGM;
        u.pm = fm + ((wgid % nig) % gsz); u.pn = (wgid % nig) / gsz; u.e = -1; u.n = 256; u.r0 = u.pm * BM; u.x = u.pm * BM; return true;
    }
    __device__ __forceinline__ int a_row(const Unit& u, int R) const { return u.r0 + R; }
    __device__ __forceinline__ void a_row_issue(const Unit& u, int R, int& out) const { out = u.r0 + R; }
    __device__ __forceinline__ int a_row_fix(const Unit& u, int R, int loaded) const { return loaded; }
    __device__ __forceinline__ const char* b_tile(const Unit& u) const { return Bt + (size_t)u.pn * tstepB; }
};
template <int NPN, bool GATHER_> struct MoeOrder {
    static constexpr bool GATHER = GATHER_;
    const LAS int* utab; const char* Wbase; size_t wstepE, tstepB; const int* ltok;
    __device__ __forceinline__ bool next(int i, Unit& u) const {
        if (i >= 64) return false;
        const LAS int* p = utab + i * 8;
        const int pm = __builtin_amdgcn_readfirstlane(p[0]); if (pm < 0) return false;
        u.pm = pm; u.pn = __builtin_amdgcn_readfirstlane(p[1]); u.e = __builtin_amdgcn_readfirstlane(p[2]); u.n = __builtin_amdgcn_readfirstlane(p[3]);
        u.r0 = __builtin_amdgcn_readfirstlane(p[4]); u.x = __builtin_amdgcn_readfirstlane(p[5]); return true;
    }
    __device__ __forceinline__ int a_row(const Unit& u, int R) const {
        if (!GATHER) return u.r0 + R;
        if (u.e == 64) return u.r0 + R;
        const int rr = R < u.n ? R : u.n - 1; return ((const GAS int*)ltok)[u.r0 + rr];
    }
    __device__ __forceinline__ void a_row_issue(const Unit& u, int R, int& out) const {
        const int rr = R < u.n ? R : u.n - 1; const GAS int* p = (const GAS int*)ltok + (u.e == 64 ? 0 : u.r0 + rr);
        asm volatile("global_load_dword %0, %1, off" : "=v"(out) : "v"(p) : "memory");
    }
    __device__ __forceinline__ int a_row_fix(const Unit& u, int R, int loaded) const { return u.e == 64 ? u.r0 + R : loaded; }
    __device__ __forceinline__ const char* b_tile(const Unit& u) const { return Wbase + (size_t)u.e * wstepE + (size_t)u.pn * tstepB; }
};
template <int NPN, bool GATHER> __device__ __forceinline__ void moe_build(LAS int* tpre, LAS int* ebase, LAS int* ecnt, LAS int* utab, const unsigned* counts, int G, int c, int tid) {
    if (tid < 64) ecnt[tid] = (int)__hip_atomic_load(counts + tid, __ATOMIC_RELAXED, __HIP_MEMORY_SCOPE_AGENT);
    __syncthreads();
    if (tid == 0) { int tp = 0, eb = 0; for (int e = 0; e < 64; ++e) { tpre[e] = tp; ebase[e] = eb; tp += (ecnt[e] + 255) >> 8; eb += ecnt[e]; } tpre[64] = tp; ebase[64] = eb; }
    __syncthreads();
#if MOE_XCD
    if (tid < 64) {
        int pm = -1, pn = 0, e = 64, n = 256;
        const int xc = c & 7; int idx = (c >> 3) + (G >> 3) * tid;
        if (idx < 4 * NPN) { pm = xc + 8 * (idx / NPN); pn = idx % NPN; }
        else { idx -= 4 * NPN;
#pragma unroll 1
            for (int j = 0; j < 8; ++j) { const int ee = xc + 8 * j, nu = ((ecnt[ee] + 255) >> 8) * NPN;
                if (pm < 0) { if (idx < nu) { e = ee; pm = idx / NPN; pn = idx % NPN; } else idx -= nu; } }
            if (pm >= 0) { const int rem = ecnt[e] - pm * BM; n = rem < BM ? rem : BM; } }
        const int hb = (e == 64 ? 65536 : ebase[e]) + pm * BM;
        const int r0 = GATHER ? (e == 64 ? pm * BM : e * 8192 + pm * BM) : hb, x = hb;
#else
    if (tid < 64) {
        int pm = -1, pn = 0, e = 64, n = 256;
        const int vc = ((G & 7) == 0) ? (c & 7) * (G >> 3) + (c >> 3) : c;
        int L = tid * G + vc; const int shared_units = 32 * NPN, tot = shared_units + NPN * tpre[64];
        if (L < tot) {
            if (L < shared_units) { pm = L / NPN; pn = L % NPN; }
            else { L -= shared_units; const int tile = L / NPN; pn = L % NPN; e = 0;
#pragma unroll 1
                for (int j = 1; j <= 64; ++j) e += (tpre[j] <= tile) ? 1 : 0;
                pm = tile - tpre[e]; const int rem = ecnt[e] - pm * BM; n = rem < BM ? rem : BM; } }
        const int hb = (e == 64 ? 65536 : ebase[e]) + pm * BM;
        const int r0 = GATHER ? (e == 64 ? pm * BM : e * 8192 + pm * BM) : hb, x = hb;
#endif
        LAS int* p = utab + tid * 8; p[0] = pm; p[1] = pn; p[2] = e; p[3] = n; p[4] = r0; p[5] = x;
    }
    __syncthreads();
}

template <class Epi, class Sched, bool ALIGN_EPI = false, bool SP2 = GEMM_SP2, bool F8 = false>
__device__ __forceinline__ void gemm_phase(LAS unsigned char* lds, const char* Abase, const int K, const Sched& S, const Epi& E) {
    int tid = threadIdx.x; asm volatile("" : "+v"(tid));
    const int wid = __builtin_amdgcn_readfirstlane(tid >> 6), lane = tid & 63, wr = wid >> 2, wc = wid & 3, fr = lane & 15, fq = lane >> 4;
    const int nt = K / BK;
    constexpr bool GA = Sched::GATHER;
    unsigned voffA[2], voffB[2];
#pragma unroll
    for (int i = 0; i < 2; ++i) { int R, C; stage_rc(tid * 16 + i * 8192, R, C); const int Rb = Epi::PERM ? ((R & ~31) + perm32(R & 31)) : R; voffA[i] = (unsigned)(R * K + C) * 2u; voffB[i] = (unsigned)(Rb * K + C) * 2u; }
    const size_t kstep = (size_t)(BK * 2);
    const size_t hstep = (size_t)HALF * K * 2;
    const unsigned ldsw = (unsigned)wid * 1024u;
    const int aoff = lds_byte(wr * 64 + fr, fq * 8), boff = lds_byte(wc * 32 + fr, fq * 8);
#define PG8_SA(b, h) (((b) * 2 + (h)) * HTB)
#define PG8_SB(b, h) ((4 + (b) * 2 + (h)) * HTB)
#define PG8_STB(bufoff, gbase) do { _Pragma("unroll") for (int _i = 0; _i < 2; ++_i) \
        __builtin_amdgcn_global_load_lds((const unsigned*)((const char*)(gbase) + voffB[_i]), (LAS unsigned*)(lds + (bufoff) + ldsw + _i * 8192), 16, 0, 0); } while (0)
#define PG8_STA(bufoff, h, kb) do { _Pragma("unroll") for (int _i = 0; _i < 2; ++_i) \
        __builtin_amdgcn_global_load_lds((const unsigned*)(GA ? (Abase + (kb) + offC[h][_i]) : (cA + (kb) + (h) * hstep + voffA[_i])), (LAS unsigned*)(lds + (bufoff) + ldsw + _i * 8192), 16, 0, 0); } while (0)
#define PG8_LDA(dst, b, h) do { _Pragma("unroll") for (int m = 0; m < 4; ++m) _Pragma("unroll") for (int k = 0; k < 2; ++k) dst[m][k] = *(const LAS bf16x8*)(lds + PG8_SA(b, h) + aoff + m * 2048 + k * 1024); } while (0)
#define PG8_LDB(dst, b, h) do { _Pragma("unroll") for (int n = 0; n < 2; ++n) _Pragma("unroll") for (int k = 0; k < 2; ++k) dst[n][k] = *(const LAS bf16x8*)(lds + PG8_SB(b, h) + boff + n * 2048 + k * 1024); } while (0)
#define PG8_CAT8(x, y) __builtin_shufflevector(__builtin_bit_cast(i32x4, x), __builtin_bit_cast(i32x4, y), 0, 1, 2, 3, 4, 5, 6, 7)
#define PG8_MMA(ai, bj, At, Bt) do { __builtin_amdgcn_s_setprio(1); _Pragma("unroll") for (int m = 0; m < 4; ++m) _Pragma("unroll") for (int n = 0; n < 2; ++n) { \
        if constexpr (F8) acc[ai][bj][m][n] = __builtin_amdgcn_mfma_scale_f32_16x16x128_f8f6f4(PG8_CAT8(Bt[n][0], Bt[n][1]), PG8_CAT8(At[m][0], At[m][1]), acc[ai][bj][m][n], 0, 0, 0, 0, 0, 0); \
        else { _Pragma("unroll") for (int k = 0; k < 2; ++k) acc[ai][bj][m][n] = __builtin_amdgcn_mfma_f32_16x16x32_bf16(Bt[n][k], At[m][k], acc[ai][bj][m][n], 0, 0, 0); } } \
        __builtin_amdgcn_s_setprio(0); } while (0)
#define PG8_WAIT_V(n) asm volatile("s_waitcnt vmcnt(" #n ")" ::: "memory")
#define PG8_WAIT_L(n) asm volatile("s_waitcnt lgkmcnt(" #n ")" ::: "memory")
#define PG8_BAR __builtin_amdgcn_s_barrier()
#define PG8_SCHED __builtin_amdgcn_sched_barrier(0)
#define PG8_AOFF(dst, u) do { if constexpr (GA) { _Pragma("unroll") for (int _h = 0; _h < 2; ++_h) _Pragma("unroll") for (int _i = 0; _i < 2; ++_i) { int _R, _C; stage_rc(tid * 16 + _i * 8192, _R, _C); \
        dst[_h][_i] = (unsigned)(S.a_row(u, _h * HALF + _R) * K + _C) * 2u; } } } while (0)
    Unit cur, nxt; int ui = 0;
    if (!S.next(0, cur)) return;
    f32x4 acc[2][2][4][2];
#pragma unroll
    for (int a = 0; a < 2; ++a)
#pragma unroll
        for (int b = 0; b < 2; ++b)
#pragma unroll
            for (int m = 0; m < 4; ++m)
#pragma unroll
                for (int n = 0; n < 2; ++n) { acc[a][b][m][n] = (f32x4){0.f, 0.f, 0.f, 0.f}; if constexpr (F8) F8_PIN_ASM(acc[a][b][m][n]); }
    bf16x8 At[4][2], B0[2][2], B1[2][2];
    unsigned offC[2][2];
    PG8_AOFF(offC, cur);
    const char* cB = S.b_tile(cur);
    const char* cA = GA ? Abase : Abase + (size_t)S.a_row(cur, 0) * K * 2;
    if constexpr (SP2) {
        PG8_STB(PG8_SB(0, 0), cB); PG8_STB(PG8_SB(0, 1), cB + hstep); PG8_STA(PG8_SA(0, 0), 0, 0); PG8_STA(PG8_SA(0, 1), 1, 0);
        if (wr == 1) PG8_BAR;
        PG8_WAIT_V(2); PG8_BAR;
        PG8_STB(PG8_SB(1, 0), cB + kstep); PG8_STA(PG8_SA(1, 0), 0, kstep); PG8_STB(PG8_SB(1, 1), cB + hstep + kstep);
        PG8_WAIT_V(6); PG8_BAR;
    } else {
    PG8_STB(PG8_SB(0, 0), cB); PG8_STA(PG8_SA(0, 0), 0, 0); PG8_STB(PG8_SB(0, 1), cB + hstep); PG8_STA(PG8_SA(0, 1), 1, 0);
    if (wr == 1) PG8_BAR;
    PG8_WAIT_V(4); PG8_BAR;
    PG8_STB(PG8_SB(1, 0), cB + kstep); PG8_STA(PG8_SA(1, 0), 0, kstep); PG8_STB(PG8_SB(1, 1), cB + hstep + kstep);
    PG8_WAIT_V(6); PG8_BAR;
    }
    for (;;) {
        int pre_v0, pre_v1; if constexpr (Epi::PRE) E.pre_issue(cur, wr, lane, pre_v0, pre_v1);
        const bool has_next = S.next(ui + 1, nxt);
        const char* nB = has_next ? S.b_tile(nxt) : cB;
        const char* nA = (!GA && has_next) ? Abase + (size_t)S.a_row(nxt, 0) * K * 2 : cA;
        int rowN[2][2];
        if constexpr (GA) { const Unit un = has_next ? nxt : cur;
#pragma unroll
            for (int h = 0; h < 2; ++h)
#pragma unroll
                for (int i = 0; i < 2; ++i) { int R_, C_; stage_rc(tid * 16 + i * 8192, R_, C_); S.a_row_issue(un, h * HALF + R_, rowN[h][i]); } }
#pragma unroll 1
        for (int t = 0; t < nt; t += 2) {
            const bool last = (t == nt - 2);
            const size_t kb1 = (size_t)(t + 1) * kstep;
            const size_t kb2 = last ? 0 : (size_t)(t + 2) * kstep, kb3 = kb2 + kstep;
            const char* b2 = last ? nB : cB + (size_t)(t + 2) * kstep; const char* b3 = b2 + kstep;
            if constexpr (SP2) {
            PG8_LDB(B0, 0, 0); PG8_LDB(B1, 0, 1); PG8_SCHED; PG8_LDA(At, 0, 0); PG8_STA(PG8_SA(1, 1), 1, kb1);
            if (last) { if constexpr (GA) { if (has_next) {
#pragma unroll
                for (int h = 0; h < 2; ++h)
#pragma unroll
                    for (int i = 0; i < 2; ++i) { int R_, C_; stage_rc(tid * 16 + i * 8192, R_, C_); int rl = rowN[h][i]; asm volatile("" : "+v"(rl));
                        offC[h][i] = (unsigned)(S.a_row_fix(nxt, h * HALF + R_, rl) * K + C_) * 2u; } } } else cA = nA; }
            PG8_WAIT_V(8); PG8_WAIT_L(0); PG8_BAR; PG8_MMA(0, 0, At, B0); PG8_MMA(0, 1, At, B1); PG8_BAR; PG8_SCHED;
            PG8_LDA(At, 0, 1); PG8_STB(PG8_SB(0, 0), b2); PG8_STB(PG8_SB(0, 1), b2 + hstep); PG8_STA(PG8_SA(0, 0), 0, kb2);
            PG8_WAIT_V(8); PG8_WAIT_L(0); PG8_BAR; PG8_MMA(1, 0, At, B0); PG8_MMA(1, 1, At, B1); PG8_BAR; PG8_SCHED;
            PG8_LDB(B0, 1, 0); PG8_LDB(B1, 1, 1); PG8_SCHED; PG8_LDA(At, 1, 0); PG8_STA(PG8_SA(0, 1), 1, kb2);
            PG8_WAIT_V(8); PG8_WAIT_L(0); PG8_BAR; PG8_MMA(0, 0, At, B0); PG8_MMA(0, 1, At, B1); PG8_BAR; PG8_SCHED;
            PG8_LDA(At, 1, 1); PG8_STB(PG8_SB(1, 0), b3); PG8_STB(PG8_SB(1, 1), b3 + hstep); PG8_STA(PG8_SA(1, 0), 0, kb3);
            PG8_WAIT_V(8); PG8_WAIT_L(0); PG8_BAR; PG8_MMA(1, 0, At, B0); PG8_MMA(1, 1, At, B1); PG8_BAR; PG8_SCHED;
            } else {
            PG8_LDB(B0, 0, 0); PG8_SCHED; PG8_LDA(At, 0, 0); PG8_STA(PG8_SA(1, 1), 1, kb1);
            if (last) { if constexpr (GA) { if (has_next) {
#pragma unroll
                for (int h = 0; h < 2; ++h)
#pragma unroll
                    for (int i = 0; i < 2; ++i) { int R_, C_; stage_rc(tid * 16 + i * 8192, R_, C_); int rl = rowN[h][i]; asm volatile("" : "+v"(rl));
                        offC[h][i] = (unsigned)(S.a_row_fix(nxt, h * HALF + R_, rl) * K + C_) * 2u; } } } else cA = nA; }
            PG8_WAIT_L(8); PG8_BAR; PG8_WAIT_L(0); PG8_MMA(0, 0, At, B0); PG8_BAR; PG8_SCHED;
            PG8_LDB(B1, 0, 1); PG8_STB(PG8_SB(0, 0), b2);
            PG8_BAR; PG8_WAIT_L(0); PG8_MMA(0, 1, At, B1); PG8_BAR;
            PG8_LDA(At, 0, 1); PG8_STA(PG8_SA(0, 0), 0, kb2);
            PG8_BAR; PG8_WAIT_L(0); PG8_MMA(1, 0, At, B0); PG8_BAR; PG8_SCHED;
            PG8_STB(PG8_SB(0, 1), b2 + hstep);
            PG8_WAIT_V(6); PG8_BAR; PG8_MMA(1, 1, At, B1); PG8_BAR;
            PG8_LDB(B0, 1, 0); PG8_SCHED; PG8_LDA(At, 1, 0); PG8_STA(PG8_SA(0, 1), 1, kb2);
            PG8_WAIT_L(8); PG8_BAR; PG8_WAIT_L(0); PG8_MMA(0, 0, At, B0); PG8_BAR; PG8_SCHED;
            PG8_LDB(B1, 1, 1); PG8_STB(PG8_SB(1, 0), b3);
            PG8_BAR; PG8_WAIT_L(0); PG8_MMA(0, 1, At, B1); PG8_BAR;
            PG8_LDA(At, 1, 1); PG8_STA(PG8_SA(1, 0), 0, kb3);
            PG8_BAR; PG8_WAIT_L(0); PG8_MMA(1, 0, At, B0); PG8_BAR; PG8_SCHED;
            PG8_STB(PG8_SB(1, 1), b3 + hstep);
            PG8_WAIT_V(6); PG8_BAR; PG8_MMA(1, 1, At, B1); PG8_BAR;
            }
        }
        if constexpr (ALIGN_EPI) { if (wr == 0) PG8_BAR; }
        if constexpr (Epi::PRE) { asm volatile("" : "+v"(pre_v0), "+v"(pre_v1)); E.pre_commit(pre_v0, pre_v1, wid, lane); }
        E(acc, cur, wr, wc, fr, fq);
        if (!has_next) break;
#pragma unroll
        for (int a = 0; a < 2; ++a)
#pragma unroll
            for (int b = 0; b < 2; ++b)
#pragma unroll
                for (int m = 0; m < 4; ++m)
#pragma unroll
                    for (int n = 0; n < 2; ++n) { acc[a][b][m][n] = (f32x4){0.f, 0.f, 0.f, 0.f}; if constexpr (F8) F8_PIN_ASM(acc[a][b][m][n]); }
        cur = nxt; cB = nB; ++ui;
        if constexpr (ALIGN_EPI) { if (wr == 1) PG8_BAR; }
    }
    PG8_WAIT_V(0);
    if constexpr (!ALIGN_EPI) { if (wr == 0) PG8_BAR; }
    PG8_BAR;
#undef PG8_SA
#undef PG8_SB
#undef PG8_STB
#undef PG8_STA
#undef PG8_LDA
#undef PG8_LDB
#undef PG8_MMA
#undef PG8_CAT8
#undef PG8_WAIT_V
#undef PG8_WAIT_L
#undef PG8_BAR
#undef PG8_SCHED
#undef PG8_AOFF
}

typedef const f32x4 (&AccRef)[2][2][4][2];
__device__ __forceinline__ u32x4 pack8(const f32x4& a, const f32x4& b) { u32x4 w; w.x = cvt_pk_bf16(a[0], a[1]); w.y = cvt_pk_bf16(a[2], a[3]); w.z = cvt_pk_bf16(b[0], b[1]); w.w = cvt_pk_bf16(b[2], b[3]); return w; }
__device__ __forceinline__ void unpack8(const u32x4 w, f32x4& a, f32x4& b) { a = (f32x4){bf_lo(w.x), bf_hi(w.x), bf_lo(w.y), bf_hi(w.y)}; b = (f32x4){bf_lo(w.z), bf_hi(w.z), bf_lo(w.w), bf_hi(w.w)}; }

struct EpiInProj {
    static constexpr bool PERM = true; static constexpr bool PRE = false;
    bf16_t* O; const float* bias; float qscale; int nostore;
    __device__ __forceinline__ void operator()(AccRef acc, const Unit& u, int wr, int wc, int fr, int fq) const {
        if (nostore) return;
        const int row0 = u.pm * BM + wr * 64 + fr, colb = u.pn * BM + wc * 32 + 8 * fq;
        const int mode = u.pn < 4 ? 1 : (u.pn >= 8 ? 2 : 0);
        f32x4 bv[2][2];
#pragma unroll
        for (int bj = 0; bj < 2; ++bj)
#pragma unroll
            for (int n = 0; n < 2; ++n) bv[bj][n] = *(const GAS f32x4*)(bias + colb + bj * HALF + 4 * n);
#pragma unroll
        for (int ai = 0; ai < 2; ++ai)
#pragma unroll
            for (int m = 0; m < 4; ++m) { bf16_t* rowp = O + (size_t)(row0 + ai * HALF + m * 16) * INW + colb;
#pragma unroll
                for (int bj = 0; bj < 2; ++bj) { f32x4 v0 = acc[ai][bj][m][0] + bv[bj][0], v1 = acc[ai][bj][m][1] + bv[bj][1];
                    if (mode == 1) { v0 = v0 * qscale; v1 = v1 * qscale; }
                    if (mode == 2) {
#pragma unroll
                        for (int j = 0; j < 4; ++j) { v0[j] = fast_sigmoid(v0[j]); v1[j] = fast_sigmoid(v1[j]); } }
                    *(GAS u32x4*)(rowp + bj * HALF) = pack8(v0, v1); } }
    }
};
struct EpiAttnProj {
    static constexpr bool PERM = true; static constexpr bool PRE = false;
    const bf16_t* proj; bf16_t* mixed;
    __device__ __forceinline__ void operator()(AccRef acc, const Unit& u, int wr, int wc, int fr, int fq) const {
        const int row0 = u.pm * BM + wr * 64 + fr, colb = u.pn * BM + wc * 32 + 8 * fq;
#pragma unroll
        for (int ai = 0; ai < 2; ++ai) {
            u32x4 gw[4][2];
#pragma unroll
            for (int m = 0; m < 4; ++m)
#pragma unroll
                for (int bj = 0; bj < 2; ++bj) gw[m][bj] = *(const GAS u32x4*)(proj + (size_t)(row0 + ai * HALF + m * 16) * INW + O_GA + colb + bj * HALF);
#pragma unroll
            for (int m = 0; m < 4; ++m) { const size_t row = (size_t)(row0 + ai * HALF + m * 16);
#pragma unroll
                for (int bj = 0; bj < 2; ++bj) { f32x4 g0, g1; unpack8(gw[m][bj], g0, g1);
                    *(GAS u32x4*)(mixed + row * D + colb + bj * HALF) = pack8(g0 * acc[ai][bj][m][0], g1 * acc[ai][bj][m][1]); } } }
    }
};
struct EpiGlu {
    static constexpr bool PERM = true; static constexpr bool PRE = false;
    const bf16_t* proj; const bf16_t* mixed; bf16_t* mixed2;
    __device__ __forceinline__ void operator()(AccRef acc, const Unit& u, int wr, int wc, int fr, int fq) const {
        const int row0 = u.pm * BM + wr * 64 + fr, col = u.pn * HALF + wc * 32 + 8 * fq;
#pragma unroll
        for (int ai = 0; ai < 2; ++ai) {
            u32x4 gw[4], pw[4];
#pragma unroll
            for (int m = 0; m < 4; ++m) { const size_t row = (size_t)(row0 + ai * HALF + m * 16);
                gw[m] = *(const GAS u32x4*)(proj + row * INW + O_GS + col); pw[m] = *(const GAS u32x4*)(mixed + row * D + col); }
#pragma unroll
            for (int m = 0; m < 4; ++m) { const size_t row = (size_t)(row0 + ai * HALF + m * 16);
                f32x4 g0, g1, p0, p1; unpack8(gw[m], g0, g1); unpack8(pw[m], p0, p1);
                const f32x4 za0 = acc[ai][0][m][0], za1 = acc[ai][0][m][1], zb0 = acc[ai][1][m][0], zb1 = acc[ai][1][m][1];
#pragma unroll
                for (int j = 0; j < 4; ++j) { p0[j] += g0[j] * za0[j] * fast_sigmoid(zb0[j]); p1[j] += g1[j] * za1[j] * fast_sigmoid(zb1[j]); }
                *(GAS u32x4*)(mixed2 + row * D + col) = pack8(p0, p1); } }
    }
};
struct EpiMixOut {
    static constexpr bool PERM = true; static constexpr bool PRE = false;
    const float* xin; const bf16_t* xsrc; bf16_t* xdst; const float* gt;
    __device__ __forceinline__ void operator()(AccRef acc, const Unit& u, int wr, int wc, int fr, int fq) const {
        const int row0 = u.pm * BM + wr * 64 + fr, colb = u.pn * BM + wc * 32 + 8 * fq;
        const float* g = gt + (u.pm >= 16 ? 12288 : 0);
        f32x4 gv[2][2];
#pragma unroll
        for (int bj = 0; bj < 2; ++bj)
#pragma unroll
            for (int n = 0; n < 2; ++n) gv[bj][n] = *(const GAS f32x4*)(g + colb + bj * HALF + 4 * n);
        if (xin) {
#pragma unroll
            for (int ai = 0; ai < 2; ++ai)
#pragma unroll
                for (int mp = 0; mp < 2; ++mp) { f32x4 xv[2][2][2];
#pragma unroll
                    for (int mm = 0; mm < 2; ++mm)
#pragma unroll
                        for (int bj = 0; bj < 2; ++bj) { const size_t off = (size_t)(row0 + ai * HALF + (2 * mp + mm) * 16) * D + colb + bj * HALF;
                            xv[mm][bj][0] = *(const GAS f32x4*)(xin + off); xv[mm][bj][1] = *(const GAS f32x4*)(xin + off + 4); }
#pragma unroll
                    for (int mm = 0; mm < 2; ++mm)
#pragma unroll
                        for (int bj = 0; bj < 2; ++bj) { const int m = 2 * mp + mm; const size_t off = (size_t)(row0 + ai * HALF + m * 16) * D + colb + bj * HALF;
                            *(GAS u32x4*)(xdst + off) = pack8(xv[mm][bj][0] + gv[bj][0] * acc[ai][bj][m][0], xv[mm][bj][1] + gv[bj][1] * acc[ai][bj][m][1]); } }
        } else {
#pragma unroll
            for (int ai = 0; ai < 2; ++ai) { u32x4 xw[4][2];
#pragma unroll
                for (int m = 0; m < 4; ++m)
#pragma unroll
                    for (int bj = 0; bj < 2; ++bj) xw[m][bj] = *(const GAS u32x4*)(xsrc + (size_t)(row0 + ai * HALF + m * 16) * D + colb + bj * HALF);
#pragma unroll
                for (int m = 0; m < 4; ++m)
#pragma unroll
                    for (int bj = 0; bj < 2; ++bj) { f32x4 x0, x1; unpack8(xw[m][bj], x0, x1);
                        *(GAS u32x4*)(xdst + (size_t)(row0 + ai * HALF + m * 16) * D + colb + bj * HALF) = pack8(x0 + gv[bj][0] * acc[ai][bj][m][0], x1 + gv[bj][1] * acc[ai][bj][m][1]); } }
        }
    }
};
constexpr float WGU_SCALE = 64.0f, WD_SCALE = 32.0f;
__device__ __forceinline__ unsigned pk_fp8x4(const f32x4& a) {
    int w = 0; w = __builtin_amdgcn_cvt_pk_fp8_f32(a[0], a[1], w, false); w = __builtin_amdgcn_cvt_pk_fp8_f32(a[2], a[3], w, true); return (unsigned)w; }
struct EpiGateUp {
    static constexpr bool PERM = true; static constexpr bool PRE = false;
    bf16_t* hid;
    __device__ __forceinline__ void operator()(AccRef acc, const Unit& u, int wr, int wc, int fr, int fq) const {
        const int r0 = wr * 64 + fr, col = u.pn * HALF + wc * 32 + 8 * fq;
#pragma unroll
        for (int ai = 0; ai < 2; ++ai)
#pragma unroll
            for (int m = 0; m < 4; ++m) { const int r = r0 + ai * HALF + m * 16;
                f32x4 g0 = acc[ai][0][m][0] * (1.0f / WGU_SCALE), g1 = acc[ai][0][m][1] * (1.0f / WGU_SCALE), u0 = acc[ai][1][m][0] * (1.0f / WGU_SCALE), u1 = acc[ai][1][m][1] * (1.0f / WGU_SCALE);
#pragma unroll
                for (int j = 0; j < 4; ++j) { g0[j] = g0[j] * fast_sigmoid(g0[j]) * u0[j]; g1[j] = g1[j] * fast_sigmoid(g1[j]) * u1[j]; }
                if (r < u.n) *(GAS u32x4*)(hid + (size_t)(u.x + r) * 512 + col) = pack8(g0, g1); }
    }
};
constexpr float YS_SCALE = 8.0f, YS_INV = 1.0f / 8.0f, YS_ACC = YS_SCALE;
struct EpiDown {
    static constexpr bool PERM = true; static constexpr bool PRE = (DOWN_PRE != 0);
    unsigned char* ys; const int* ldst; LAS int* dstl; int nostore;
    __device__ __forceinline__ void pre_issue(const Unit& u, int wr, int lane, int& v0, int& v1) const {
        const int ra = 64 * wr + lane, rb = ra + 128; const GAS int* p = (const GAS int*)ldst + (u.e == 64 ? 0 : u.e * 8192 + u.pm * BM);
        const GAS int* pa = p + ((u.e != 64 && ra < u.n) ? ra : 0); const GAS int* pb = p + ((u.e != 64 && rb < u.n) ? rb : 0);
        asm volatile("global_load_dword %0, %1, off" : "=v"(v0) : "v"(pa) : "memory");
        asm volatile("global_load_dword %0, %1, off" : "=v"(v1) : "v"(pb) : "memory");
    }
    __device__ __forceinline__ void pre_commit(int v0, int v1, int wid, int lane_) const { const int lane = opaque(lane_); dstl[wid * 128 + lane] = v0; dstl[wid * 128 + 64 + lane] = v1; }
    __device__ __forceinline__ void operator()(AccRef acc, const Unit& u, int wr, int wc, int fr_, int fq_) const {
        const int fr = opaque(fr_), fq = opaque(fq_);
        const int r0 = wr * 64 + fr, colb = u.pn * BM + 16 * (4 * wc + fq);
#pragma unroll
        for (int ai = 0; ai < 2; ++ai)
#pragma unroll
            for (int m = 0; m < 4; ++m) { const int r = r0 + ai * HALF + m * 16;
                int dst;
                if constexpr (PRE) dst = (u.e == 64) ? (u.pm * BM + r) * NSLOT + 8 : dstl[(wr * 4 + wc) * 128 + ai * 64 + m * 16 + fr];
                else dst = (u.e == 64) ? (u.pm * BM + r) * NSLOT + 8 : ((const GAS int*)ldst)[u.e * 8192 + u.pm * BM + (r < u.n ? r : 0)];
                if (r < u.n && !nostore)
                    *(GAS u32x4*)(ys + (size_t)dst * D + colb) = (u32x4){pk_fp8x4(acc[ai][0][m][0] * YS_ACC), pk_fp8x4(acc[ai][0][m][1] * YS_ACC), pk_fp8x4(acc[ai][1][m][0] * YS_ACC), pk_fp8x4(acc[ai][1][m][1] * YS_ACC)}; }
    }
};
}

struct Args { const float* in[29]; float* out; unsigned char* ws; int ph_lo, ph_hi; };
enum { I_X = 0, I_C, I_WADA, I_BADA, I_NMIX, I_WIN, I_BIN, I_SINK, I_WO, I_ARE, I_AIM, I_LDT, I_BRE, I_BIM, I_CRE, I_CIM, I_SD, I_WGLU, I_WMIX, I_NFFN, I_WR, I_BR, I_WEG, I_WEU, I_WED, I_WSG, I_WSU, I_WSD, I_NFIN };

struct TDesc { const float* src; bf16_t* dst; int N, K, cc0; float f8s; };
__device__ __forceinline__ void tr_load(const TDesc& d, int lane, f32x4 (&v)[16]) {
    const int kr = lane >> 4, nq = lane & 15;
    const GAS float* p = (const GAS float*)d.src + (size_t)kr * d.N + 4 * nq; const size_t step = (size_t)4 * d.N;
#pragma unroll
    for (int i = 0; i < 16; ++i) { v[i] = __builtin_nontemporal_load((const GAS f32x4*)p); p += step; }
}
__device__ __forceinline__ void tr_finish(const TDesc& d, int lane, LAS float* scr, const f32x4 (&v)[16]) {
    const int kr = lane >> 4, nq = lane & 15;
#pragma unroll
    for (int i = 0; i < 16; ++i) { const int k = 4 * i + kr;
#pragma unroll
        for (int e = 0; e < 4; ++e) scr[k * 64 + ((4 * nq + e) ^ k)] = v[i][e]; }
    LDS_WAIT();
    const int c = lane & 7;
#pragma unroll
    for (int j = 0; j < 8; ++j) { const int n = (lane >> 3) + 8 * j; float s[8];
#pragma unroll
        for (int i = 0; i < 8; ++i) { const int k = 8 * c + i; s[i] = scr[k * 64 + (n ^ k)]; }
        u32x4 o; o.x = cvt_pk_bf16(s[0], s[1]); o.y = cvt_pk_bf16(s[2], s[3]); o.z = cvt_pk_bf16(s[4], s[5]); o.w = cvt_pk_bf16(s[6], s[7]);
        const int cc = d.cc0 + n, drow = d.cc0 >= 0 ? (128 * ((cc & 15) >> 3) + 8 * (cc >> 4) + (cc & 7)) : n;
        if (d.f8s != 0.f) { const f32x4 sa = (f32x4){s[0], s[1], s[2], s[3]} * d.f8s, sb = (f32x4){s[4], s[5], s[6], s[7]} * d.f8s;
            __builtin_nontemporal_store((u32x2){pg8::pk_fp8x4(sa), pg8::pk_fp8x4(sb)}, (GAS u32x2*)((unsigned char*)d.dst + (size_t)drow * d.K + 8 * c)); }
        else __builtin_nontemporal_store(o, (GAS u32x4*)(d.dst + (size_t)drow * d.K + 8 * c)); }
    LDS_WAIT();
}
constexpr int IT_WIN = 3072, IT_WO = 512, IT_WGLU = 512, IT_WMIX = 1024, IT_EXP = 16384, IT_SH = 256;
constexpr int IT_LAYER = IT_WIN + IT_WO + IT_WGLU + IT_WMIX + 3 * IT_EXP + 3 * IT_SH;
constexpr int IT_MOD = 768;
constexpr int IT_TR = 2 * IT_LAYER;

__device__ __forceinline__ TDesc tr_desc(const float* W, int K, int N, bf16_t* WT, int kb, int nb, int drow0) {
    TDesc d; d.src = W + (size_t)(64 * kb) * N + 64 * nb; d.dst = WT + (size_t)drow0 * K + 64 * kb; d.N = N; d.K = K; d.cc0 = -1; d.f8s = 0.f; return d;
}
__device__ __forceinline__ TDesc tr_desc8(const float* W, int K, int N, unsigned char* WT, int kb, int nb, int drow0, float scale) {
    TDesc d; d.src = W + (size_t)(64 * kb) * N + 64 * nb; d.dst = (bf16_t*)(WT + (size_t)drow0 * K + 64 * kb); d.N = N; d.K = K; d.cc0 = -1; d.f8s = scale; return d;
}
__device__ __forceinline__ TDesc tr_decode(const Args& a, int it) {
    unsigned char* ws = a.ws;
    const int l = 1 - it / IT_LAYER; int r = it % IT_LAYER;
    if (r < IT_WIN) return tr_desc(a.in[I_WIN] + (size_t)l * 2048 * 6144, 2048, 6144, (bf16_t*)(ws + WS_WIN) + (size_t)l * 6144 * 2048, r / 96, r % 96, 64 * (r % 96));
    r -= IT_WIN;
    if (r < IT_WO) return tr_desc(a.in[I_WO] + (size_t)l * 1024 * 2048, 1024, 2048, (bf16_t*)(ws + WS_WO) + (size_t)l * 2048 * 1024, r / 32, r % 32, 64 * (r % 32));
    r -= IT_WO;
    if (r < IT_WGLU) { const int kb = r / 64, nb = r % 64, n0 = 64 * nb; const int drow = n0 < 2048 ? 256 * (n0 / 128) + (n0 % 128) : 256 * ((n0 - 2048) / 128) + 128 + (n0 % 128);
        return tr_desc(a.in[I_WGLU] + (size_t)l * 512 * 4096, 512, 4096, (bf16_t*)(ws + WS_WGLU) + (size_t)l * 4096 * 512, kb, nb, drow); }
    r -= IT_WGLU;
    if (r < IT_WMIX) return tr_desc(a.in[I_WMIX] + (size_t)l * 2048 * 2048, 2048, 2048, (bf16_t*)(ws + WS_WMIX) + (size_t)l * 2048 * 2048, r / 32, r % 32, 64 * (r % 32));
    r -= IT_WMIX;
    unsigned char* wgu = ws + WS_WGU + (size_t)l * 65 * 1024 * 2048; bf16_t* wd = (bf16_t*)(ws + WS_WD) + (size_t)l * 65 * 2048 * 512;
    if (r < 2 * IT_EXP) { const int up = r >= IT_EXP; r -= up * IT_EXP; const int e = r / 256, q = r % 256, kb = q / 8, nb = q % 8, n0 = 64 * nb;
        return tr_desc8(a.in[up ? I_WEU : I_WEG] + ((size_t)l * 64 + e) * 2048 * 512, 2048, 512, wgu + (size_t)e * 1024 * 2048, kb, nb, 256 * (n0 / 128) + (n0 % 128) + 128 * up, pg8::WGU_SCALE); }
    r -= 2 * IT_EXP;
    if (r < IT_EXP) { const int e = r / 256, q = r % 256, kb = q / 32, nb = q % 32;
        TDesc d = tr_desc(a.in[I_WED] + ((size_t)l * 64 + e) * 512 * 2048, 512, 2048, wd + (size_t)e * 2048 * 512, kb, nb, 256 * (nb / 4)); d.cc0 = 64 * (nb % 4); return d; }
    r -= IT_EXP;
    if (r < 2 * IT_SH) { const int up = r >= IT_SH; r -= up * IT_SH; const int kb = r / 8, nb = r % 8, n0 = 64 * nb;
        return tr_desc8(a.in[up ? I_WSU : I_WSG] + (size_t)l * 2048 * 512, 2048, 512, wgu + (size_t)64 * 1024 * 2048, kb, nb, 256 * (n0 / 128) + (n0 % 128) + 128 * up, pg8::WGU_SCALE); }
    r -= 2 * IT_SH;
    { const int kb = r / 32, nb = r % 32; TDesc d = tr_desc(a.in[I_WSD] + (size_t)l * 512 * 2048, 512, 2048, wd + (size_t)64 * 2048 * 512, kb, nb, 256 * (nb / 4)); d.cc0 = 64 * (nb % 4); return d; }
}
__device__ __forceinline__ void mod_item(const Args& a, int it, int tid, LAS unsigned char* lds) {
    const int lane = tid & 63, wave = tid >> 6;
    const int l = it / 384, r = it % 384, ks = r / 48, cc = r % 48;
    const float* W = a.in[I_WADA] + (size_t)l * 2048 * 12288 + (size_t)(256 * ks + 32 * wave) * 12288 + 256 * cc + 4 * lane;
    const float* c0 = a.in[I_C] + 256 * ks + 32 * wave, *c1 = c0 + 2048;
    f32x4 a0 = {0.f, 0.f, 0.f, 0.f}, a1 = {0.f, 0.f, 0.f, 0.f};
#pragma unroll 1
    for (int h = 0; h < 2; ++h) { f32x4 w[16]; const GAS float* wp = (const GAS float*)W + (size_t)(16 * h) * 12288;
#pragma unroll
        for (int i = 0; i < 16; ++i) { w[i] = __builtin_nontemporal_load((const GAS f32x4*)wp); wp += 12288; }
#pragma unroll
        for (int i = 0; i < 16; ++i) { const float x0 = c0[16 * h + i], x1 = c1[16 * h + i]; const float s0 = x0 * fast_sigmoid(x0), s1 = x1 * fast_sigmoid(x1); a0 += w[i] * s0; a1 += w[i] * s1; } }
    LAS f32x4* red = (LAS f32x4*)lds;
    red[(wave * 2 + 0) * 64 + lane] = a0; red[(wave * 2 + 1) * 64 + lane] = a1;
    __syncthreads();
    { const int b = tid >> 8, col = tid & 255; LAS float* rf = (LAS float*)lds; float s = 0.f;
#pragma unroll
        for (int w8 = 0; w8 < 8; ++w8) s += rf[((w8 * 2 + b) * 64) * 4 + col];
        ((float*)(a.ws + WS_MODP))[((size_t)(ks * 2 + l) * 2 + b) * 12288 + 256 * cc + col] = s; }
    __syncthreads();
}
__device__ __forceinline__ void p0_items(const Args& a, int gw, int ngw, LAS float* scr, int lane) {
#pragma unroll 1
    for (int it = gw; it < IT_TR; it += ngw) { f32x4 v[16]; const TDesc d = tr_decode(a, it); tr_load(d, lane, v); tr_finish(d, lane, scr, v); }
}

__device__ __forceinline__ void cpow(float are, float aim, float dt, int n, float& pr, float& pi) {
    const float mag = __builtin_amdgcn_exp2f((float)n * dt * are * LOG2E);
    const double turns = (double)n * ((double)dt * (double)aim * 0.15915494309189535);
    const float fr = (float)(turns - __builtin_rint(turns));
    pr = mag * __builtin_amdgcn_cosf(fr); pi = mag * __builtin_amdgcn_sinf(fr);
}
__device__ __forceinline__ void ssm_tables(const Args& a, int l, int g, LAS unsigned char* lds, int tid) {
    LAS f32x2* Apow = (LAS f32x2*)lds;
    LAS f32x2* Bb = (LAS f32x2*)(lds + 65 * 64 * 8);
    LAS f32x2* Cc = (LAS f32x2*)(lds + 65 * 64 * 8 + 64 * 16 * 8);
    const int lg = l * 32 + g;
    const float* are_p = a.in[I_ARE] + lg * 64; const float* aim_p = a.in[I_AIM] + lg * 64;
    const float dt = __expf(a.in[I_LDT][lg]);
    unsigned char* tb = a.ws + WS_SSM + (size_t)lg * SSM_STRIDE;
    bf16_t* Et = (bf16_t*)(tb + SSM_E); bf16_t* Ft = (bf16_t*)(tb + SSM_F); bf16_t* Kt = (bf16_t*)(tb + SSM_KT); GAS f32x2* Pt = (GAS f32x2*)(tb + SSM_P);
    for (int idx = tid; idx < 65 * 64; idx += 512) { const int n = idx >> 6, p = idx & 63; float pr, pi; cpow(are_p[p], aim_p[p], dt, n, pr, pi); Apow[idx] = (f32x2){pr, pi}; }
    for (int idx = tid; idx < 64 * 64; idx += 512) { const int m = idx >> 6, p = idx & 63; float pr, pi; cpow(are_p[p], aim_p[p], dt, 64 * m, pr, pi); Pt[idx] = (f32x2){pr, pi}; }
    for (int idx = tid; idx < 64 * 16; idx += 512) { const int p = idx >> 4, c = idx & 15;
        const float ar = are_p[p], ai = aim_p[p]; float br, bi; cpow(ar, ai, dt, 1, br, bi);
        const float nr = br - 1.0f, ni = bi, den = ar * ar + ai * ai; const float fr = (nr * ar + ni * ai) / den, fi = (ni * ar - nr * ai) / den;
        const float b_r = a.in[I_BRE][(size_t)lg * 1024 + idx], b_i = a.in[I_BIM][(size_t)lg * 1024 + idx];
        Bb[idx] = (f32x2){fr * b_r - fi * b_i, fr * b_i + fi * b_r}; }
    for (int idx = tid; idx < 16 * 64; idx += 512) Cc[idx] = (f32x2){a.in[I_CRE][(size_t)lg * 1024 + idx], a.in[I_CIM][(size_t)lg * 1024 + idx]};
    __syncthreads();
    for (int idx = tid; idx < 128 * 128; idx += 512) { const int n = idx >> 7, k8 = idx & 127, ri = n >> 6, p = n & 63, s = k8 >> 1, c0 = (k8 & 1) * 8;
        const f32x2 ap = Apow[(63 - s) * 64 + p]; float v[8];
#pragma unroll
        for (int j = 0; j < 8; ++j) { const f32x2 b = Bb[p * 16 + c0 + j]; v[j] = ri ? (ap.x * b.y + ap.y * b.x) : (ap.x * b.x - ap.y * b.y); }
        u32x4 o; o.x = cvt_pk_bf16(v[0], v[1]); o.y = cvt_pk_bf16(v[2], v[3]); o.z = cvt_pk_bf16(v[4], v[5]); o.w = cvt_pk_bf16(v[6], v[7]);
        *(GAS u32x4*)(Et + (size_t)n * 1024 + k8 * 8) = o; }
    for (int idx = tid; idx < 1024 * 16; idx += 512) { const int n = idx >> 4, k8 = idx & 15, t = n >> 4, c = n & 15, ri = k8 >> 3, p0 = (k8 & 7) * 8; float v[8];
#pragma unroll
        for (int j = 0; j < 8; ++j) { const f32x2 ap = Apow[(t + 1) * 64 + p0 + j], cc = Cc[c * 64 + p0 + j]; v[j] = ri ? -(cc.x * ap.y + cc.y * ap.x) : (cc.x * ap.x - cc.y * ap.y); }
        u32x4 o; o.x = cvt_pk_bf16(v[0], v[1]); o.y = cvt_pk_bf16(v[2], v[3]); o.z = cvt_pk_bf16(v[4], v[5]); o.w = cvt_pk_bf16(v[6], v[7]);
        *(GAS u32x4*)(Ft + (size_t)n * 128 + k8 * 8) = o; }
    for (int idx = tid; idx < 65 * 16 * 2; idx += 512) { const int t1 = idx >> 5, c = (idx >> 1) & 15, c0 = (idx & 1) * 8; float v[8];
#pragma unroll
        for (int j = 0; j < 8; ++j) v[j] = 0.f;
        if (t1 > 0) for (int p = 0; p < 64; ++p) { const f32x2 ap = Apow[(t1 - 1) * 64 + p], cc = Cc[c * 64 + p]; const float cr = cc.x * ap.x - cc.y * ap.y, ci = cc.x * ap.y + cc.y * ap.x;
#pragma unroll
            for (int j = 0; j < 8; ++j) { const f32x2 b = Bb[p * 16 + c0 + j]; v[j] += cr * b.x - ci * b.y; } }
        u32x4 o; o.x = cvt_pk_bf16(v[0], v[1]); o.y = cvt_pk_bf16(v[2], v[3]); o.z = cvt_pk_bf16(v[4], v[5]); o.w = cvt_pk_bf16(v[6], v[7]);
        *(GAS u32x4*)(Kt + (size_t)(t1 * 16 + c) * 16 + c0) = o; }
    __syncthreads();
}

__device__ __forceinline__ void attn_unit(const bf16_t* __restrict__ proj, bf16_t* __restrict__ attn, const float* sinks, int unit, LAS unsigned char* lds, int tid_) {
    const int tid = opaque(tid_);
    const int b = unit >> 7, hk = (unit >> 5) & 3, nb = unit & 31;
    const int wave = __builtin_amdgcn_readfirstlane(tid >> 6), lane = tid & 63, r16 = lane & 15, q4 = lane >> 4;
    LAS unsigned char* Kl = lds;
    LAS unsigned char* Vt = lds + 36864;
    const int gh0 = wave >> 1, half0 = wave & 1, qh0 = hk * 4 + gh0;
    bf16x8 qfa[4][2];
#pragma unroll
    for (int pass = 0; pass < 4; ++pass)
#pragma unroll
        for (int s = 0; s < 2; ++s) qfa[pass][s] = *(const GAS bf16x8*)(proj + (size_t)(b * SEQ + nb * 128 + 16 * (half0 * 4 + pass) + r16) * INW + O_Q + qh0 * 64 + 32 * s + 8 * q4);
#pragma unroll
    for (int i = 0; i < 4; ++i) { const int id = tid + 512 * i, key = id >> 3, ch = id & 7; const int tp = nb * 128 - 128 + key;
        u32x4 kv = {0u, 0u, 0u, 0u}, vv = {0u, 0u, 0u, 0u};
        if (tp >= 0) { const bf16_t* src = proj + (size_t)(b * SEQ + tp) * INW + hk * 64 + ch * 8; kv = *(const GAS u32x4*)(src + O_K); vv = *(const GAS u32x4*)(src + O_V); }
        *(LAS u32x4*)(Kl + key * 144 + ch * 16) = kv;
        LAS bf16_t* vd = (LAS bf16_t*)(Vt + (ch * 8) * 528 + key * 2);
        vd[0 * 264] = (bf16_t)(vv.x & 0xffff); vd[1 * 264] = (bf16_t)(vv.x >> 16); vd[2 * 264] = (bf16_t)(vv.y & 0xffff); vd[3 * 264] = (bf16_t)(vv.y >> 16);
        vd[4 * 264] = (bf16_t)(vv.z & 0xffff); vd[5 * 264] = (bf16_t)(vv.z >> 16); vd[6 * 264] = (bf16_t)(vv.w & 0xffff); vd[7 * 264] = (bf16_t)(vv.w >> 16); }
    __syncthreads();
    const int gh = wave >> 1, half = wave & 1, qh = hk * 4 + gh;
    const float sink = sinks[qh] * LOG2E;
#pragma unroll
    for (int pass = 0; pass < 4; ++pass) {
        const int kt0 = half * 4 + pass, i0 = 16 * kt0, iabs = i0 + r16; const size_t qtok = (size_t)(b * SEQ + nb * 128 + iabs);
        bf16x8 qf[2];
#pragma unroll
        for (int s = 0; s < 2; ++s) qf[s] = qfa[pass][s];
        __builtin_amdgcn_sched_barrier(0);
        f32x4 st[10];
        const LAS unsigned char* kbase = Kl + (16 * kt0 + r16) * 144 + (8 * q4) * 2;
#pragma unroll
        for (int i = 0; i < 9; ++i) { st[i] = (f32x4){0.f, 0.f, 0.f, 0.f};
#pragma unroll
            for (int s = 0; s < 2; ++s) { const bf16x8 kf = *(const LAS bf16x8*)(kbase + i * 16 * 144 + s * 64);
                st[i] = __builtin_amdgcn_mfma_f32_16x16x32_bf16(kf, qf[s], st[i], 0, 0, 0); } }
        st[9] = (f32x4){0.f, 0.f, 0.f, 0.f};
        float mx = sink;
#pragma unroll
        for (int i = 0; i < 9; ++i)
#pragma unroll
            for (int r = 0; r < 4; ++r) { const int jj = 16 * i + 4 * q4 + r; const bool ok = (jj > r16) && (jj <= r16 + 128) && (nb > 0 || jj + i0 >= 128);
                st[i][r] = ok ? st[i][r] : -1e30f; mx = fmaxf(mx, st[i][r]); }
        mx = fmaxf(mx, __shfl_xor(mx, 16)); mx = fmaxf(mx, __shfl_xor(mx, 32));
        float sum = 0.f;
#pragma unroll
        for (int i = 0; i < 9; ++i)
#pragma unroll
            for (int r = 0; r < 4; ++r) { const float p = __builtin_amdgcn_exp2f(st[i][r] - mx); st[i][r] = p; sum += p; }
        sum += __shfl_xor(sum, 16); sum += __shfl_xor(sum, 32);
        const float inv = __builtin_amdgcn_rcpf(sum + __builtin_amdgcn_exp2f(sink - mx));
        f32x4 ot[4];
#pragma unroll
        for (int dt = 0; dt < 4; ++dt) ot[dt] = (f32x4){0.f, 0.f, 0.f, 0.f};
#pragma unroll
        for (int kk = 0; kk < 5; ++kk) {
            u32x4 pw; pw.x = cvt_pk_bf16(st[2 * kk][0], st[2 * kk][1]); pw.y = cvt_pk_bf16(st[2 * kk][2], st[2 * kk][3]); pw.z = cvt_pk_bf16(st[2 * kk + 1][0], st[2 * kk + 1][1]); pw.w = cvt_pk_bf16(st[2 * kk + 1][2], st[2 * kk + 1][3]);
            const bf16x8 pf = __builtin_bit_cast(bf16x8, pw);
            const int t0 = kt0 + 2 * kk, t1 = (t0 + 1) < 15 ? (t0 + 1) : 15;
#pragma unroll
            for (int dt = 0; dt < 4; ++dt) { const LAS unsigned char* vp = Vt + (16 * dt + r16) * 528 + (4 * q4) * 2;
                const u32x2 lo = *(const LAS u32x2*)(vp + t0 * 32), hi = *(const LAS u32x2*)(vp + t1 * 32);
                const u32x4 vw = {lo.x, lo.y, hi.x, hi.y};
                ot[dt] = __builtin_amdgcn_mfma_f32_16x16x32_bf16(__builtin_bit_cast(bf16x8, vw), pf, ot[dt], 0, 0, 0); } }
#pragma unroll
        for (int dt = 0; dt < 4; ++dt) { u32x2 o; o.x = cvt_pk_bf16(ot[dt][0] * inv, ot[dt][1] * inv); o.y = cvt_pk_bf16(ot[dt][2] * inv, ot[dt][3] * inv);
            *(GAS u32x2*)(attn + qtok * 1024 + qh * 64 + 16 * dt + 4 * q4) = o; }
    }
    __syncthreads();
}

constexpr int UPITCH = 2064;
__device__ __forceinline__ void stage_u_issue(const bf16_t* __restrict__ proj, int g, int b, int q, int tid, u32x4 (&uu)[4]) {
#pragma unroll
    for (int i = 0; i < 4; ++i) { const int id = tid + 512 * i, tl = id >> 1, half = id & 1, chunk = tl >> 6, s = tl & 63;
        uu[i] = *(const GAS u32x4*)(proj + (size_t)(b * SEQ + (16 * q + chunk) * 64 + s) * INW + O_U + g * 16 + 8 * half); }
}
__device__ __forceinline__ void stage_u_commit(LAS unsigned char* Al, int tid, u32x4 (&uu)[4]) {
    asm volatile("" : "+v"(uu[0]), "+v"(uu[1]), "+v"(uu[2]), "+v"(uu[3]) :: "memory");
#pragma unroll
    for (int i = 0; i < 4; ++i) { const int id = tid + 512 * i, tl = id >> 1, half = id & 1, chunk = tl >> 6, s = tl & 63;
        *(LAS u32x4*)(Al + chunk * UPITCH + (s * 16 + 8 * half) * 2) = uu[i]; }
}
__device__ __forceinline__ void ssm_s1_unit(const bf16_t* __restrict__ proj, const bf16_t* __restrict__ Et, float* __restrict__ sloc, int g, int b, int q, LAS unsigned char* lds, int tid_) {
    const int tid = opaque(tid_);
    const int wave = __builtin_amdgcn_readfirstlane(tid >> 6), lane = tid & 63, r16 = lane & 15, q4 = lane >> 4;
    const bf16_t* eb = Et + (size_t)(16 * wave + r16) * 1024 + 8 * q4;
    u32x4 uu[4]; stage_u_issue(proj, g, b, q, tid, uu);
    bf16x8 bf[32];
#pragma unroll
    for (int ks = 0; ks < 32; ++ks) bf[ks] = *(const GAS bf16x8*)(eb + 32 * ks);
    stage_u_commit(lds, tid, uu);
    __syncthreads();
    f32x4 acc = {0.f, 0.f, 0.f, 0.f};
#pragma unroll
    for (int ks = 0; ks < 32; ++ks) { const bf16x8 af = *(const LAS bf16x8*)(lds + r16 * UPITCH + (32 * ks + 8 * q4) * 2);
        acc = __builtin_amdgcn_mfma_f32_16x16x32_bf16(af, bf[ks], acc, 0, 0, 0); }
#pragma unroll
    for (int r = 0; r < 4; ++r) sloc[((size_t)(b * 64 + 16 * q + 4 * q4 + r) * 32 + g) * 128 + 16 * wave + r16] = acc[r];
    __syncthreads();
}

__device__ __forceinline__ void ssm_s2_unit(const bf16_t* __restrict__ proj, const unsigned char* __restrict__ tb, const float* __restrict__ sloc, const float* __restrict__ dskip, bf16_t* __restrict__ ybuf,
                                            int g, int b, int q, LAS unsigned char* lds, int tid_) {
    const int tid = opaque(tid_);
    const int wave = __builtin_amdgcn_readfirstlane(tid >> 6), lane = tid & 63, r16 = lane & 15, q4 = lane >> 4;
    LAS unsigned char* Ktl = lds;
    LAS bf16_t* x0l = (LAS bf16_t*)(lds + 33280);
    LAS unsigned char* Al = lds + 49152;
    const bf16_t* Ft = (const bf16_t*)(tb + SSM_F); const GAS f32x2* Pt = (const GAS f32x2*)(tb + SSM_P);
    const int p = tid & 63, part = tid >> 6, j0 = 16 * q;
    f32x2 Pp[6]; float srp[6], sip[6];
#pragma unroll
    for (int ii = 0; ii < 6; ++ii) { const int i = part + 8 * ii; const bool ok = i < j0; const int ic = ok ? i : 0, pc = ok ? (j0 - 1 - i) : 0;
        Pp[ii] = Pt[pc * 64 + p]; const GAS float* sp = (const GAS float*)(sloc + ((size_t)(b * 64 + ic) * 32 + g) * 128); srp[ii] = sp[p]; sip[ii] = sp[64 + p]; }
    u32x4 kt[5];
    { const GAS u32x4* src = (const GAS u32x4*)(tb + SSM_KT);
#pragma unroll
      for (int j = 0; j < 5; ++j) { const int i = tid + 512 * j; kt[j] = src[i < 33280 / 16 ? i : 33280 / 16 - 1]; } }
    u32x4 uu[4]; stage_u_issue(proj, g, b, q, tid, uu);
    const f32x2 A64 = Pt[64 + p];
    float sr[15], si[15];
#pragma unroll
    for (int jq = 0; jq < 15; ++jq) { const GAS float* sp = (const GAS float*)(sloc + ((size_t)(b * 64 + j0 + jq) * 32 + g) * 128); sr[jq] = sp[p]; si[jq] = sp[64 + p]; }
    bf16x8 ff[4][8];
#pragma unroll
    for (int k2 = 0; k2 < 4; ++k2)
#pragma unroll
        for (int tt = 0; tt < 8; ++tt) ff[k2][tt] = *(const GAS bf16x8*)(Ft + (size_t)((wave + 8 * tt) * 16 + r16) * 128 + 32 * k2 + 8 * q4);
    {
        LAS f32x2* red = (LAS f32x2*)(lds + 40960);
        asm volatile("" : "+v"(Pp[0]), "+v"(Pp[1]), "+v"(Pp[2]), "+v"(Pp[3]), "+v"(Pp[4]), "+v"(Pp[5]) :: "memory");
        asm volatile("" : "+v"(srp[0]), "+v"(srp[1]), "+v"(srp[2]), "+v"(srp[3]), "+v"(srp[4]), "+v"(srp[5]), "+v"(sip[0]), "+v"(sip[1]), "+v"(sip[2]), "+v"(sip[3]), "+v"(sip[4]), "+v"(sip[5]) :: "memory");
        float xr = 0.f, xi = 0.f;
#pragma unroll
        for (int ii = 0; ii < 6; ++ii) { const bool ok = part + 8 * ii < j0; const float pr = ok ? Pp[ii].x : 0.f, pi = ok ? Pp[ii].y : 0.f;
            xr += pr * srp[ii] - pi * sip[ii]; xi += pr * sip[ii] + pi * srp[ii]; }
        red[part * 64 + p] = (f32x2){xr, xi};
        asm volatile("" : "+v"(kt[0]), "+v"(kt[1]), "+v"(kt[2]), "+v"(kt[3]), "+v"(kt[4]) :: "memory");
#pragma unroll
        for (int j = 0; j < 5; ++j) { const int i = tid + 512 * j; if (i < 33280 / 16) *(LAS u32x4*)(Ktl + i * 16) = kt[j]; }
        stage_u_commit(Al, tid, uu);
        __syncthreads();
        if (part == 0) {
            float ar = 0.f, ai = 0.f;
#pragma unroll
            for (int w8 = 0; w8 < 8; ++w8) { const f32x2 t = red[w8 * 64 + p]; ar += t.x; ai += t.y; }
#pragma unroll
            for (int jq = 0; jq < 16; ++jq) {
                x0l[jq * 136 + p] = (bf16_t)(cvt_pk_bf16(ar, 0.f) & 0xffff); x0l[jq * 136 + 64 + p] = (bf16_t)(cvt_pk_bf16(ai, 0.f) & 0xffff);
                if (jq < 15) { const float nr = A64.x * ar - A64.y * ai + sr[jq], ni = A64.x * ai + A64.y * ar + si[jq]; ar = nr; ai = ni; } }
        }
    }
    __syncthreads();
    f32x4 acc[8];
#pragma unroll
    for (int tt = 0; tt < 8; ++tt) acc[tt] = (f32x4){0.f, 0.f, 0.f, 0.f};
#pragma unroll 2
    for (int ks = 0; ks < 32; ++ks) { const int s = 2 * ks + (q4 >> 1);
        const bf16x8 af = *(const LAS bf16x8*)(Al + r16 * UPITCH + (32 * ks + 8 * q4) * 2);
#pragma unroll
        for (int tt = 0; tt < 8; ++tt) { const int t = wave + 8 * tt;
            const int tau1 = t - s + 1, tc = tau1 > 0 ? tau1 : 0;
            const bf16x8 bf = *(const LAS bf16x8*)(Ktl + ((tc * 16 + r16) * 16 + 8 * (q4 & 1)) * 2);
            acc[tt] = __builtin_amdgcn_mfma_f32_16x16x32_bf16(af, bf, acc[tt], 0, 0, 0); }
        __builtin_amdgcn_sched_barrier(0); }
#pragma unroll
    for (int k2 = 0; k2 < 4; ++k2) { const bf16x8 ax = *(const LAS bf16x8*)(x0l + r16 * 136 + 32 * k2 + 8 * q4);
#pragma unroll
        for (int tt = 0; tt < 8; ++tt) acc[tt] = __builtin_amdgcn_mfma_f32_16x16x32_bf16(ax, ff[k2][tt], acc[tt], 0, 0, 0); }
    const float dsk = dskip[g * 16 + r16];
#pragma unroll
    for (int tt = 0; tt < 8; ++tt) { const int t = wave + 8 * tt;
#pragma unroll
        for (int r = 0; r < 4; ++r) { const int jq = 4 * q4 + r; const size_t tok = (size_t)(b * SEQ + (16 * q + jq) * 64 + t);
            const float uv = bf1(*(const LAS bf16_t*)(Al + jq * UPITCH + (t * 16 + r16) * 2)); const float y = acc[tt][r] + dsk * uv;
            const float z = 0.7978845608028654f * (y + 0.044715f * y * y * y); const float gl = y * fast_sigmoid(2.0f * z);
            ybuf[tok * 512 + g * 16 + r16] = (bf16_t)(cvt_pk_bf16(gl, 0.f) & 0xffff); } }
    __syncthreads();
}

__device__ __forceinline__ unsigned char* opaque_p(unsigned char* p) { asm volatile("" : "+s"(p)); return p; }
#define PH_BEGIN const int tid = opaque((int)threadIdx.x), lane = tid & 63, wave = __builtin_amdgcn_readfirstlane(tid >> 6); unsigned char* const ws = opaque_p(args.ws); (void)lane; (void)wave; \
    bf16_t* const hbuf = (bf16_t*)(ws + WS_H); bf16_t* const proj = (bf16_t*)(ws + WS_PROJ); float* const mod = (float*)(ws + WS_MOD); float* const xbuf = args.out; unsigned* const ctl = (unsigned*)(ws + WS_CTL); \
    (void)hbuf; (void)proj; (void)mod; (void)xbuf; (void)ctl;

__global__ void __launch_bounds__(NWAVES * 64, 2) mega_fwd(Args args) {
    extern __shared__ __attribute__((aligned(16))) unsigned char lds_raw[];
    LAS unsigned char* lds = (LAS unsigned char*)lds_raw;
    const int G = gridDim.x, blk = blockIdx.x;
    XcdBarrier bar;
    {
        volatile LAS unsigned* MISC = (volatile LAS unsigned*)(lds + MISC_OFF);
        unsigned* ctl0 = (unsigned*)(args.ws + WS_CTL);
        for (int u = threadIdx.x; u < (LDS_BYTES - LDSCTL_OFF) / 4; u += NWAVES * 64) ((LAS unsigned*)(lds + LDSCTL_OFF))[u] = 0u;
        __syncthreads();
        bar.bar = ctl0 + CW_BAR; bar.x = 0; bar.st = nullptr;
        if (N_LAUNCHES == 1) bar = xcd_barrier_post(ctl0 + CW_BAR, MISC + 8);
    }
#define GRID_BAR() do { if (N_LAUNCHES == 1) xcd_barrier(bar); } while (0)
    const int lo = args.ph_lo, hi = args.ph_hi;
#ifndef PH_MASK
#define PH_MASK 0x7ff
#endif
#ifndef REP_MASK
#define REP_MASK 0
#endif
#ifndef REP_VARIANT
#define REP_VARIANT 0
#endif
#define REPS(bit) (((REP_MASK) >> (bit)) & 1 ? 2 : 1)
#define IN(k) (lo <= (k) && (k) < hi)
#define BOTH(k) (IN(k) && IN((k) + 1))

    if ((PH_MASK & 1) && IN(0)) {
        PH_BEGIN
            _Pragma("unroll 1") for (int rep = 0; rep < REPS(9); ++rep) {
        if (blk < 64) ssm_tables(args, blk >> 5, blk & 31, lds, tid);
        LAS float* scr = (LAS float*)(lds + wave * 16384);
        for (int idx = blk * 512 + tid; idx < 2 * 64 * 256; idx += G * 512) {
            const int e = idx & 63, kc = (idx >> 6) & 255, l = idx >> 14; const float* wsrc = args.in[I_WR] + (size_t)l * D * NE + (size_t)(8 * kc) * NE + e;
            float w[8], lo[8]; unsigned hi[4];
#pragma unroll
            for (int i = 0; i < 8; ++i) w[i] = wsrc[i * NE];
#pragma unroll
            for (int i = 0; i < 4; ++i) { hi[i] = cvt_pk_bf16(w[2 * i], w[2 * i + 1]); lo[2 * i] = w[2 * i] - bf_lo(hi[i]); lo[2 * i + 1] = w[2 * i + 1] - bf_hi(hi[i]); }
            bf16_t* dsth = (bf16_t*)(ws + WS_WRT) + ((size_t)(l * 2) * 64 + e) * 2048 + 8 * kc;
            *(GAS u32x4*)dsth = (u32x4){hi[0], hi[1], hi[2], hi[3]};
            *(GAS u32x4*)(dsth + 64 * 2048) = (u32x4){cvt_pk_bf16(lo[0], lo[1]), cvt_pk_bf16(lo[2], lo[3]), cvt_pk_bf16(lo[4], lo[5]), cvt_pk_bf16(lo[6], lo[7])}; }
        for (int it = blk; it < IT_MOD; it += G) mod_item(args, it, tid, lds);
        p0_items(args, blk * NWAVES + wave, G * NWAVES, scr, lane);
            if (rep + 1 < REPS(9)) GRID_BAR(); }
        if (BOTH(0)) GRID_BAR();
    }
    if ((PH_MASK & 2) && IN(1)) {
        PH_BEGIN
        const float* modp = (const float*)(ws + WS_MODP);
        for (int idx = blk * 512 + tid; idx < 2 * 2 * 12288; idx += G * 512) { const int l = idx / 24576, c = idx % 12288; float s = args.in[I_BADA][l * 12288 + c];
#pragma unroll
            for (int ks = 0; ks < 8; ++ks) s += modp[(size_t)ks * 49152 + idx];
            mod[idx] = s; }
        for (int rb = blk; rb < T / 32; rb += G) {
            const int bb = (rb * 32) / SEQ;
            LAS float* shl = (LAS float*)lds; LAS float* scl = shl + 2048;
            for (int c = tid; c < 4096; c += 512) { float s = args.in[I_BADA][c];
#pragma unroll
                for (int ks = 0; ks < 8; ++ks) s += modp[(size_t)ks * 49152 + bb * 12288 + c];
                shl[c] = s; }
            __syncthreads();
#pragma unroll 1
            for (int pr = 0; pr < 2; ++pr) {
                f32x4 v[2][4][2]; float ss[2] = {0.f, 0.f};
#pragma unroll
                for (int rr = 0; rr < 2; ++rr) { const float* xr = args.in[I_X] + (size_t)(rb * 32 + wave * 4 + pr * 2 + rr) * D;
#pragma unroll
                    for (int j = 0; j < 4; ++j)
#pragma unroll
                        for (int h = 0; h < 2; ++h) v[rr][j][h] = *(const GAS f32x4*)(xr + 8 * (lane + 64 * j) + 4 * h); }
#pragma unroll
                for (int rr = 0; rr < 2; ++rr)
#pragma unroll
                    for (int j = 0; j < 4; ++j)
#pragma unroll
                        for (int h = 0; h < 2; ++h) ss[rr] += v[rr][j][h][0] * v[rr][j][h][0] + v[rr][j][h][1] * v[rr][j][h][1] + v[rr][j][h][2] * v[rr][j][h][2] + v[rr][j][h][3] * v[rr][j][h][3];
#pragma unroll
                for (int rr = 0; rr < 2; ++rr) { const int row = rb * 32 + wave * 4 + pr * 2 + rr;
                    const float rstd = 1.0f / sqrtf(wave_sum(ss[rr]) * (1.0f / D) + NORM_EPS);
                    bf16_t* hrow = hbuf + (size_t)row * D;
#pragma unroll
                    for (int j = 0; j < 4; ++j) { const int c = 8 * (lane + 64 * j); f32x4 o[2];
#pragma unroll
                        for (int h = 0; h < 2; ++h) { const f32x4 g = *(const GAS f32x4*)(args.in[I_NMIX] + c + 4 * h); const f32x4 s1 = *(const LAS f32x4*)(scl + c + 4 * h), s0 = *(const LAS f32x4*)(shl + c + 4 * h);
                            o[h] = v[rr][j][h] * rstd * g * (s1 + 1.0f) + s0; }
                        *(GAS u32x4*)(hrow + c) = pg8::pack8(o[0], o[1]); } } }
            __syncthreads();
        }
        if (BOTH(1)) GRID_BAR();
    }

#pragma unroll 1
    for (int l = 0; l < DEPTH; ++l) {
        const int pb = 2 + 9 * l;
        if ((PH_MASK & 4) && IN(pb + 0)) {
            PH_BEGIN
            _Pragma("unroll 1") for (int rep = 0; rep < REPS(0); ++rep) {
            pg8::DenseOrder S; S.init(T, INW, D, G, blk, (bf16_t*)(ws + WS_WIN) + (size_t)l * INW * D);
            pg8::EpiInProj E{proj, args.in[I_BIN] + l * INW, 0.125f * LOG2E, (REP_VARIANT && rep == 1) ? 1 : 0};
            pg8::gemm_phase<pg8::EpiInProj, pg8::DenseOrder, GEMM_ALIGN>(lds, (const char*)hbuf, D, S, E);
            if (rep + 1 < REPS(0)) GRID_BAR(); }
            if (BOTH(pb + 0)) GRID_BAR();
        }
        if ((PH_MASK & 8) && IN(pb + 1)) {
            PH_BEGIN
            _Pragma("unroll 1") for (int rep = 0; rep < REPS(1); ++rep) {
            for (int u = blk; u < 256; u += G) attn_unit(proj, (bf16_t*)(ws + WS_ATTN), args.in[I_SINK] + l * 16, u, lds, tid);
            if (!(REP_VARIANT == 1 && rep == 1)) for (int u = blk; u < 256; u += G) { const int g = u >> 3, b = (u >> 2) & 1, q = u & 3;
                ssm_s1_unit(proj, (const bf16_t*)(ws + WS_SSM + (size_t)(l * 32 + g) * SSM_STRIDE + SSM_E), (float*)(ws + WS_SLOC), g, b, q, lds, tid); }
            if (rep + 1 < REPS(1)) GRID_BAR(); }
            if (BOTH(pb + 1)) GRID_BAR();
        }
        if ((PH_MASK & 16) && IN(pb + 2)) {
            PH_BEGIN
            _Pragma("unroll 1") for (int rep = 0; rep < REPS(2); ++rep) {
            if (!(REP_VARIANT == 1 && rep == 1)) for (int u = blk; u < 256; u += G) { const int g = u >> 3, b = (u >> 2) & 1, q = u & 3;
                ssm_s2_unit(proj, ws + WS_SSM + (size_t)(l * 32 + g) * SSM_STRIDE, (const float*)(ws + WS_SLOC), args.in[I_SD] + l * 512, (bf16_t*)(ws + WS_Y), g, b, q, lds, tid); }
            pg8::DenseOrder S; S.init(T, D, 1024, G, blk, (bf16_t*)(ws + WS_WO) + (size_t)l * D * 1024);
            pg8::EpiAttnProj E{proj, (bf16_t*)(ws + WS_MIXED)};
            pg8::gemm_phase<pg8::EpiAttnProj, pg8::DenseOrder>(lds, (const char*)(ws + WS_ATTN), 1024, S, E);
            if (rep + 1 < REPS(2)) GRID_BAR(); }
            if (BOTH(pb + 2)) GRID_BAR();
        }
        if ((PH_MASK & 32) && IN(pb + 3)) {
            PH_BEGIN
            const int nrep = REPS(3);
            _Pragma("unroll 1") for (int rep = 0; rep < nrep; ++rep) {
            pg8::DenseOrder S; S.init(T, 4096, 512, G, blk, (bf16_t*)(ws + WS_WGLU) + (size_t)l * 4096 * 512);
            pg8::EpiGlu E{proj, (const bf16_t*)(ws + WS_MIXED), (bf16_t*)(ws + WS_MIXED2)};
            pg8::gemm_phase<pg8::EpiGlu, pg8::DenseOrder, GEMM_ALIGN>(lds, (const char*)(ws + WS_Y), 512, S, E);
            if (rep + 1 < nrep) GRID_BAR(); }
            if (BOTH(pb + 3)) GRID_BAR();
        }
        if ((PH_MASK & 64) && IN(pb + 4)) {
            PH_BEGIN
            const int nrep = (l == 0 ? REPS(4) : 1);
            _Pragma("unroll 1") for (int rep = 0; rep < nrep; ++rep) {
            pg8::DenseOrder S; S.init(T, D, D, G, blk, (bf16_t*)(ws + WS_WMIX) + (size_t)l * D * D);
            pg8::EpiMixOut E{l == 0 ? args.in[I_X] : (const float*)nullptr, (const bf16_t*)(ws + WS_XB), (bf16_t*)(ws + WS_XB), mod + (size_t)l * 2 * 12288 + 2 * 2048};
            pg8::gemm_phase<pg8::EpiMixOut, pg8::DenseOrder>(lds, (const char*)(ws + WS_MIXED2), D, S, E);
            if (rep + 1 < nrep) GRID_BAR(); }
            if (BOTH(pb + 4)) GRID_BAR();
        }
        if ((PH_MASK & 128) && IN(pb + 5)) {
            PH_BEGIN
            const int nrep = REPS(5);
            _Pragma("unroll 1") for (int rep = 0; rep < nrep; ++rep) {
            const float* modl = mod + (size_t)l * 2 * 12288;
            int* ltok = (int*)(ws + WS_LTOK); int* ldst = (int*)(ws + WS_LDST); float* lw = (float*)(ws + WS_LW);
            LAS unsigned long long* selmask = (LAS unsigned long long*)(lds + SEL_OFF);
            LAS float* selw = (LAS float*)(lds + SEL_OFF + 256);
            const float* wrt = args.in[I_WR] + (size_t)l * D * NE; const float brt = args.in[I_BR][l * NE + lane];
            for (int rb = blk; rb < T / 32; rb += G) {
                const int bb = (rb * 32) / SEQ; const float* sh2 = modl + bb * 12288 + 3 * 2048; const float* sc2 = sh2 + 2048;
#pragma unroll 1
                for (int it = 0; it < 2; ++it) {
                    {
                        f32x4 v[2][4][2]; float ss[2] = {0.f, 0.f};
                        u32x4 xw[2][4]; f32x4 gsc[4][2], gsh[4][2], sc1[4][2];
#pragma unroll
                        for (int rr = 0; rr < 2; ++rr) { const bf16_t* xr = (const bf16_t*)(ws + WS_XB) + (size_t)(rb * 32 + it * 16 + 2 * wave + rr) * D;
#pragma unroll
                            for (int j = 0; j < 4; ++j) xw[rr][j] = *(const GAS u32x4*)(xr + 8 * (lane + 64 * j)); }
#pragma unroll
                        for (int j = 0; j < 4; ++j)
#pragma unroll
                            for (int h = 0; h < 2; ++h) { const int c = 8 * (lane + 64 * j) + 4 * h;
                                gsc[j][h] = *(const GAS f32x4*)(args.in[I_NFFN] + l * D + c); sc1[j][h] = *(const GAS f32x4*)(sc2 + c); gsh[j][h] = *(const GAS f32x4*)(sh2 + c); }
#pragma unroll
                        for (int rr = 0; rr < 2; ++rr) asm volatile("" : "+v"(xw[rr][0]), "+v"(xw[rr][1]), "+v"(xw[rr][2]), "+v"(xw[rr][3]) :: "memory");
#pragma unroll
                        for (int j = 0; j < 4; ++j) asm volatile("" : "+v"(gsc[j][0]), "+v"(gsc[j][1]), "+v"(sc1[j][0]), "+v"(sc1[j][1]), "+v"(gsh[j][0]), "+v"(gsh[j][1]) :: "memory");
#pragma unroll
                        for (int rr = 0; rr < 2; ++rr)
#pragma unroll
                            for (int j = 0; j < 4; ++j) pg8::unpack8(xw[rr][j], v[rr][j][0], v[rr][j][1]);
#pragma unroll
                        for (int j = 0; j < 4; ++j)
#pragma unroll
                            for (int h = 0; h < 2; ++h) gsc[j][h] = gsc[j][h] * (sc1[j][h] + 1.0f);
#pragma unroll
                        for (int rr = 0; rr < 2; ++rr)
#pragma unroll
                            for (int j = 0; j < 4; ++j)
#pragma unroll
                                for (int h = 0; h < 2; ++h) ss[rr] += v[rr][j][h][0] * v[rr][j][h][0] + v[rr][j][h][1] * v[rr][j][h][1] + v[rr][j][h][2] * v[rr][j][h][2] + v[rr][j][h][3] * v[rr][j][h][3];
#pragma unroll
                        for (int rr = 0; rr < 2; ++rr) { const int lr = 2 * wave + rr, row = rb * 32 + it * 16 + lr;
                            const float rstd = 1.0f / sqrtf(wave_sum(ss[rr]) * (1.0f / D) + NORM_EPS);
                            unsigned char* hrow8 = (unsigned char*)hbuf + (size_t)row * D;
#pragma unroll
                            for (int j = 0; j < 4; ++j) { const int c = 8 * (lane + 64 * j); f32x4 o[2];
#pragma unroll
                                for (int h = 0; h < 2; ++h) o[h] = v[rr][j][h] * rstd * gsc[j][h] + gsh[j][h];
                                const u32x4 hiw = pg8::pack8(o[0], o[1]); *(GAS u32x2*)(hrow8 + c) = (u32x2){pg8::pk_fp8x4(o[0]), pg8::pk_fp8x4(o[1])};
                                f32x4 h0, h1; pg8::unpack8(hiw, h0, h1); const u32x4 low = pg8::pack8(o[0] - h0, o[1] - h1);
                                const int so = lr * 4096 + (((lane + 64 * j) ^ lr) << 4);
                                *(LAS u32x4*)(lds + so) = hiw; *(LAS u32x4*)(lds + 65536 + so) = low; } }
                    }
                    f32x4 racc[4];
                    {
                        const GAS bf16_t* whi = (const GAS bf16_t*)(ws + WS_WRT) + (size_t)(l * 2) * 64 * 2048 + 256 * wave; const GAS bf16_t* wlo = whi + 64 * 2048;
                        const int lop = opaque(lane), r16 = lop & 15, q4 = lop >> 4;
#pragma unroll
                        for (int nt = 0; nt < 4; ++nt) racc[nt] = (f32x4){0.f, 0.f, 0.f, 0.f};
                        auto ldB = [&](int kp, bf16x8 (&bh)[2][4], bf16x8 (&bl)[2][4]) {
#pragma unroll
                            for (int k2 = 0; k2 < 2; ++k2)
#pragma unroll
                                for (int nt = 0; nt < 4; ++nt) { const size_t wo = (size_t)(16 * nt + r16) * 2048 + 32 * (2 * kp + k2) + 8 * q4; bh[k2][nt] = *(const GAS bf16x8*)(whi + wo); bl[k2][nt] = *(const GAS bf16x8*)(wlo + wo); } };
                        auto mm = [&](int kp, const bf16x8 (&bh)[2][4], const bf16x8 (&bl)[2][4]) {
#pragma unroll
                            for (int k2 = 0; k2 < 2; ++k2) { const int chunk = 32 * wave + 4 * (2 * kp + k2) + q4, so = r16 * 4096 + ((chunk ^ r16) << 4);
                                const bf16x8 ah = *(const LAS bf16x8*)(lds + so), al = *(const LAS bf16x8*)(lds + 65536 + so);
#pragma unroll
                                for (int nt = 0; nt < 4; ++nt) {
                                    racc[nt] = __builtin_amdgcn_mfma_f32_16x16x32_bf16(ah, bh[k2][nt], racc[nt], 0, 0, 0);
                                    racc[nt] = __builtin_amdgcn_mfma_f32_16x16x32_bf16(al, bh[k2][nt], racc[nt], 0, 0, 0);
                                    racc[nt] = __builtin_amdgcn_mfma_f32_16x16x32_bf16(ah, bl[k2][nt], racc[nt], 0, 0, 0); } } };
#define RT_FENCE() asm volatile("" ::: "memory")
#define RT_PIN() asm volatile("" : "+v"(racc[0]), "+v"(racc[1]), "+v"(racc[2]), "+v"(racc[3]) :: "memory")
                        bf16x8 bhA[2][4], blA[2][4], bhB[2][4], blB[2][4];
                        RT_FENCE(); ldB(0, bhA, blA); ldB(1, bhB, blB); RT_FENCE();
                        __syncthreads();
                        mm(0, bhA, blA); RT_PIN(); ldB(2, bhA, blA); RT_FENCE();
                        mm(1, bhB, blB); RT_PIN(); ldB(3, bhB, blB); RT_FENCE();
                        mm(2, bhA, blA); mm(3, bhB, blB);
#undef RT_FENCE
#undef RT_PIN
                    }
                    __syncthreads();
                    LAS float* part = (LAS float*)lds;
#pragma unroll
                    for (int nt = 0; nt < 4; ++nt)
#pragma unroll
                        for (int r = 0; r < 4; ++r) part[(wave * 16 + 4 * (lane >> 4) + r) * 64 + 16 * nt + (lane & 15)] = racc[nt][r];
                    __syncthreads();
#pragma unroll 1
                    for (int rr = 0; rr < 2; ++rr) { const int lr = 2 * wave + rr; float logit = 0.f;
#pragma unroll
                        for (int w8 = 0; w8 < 8; ++w8) logit += part[(w8 * 16 + lr) * 64 + lane];
                        const float score = 1.0f / (1.0f + __expf(-logit)); const float sel = score + brt;
                        float m1 = sel; m1 = fmaxf(m1, __shfl_xor(m1, 1)); m1 = fmaxf(m1, __shfl_xor(m1, 2)); m1 = fmaxf(m1, __shfl_xor(m1, 4));
                        const unsigned long long bm = __ballot(sel == m1); const unsigned gb = (unsigned)(bm >> (lane & 56)) & 0xffu; const int first = __builtin_ctz(gb);
                        float v2 = ((lane & 7) == first) ? -3.0e38f : sel; v2 = fmaxf(v2, __shfl_xor(v2, 1)); v2 = fmaxf(v2, __shfl_xor(v2, 2)); v2 = fmaxf(v2, __shfl_xor(v2, 4));
                        const float gs = m1 + v2; int grank = 0; const int mygrp = lane >> 3;
#pragma unroll
                        for (int gg = 0; gg < 8; ++gg) { const float o = __shfl(gs, gg * 8); grank += (o > gs || (o == gs && gg < mygrp)) ? 1 : 0; }
                        float val = grank < 4 ? sel : -3.0e38f; unsigned long long cm = 0ull;
#pragma unroll
                        for (int pick = 0; pick < 8; ++pick) {
                            float mxv = val;
#pragma unroll
                            for (int o = 1; o < 64; o <<= 1) mxv = fmaxf(mxv, __shfl_xor(mxv, o));
                            const unsigned long long bmx = __ballot(val == mxv); const int sl = __builtin_ctzll(bmx);
                            cm |= 1ull << sl; if (lane == sl) val = -3.4e38f; }
                        const bool chosen = (cm >> lane) & 1ull; const float sw = wave_sum(chosen ? score : 0.f);
                        const int gr = it * 16 + lr;
                        selw[gr * 64 + lane] = chosen ? score / sw * 2.5f : 0.f;
                        if (lane == 0) selmask[gr] = cm; }
                    __syncthreads();
                }
                if (wave == 0 && rep + 1 == nrep) {
                    int cntl = 0;
                    for (int r = 0; r < 32; ++r) cntl += (int)((selmask[r] >> lane) & 1ull);
                    int pos = cntl ? (int)atomicAdd(ctl + CW_CNT + l * 64 + lane, (unsigned)cntl) : 0;
                    for (int r = 0; r < 32; ++r) { const unsigned long long m = selmask[r];
                        if ((m >> lane) & 1ull) { const int k = __builtin_popcountll(m & ((1ull << lane) - 1ull)); const int tok = rb * 32 + r; const int li = lane * 8192 + pos;
                            ltok[li] = tok; ldst[li] = tok * NSLOT + k; ((float*)(ws + WS_TOKW))[tok * 8 + k] = selw[r * 64 + lane]; ++pos; } }
                }
                __syncthreads();
            }
            if (rep + 1 < nrep) GRID_BAR(); }
            if (BOTH(pb + 5)) GRID_BAR();
        }
        if ((PH_MASK & 256) && IN(pb + 6)) {
            PH_BEGIN
            _Pragma("unroll 1") for (int rep = 0; rep < REPS(6); ++rep) {
            LAS int* tpre = (LAS int*)(lds + MOE_OFF); LAS int* ebase = tpre + 65; LAS int* ecnt = ebase + 65; LAS int* utab = (LAS int*)(lds + MOE_OFF + 1024);
            pg8::moe_build<4, true>(tpre, ebase, ecnt, utab, ctl + CW_CNT + l * 64, G, blk, tid);
            pg8::MoeOrder<4, true> S{utab, (const char*)(ws + WS_WGU + (size_t)l * 65 * 1024 * 2048), (size_t)1024 * 2048, (size_t)256 * 2048, (const int*)(ws + WS_LTOK)};
            pg8::EpiGateUp E{(bf16_t*)(ws + WS_HID)};
            pg8::gemm_phase<pg8::EpiGateUp, pg8::MoeOrder<4, true>, GEMM_ALIGN, GEMM_SP2, true>(lds, (const char*)hbuf, D / 2, S, E);
            if (rep + 1 < REPS(6)) GRID_BAR(); }
            if (BOTH(pb + 6)) GRID_BAR();
        }
        if ((PH_MASK & 512) && IN(pb + 7)) {
            PH_BEGIN
            _Pragma("unroll 1") for (int rep = 0; rep < REPS(7); ++rep) {
            LAS int* tpre = (LAS int*)(lds + MOE_OFF); LAS int* ebase = tpre + 65; LAS int* ecnt = ebase + 65; LAS int* utab = (LAS int*)(lds + MOE_OFF + 1024);
            pg8::moe_build<8, false>(tpre, ebase, ecnt, utab, ctl + CW_CNT + l * 64, G, blk, tid);
            pg8::MoeOrder<8, false> S{utab, (const char*)((bf16_t*)(ws + WS_WD) + (size_t)l * 65 * 2048 * 512), (size_t)2048 * 512 * 2, (size_t)256 * 512 * 2, (const int*)(ws + WS_LTOK)};
            pg8::EpiDown E{(unsigned char*)(ws + WS_YSLOT), (const int*)(ws + WS_LDST), (LAS int*)(lds + SEL_OFF), (REP_VARIANT && rep == 1) ? 1 : 0};
            pg8::gemm_phase<pg8::EpiDown, pg8::MoeOrder<8, false>, GEMM_ALIGN>(lds, (const char*)(ws + WS_HID), 512, S, E);
            if (rep + 1 < REPS(7)) GRID_BAR(); }
            if (BOTH(pb + 7)) GRID_BAR();
        }
        if ((PH_MASK & 1024) && IN(pb + 8)) {
            PH_BEGIN
            const int nrep = REPS(8);
            _Pragma("unroll 1") for (int rep = 0; rep < nrep; ++rep) {
            const float* modl = mod + (size_t)l * 2 * 12288;
            const unsigned char* yslot = (const unsigned char*)(ws + WS_YSLOT);
            for (int run = blk * NWAVES + wave; run < T / 4; run += G * NWAVES) {
                const int bb = (run * 4) / SEQ; const float* gt2 = modl + bb * 12288 + 5 * 2048;
                const float* m1 = mod + (size_t)2 * 12288 + bb * 12288;
                f32x4 gtv[2][4];
#pragma unroll
                for (int jj = 0; jj < 2; ++jj)
#pragma unroll
                    for (int q = 0; q < 4; ++q) { const int c = 16 * (lane + 64 * jj) + 4 * q; gtv[jj][q] = *(const GAS f32x4*)(gt2 + c) * pg8::YS_INV; }
#pragma unroll 1
                for (int pr = 0; pr < 2; ++pr) {
                    f32x4 v[2][2][4]; float ss[2] = {0.f, 0.f};
                    const int rowb = run * 4 + pr * 2;
                    f32x4 tw[2][2];
#pragma unroll
                    for (int rr = 0; rr < 2; ++rr) { tw[rr][0] = *(const GAS f32x4*)((const float*)(ws + WS_TOKW) + (rowb + rr) * 8); tw[rr][1] = *(const GAS f32x4*)((const float*)(ws + WS_TOKW) + (rowb + rr) * 8 + 4); }
                    auto issue = [&](int rr, int jj, u32x4 (&w)[NSLOT], u32x4 (&xq)[2]) {
                        const int c = 16 * (lane + 64 * jj); const unsigned char* ys = yslot + (size_t)(rowb + rr) * NSLOT * D + c;
#pragma unroll
                        for (int k = 0; k < NSLOT; ++k) w[k] = *(const GAS u32x4*)(ys + (size_t)k * D);
                        const bf16_t* xr = (const bf16_t*)(ws + WS_XB) + (size_t)(rowb + rr) * D + c; xq[0] = *(const GAS u32x4*)xr; xq[1] = *(const GAS u32x4*)(xr + 8); };
                    auto consume = [&](int rr, int jj, const u32x4 (&w)[NSLOT], const u32x4 (&xq)[2]) {
                        f32x4 a[4];
#pragma unroll
                        for (int q = 0; q < 4; ++q) a[q] = (f32x4){0.f, 0.f, 0.f, 0.f};
#pragma unroll
                        for (int k = 0; k < NSLOT; ++k) { const float wk = k < 8 ? tw[rr][k >> 2][k & 3] : 1.0f;
#pragma unroll
                            for (int q = 0; q < 4; ++q) { const f32x2 lo = __builtin_amdgcn_cvt_pk_f32_fp8((int)w[k][q], false), hi = __builtin_amdgcn_cvt_pk_f32_fp8((int)w[k][q], true); a[q] += (f32x4){lo.x, lo.y, hi.x, hi.y} * wk; } }
                        f32x4 xv[4]; pg8::unpack8(xq[0], xv[0], xv[1]); pg8::unpack8(xq[1], xv[2], xv[3]);
#pragma unroll
                        for (int q = 0; q < 4; ++q) { v[rr][jj][q] = xv[q] + gtv[jj][q] * a[q];
                            ss[rr] += v[rr][jj][q][0] * v[rr][jj][q][0] + v[rr][jj][q][1] * v[rr][jj][q][1] + v[rr][jj][q][2] * v[rr][jj][q][2] + v[rr][jj][q][3] * v[rr][jj][q][3]; } };
                    {
                        u32x4 wA[NSLOT], xA[2], wB[NSLOT], xB[2];
#define CMB_FENCE() asm volatile("" ::: "memory")
#define CMB_PIN(x) asm volatile("" : "+v"(x) :: "memory")
                        issue(0, 0, wA, xA); issue(0, 1, wB, xB); CMB_FENCE();
                        consume(0, 0, wA, xA); CMB_PIN(ss[0]); issue(1, 0, wA, xA); CMB_FENCE();
                        consume(0, 1, wB, xB); CMB_PIN(ss[0]); issue(1, 1, wB, xB); CMB_FENCE();
                        consume(1, 0, wA, xA); consume(1, 1, wB, xB); CMB_PIN(ss[1]);
#undef CMB_FENCE
#undef CMB_PIN
                    }
                    f32x4 gs[2][4], gh[2][4];
                    if (l == 0) {
#pragma unroll
                        for (int jj = 0; jj < 2; ++jj)
#pragma unroll
                            for (int q = 0; q < 4; ++q) { const int c = 16 * (lane + 64 * jj) + 4 * q;
                                gs[jj][q] = *(const GAS f32x4*)(args.in[I_NMIX] + D + c) * (*(const GAS f32x4*)(m1 + 2048 + c) + 1.0f); gh[jj][q] = *(const GAS f32x4*)(m1 + c); }
                    } else {
#pragma unroll
                        for (int jj = 0; jj < 2; ++jj)
#pragma unroll
                            for (int q = 0; q < 4; ++q) { const int c = 16 * (lane + 64 * jj) + 4 * q; gs[jj][q] = *(const GAS f32x4*)(args.in[I_NFIN] + c); gh[jj][q] = (f32x4){0.f, 0.f, 0.f, 0.f}; }
                    }
#pragma unroll
                    for (int rr = 0; rr < 2; ++rr) { const int row = rowb + rr;
                        const float rstd = 1.0f / sqrtf(wave_sum(ss[rr]) * (1.0f / D) + NORM_EPS);
                        float* xw = (rep + 1 == nrep) ? xbuf + (size_t)row * D : (float*)(ws + WS_HID) + (size_t)row * D; bf16_t* hw = (rep + 1 == nrep) ? hbuf + (size_t)row * D : (bf16_t*)(ws + WS_MIXED2) + (size_t)row * D;
                        bf16_t* xbw = (rep + 1 == nrep) ? (bf16_t*)(ws + WS_XB) + (size_t)row * D : (bf16_t*)(ws + WS_MIXED) + (size_t)row * D;
                        if (l == 0) {
#pragma unroll
                            for (int jj = 0; jj < 2; ++jj) { const int c = 16 * (lane + 64 * jj); f32x4 o[4];
                                *(GAS u32x4*)(xbw + c) = pg8::pack8(v[rr][jj][0], v[rr][jj][1]); *(GAS u32x4*)(xbw + c + 8) = pg8::pack8(v[rr][jj][2], v[rr][jj][3]);
#pragma unroll
                                for (int q = 0; q < 4; ++q) o[q] = v[rr][jj][q] * rstd * gs[jj][q] + gh[jj][q];
                                *(GAS u32x4*)(hw + c) = pg8::pack8(o[0], o[1]); *(GAS u32x4*)(hw + c + 8) = pg8::pack8(o[2], o[3]); }
                        } else {
#pragma unroll
                            for (int jj = 0; jj < 2; ++jj) { const int c = 16 * (lane + 64 * jj);
#pragma unroll
                                for (int q = 0; q < 4; ++q) *(GAS f32x4*)(xw + c + 4 * q) = v[rr][jj][q] * rstd * gs[jj][q]; }
                        } }
                }
            }
            if (rep + 1 < nrep) GRID_BAR(); }
            if (BOTH(pb + 8)) GRID_BAR();
        }
    }
#undef IN
#undef BOTH
#undef GRID_BAR
}

extern "C" void kernel_launch(void* const* d_in, const int* in_sizes, int n_in, void* d_out, int out_size, void* d_ws, size_t ws_size, hipStream_t stream) {
    static int grid = 0;
    if (grid == 0) {
        if (n_in != 29 || out_size != T * D || ws_size < WS_END) { fprintf(stderr, "kernel_launch: unexpected shapes (n_in %d out %d ws %zu)\n", n_in, out_size, ws_size); grid = -1; return; }
        int dev = 0, cus = 0, per_cu = 0;
        if (hipGetDevice(&dev) != hipSuccess || hipDeviceGetAttribute(&cus, hipDeviceAttributeMultiprocessorCount, dev) != hipSuccess) { grid = -1; return; }
        if (hipFuncSetAttribute((const void*)mega_fwd, hipFuncAttributeMaxDynamicSharedMemorySize, LDS_BYTES) != hipSuccess) { fprintf(stderr, "kernel_launch: hipFuncSetAttribute failed\n"); grid = -1; return; }
        if (hipOccupancyMaxActiveBlocksPerMultiprocessor(&per_cu, (const void*)mega_fwd, NWAVES * 64, LDS_BYTES) != hipSuccess || per_cu < 1) { fprintf(stderr, "kernel_launch: occupancy query says %d\n", per_cu); }
        (void)hipGetLastError();
        grid = cus & ~7;
    }
    if (grid < 0) return;
    (void)hipMemsetAsync((char*)d_ws + WS_CTL, 0, CTL_ZERO_BYTES, stream);
    Args a{};
    for (int i = 0; i < 29; ++i) a.in[i] = (const float*)d_in[i];
    a.out = (float*)d_out; a.ws = (unsigned char*)d_ws;
    if (N_LAUNCHES == 1) { a.ph_lo = 0; a.ph_hi = 20; hipLaunchKernelGGL(mega_fwd, dim3(grid), dim3(NWAVES * 64), LDS_BYTES, stream, a); }
    else { for (int p = 0; p < 20; ++p) { a.ph_lo = p; a.ph_hi = p + 1; hipLaunchKernelGGL(mega_fwd, dim3(grid), dim3(NWAVES * 64), LDS_BYTES, stream, a); } }
}
```

```cpp
#include <hip/hip_runtime.h>
#include <cstdio>
#include <cstdint>

#ifndef N_LAUNCHES
#define N_LAUNCHES 1
#endif
#ifndef GEMM_ALIGN
#define GEMM_ALIGN true
#endif
#ifndef GEMM_SP2
#define GEMM_SP2 true
#endif
#ifndef MOE_XCD
#define MOE_XCD 0
#endif
#ifndef F8_PIN
#define F8_PIN 1
#endif
#if F8_PIN == 1
#define F8_PIN_ASM(x) asm volatile("" : "+v"(x))
#elif F8_PIN == 2
#define F8_PIN_ASM(x) asm volatile("" : "+a"(x))
#else
#define F8_PIN_ASM(x) do {} while (0)
#endif
#ifndef DOWN_PRE
#define DOWN_PRE 1
#endif
#ifndef DOWN_F8
#define DOWN_F8 0
#endif

#define LAS __attribute__((address_space(3)))
#define GAS __attribute__((address_space(1)))
typedef unsigned short bf16_t;
typedef short bf16x8 __attribute__((ext_vector_type(8)));
typedef float f32x4 __attribute__((ext_vector_type(4)));
typedef float f32x2 __attribute__((ext_vector_type(2)));
typedef unsigned u32x4 __attribute__((ext_vector_type(4)));
typedef unsigned u32x2 __attribute__((ext_vector_type(2)));
typedef int i32x4 __attribute__((ext_vector_type(4)));
typedef int i32x8 __attribute__((ext_vector_type(8)));

constexpr int T = 8192, D = 2048, SEQ = 4096, DEPTH = 2;
constexpr int INW = 6144, O_Q = 0, O_K = 1024, O_V = 1280, O_U = 1536, O_GA = 2048, O_GS = 4096;
constexpr int NE = 64, NSLOT = 9;
constexpr float NORM_EPS = 1e-6f;
constexpr float LOG2E = 1.4426950408889634f;

constexpr size_t MiB = 1u << 20;
constexpr size_t WS_CTL = 0, CTL_ZERO_BYTES = 1 * MiB;
constexpr size_t WS_MODP = 1 * MiB;
constexpr size_t WS_MOD = 3 * MiB;
constexpr size_t WS_SSM = 4 * MiB;
constexpr size_t SSM_STRIDE = 640 * 1024, SSM_E = 0, SSM_F = 256 * 1024, SSM_KT = 512 * 1024, SSM_P = 560 * 1024;
constexpr size_t WS_WIN = 44 * MiB;
constexpr size_t WS_WO = 92 * MiB;
constexpr size_t WS_WGLU = 100 * MiB;
constexpr size_t WS_WMIX = 108 * MiB;
constexpr size_t WS_WGU = 124 * MiB;
constexpr size_t WS_WD = 644 * MiB;
constexpr size_t WS_H = 904 * MiB;
constexpr size_t WS_PROJ = 936 * MiB;
constexpr size_t WS_ATTN = 1032 * MiB;
constexpr size_t WS_SLOC = 1048 * MiB;
constexpr size_t WS_Y = 1050 * MiB;
constexpr size_t WS_MIXED = 1058 * MiB;
constexpr size_t WS_HID = 1090 * MiB;
constexpr size_t WS_YSLOT = 1163 * MiB;
constexpr size_t WS_LTOK = 1451 * MiB, WS_LDST = 1453 * MiB, WS_LW = 1455 * MiB;
constexpr size_t WS_MIXED2 = 1457 * MiB;
constexpr size_t WS_WRT = 1489 * MiB;
constexpr size_t WS_XB = 1490 * MiB;
constexpr size_t WS_TOKW = 1522 * MiB;
constexpr size_t WS_END = 1523 * MiB;
constexpr int CW_TMO = 0, CW_BAR = 4096, CW_CNT = 8192;

constexpr int RING_BYTES = 131072, LDSCTL_OFF = RING_BYTES, MISC_OFF = LDSCTL_OFF + 320;
constexpr int SEL_OFF = LDSCTL_OFF + 1024;
constexpr int MOE_OFF = LDSCTL_OFF + 10240;
constexpr int LDS_BYTES = 147456;
constexpr int NWAVES = 8;

__device__ __forceinline__ unsigned cvt_pk_bf16(float lo, float hi) { unsigned r; asm("v_cvt_pk_bf16_f32 %0, %1, %2" : "=v"(r) : "v"(lo), "v"(hi)); return r; }
__device__ __forceinline__ float bf_lo(unsigned w) { return __uint_as_float(w << 16); }
__device__ __forceinline__ float bf_hi(unsigned w) { return __uint_as_float(w & 0xffff0000u); }
__device__ __forceinline__ float bf1(bf16_t h) { return __uint_as_float(((unsigned)h) << 16); }
__device__ __forceinline__ float fast_sigmoid(float x) { return __builtin_amdgcn_rcpf(1.0f + __builtin_amdgcn_exp2f(-x * LOG2E)); }
__device__ __forceinline__ float wave_sum(float v) {
#pragma unroll
    for (int o = 1; o < 64; o <<= 1) v += __shfl_xor(v, o);
    return v;
}
__device__ __forceinline__ int opaque(int v) { asm volatile("" : "+v"(v)); return v; }
#define LDS_WAIT() asm volatile("s_waitcnt lgkmcnt(0)" ::: "memory")
#define VM_WAIT() asm volatile("s_waitcnt vmcnt(0)" ::: "memory")

#define XB_TMO      128
#define XB_XCNT(j)  (256  + 64 * (j))
#define XB_XSUB(j)  (1280 + 64 * (j))
#define XB_XGEN(j)  (2304 + 64 * (j))
#define XB_TOP      3328
#define XB_TOPGEN   3392
#define XCD_BAR_WORDS 3456
#define XB_SPIN_CAP (1u << 18)
__device__ __forceinline__ unsigned xb_ld(unsigned* p)              { return __hip_atomic_load(p, __ATOMIC_RELAXED, __HIP_MEMORY_SCOPE_AGENT); }
__device__ __forceinline__ unsigned xb_add(unsigned* p, unsigned v) { return __hip_atomic_fetch_add(p, v, __ATOMIC_RELAXED, __HIP_MEMORY_SCOPE_AGENT); }
__device__ __forceinline__ unsigned xb_xcc_id() { return (unsigned)__builtin_amdgcn_s_getreg((3 << 11) | 20) & 0xFu; }
#define XB_SPIN(cond, bar) do { unsigned _sp = 0; while (cond) { __builtin_amdgcn_s_sleep(1); \
    if ((++_sp & 255u) == 0u) { if (xb_ld(&(bar)[XB_TMO])) break; if (_sp > XB_SPIN_CAP) { atomicAdd(&(bar)[XB_TMO], 1u); break; } } } } while (0)
struct XcdBarrier { unsigned* bar; unsigned x; volatile LAS unsigned* st; };
__device__ __forceinline__ XcdBarrier xcd_barrier_post(unsigned* bar, volatile LAS unsigned* st) {
    XcdBarrier b; b.bar = bar; b.x = xb_xcc_id(); b.st = st;
    if (threadIdx.x == 0) (void)xb_add(&bar[XB_XCNT(b.x)], 1u);
    return b;
}
__device__ __forceinline__ void xcd_barrier_complete(unsigned* bar, unsigned x, unsigned& nloc, unsigned& nx) {
    const unsigned G = gridDim.x * gridDim.y * gridDim.z;
    unsigned sum, cnt, mine, sp = 0u;
    for (;;) {
        sum = 0u; cnt = 0u; mine = 0u;
#pragma unroll
        for (unsigned j = 0; j < 16; ++j) { const unsigned c = xb_ld(&bar[XB_XCNT(j)]); sum += c; cnt += (c > 0u) ? 1u : 0u; mine = (j == x) ? c : mine; }
        if (sum == G) break;
        __builtin_amdgcn_s_sleep(1);
        if ((++sp & 255u) == 0u) { if (xb_ld(&bar[XB_TMO])) break; if (sp > XB_SPIN_CAP) { atomicAdd(&bar[XB_TMO], 1u); break; } }
    }
    nloc = mine > 0u ? mine : 1u; nx = cnt > 0u ? cnt : 1u;
}
__device__ __forceinline__ void xcd_barrier(const XcdBarrier& b) {
    asm volatile("s_waitcnt vmcnt(0)" ::: "memory");
    __syncthreads();
    if (threadIdx.x == 0) {
        unsigned* bar = b.bar;
        __builtin_amdgcn_s_waitcnt(0);
        unsigned nloc = b.st[0], nx = b.st[1];
        if (nloc == 0u) { xcd_barrier_complete(bar, b.x, nloc, nx); b.st[0] = nloc; b.st[1] = nx; }
        const unsigned old = xb_add(&bar[XB_XSUB(b.x)], 1u);
        const unsigned gen = old / nloc;
        if (old + 1u == (gen + 1u) * nloc) {
            __builtin_amdgcn_fence(__ATOMIC_RELEASE, "agent");
            asm volatile("s_waitcnt vmcnt(0)" ::: "memory");
            const unsigned og = xb_add(&bar[XB_TOP], 1u);
            const unsigned tg = og / nx;
            if (og + 1u == (tg + 1u) * nx) xb_add(&bar[XB_TOPGEN], 1u);
            else XB_SPIN(xb_ld(&bar[XB_TOPGEN]) == tg, bar);
            __builtin_amdgcn_fence(__ATOMIC_ACQUIRE, "agent");
            xb_add(&bar[XB_XGEN(b.x)], 1u);
            asm volatile("s_waitcnt vmcnt(0)" ::: "memory");
        } else {
            XB_SPIN(xb_ld(&bar[XB_XGEN(b.x)]) == gen, bar);
            __builtin_amdgcn_fence(__ATOMIC_ACQUIRE, "agent");
            asm volatile("s_waitcnt vmcnt(0)" ::: "memory");
        }
    }
    __syncthreads();
}

namespace pg8 {
constexpr int BM = 256, BK = 64, HALF = 128, HTB = HALF * BK * 2, STAGE_BYTES = 8 * HTB, NXCD = 8, WGM = 8;
__host__ __device__ __forceinline__ int lds_byte(int r, int c) { const int st = (r >> 4) * 2 + (c >> 5), rr = r & 15, cc = c & 31, ob = rr * 64 + cc * 2; return st * 1024 + (ob ^ (((ob >> 9) & 1) << 5)); }
__host__ __device__ __forceinline__ void stage_rc(int b, int& R, int& C) { const int st = b / 1024, sb = b % 1024, swz = sb ^ (((sb >> 9) & 1) << 5); R = (st >> 1) * 16 + swz / 64; C = (st & 1) * 32 + (swz % 64) / 2; }
__host__ __device__ __forceinline__ int perm32(int rho) { const int n = rho >> 4, i = rho & 15; return 8 * (i >> 2) + 4 * n + (i & 3); }

struct Unit { int pm, pn, e, n, r0, x; };

struct DenseOrder {
    static constexpr bool GATHER = false;
    int nM, nN, nwg, G, c; const char* Bt; size_t tstepB;
    __device__ void init(int M, int N, int K, int G_, int c_, const void* Bt_) { nM = M / BM; nN = N / BM; nwg = nM * nN; G = G_; c = c_; Bt = (const char*)Bt_; tstepB = (size_t)BM * K * 2; }
    __device__ __forceinline__ bool next(int i, Unit& u) const {
        const long L = (long)i * G + c; if (L >= nwg) return false;
        int wgid = (int)L; { const int q = nwg / NXCD, r = nwg % NXCD, xcd = wgid % NXCD, off = wgid / NXCD; wgid = (xcd < r ? xcd * (q + 1) : r * (q + 1) + (xcd - r) * q) + off; }
        const int nig = WGM * nN, gid = wgid / nig, fm = gid * WGM, gsz = (nM - fm) < WGM ? (nM - fm) : WGM;
        u.pm = fm + ((wgid % nig) % gsz); u.pn = (wgid % nig) / gsz; u.e = -1; u.n = 256; u.r0 = u.pm * BM; u.x = u.pm * BM; return true;
    }
    __device__ __forceinline__ int a_row(const Unit& u, int R) const { return u.r0 + R; }
    __device__ __forceinline__ void a_row_issue(const Unit& u, int R, int& out) const { out = u.r0 + R; }
    __device__ __forceinline__ int a_row_fix(const Unit& u, int R, int loaded) const { return loaded; }
    __device__ __forceinline__ const char* b_tile(const Unit& u) const { return Bt + (size_t)u.pn * tstepB; }
};
template <int NPN, bool GATHER_> struct MoeOrder {
    static constexpr bool GATHER = GATHER_;
    const LAS int* utab; const char* Wbase; size_t wstepE, tstepB; const int* ltok;
    __device__ __forceinline__ bool next(int i, Unit& u) const {
        if (i >= 64) return false;
        const LAS int* p = utab + i * 8;
        const int pm = __builtin_amdgcn_readfirstlane(p[0]); if (pm < 0) return false;
        u.pm = pm; u.pn = __builtin_amdgcn_readfirstlane(p[1]); u.e = __builtin_amdgcn_readfirstlane(p[2]); u.n = __builtin_amdgcn_readfirstlane(p[3]);
        u.r0 = __builtin_amdgcn_readfirstlane(p[4]); u.x = __builtin_amdgcn_readfirstlane(p[5]); return true;
    }
    __device__ __forceinline__ int a_row(const Unit& u, int R) const {
        if (!GATHER) return u.r0 + R;
        if (u.e == 64) return u.r0 + R;
        const int rr = R < u.n ? R : u.n - 1; return ((const GAS int*)ltok)[u.r0 + rr];
    }
    __device__ __forceinline__ void a_row_issue(const Unit& u, int R, int& out) const {
        const int rr = R < u.n ? R : u.n - 1; const GAS int* p = (const GAS int*)ltok + (u.e == 64 ? 0 : u.r0 + rr);
        asm volatile("global_load_dword %0, %1, off" : "=v"(out) : "v"(p) : "memory");
    }
    __device__ __forceinline__ int a_row_fix(const Unit& u, int R, int loaded) const { return u.e == 64 ? u.r0 + R : loaded; }
    __device__ __forceinline__ const char* b_tile(const Unit& u) const { return Wbase + (size_t)u.e * wstepE + (size_t)u.pn * tstepB; }
};
template <int NPN, bool GATHER> __device__ __forceinline__ void moe_build(LAS int* tpre, LAS int* ebase, LAS int* ecnt, LAS int* utab, const unsigned* counts, int G, int c, int tid) {
    if (tid < 64) ecnt[tid] = (int)__hip_atomic_load(counts + tid, __ATOMIC_RELAXED, __HIP_MEMORY_SCOPE_AGENT);
    __syncthreads();
    if (tid == 0) { int tp = 0, eb = 0; for (int e = 0; e < 64; ++e) { tpre[e] = tp; ebase[e] = eb; tp += (ecnt[e] + 255) >> 8; eb += ecnt[e]; } tpre[64] = tp; ebase[64] = eb; }
    __syncthreads();
#if MOE_XCD
    if (tid < 64) {
        int pm = -1, pn = 0, e = 64, n = 256;
        const int xc = c & 7; int idx = (c >> 3) + (G >> 3) * tid;
        if (idx < 4 * NPN) { pm = xc + 8 * (idx / NPN); pn = idx % NPN; }
        else { idx -= 4 * NPN;
#pragma unroll 1
            for (int j = 0; j < 8; ++j) { const int ee = xc + 8 * j, nu = ((ecnt[ee] + 255) >> 8) * NPN;
                if (pm < 0) { if (idx < nu) { e = ee; pm = idx / NPN; pn = idx % NPN; } else idx -= nu; } }
            if (pm >= 0) { const int rem = ecnt[e] - pm * BM; n = rem < BM ? rem : BM; } }
        const int hb = (e == 64 ? 65536 : ebase[e]) + pm * BM;
        const int r0 = GATHER ? (e == 64 ? pm * BM : e * 8192 + pm * BM) : hb, x = hb;
#else
    if (tid < 64) {
        int pm = -1, pn = 0, e = 64, n = 256;
        const int vc = ((G & 7) == 0) ? (c & 7) * (G >> 3) + (c >> 3) : c;
        int L = tid * G + vc; const int shared_units = 32 * NPN, tot = shared_units + NPN * tpre[64];
        if (L < tot) {
            if (L < shared_units) { pm = L / NPN; pn = L % NPN; }
            else { L -= shared_units; const int tile = L / NPN; pn = L % NPN; e = 0;
#pragma unroll 1
                for (int j = 1; j <= 64; ++j) e += (tpre[j] <= tile) ? 1 : 0;
                pm = tile - tpre[e]; const int rem = ecnt[e] - pm * BM; n = rem < BM ? rem : BM; } }
        const int hb = (e == 64 ? 65536 : ebase[e]) + pm * BM;
        const int r0 = GATHER ? (e == 64 ? pm * BM : e * 8192 + pm * BM) : hb, x = hb;
#endif
        LAS int* p = utab + tid * 8; p[0] = pm; p[1] = pn; p[2] = e; p[3] = n; p[4] = r0; p[5] = x;
    }
    __syncthreads();
}

template <class Epi, class Sched, bool ALIGN_EPI = false, bool SP2 = GEMM_SP2, bool F8 = false>
__device__ __forceinline__ void gemm_phase(LAS unsigned char* lds, const char* Abase, const int K, const Sched& S, const Epi& E) {
    int tid = threadIdx.x; asm volatile("" : "+v"(tid));
    const int wid = __builtin_amdgcn_readfirstlane(tid >> 6), lane = tid & 63, wr = wid >> 2, wc = wid & 3, fr = lane & 15, fq = lane >> 4;
    const int nt = K / BK;
    constexpr bool GA = Sched::GATHER;
    unsigned voffA[2], voffB[2];
#pragma unroll
    for (int i = 0; i < 2; ++i) { int R, C; stage_rc(tid * 16 + i * 8192, R, C); const int Rb = Epi::PERM ? ((R & ~31) + perm32(R & 31)) : R; voffA[i] = (unsigned)(R * K + C) * 2u; voffB[i] = (unsigned)(Rb * K + C) * 2u; }
    const size_t kstep = (size_t)(BK * 2);
    const size_t hstep = (size_t)HALF * K * 2;
    const unsigned ldsw = (unsigned)wid * 1024u;
    const int aoff = lds_byte(wr * 64 + fr, fq * 8), boff = lds_byte(wc * 32 + fr, fq * 8);
#define PG8_SA(b, h) (((b) * 2 + (h)) * HTB)
#define PG8_SB(b, h) ((4 + (b) * 2 + (h)) * HTB)
#define PG8_STB(bufoff, gbase) do { const char* _sb = (const char*)(gbase); asm volatile("" : "+s"(_sb)); _Pragma("unroll") for (int _i = 0; _i < 2; ++_i) \
        { unsigned _vo = voffB[_i]; asm volatile("" : "+v"(_vo)); __builtin_amdgcn_global_load_lds((const unsigned*)(_sb + _vo), (LAS unsigned*)(lds + (bufoff) + ldsw + _i * 8192), 16, 0, 0); } } while (0)
#define PG8_STA(bufoff, h, kb) do { const char* _sa = GA ? (Abase + (kb)) : (cA + (kb) + (h) * hstep); asm volatile("" : "+s"(_sa)); _Pragma("unroll") for (int _i = 0; _i < 2; ++_i) \
        { unsigned _vo = GA ? offC[h][_i] : voffA[_i]; asm volatile("" : "+v"(_vo)); __builtin_amdgcn_global_load_lds((const unsigned*)(_sa + _vo), (LAS unsigned*)(lds + (bufoff) + ldsw + _i * 8192), 16, 0, 0); } } while (0)
#define PG8_LDA(dst, b, h) do { _Pragma("unroll") for (int m = 0; m < 4; ++m) _Pragma("unroll") for (int k = 0; k < 2; ++k) dst[m][k] = *(const LAS bf16x8*)(lds + PG8_SA(b, h) + aoff + m * 2048 + k * 1024); } while (0)
#define PG8_LDB(dst, b, h) do { _Pragma("unroll") for (int n = 0; n < 2; ++n) _Pragma("unroll") for (int k = 0; k < 2; ++k) dst[n][k] = *(const LAS bf16x8*)(lds + PG8_SB(b, h) + boff + n * 2048 + k * 1024); } while (0)
#define PG8_CAT8(x, y) __builtin_shufflevector(__builtin_bit_cast(i32x4, x), __builtin_bit_cast(i32x4, y), 0, 1, 2, 3, 4, 5, 6, 7)
#define PG8_MMA(ai, bj, At, Bt) do { __builtin_amdgcn_s_setprio(1); _Pragma("unroll") for (int m = 0; m < 4; ++m) _Pragma("unroll") for (int n = 0; n < 2; ++n) { \
        if constexpr (F8) acc[ai][bj][m][n] = __builtin_amdgcn_mfma_scale_f32_16x16x128_f8f6f4(PG8_CAT8(Bt[n][0], Bt[n][1]), PG8_CAT8(At[m][0], At[m][1]), acc[ai][bj][m][n], 0, 0, 0, 0, 0, 0); \
        else { _Pragma("unroll") for (int k = 0; k < 2; ++k) acc[ai][bj][m][n] = __builtin_amdgcn_mfma_f32_16x16x32_bf16(Bt[n][k], At[m][k], acc[ai][bj][m][n], 0, 0, 0); } } \
        __builtin_amdgcn_s_setprio(0); } while (0)
#define PG8_WAIT_V(n) asm volatile("s_waitcnt vmcnt(" #n ")" ::: "memory")
#define PG8_WAIT_L(n) asm volatile("s_waitcnt lgkmcnt(" #n ")" ::: "memory")
#define PG8_BAR __builtin_amdgcn_s_barrier()
#define PG8_SCHED __builtin_amdgcn_sched_barrier(0)
#define PG8_AOFF(dst, u) do { if constexpr (GA) { _Pragma("unroll") for (int _h = 0; _h < 2; ++_h) _Pragma("unroll") for (int _i = 0; _i < 2; ++_i) { int _R, _C; stage_rc(tid * 16 + _i * 8192, _R, _C); \
        dst[_h][_i] = (unsigned)(S.a_row(u, _h * HALF + _R) * K + _C) * 2u; } } } while (0)
    Unit cur, nxt; int ui = 0;
    if (!S.next(0, cur)) return;
    f32x4 acc[2][2][4][2];
#pragma unroll
    for (int a = 0; a < 2; ++a)
#pragma unroll
        for (int b = 0; b < 2; ++b)
#pragma unroll
            for (int m = 0; m < 4; ++m)
#pragma unroll
                for (int n = 0; n < 2; ++n) { acc[a][b][m][n] = (f32x4){0.f, 0.f, 0.f, 0.f}; if constexpr (F8) F8_PIN_ASM(acc[a][b][m][n]); }
    bf16x8 At[4][2], B0[2][2], B1[2][2];
    unsigned offC[2][2];
    PG8_AOFF(offC, cur);
    const char* cB = S.b_tile(cur);
    const char* cA = GA ? Abase : Abase + (size_t)S.a_row(cur, 0) * K * 2;
    if constexpr (SP2) {
        PG8_STB(PG8_SB(0, 0), cB); PG8_STB(PG8_SB(0, 1), cB + hstep); PG8_STA(PG8_SA(0, 0), 0, 0); PG8_STA(PG8_SA(0, 1), 1, 0);
        if (wr == 1) PG8_BAR;
        PG8_WAIT_V(2); PG8_BAR;
        PG8_STB(PG8_SB(1, 0), cB + kstep); PG8_STA(PG8_SA(1, 0), 0, kstep); PG8_STB(PG8_SB(1, 1), cB + hstep + kstep);
        PG8_WAIT_V(6); PG8_BAR;
    } else {
    PG8_STB(PG8_SB(0, 0), cB); PG8_STA(PG8_SA(0, 0), 0, 0); PG8_STB(PG8_SB(0, 1), cB + hstep); PG8_STA(PG8_SA(0, 1), 1, 0);
    if (wr == 1) PG8_BAR;
    PG8_WAIT_V(4); PG8_BAR;
    PG8_STB(PG8_SB(1, 0), cB + kstep); PG8_STA(PG8_SA(1, 0), 0, kstep); PG8_STB(PG8_SB(1, 1), cB + hstep + kstep);
    PG8_WAIT_V(6); PG8_BAR;
    }
    for (;;) {
        int pre_v0, pre_v1; if constexpr (Epi::PRE) E.pre_issue(cur, wr, lane, pre_v0, pre_v1);
        const bool has_next = S.next(ui + 1, nxt);
        const char* nB = has_next ? S.b_tile(nxt) : cB;
        const char* nA = (!GA && has_next) ? Abase + (size_t)S.a_row(nxt, 0) * K * 2 : cA;
        int rowN[2][2];
        if constexpr (GA) { const Unit un = has_next ? nxt : cur;
#pragma unroll
            for (int h = 0; h < 2; ++h)
#pragma unroll
                for (int i = 0; i < 2; ++i) { int R_, C_; stage_rc(tid * 16 + i * 8192, R_, C_); S.a_row_issue(un, h * HALF + R_, rowN[h][i]); } }
#pragma unroll 1
        for (int t = 0; t < nt; t += 2) {
            const bool last = (t == nt - 2);
            const size_t kb1 = (size_t)(t + 1) * kstep;
            const size_t kb2 = last ? 0 : (size_t)(t + 2) * kstep, kb3 = kb2 + kstep;
            const char* b2 = last ? nB : cB + (size_t)(t + 2) * kstep; const char* b3 = b2 + kstep;
            if constexpr (SP2) {
            PG8_LDB(B0, 0, 0); PG8_LDB(B1, 0, 1); PG8_SCHED; PG8_LDA(At, 0, 0); PG8_STA(PG8_SA(1, 1), 1, kb1);
            if (last) { if constexpr (GA) { if (has_next) {
#pragma unroll
                for (int h = 0; h < 2; ++h)
#pragma unroll
                    for (int i = 0; i < 2; ++i) { int R_, C_; stage_rc(tid * 16 + i * 8192, R_, C_); int rl = rowN[h][i]; asm volatile("" : "+v"(rl));
                        offC[h][i] = (unsigned)(S.a_row_fix(nxt, h * HALF + R_, rl) * K + C_) * 2u; } } } else cA = nA; }
            PG8_WAIT_V(8); PG8_WAIT_L(0); PG8_BAR; PG8_MMA(0, 0, At, B0); PG8_MMA(0, 1, At, B1); PG8_BAR; PG8_SCHED;
            PG8_LDA(At, 0, 1); PG8_STB(PG8_SB(0, 0), b2); PG8_STB(PG8_SB(0, 1), b2 + hstep); PG8_STA(PG8_SA(0, 0), 0, kb2);
            PG8_WAIT_V(8); PG8_WAIT_L(0); PG8_BAR; PG8_MMA(1, 0, At, B0); PG8_MMA(1, 1, At, B1); PG8_BAR; PG8_SCHED;
            PG8_LDB(B0, 1, 0); PG8_LDB(B1, 1, 1); PG8_SCHED; PG8_LDA(At, 1, 0); PG8_STA(PG8_SA(0, 1), 1, kb2);
            PG8_WAIT_V(8); PG8_WAIT_L(0); PG8_BAR; PG8_MMA(0, 0, At, B0); PG8_MMA(0, 1, At, B1); PG8_BAR; PG8_SCHED;
            PG8_LDA(At, 1, 1); PG8_STB(PG8_SB(1, 0), b3); PG8_STB(PG8_SB(1, 1), b3 + hstep); PG8_STA(PG8_SA(1, 0), 0, kb3);
            PG8_WAIT_V(8); PG8_WAIT_L(0); PG8_BAR; PG8_MMA(1, 0, At, B0); PG8_MMA(1, 1, At, B1); PG8_BAR; PG8_SCHED;
            } else {
            PG8_LDB(B0, 0, 0); PG8_SCHED; PG8_LDA(At, 0, 0); PG8_STA(PG8_SA(1, 1), 1, kb1);
            if (last) { if constexpr (GA) { if (has_next) {
#pragma unroll
                for (int h = 0; h < 2; ++h)
#pragma unroll
                    for (int i = 0; i < 2; ++i) { int R_, C_; stage_rc(tid * 16 + i * 8192, R_, C_); int rl = rowN[h][i]; asm volatile("" : "+v"(rl));
                        offC[h][i] = (unsigned)(S.a_row_fix(nxt, h * HALF + R_, rl) * K + C_) * 2u; } } } else cA = nA; }
            PG8_WAIT_L(8); PG8_BAR; PG8_WAIT_L(0); PG8_MMA(0, 0, At, B0); PG8_BAR; PG8_SCHED;
            PG8_LDB(B1, 0, 1); PG8_STB(PG8_SB(0, 0), b2);
            PG8_BAR; PG8_WAIT_L(0); PG8_MMA(0, 1, At, B1); PG8_BAR;
            PG8_LDA(At, 0, 1); PG8_STA(PG8_SA(0, 0), 0, kb2);
            PG8_BAR; PG8_WAIT_L(0); PG8_MMA(1, 0, At, B0); PG8_BAR; PG8_SCHED;
            PG8_STB(PG8_SB(0, 1), b2 + hstep);
            PG8_WAIT_V(6); PG8_BAR; PG8_MMA(1, 1, At, B1); PG8_BAR;
            PG8_LDB(B0, 1, 0); PG8_SCHED; PG8_LDA(At, 1, 0); PG8_STA(PG8_SA(0, 1), 1, kb2);
            PG8_WAIT_L(8); PG8_BAR; PG8_WAIT_L(0); PG8_MMA(0, 0, At, B0); PG8_BAR; PG8_SCHED;
            PG8_LDB(B1, 1, 1); PG8_STB(PG8_SB(1, 0), b3);
            PG8_BAR; PG8_WAIT_L(0); PG8_MMA(0, 1, At, B1); PG8_BAR;
            PG8_LDA(At, 1, 1); PG8_STA(PG8_SA(1, 0), 0, kb3);
            PG8_BAR; PG8_WAIT_L(0); PG8_MMA(1, 0, At, B0); PG8_BAR; PG8_SCHED;
            PG8_STB(PG8_SB(1, 1), b3 + hstep);
            PG8_WAIT_V(6); PG8_BAR; PG8_MMA(1, 1, At, B1); PG8_BAR;
            }
        }
        if constexpr (ALIGN_EPI) { if (wr == 0) PG8_BAR; }
        if constexpr (Epi::PRE) { asm volatile("" : "+v"(pre_v0), "+v"(pre_v1)); E.pre_commit(pre_v0, pre_v1, wid, lane); }
        E(acc, cur, wr, wc, fr, fq);
        if (!has_next) break;
#pragma unroll
        for (int a = 0; a < 2; ++a)
#pragma unroll
            for (int b = 0; b < 2; ++b)
#pragma unroll
                for (int m = 0; m < 4; ++m)
#pragma unroll
                    for (int n = 0; n < 2; ++n) { acc[a][b][m][n] = (f32x4){0.f, 0.f, 0.f, 0.f}; if constexpr (F8) F8_PIN_ASM(acc[a][b][m][n]); }
        cur = nxt; cB = nB; ++ui;
        if constexpr (ALIGN_EPI) { if (wr == 1) PG8_BAR; }
    }
    PG8_WAIT_V(0);
    if constexpr (!ALIGN_EPI) { if (wr == 0) PG8_BAR; }
    PG8_BAR;
#undef PG8_SA
#undef PG8_SB
#undef PG8_STB
#undef PG8_STA
#undef PG8_LDA
#undef PG8_LDB
#undef PG8_MMA
#undef PG8_CAT8
#undef PG8_WAIT_V
#undef PG8_WAIT_L
#undef PG8_BAR
#undef PG8_SCHED
#undef PG8_AOFF
}

typedef const f32x4 (&AccRef)[2][2][4][2];
__device__ __forceinline__ u32x4 pack8(const f32x4& a, const f32x4& b) { u32x4 w; w.x = cvt_pk_bf16(a[0], a[1]); w.y = cvt_pk_bf16(a[2], a[3]); w.z = cvt_pk_bf16(b[0], b[1]); w.w = cvt_pk_bf16(b[2], b[3]); return w; }
__device__ __forceinline__ void unpack8(const u32x4 w, f32x4& a, f32x4& b) { a = (f32x4){bf_lo(w.x), bf_hi(w.x), bf_lo(w.y), bf_hi(w.y)}; b = (f32x4){bf_lo(w.z), bf_hi(w.z), bf_lo(w.w), bf_hi(w.w)}; }

struct EpiInProj {
    static constexpr bool PERM = true; static constexpr bool PRE = false;
    bf16_t* O; const float* bias; float qscale; int nostore;
    __device__ __forceinline__ void operator()(AccRef acc, const Unit& u, int wr, int wc, int fr, int fq) const {
        if (nostore) return;
        const int row0 = u.pm * BM + wr * 64 + fr, colb = u.pn * BM + wc * 32 + 8 * fq;
        const int mode = u.pn < 4 ? 1 : (u.pn >= 8 ? 2 : 0);
        f32x4 bv[2][2];
#pragma unroll
        for (int bj = 0; bj < 2; ++bj)
#pragma unroll
            for (int n = 0; n < 2; ++n) bv[bj][n] = *(const GAS f32x4*)(bias + colb + bj * HALF + 4 * n);
#pragma unroll
        for (int ai = 0; ai < 2; ++ai)
#pragma unroll
            for (int m = 0; m < 4; ++m) { bf16_t* rowp = O + (size_t)(row0 + ai * HALF + m * 16) * INW + colb;
#pragma unroll
                for (int bj = 0; bj < 2; ++bj) { f32x4 v0 = acc[ai][bj][m][0] + bv[bj][0], v1 = acc[ai][bj][m][1] + bv[bj][1];
                    if (mode == 1) { v0 = v0 * qscale; v1 = v1 * qscale; }
                    if (mode == 2) {
#pragma unroll
                        for (int j = 0; j < 4; ++j) { v0[j] = fast_sigmoid(v0[j]); v1[j] = fast_sigmoid(v1[j]); } }
                    *(GAS u32x4*)(rowp + bj * HALF) = pack8(v0, v1); } }
    }
};
struct EpiAttnProj {
    static constexpr bool PERM = true; static constexpr bool PRE = false;
    const bf16_t* proj; bf16_t* mixed;
    __device__ __forceinline__ void operator()(AccRef acc, const Unit& u, int wr, int wc, int fr, int fq) const {
        const int row0 = u.pm * BM + wr * 64 + fr, colb = u.pn * BM + wc * 32 + 8 * fq;
#pragma unroll
        for (int ai = 0; ai < 2; ++ai) {
            u32x4 gw[4][2];
#pragma unroll
            for (int m = 0; m < 4; ++m)
#pragma unroll
                for (int bj = 0; bj < 2; ++bj) gw[m][bj] = *(const GAS u32x4*)(proj + (size_t)(row0 + ai * HALF + m * 16) * INW + O_GA + colb + bj * HALF);
#pragma unroll
            for (int m = 0; m < 4; ++m) { const size_t row = (size_t)(row0 + ai * HALF + m * 16);
#pragma unroll
                for (int bj = 0; bj < 2; ++bj) { f32x4 g0, g1; unpack8(gw[m][bj], g0, g1);
                    *(GAS u32x4*)(mixed + row * D + colb + bj * HALF) = pack8(g0 * acc[ai][bj][m][0], g1 * acc[ai][bj][m][1]); } } }
    }
};
struct EpiGlu {
    static constexpr bool PERM = true; static constexpr bool PRE = false;
    const bf16_t* proj; const bf16_t* mixed; bf16_t* mixed2;
    __device__ __forceinline__ void operator()(AccRef acc, const Unit& u, int wr, int wc, int fr, int fq) const {
        const int row0 = u.pm * BM + wr * 64 + fr, col = u.pn * HALF + wc * 32 + 8 * fq;
#pragma unroll
        for (int ai = 0; ai < 2; ++ai) {
            u32x4 gw[4], pw[4];
#pragma unroll
            for (int m = 0; m < 4; ++m) { const size_t row = (size_t)(row0 + ai * HALF + m * 16);
                gw[m] = *(const GAS u32x4*)(proj + row * INW + O_GS + col); pw[m] = *(const GAS u32x4*)(mixed + row * D + col); }
#pragma unroll
            for (int m = 0; m < 4; ++m) { const size_t row = (size_t)(row0 + ai * HALF + m * 16);
                f32x4 g0, g1, p0, p1; unpack8(gw[m], g0, g1); unpack8(pw[m], p0, p1);
                const f32x4 za0 = acc[ai][0][m][0], za1 = acc[ai][0][m][1], zb0 = acc[ai][1][m][0], zb1 = acc[ai][1][m][1];
#pragma unroll
                for (int j = 0; j < 4; ++j) { p0[j] += g0[j] * za0[j] * fast_sigmoid(zb0[j]); p1[j] += g1[j] * za1[j] * fast_sigmoid(zb1[j]); }
                *(GAS u32x4*)(mixed2 + row * D + col) = pack8(p0, p1); } }
    }
};
struct EpiMixOut {
    static constexpr bool PERM = true; static constexpr bool PRE = false;
    const float* xin; const bf16_t* xsrc; bf16_t* xdst; const float* gt;
    __device__ __forceinline__ void operator()(AccRef acc, const Unit& u, int wr, int wc, int fr, int fq) const {
        const int row0 = u.pm * BM + wr * 64 + fr, colb = u.pn * BM + wc * 32 + 8 * fq;
        const float* g = gt + (u.pm >= 16 ? 12288 : 0);
        f32x4 gv[2][2];
#pragma unroll
        for (int bj = 0; bj < 2; ++bj)
#pragma unroll
            for (int n = 0; n < 2; ++n) gv[bj][n] = *(const GAS f32x4*)(g + colb + bj * HALF + 4 * n);
        if (xin) {
#pragma unroll
            for (int ai = 0; ai < 2; ++ai)
#pragma unroll
                for (int mp = 0; mp < 2; ++mp) { f32x4 xv[2][2][2];
#pragma unroll
                    for (int mm = 0; mm < 2; ++mm)
#pragma unroll
                        for (int bj = 0; bj < 2; ++bj) { const size_t off = (size_t)(row0 + ai * HALF + (2 * mp + mm) * 16) * D + colb + bj * HALF;
                            xv[mm][bj][0] = *(const GAS f32x4*)(xin + off); xv[mm][bj][1] = *(const GAS f32x4*)(xin + off + 4); }
#pragma unroll
                    for (int mm = 0; mm < 2; ++mm)
#pragma unroll
                        for (int bj = 0; bj < 2; ++bj) { const int m = 2 * mp + mm; const size_t off = (size_t)(row0 + ai * HALF + m * 16) * D + colb + bj * HALF;
                            *(GAS u32x4*)(xdst + off) = pack8(xv[mm][bj][0] + gv[bj][0] * acc[ai][bj][m][0], xv[mm][bj][1] + gv[bj][1] * acc[ai][bj][m][1]); } }
        } else {
#pragma unroll
            for (int ai = 0; ai < 2; ++ai) { u32x4 xw[4][2];
#pragma unroll
                for (int m = 0; m < 4; ++m)
#pragma unroll
                    for (int bj = 0; bj < 2; ++bj) xw[m][bj] = *(const GAS u32x4*)(xsrc + (size_t)(row0 + ai * HALF + m * 16) * D + colb + bj * HALF);
#pragma unroll
                for (int m = 0; m < 4; ++m)
#pragma unroll
                    for (int bj = 0; bj < 2; ++bj) { f32x4 x0, x1; unpack8(xw[m][bj], x0, x1);
                        *(GAS u32x4*)(xdst + (size_t)(row0 + ai * HALF + m * 16) * D + colb + bj * HALF) = pack8(x0 + gv[bj][0] * acc[ai][bj][m][0], x1 + gv[bj][1] * acc[ai][bj][m][1]); } }
        }
    }
};
constexpr float WGU_SCALE = 64.0f, WD_SCALE = 32.0f;
__device__ __forceinline__ unsigned pk_fp8x4(const f32x4& a) {
    int w = 0; w = __builtin_amdgcn_cvt_pk_fp8_f32(a[0], a[1], w, false); w = __builtin_amdgcn_cvt_pk_fp8_f32(a[2], a[3], w, true); return (unsigned)w; }
struct EpiGateUp {
    static constexpr bool PERM = true; static constexpr bool PRE = false;
    unsigned char* hid;
    __device__ __forceinline__ void operator()(AccRef acc, const Unit& u, int wr, int wc, int fr, int fq) const {
        const int r0 = wr * 64 + fr, col = u.pn * HALF + wc * 32 + 8 * fq;
#pragma unroll
        for (int ai = 0; ai < 2; ++ai)
#pragma unroll
            for (int m = 0; m < 4; ++m) { const int r = r0 + ai * HALF + m * 16;
                f32x4 g0 = acc[ai][0][m][0] * (1.0f / WGU_SCALE), g1 = acc[ai][0][m][1] * (1.0f / WGU_SCALE), u0 = acc[ai][1][m][0] * (1.0f / WGU_SCALE), u1 = acc[ai][1][m][1] * (1.0f / WGU_SCALE);
#pragma unroll
                for (int j = 0; j < 4; ++j) { g0[j] = g0[j] * fast_sigmoid(g0[j]) * u0[j]; g1[j] = g1[j] * fast_sigmoid(g1[j]) * u1[j]; }
                if (r < u.n) { if constexpr (DOWN_F8 != 0) *(GAS u32x2*)(hid + (size_t)(u.x + r) * 512 + col) = (u32x2){pk_fp8x4(g0), pk_fp8x4(g1)};
                               else *(GAS u32x4*)(hid + ((size_t)(u.x + r) * 512 + col) * 2) = pack8(g0, g1); } }
    }
};
constexpr float YS_SCALE = 8.0f, YS_INV = 1.0f / 8.0f, YS_ACC = DOWN_F8 ? YS_SCALE / WD_SCALE : YS_SCALE;
struct EpiDown {
    static constexpr bool PERM = true; static constexpr bool PRE = (DOWN_PRE != 0);
    unsigned char* ys; const int* ldst; LAS int* dstl; int nostore;
    __device__ __forceinline__ void pre_issue(const Unit& u, int wr, int lane, int& v0, int& v1) const {
        const int ra = 64 * wr + lane, rb = ra + 128; const GAS int* p = (const GAS int*)ldst + (u.e == 64 ? 0 : u.e * 8192 + u.pm * BM);
        const GAS int* pa = p + ((u.e != 64 && ra < u.n) ? ra : 0); const GAS int* pb = p + ((u.e != 64 && rb < u.n) ? rb : 0);
        asm volatile("global_load_dword %0, %1, off" : "=v"(v0) : "v"(pa) : "memory");
        asm volatile("global_load_dword %0, %1, off" : "=v"(v1) : "v"(pb) : "memory");
    }
    __device__ __forceinline__ void pre_commit(int v0, int v1, int wid, int lane_) const { const int lane = opaque(lane_); dstl[wid * 128 + lane] = v0; dstl[wid * 128 + 64 + lane] = v1; }
    __device__ __forceinline__ void operator()(AccRef acc, const Unit& u, int wr, int wc, int fr_, int fq_) const {
        const int fr = opaque(fr_), fq = opaque(fq_);
        const int r0 = wr * 64 + fr, colb = u.pn * BM + 16 * (4 * wc + fq);
#pragma unroll
        for (int ai = 0; ai < 2; ++ai)
#pragma unroll
            for (int m = 0; m < 4; ++m) { const int r = r0 + ai * HALF + m * 16;
                int dst;
                if constexpr (PRE) dst = (u.e == 64) ? (u.pm * BM + r) * NSLOT + 8 : dstl[(wr * 4 + wc) * 128 + ai * 64 + m * 16 + fr];
                else dst = (u.e == 64) ? (u.pm * BM + r) * NSLOT + 8 : ((const GAS int*)ldst)[u.e * 8192 + u.pm * BM + (r < u.n ? r : 0)];
                if (r < u.n && !nostore)
                    *(GAS u32x4*)(ys + (size_t)dst * D + colb) = (u32x4){pk_fp8x4(acc[ai][0][m][0] * YS_ACC), pk_fp8x4(acc[ai][0][m][1] * YS_ACC), pk_fp8x4(acc[ai][1][m][0] * YS_ACC), pk_fp8x4(acc[ai][1][m][1] * YS_ACC)}; }
    }
};
}

struct Args { const float* in[29]; float* out; unsigned char* ws; int ph_lo, ph_hi; };
enum { I_X = 0, I_C, I_WADA, I_BADA, I_NMIX, I_WIN, I_BIN, I_SINK, I_WO, I_ARE, I_AIM, I_LDT, I_BRE, I_BIM, I_CRE, I_CIM, I_SD, I_WGLU, I_WMIX, I_NFFN, I_WR, I_BR, I_WEG, I_WEU, I_WED, I_WSG, I_WSU, I_WSD, I_NFIN };

struct TDesc { const float* src; bf16_t* dst; int N, K, cc0; float f8s; };
__device__ __forceinline__ void tr_load(const TDesc& d, int lane, f32x4 (&v)[16]) {
    const int kr = lane >> 4, nq = lane & 15;
    const GAS float* p = (const GAS float*)d.src + (size_t)kr * d.N + 4 * nq; const size_t step = (size_t)4 * d.N;
#pragma unroll
    for (int i = 0; i < 16; ++i) { v[i] = __builtin_nontemporal_load((const GAS f32x4*)p); p += step; }
}
__device__ __forceinline__ void tr_finish(const TDesc& d, int lane, LAS float* scr, const f32x4 (&v)[16]) {
    const int kr = lane >> 4, nq = lane & 15;
#pragma unroll
    for (int i = 0; i < 16; ++i) { const int k = 4 * i + kr;
#pragma unroll
        for (int e = 0; e < 4; ++e) scr[k * 64 + ((4 * nq + e) ^ k)] = v[i][e]; }
    LDS_WAIT();
    const int c = lane & 7;
#pragma unroll
    for (int j = 0; j < 8; ++j) { const int n = (lane >> 3) + 8 * j; float s[8];
#pragma unroll
        for (int i = 0; i < 8; ++i) { const int k = 8 * c + i; s[i] = scr[k * 64 + (n ^ k)]; }
        u32x4 o; o.x = cvt_pk_bf16(s[0], s[1]); o.y = cvt_pk_bf16(s[2], s[3]); o.z = cvt_pk_bf16(s[4], s[5]); o.w = cvt_pk_bf16(s[6], s[7]);
        const int cc = d.cc0 + n, drow = d.cc0 >= 0 ? (128 * ((cc & 15) >> 3) + 8 * (cc >> 4) + (cc & 7)) : n;
        if (d.f8s != 0.f) { const f32x4 sa = (f32x4){s[0], s[1], s[2], s[3]} * d.f8s, sb = (f32x4){s[4], s[5], s[6], s[7]} * d.f8s;
            __builtin_nontemporal_store((u32x2){pg8::pk_fp8x4(sa), pg8::pk_fp8x4(sb)}, (GAS u32x2*)((unsigned char*)d.dst + (size_t)drow * d.K + 8 * c)); }
        else __builtin_nontemporal_store(o, (GAS u32x4*)(d.dst + (size_t)drow * d.K + 8 * c)); }
    LDS_WAIT();
}
constexpr int IT_WIN = 3072, IT_WO = 512, IT_WGLU = 512, IT_WMIX = 1024, IT_EXP = 16384, IT_SH = 256;
constexpr int IT_LAYER = IT_WIN + IT_WO + IT_WGLU + IT_WMIX + 3 * IT_EXP + 3 * IT_SH;
constexpr int IT_MOD = 768;
constexpr int IT_TR = 2 * IT_LAYER;

__device__ __forceinline__ TDesc tr_desc(const float* W, int K, int N, bf16_t* WT, int kb, int nb, int drow0) {
    TDesc d; d.src = W + (size_t)(64 * kb) * N + 64 * nb; d.dst = WT + (size_t)drow0 * K + 64 * kb; d.N = N; d.K = K; d.cc0 = -1; d.f8s = 0.f; return d;
}
__device__ __forceinline__ TDesc tr_desc8(const float* W, int K, int N, unsigned char* WT, int kb, int nb, int drow0, float scale) {
    TDesc d; d.src = W + (size_t)(64 * kb) * N + 64 * nb; d.dst = (bf16_t*)(WT + (size_t)drow0 * K + 64 * kb); d.N = N; d.K = K; d.cc0 = -1; d.f8s = scale; return d;
}
__device__ __forceinline__ TDesc tr_decode(const Args& a, int it) {
    unsigned char* ws = a.ws;
    const int l = 1 - it / IT_LAYER; int r = it % IT_LAYER;
    if (r < IT_WIN) return tr_desc(a.in[I_WIN] + (size_t)l * 2048 * 6144, 2048, 6144, (bf16_t*)(ws + WS_WIN) + (size_t)l * 6144 * 2048, r / 96, r % 96, 64 * (r % 96));
    r -= IT_WIN;
    if (r < IT_WO) return tr_desc(a.in[I_WO] + (size_t)l * 1024 * 2048, 1024, 2048, (bf16_t*)(ws + WS_WO) + (size_t)l * 2048 * 1024, r / 32, r % 32, 64 * (r % 32));
    r -= IT_WO;
    if (r < IT_WGLU) { const int kb = r / 64, nb = r % 64, n0 = 64 * nb; const int drow = n0 < 2048 ? 256 * (n0 / 128) + (n0 % 128) : 256 * ((n0 - 2048) / 128) + 128 + (n0 % 128);
        return tr_desc(a.in[I_WGLU] + (size_t)l * 512 * 4096, 512, 4096, (bf16_t*)(ws + WS_WGLU) + (size_t)l * 4096 * 512, kb, nb, drow); }
    r -= IT_WGLU;
    if (r < IT_WMIX) return tr_desc(a.in[I_WMIX] + (size_t)l * 2048 * 2048, 2048, 2048, (bf16_t*)(ws + WS_WMIX) + (size_t)l * 2048 * 2048, r / 32, r % 32, 64 * (r % 32));
    r -= IT_WMIX;
    unsigned char* wgu = ws + WS_WGU + (size_t)l * 65 * 1024 * 2048; bf16_t* wd = (bf16_t*)(ws + WS_WD) + (size_t)l * 65 * 2048 * 512;
    unsigned char* wd8 = ws + WS_WD + (size_t)l * 65 * 2048 * 512;
    if (r < 2 * IT_EXP) { const int up = r >= IT_EXP; r -= up * IT_EXP; const int e = r / 256, q = r % 256, kb = q / 8, nb = q % 8, n0 = 64 * nb;
        return tr_desc8(a.in[up ? I_WEU : I_WEG] + ((size_t)l * 64 + e) * 2048 * 512, 2048, 512, wgu + (size_t)e * 1024 * 2048, kb, nb, 256 * (n0 / 128) + (n0 % 128) + 128 * up, pg8::WGU_SCALE); }
    r -= 2 * IT_EXP;
    if (r < IT_EXP) { const int e = r / 256, q = r % 256, kb = q / 32, nb = q % 32;
        TDesc d = DOWN_F8 ? tr_desc8(a.in[I_WED] + ((size_t)l * 64 + e) * 512 * 2048, 512, 2048, wd8 + (size_t)e * 2048 * 512, kb, nb, 256 * (nb / 4), pg8::WD_SCALE)
                          : tr_desc(a.in[I_WED] + ((size_t)l * 64 + e) * 512 * 2048, 512, 2048, wd + (size_t)e * 2048 * 512, kb, nb, 256 * (nb / 4)); d.cc0 = 64 * (nb % 4); return d; }
    r -= IT_EXP;
    if (r < 2 * IT_SH) { const int up = r >= IT_SH; r -= up * IT_SH; const int kb = r / 8, nb = r % 8, n0 = 64 * nb;
        return tr_desc8(a.in[up ? I_WSU : I_WSG] + (size_t)l * 2048 * 512, 2048, 512, wgu + (size_t)64 * 1024 * 2048, kb, nb, 256 * (n0 / 128) + (n0 % 128) + 128 * up, pg8::WGU_SCALE); }
    r -= 2 * IT_SH;
    { const int kb = r / 32, nb = r % 32; TDesc d = DOWN_F8 ? tr_desc8(a.in[I_WSD] + (size_t)l * 512 * 2048, 512, 2048, wd8 + (size_t)64 * 2048 * 512, kb, nb, 256 * (nb / 4), pg8::WD_SCALE)
                                                          : tr_desc(a.in[I_WSD] + (size_t)l * 512 * 2048, 512, 2048, wd + (size_t)64 * 2048 * 512, kb, nb, 256 * (nb / 4)); d.cc0 = 64 * (nb % 4); return d; }
}
__device__ __forceinline__ void mod_item(const Args& a, int it, int tid, LAS unsigned char* lds) {
    const int lane = tid & 63, wave = tid >> 6;
    const int l = it / 384, r = it % 384, ks = r / 48, cc = r % 48;
    const float* W = a.in[I_WADA] + (size_t)l * 2048 * 12288 + (size_t)(256 * ks + 32 * wave) * 12288 + 256 * cc + 4 * lane;
    const float* c0 = a.in[I_C] + 256 * ks + 32 * wave, *c1 = c0 + 2048;
    f32x4 a0 = {0.f, 0.f, 0.f, 0.f}, a1 = {0.f, 0.f, 0.f, 0.f};
#pragma unroll 1
    for (int h = 0; h < 2; ++h) { f32x4 w[16]; const GAS float* wp = (const GAS float*)W + (size_t)(16 * h) * 12288;
#pragma unroll
        for (int i = 0; i < 16; ++i) { w[i] = __builtin_nontemporal_load((const GAS f32x4*)wp); wp += 12288; }
#pragma unroll
        for (int i = 0; i < 16; ++i) { const float x0 = c0[16 * h + i], x1 = c1[16 * h + i]; const float s0 = x0 * fast_sigmoid(x0), s1 = x1 * fast_sigmoid(x1); a0 += w[i] * s0; a1 += w[i] * s1; } }
    LAS f32x4* red = (LAS f32x4*)lds;
    red[(wave * 2 + 0) * 64 + lane] = a0; red[(wave * 2 + 1) * 64 + lane] = a1;
    __syncthreads();
    { const int b = tid >> 8, col = tid & 255; LAS float* rf = (LAS float*)lds; float s = 0.f;
#pragma unroll
        for (int w8 = 0; w8 < 8; ++w8) s += rf[((w8 * 2 + b) * 64) * 4 + col];
        ((float*)(a.ws + WS_MODP))[((size_t)(ks * 2 + l) * 2 + b) * 12288 + 256 * cc + col] = s; }
    __syncthreads();
}
__device__ __forceinline__ void p0_items(const Args& a, int gw, int ngw, LAS float* scr, int lane) {
#pragma unroll 1
    for (int it = gw; it < IT_TR; it += ngw) { f32x4 v[16]; const TDesc d = tr_decode(a, it); tr_load(d, lane, v); tr_finish(d, lane, scr, v); }
}

__device__ __forceinline__ void cpow(float are, float aim, float dt, int n, float& pr, float& pi) {
    const float mag = __builtin_amdgcn_exp2f((float)n * dt * are * LOG2E);
    const double turns = (double)n * ((double)dt * (double)aim * 0.15915494309189535);
    const float fr = (float)(turns - __builtin_rint(turns));
    pr = mag * __builtin_amdgcn_cosf(fr); pi = mag * __builtin_amdgcn_sinf(fr);
}
__device__ __forceinline__ void ssm_tables(const Args& a, int l, int g, LAS unsigned char* lds, int tid) {
    LAS f32x2* Apow = (LAS f32x2*)lds;
    LAS f32x2* Bb = (LAS f32x2*)(lds + 65 * 64 * 8);
    LAS f32x2* Cc = (LAS f32x2*)(lds + 65 * 64 * 8 + 64 * 16 * 8);
    const int lg = l * 32 + g;
    const float* are_p = a.in[I_ARE] + lg * 64; const float* aim_p = a.in[I_AIM] + lg * 64;
    const float dt = __expf(a.in[I_LDT][lg]);
    unsigned char* tb = a.ws + WS_SSM + (size_t)lg * SSM_STRIDE;
    bf16_t* Et = (bf16_t*)(tb + SSM_E); bf16_t* Ft = (bf16_t*)(tb + SSM_F); bf16_t* Kt = (bf16_t*)(tb + SSM_KT); GAS f32x2* Pt = (GAS f32x2*)(tb + SSM_P);
    for (int idx = tid; idx < 65 * 64; idx += 512) { const int n = idx >> 6, p = idx & 63; float pr, pi; cpow(are_p[p], aim_p[p], dt, n, pr, pi); Apow[idx] = (f32x2){pr, pi}; }
    for (int idx = tid; idx < 64 * 64; idx += 512) { const int m = idx >> 6, p = idx & 63; float pr, pi; cpow(are_p[p], aim_p[p], dt, 64 * m, pr, pi); Pt[idx] = (f32x2){pr, pi}; }
    for (int idx = tid; idx < 64 * 16; idx += 512) { const int p = idx >> 4, c = idx & 15;
        const float ar = are_p[p], ai = aim_p[p]; float br, bi; cpow(ar, ai, dt, 1, br, bi);
        const float nr = br - 1.0f, ni = bi, den = ar * ar + ai * ai; const float fr = (nr * ar + ni * ai) / den, fi = (ni * ar - nr * ai) / den;
        const float b_r = a.in[I_BRE][(size_t)lg * 1024 + idx], b_i = a.in[I_BIM][(size_t)lg * 1024 + idx];
        Bb[idx] = (f32x2){fr * b_r - fi * b_i, fr * b_i + fi * b_r}; }
    for (int idx = tid; idx < 16 * 64; idx += 512) Cc[idx] = (f32x2){a.in[I_CRE][(size_t)lg * 1024 + idx], a.in[I_CIM][(size_t)lg * 1024 + idx]};
    __syncthreads();
    for (int idx = tid; idx < 128 * 128; idx += 512) { const int n = idx >> 7, k8 = idx & 127, ri = n >> 6, p = n & 63, s = k8 >> 1, c0 = (k8 & 1) * 8;
        const f32x2 ap = Apow[(63 - s) * 64 + p]; float v[8];
#pragma unroll
        for (int j = 0; j < 8; ++j) { const f32x2 b = Bb[p * 16 + c0 + j]; v[j] = ri ? (ap.x * b.y + ap.y * b.x) : (ap.x * b.x - ap.y * b.y); }
        u32x4 o; o.x = cvt_pk_bf16(v[0], v[1]); o.y = cvt_pk_bf16(v[2], v[3]); o.z = cvt_pk_bf16(v[4], v[5]); o.w = cvt_pk_bf16(v[6], v[7]);
        *(GAS u32x4*)(Et + (size_t)n * 1024 + k8 * 8) = o; }
    for (int idx = tid; idx < 1024 * 16; idx += 512) { const int n = idx >> 4, k8 = idx & 15, t = n >> 4, c = n & 15, ri = k8 >> 3, p0 = (k8 & 7) * 8; float v[8];
#pragma unroll
        for (int j = 0; j < 8; ++j) { const f32x2 ap = Apow[(t + 1) * 64 + p0 + j], cc = Cc[c * 64 + p0 + j]; v[j] = ri ? -(cc.x * ap.y + cc.y * ap.x) : (cc.x * ap.x - cc.y * ap.y); }
        u32x4 o; o.x = cvt_pk_bf16(v[0], v[1]); o.y = cvt_pk_bf16(v[2], v[3]); o.z = cvt_pk_bf16(v[4], v[5]); o.w = cvt_pk_bf16(v[6], v[7]);
        *(GAS u32x4*)(Ft + (size_t)n * 128 + k8 * 8) = o; }
    for (int idx = tid; idx < 65 * 16 * 2; idx += 512) { const int t1 = idx >> 5, c = (idx >> 1) & 15, c0 = (idx & 1) * 8; float v[8];
#pragma unroll
        for (int j = 0; j < 8; ++j) v[j] = 0.f;
        if (t1 > 0) for (int p = 0; p < 64; ++p) { const f32x2 ap = Apow[(t1 - 1) * 64 + p], cc = Cc[c * 64 + p]; const float cr = cc.x * ap.x - cc.y * ap.y, ci = cc.x * ap.y + cc.y * ap.x;
#pragma unroll
            for (int j = 0; j < 8; ++j) { const f32x2 b = Bb[p * 16 + c0 + j]; v[j] += cr * b.x - ci * b.y; } }
        u32x4 o; o.x = cvt_pk_bf16(v[0], v[1]); o.y = cvt_pk_bf16(v[2], v[3]); o.z = cvt_pk_bf16(v[4], v[5]); o.w = cvt_pk_bf16(v[6], v[7]);
        *(GAS u32x4*)(Kt + (size_t)(t1 * 16 + c) * 16 + c0) = o; }
    __syncthreads();
}

__device__ __forceinline__ void attn_unit(const bf16_t* __restrict__ proj, bf16_t* __restrict__ attn, const float* sinks, int unit, LAS unsigned char* lds, int tid_) {
    const int tid = opaque(tid_);
    const int b = unit >> 7, hk = (unit >> 5) & 3, nb = unit & 31;
    const int wave = __builtin_amdgcn_readfirstlane(tid >> 6), lane = tid & 63, r16 = lane & 15, q4 = lane >> 4;
    LAS unsigned char* Kl = lds;
    LAS unsigned char* Vt = lds + 36864;
    const int gh0 = wave >> 1, half0 = wave & 1, qh0 = hk * 4 + gh0;
    bf16x8 qfa[4][2];
#pragma unroll
    for (int pass = 0; pass < 4; ++pass)
#pragma unroll
        for (int s = 0; s < 2; ++s) qfa[pass][s] = *(const GAS bf16x8*)(proj + (size_t)(b * SEQ + nb * 128 + 16 * (half0 * 4 + pass) + r16) * INW + O_Q + qh0 * 64 + 32 * s + 8 * q4);
#pragma unroll
    for (int i = 0; i < 4; ++i) { const int id = tid + 512 * i, key = id >> 3, ch = id & 7; const int tp = nb * 128 - 128 + key;
        u32x4 kv = {0u, 0u, 0u, 0u}, vv = {0u, 0u, 0u, 0u};
        if (tp >= 0) { const bf16_t* src = proj + (size_t)(b * SEQ + tp) * INW + hk * 64 + ch * 8; kv = *(const GAS u32x4*)(src + O_K); vv = *(const GAS u32x4*)(src + O_V); }
        *(LAS u32x4*)(Kl + key * 144 + ch * 16) = kv;
        LAS bf16_t* vd = (LAS bf16_t*)(Vt + (ch * 8) * 528 + key * 2);
        vd[0 * 264] = (bf16_t)(vv.x & 0xffff); vd[1 * 264] = (bf16_t)(vv.x >> 16); vd[2 * 264] = (bf16_t)(vv.y & 0xffff); vd[3 * 264] = (bf16_t)(vv.y >> 16);
        vd[4 * 264] = (bf16_t)(vv.z & 0xffff); vd[5 * 264] = (bf16_t)(vv.z >> 16); vd[6 * 264] = (bf16_t)(vv.w & 0xffff); vd[7 * 264] = (bf16_t)(vv.w >> 16); }
    __syncthreads();
    const int gh = wave >> 1, half = wave & 1, qh = hk * 4 + gh;
    const float sink = sinks[qh] * LOG2E;
#pragma unroll
    for (int pass = 0; pass < 4; ++pass) {
        const int kt0 = half * 4 + pass, i0 = 16 * kt0, iabs = i0 + r16; const size_t qtok = (size_t)(b * SEQ + nb * 128 + iabs);
        bf16x8 qf[2];
#pragma unroll
        for (int s = 0; s < 2; ++s) qf[s] = qfa[pass][s];
        __builtin_amdgcn_sched_barrier(0);
        f32x4 st[10];
        const LAS unsigned char* kbase = Kl + (16 * kt0 + r16) * 144 + (8 * q4) * 2;
#pragma unroll
        for (int i = 0; i < 9; ++i) { st[i] = (f32x4){0.f, 0.f, 0.f, 0.f};
#pragma unroll
            for (int s = 0; s < 2; ++s) { const bf16x8 kf = *(const LAS bf16x8*)(kbase + i * 16 * 144 + s * 64);
                st[i] = __builtin_amdgcn_mfma_f32_16x16x32_bf16(kf, qf[s], st[i], 0, 0, 0); } }
        st[9] = (f32x4){0.f, 0.f, 0.f, 0.f};
        float mx = sink;
#pragma unroll
        for (int i = 0; i < 9; ++i)
#pragma unroll
            for (int r = 0; r < 4; ++r) { const int jj = 16 * i + 4 * q4 + r; const bool ok = (jj > r16) && (jj <= r16 + 128) && (nb > 0 || jj + i0 >= 128);
                st[i][r] = ok ? st[i][r] : -1e30f; mx = fmaxf(mx, st[i][r]); }
        mx = fmaxf(mx, __shfl_xor(mx, 16)); mx = fmaxf(mx, __shfl_xor(mx, 32));
        float sum = 0.f;
#pragma unroll
        for (int i = 0; i < 9; ++i)
#pragma unroll
            for (int r = 0; r < 4; ++r) { const float p = __builtin_amdgcn_exp2f(st[i][r] - mx); st[i][r] = p; sum += p; }
        sum += __shfl_xor(sum, 16); sum += __shfl_xor(sum, 32);
        const float inv = __builtin_amdgcn_rcpf(sum + __builtin_amdgcn_exp2f(sink - mx));
        f32x4 ot[4];
#pragma unroll
        for (int dt = 0; dt < 4; ++dt) ot[dt] = (f32x4){0.f, 0.f, 0.f, 0.f};
#pragma unroll
        for (int kk = 0; kk < 5; ++kk) {
            u32x4 pw; pw.x = cvt_pk_bf16(st[2 * kk][0], st[2 * kk][1]); pw.y = cvt_pk_bf16(st[2 * kk][2], st[2 * kk][3]); pw.z = cvt_pk_bf16(st[2 * kk + 1][0], st[2 * kk + 1][1]); pw.w = cvt_pk_bf16(st[2 * kk + 1][2], st[2 * kk + 1][3]);
            const bf16x8 pf = __builtin_bit_cast(bf16x8, pw);
            const int t0 = kt0 + 2 * kk, t1 = (t0 + 1) < 15 ? (t0 + 1) : 15;
#pragma unroll
            for (int dt = 0; dt < 4; ++dt) { const LAS unsigned char* vp = Vt + (16 * dt + r16) * 528 + (4 * q4) * 2;
                const u32x2 lo = *(const LAS u32x2*)(vp + t0 * 32), hi = *(const LAS u32x2*)(vp + t1 * 32);
                const u32x4 vw = {lo.x, lo.y, hi.x, hi.y};
                ot[dt] = __builtin_amdgcn_mfma_f32_16x16x32_bf16(__builtin_bit_cast(bf16x8, vw), pf, ot[dt], 0, 0, 0); } }
#pragma unroll
        for (int dt = 0; dt < 4; ++dt) { u32x2 o; o.x = cvt_pk_bf16(ot[dt][0] * inv, ot[dt][1] * inv); o.y = cvt_pk_bf16(ot[dt][2] * inv, ot[dt][3] * inv);
            *(GAS u32x2*)(attn + qtok * 1024 + qh * 64 + 16 * dt + 4 * q4) = o; }
    }
    __syncthreads();
}

constexpr int UPITCH = 2064;
__device__ __forceinline__ void stage_u_issue(const bf16_t* __restrict__ proj, int g, int b, int q, int tid, u32x4 (&uu)[4]) {
#pragma unroll
    for (int i = 0; i < 4; ++i) { const int id = tid + 512 * i, tl = id >> 1, half = id & 1, chunk = tl >> 6, s = tl & 63;
        uu[i] = *(const GAS u32x4*)(proj + (size_t)(b * SEQ + (16 * q + chunk) * 64 + s) * INW + O_U + g * 16 + 8 * half); }
}
__device__ __forceinline__ void stage_u_commit(LAS unsigned char* Al, int tid, u32x4 (&uu)[4]) {
    asm volatile("" : "+v"(uu[0]), "+v"(uu[1]), "+v"(uu[2]), "+v"(uu[3]) :: "memory");
#pragma unroll
    for (int i = 0; i < 4; ++i) { const int id = tid + 512 * i, tl = id >> 1, half = id & 1, chunk = tl >> 6, s = tl & 63;
        *(LAS u32x4*)(Al + chunk * UPITCH + (s * 16 + 8 * half) * 2) = uu[i]; }
}
__device__ __forceinline__ void ssm_s1_unit(const bf16_t* __restrict__ proj, const bf16_t* __restrict__ Et, float* __restrict__ sloc, int g, int b, int q, LAS unsigned char* lds, int tid_) {
    const int tid = opaque(tid_);
    const int wave = __builtin_amdgcn_readfirstlane(tid >> 6), lane = tid & 63, r16 = lane & 15, q4 = lane >> 4;
    const bf16_t* eb = Et + (size_t)(16 * wave + r16) * 1024 + 8 * q4;
    u32x4 uu[4]; stage_u_issue(proj, g, b, q, tid, uu);
    bf16x8 bf[32];
#pragma unroll
    for (int ks = 0; ks < 32; ++ks) bf[ks] = *(const GAS bf16x8*)(eb + 32 * ks);
    stage_u_commit(lds, tid, uu);
    __syncthreads();
    f32x4 acc = {0.f, 0.f, 0.f, 0.f};
#pragma unroll
    for (int ks = 0; ks < 32; ++ks) { const bf16x8 af = *(const LAS bf16x8*)(lds + r16 * UPITCH + (32 * ks + 8 * q4) * 2);
        acc = __builtin_amdgcn_mfma_f32_16x16x32_bf16(af, bf[ks], acc, 0, 0, 0); }
#pragma unroll
    for (int r = 0; r < 4; ++r) sloc[((size_t)(b * 64 + 16 * q + 4 * q4 + r) * 32 + g) * 128 + 16 * wave + r16] = acc[r];
    __syncthreads();
}

__device__ __forceinline__ void ssm_s2_unit(const bf16_t* __restrict__ proj, const unsigned char* __restrict__ tb, const float* __restrict__ sloc, const float* __restrict__ dskip, bf16_t* __restrict__ ybuf,
                                            int g, int b, int q, LAS unsigned char* lds, int tid_) {
    const int tid = opaque(tid_);
    const int wave = __builtin_amdgcn_readfirstlane(tid >> 6), lane = tid & 63, r16 = lane & 15, q4 = lane >> 4;
    LAS unsigned char* Ktl = lds;
    LAS bf16_t* x0l = (LAS bf16_t*)(lds + 33280);
    LAS unsigned char* Al = lds + 49152;
    const bf16_t* Ft = (const bf16_t*)(tb + SSM_F); const GAS f32x2* Pt = (const GAS f32x2*)(tb + SSM_P);
    const int p = tid & 63, part = tid >> 6, j0 = 16 * q;
    f32x2 Pp[6]; float srp[6], sip[6];
#pragma unroll
    for (int ii = 0; ii < 6; ++ii) { const int i = part + 8 * ii; const bool ok = i < j0; const int ic = ok ? i : 0, pc = ok ? (j0 - 1 - i) : 0;
        Pp[ii] = Pt[pc * 64 + p]; const GAS float* sp = (const GAS float*)(sloc + ((size_t)(b * 64 + ic) * 32 + g) * 128); srp[ii] = sp[p]; sip[ii] = sp[64 + p]; }
    u32x4 kt[5];
    { const GAS u32x4* src = (const GAS u32x4*)(tb + SSM_KT);
#pragma unroll
      for (int j = 0; j < 5; ++j) { const int i = tid + 512 * j; kt[j] = src[i < 33280 / 16 ? i : 33280 / 16 - 1]; } }
    u32x4 uu[4]; stage_u_issue(proj, g, b, q, tid, uu);
    const f32x2 A64 = Pt[64 + p];
    float sr[15], si[15];
#pragma unroll
    for (int jq = 0; jq < 15; ++jq) { const GAS float* sp = (const GAS float*)(sloc + ((size_t)(b * 64 + j0 + jq) * 32 + g) * 128); sr[jq] = sp[p]; si[jq] = sp[64 + p]; }
    bf16x8 ff[4][8];
#pragma unroll
    for (int k2 = 0; k2 < 4; ++k2)
#pragma unroll
        for (int tt = 0; tt < 8; ++tt) ff[k2][tt] = *(const GAS bf16x8*)(Ft + (size_t)((wave + 8 * tt) * 16 + r16) * 128 + 32 * k2 + 8 * q4);
    {
        LAS f32x2* red = (LAS f32x2*)(lds + 40960);
        asm volatile("" : "+v"(Pp[0]), "+v"(Pp[1]), "+v"(Pp[2]), "+v"(Pp[3]), "+v"(Pp[4]), "+v"(Pp[5]) :: "memory");
        asm volatile("" : "+v"(srp[0]), "+v"(srp[1]), "+v"(srp[2]), "+v"(srp[3]), "+v"(srp[4]), "+v"(srp[5]), "+v"(sip[0]), "+v"(sip[1]), "+v"(sip[2]), "+v"(sip[3]), "+v"(sip[4]), "+v"(sip[5]) :: "memory");
        float xr = 0.f, xi = 0.f;
#pragma unroll
        for (int ii = 0; ii < 6; ++ii) { const bool ok = part + 8 * ii < j0; const float pr = ok ? Pp[ii].x : 0.f, pi = ok ? Pp[ii].y : 0.f;
            xr += pr * srp[ii] - pi * sip[ii]; xi += pr * sip[ii] + pi * srp[ii]; }
        red[part * 64 + p] = (f32x2){xr, xi};
        asm volatile("" : "+v"(kt[0]), "+v"(kt[1]), "+v"(kt[2]), "+v"(kt[3]), "+v"(kt[4]) :: "memory");
#pragma unroll
        for (int j = 0; j < 5; ++j) { const int i = tid + 512 * j; if (i < 33280 / 16) *(LAS u32x4*)(Ktl + i * 16) = kt[j]; }
        stage_u_commit(Al, tid, uu);
        __syncthreads();
        if (part == 0) {
            float ar = 0.f, ai = 0.f;
#pragma unroll
            for (int w8 = 0; w8 < 8; ++w8) { const f32x2 t = red[w8 * 64 + p]; ar += t.x; ai += t.y; }
#pragma unroll
            for (int jq = 0; jq < 16; ++jq) {
                x0l[jq * 136 + p] = (bf16_t)(cvt_pk_bf16(ar, 0.f) & 0xffff); x0l[jq * 136 + 64 + p] = (bf16_t)(cvt_pk_bf16(ai, 0.f) & 0xffff);
                if (jq < 15) { const float nr = A64.x * ar - A64.y * ai + sr[jq], ni = A64.x * ai + A64.y * ar + si[jq]; ar = nr; ai = ni; } }
        }
    }
    __syncthreads();
    f32x4 acc[8];
#pragma unroll
    for (int tt = 0; tt < 8; ++tt) acc[tt] = (f32x4){0.f, 0.f, 0.f, 0.f};
#pragma unroll 2
    for (int ks = 0; ks < 32; ++ks) { const int s = 2 * ks + (q4 >> 1);
        const bf16x8 af = *(const LAS bf16x8*)(Al + r16 * UPITCH + (32 * ks + 8 * q4) * 2);
#pragma unroll
        for (int tt = 0; tt < 8; ++tt) { const int t = wave + 8 * tt;
            const int tau1 = t - s + 1, tc = tau1 > 0 ? tau1 : 0;
            const bf16x8 bf = *(const LAS bf16x8*)(Ktl + ((tc * 16 + r16) * 16 + 8 * (q4 & 1)) * 2);
            acc[tt] = __builtin_amdgcn_mfma_f32_16x16x32_bf16(af, bf, acc[tt], 0, 0, 0); }
        __builtin_amdgcn_sched_barrier(0); }
#pragma unroll
    for (int k2 = 0; k2 < 4; ++k2) { const bf16x8 ax = *(const LAS bf16x8*)(x0l + r16 * 136 + 32 * k2 + 8 * q4);
#pragma unroll
        for (int tt = 0; tt < 8; ++tt) acc[tt] = __builtin_amdgcn_mfma_f32_16x16x32_bf16(ax, ff[k2][tt], acc[tt], 0, 0, 0); }
    const float dsk = dskip[g * 16 + r16];
#pragma unroll
    for (int tt = 0; tt < 8; ++tt) { const int t = wave + 8 * tt;
#pragma unroll
        for (int r = 0; r < 4; ++r) { const int jq = 4 * q4 + r; const size_t tok = (size_t)(b * SEQ + (16 * q + jq) * 64 + t);
            const float uv = bf1(*(const LAS bf16_t*)(Al + jq * UPITCH + (t * 16 + r16) * 2)); const float y = acc[tt][r] + dsk * uv;
            const float z = 0.7978845608028654f * (y + 0.044715f * y * y * y); const float gl = y * fast_sigmoid(2.0f * z);
            ybuf[tok * 512 + g * 16 + r16] = (bf16_t)(cvt_pk_bf16(gl, 0.f) & 0xffff); } }
    __syncthreads();
}

__device__ __forceinline__ unsigned char* opaque_p(unsigned char* p) { asm volatile("" : "+s"(p)); return p; }
#define PH_BEGIN const int tid = opaque((int)threadIdx.x), lane = tid & 63, wave = __builtin_amdgcn_readfirstlane(tid >> 6); unsigned char* const ws = opaque_p(args.ws); (void)lane; (void)wave; \
    bf16_t* const hbuf = (bf16_t*)(ws + WS_H); bf16_t* const proj = (bf16_t*)(ws + WS_PROJ); float* const mod = (float*)(ws + WS_MOD); float* const xbuf = args.out; unsigned* const ctl = (unsigned*)(ws + WS_CTL); \
    (void)hbuf; (void)proj; (void)mod; (void)xbuf; (void)ctl;

__global__ void __launch_bounds__(NWAVES * 64, 2) mega_fwd(Args args) {
    extern __shared__ __attribute__((aligned(16))) unsigned char lds_raw[];
    LAS unsigned char* lds = (LAS unsigned char*)lds_raw;
    const int G = gridDim.x, blk = blockIdx.x;
    XcdBarrier bar;
    {
        volatile LAS unsigned* MISC = (volatile LAS unsigned*)(lds + MISC_OFF);
        unsigned* ctl0 = (unsigned*)(args.ws + WS_CTL);
        for (int u = threadIdx.x; u < (LDS_BYTES - LDSCTL_OFF) / 4; u += NWAVES * 64) ((LAS unsigned*)(lds + LDSCTL_OFF))[u] = 0u;
        __syncthreads();
        bar.bar = ctl0 + CW_BAR; bar.x = 0; bar.st = nullptr;
        if (N_LAUNCHES == 1) bar = xcd_barrier_post(ctl0 + CW_BAR, MISC + 8);
    }
#define GRID_BAR() do { if (N_LAUNCHES == 1) xcd_barrier(bar); } while (0)
    const int lo = args.ph_lo, hi = args.ph_hi;
#ifndef PH_MASK
#define PH_MASK 0x7ff
#endif
#ifndef REP_MASK
#define REP_MASK 0
#endif
#ifndef REP_VARIANT
#define REP_VARIANT 0
#endif
#define REPS(bit) (((REP_MASK) >> (bit)) & 1 ? 2 : 1)
#define IN(k) (lo <= (k) && (k) < hi)
#define BOTH(k) (IN(k) && IN((k) + 1))

    if ((PH_MASK & 1) && IN(0)) {
        PH_BEGIN
            _Pragma("unroll 1") for (int rep = 0; rep < REPS(9); ++rep) {
        if (blk < 64) ssm_tables(args, blk >> 5, blk & 31, lds, tid);
        LAS float* scr = (LAS float*)(lds + wave * 16384);
        for (int idx = blk * 512 + tid; idx < 2 * 64 * 256; idx += G * 512) {
            const int e = idx & 63, kc = (idx >> 6) & 255, l = idx >> 14; const float* wsrc = args.in[I_WR] + (size_t)l * D * NE + (size_t)(8 * kc) * NE + e;
            float w[8], lo[8]; unsigned hi[4];
#pragma unroll
            for (int i = 0; i < 8; ++i) w[i] = wsrc[i * NE];
#pragma unroll
            for (int i = 0; i < 4; ++i) { hi[i] = cvt_pk_bf16(w[2 * i], w[2 * i + 1]); lo[2 * i] = w[2 * i] - bf_lo(hi[i]); lo[2 * i + 1] = w[2 * i + 1] - bf_hi(hi[i]); }
            bf16_t* dsth = (bf16_t*)(ws + WS_WRT) + ((size_t)(l * 2) * 64 + e) * 2048 + 8 * kc;
            *(GAS u32x4*)dsth = (u32x4){hi[0], hi[1], hi[2], hi[3]};
            *(GAS u32x4*)(dsth + 64 * 2048) = (u32x4){cvt_pk_bf16(lo[0], lo[1]), cvt_pk_bf16(lo[2], lo[3]), cvt_pk_bf16(lo[4], lo[5]), cvt_pk_bf16(lo[6], lo[7])}; }
        for (int it = blk; it < IT_MOD; it += G) mod_item(args, it, tid, lds);
        p0_items(args, blk * NWAVES + wave, G * NWAVES, scr, lane);
            if (rep + 1 < REPS(9)) GRID_BAR(); }
        if (BOTH(0)) GRID_BAR();
    }
    if ((PH_MASK & 2) && IN(1)) {
        PH_BEGIN
        const float* modp = (const float*)(ws + WS_MODP);
        for (int idx = blk * 512 + tid; idx < 2 * 2 * 12288; idx += G * 512) { const int l = idx / 24576, c = idx % 12288; float s = args.in[I_BADA][l * 12288 + c];
#pragma unroll
            for (int ks = 0; ks < 8; ++ks) s += modp[(size_t)ks * 49152 + idx];
            mod[idx] = s; }
        for (int rb = blk; rb < T / 32; rb += G) {
            const int bb = (rb * 32) / SEQ;
            LAS float* shl = (LAS float*)lds; LAS float* scl = shl + 2048;
            for (int c = tid; c < 4096; c += 512) { float s = args.in[I_BADA][c];
#pragma unroll
                for (int ks = 0; ks < 8; ++ks) s += modp[(size_t)ks * 49152 + bb * 12288 + c];
                shl[c] = s; }
            __syncthreads();
#pragma unroll 1
            for (int pr = 0; pr < 2; ++pr) {
                f32x4 v[2][4][2]; float ss[2] = {0.f, 0.f};
#pragma unroll
                for (int rr = 0; rr < 2; ++rr) { const float* xr = args.in[I_X] + (size_t)(rb * 32 + wave * 4 + pr * 2 + rr) * D;
#pragma unroll
                    for (int j = 0; j < 4; ++j)
#pragma unroll
                        for (int h = 0; h < 2; ++h) v[rr][j][h] = *(const GAS f32x4*)(xr + 8 * (lane + 64 * j) + 4 * h); }
#pragma unroll
                for (int rr = 0; rr < 2; ++rr)
#pragma unroll
                    for (int j = 0; j < 4; ++j)
#pragma unroll
                        for (int h = 0; h < 2; ++h) ss[rr] += v[rr][j][h][0] * v[rr][j][h][0] + v[rr][j][h][1] * v[rr][j][h][1] + v[rr][j][h][2] * v[rr][j][h][2] + v[rr][j][h][3] * v[rr][j][h][3];
#pragma unroll
                for (int rr = 0; rr < 2; ++rr) { const int row = rb * 32 + wave * 4 + pr * 2 + rr;
                    const float rstd = 1.0f / sqrtf(wave_sum(ss[rr]) * (1.0f / D) + NORM_EPS);
                    bf16_t* hrow = hbuf + (size_t)row * D;
#pragma unroll
                    for (int j = 0; j < 4; ++j) { const int c = 8 * (lane + 64 * j); f32x4 o[2];
#pragma unroll
                        for (int h = 0; h < 2; ++h) { const f32x4 g = *(const GAS f32x4*)(args.in[I_NMIX] + c + 4 * h); const f32x4 s1 = *(const LAS f32x4*)(scl + c + 4 * h), s0 = *(const LAS f32x4*)(shl + c + 4 * h);
                            o[h] = v[rr][j][h] * rstd * g * (s1 + 1.0f) + s0; }
                        *(GAS u32x4*)(hrow + c) = pg8::pack8(o[0], o[1]); } } }
            __syncthreads();
        }
        if (BOTH(1)) GRID_BAR();
    }

#pragma unroll 1
    for (int l = 0; l < DEPTH; ++l) {
        const int pb = 2 + 9 * l;
        if ((PH_MASK & 4) && IN(pb + 0)) {
            PH_BEGIN
            _Pragma("unroll 1") for (int rep = 0; rep < REPS(0); ++rep) {
            pg8::DenseOrder S; S.init(T, INW, D, G, blk, (bf16_t*)(ws + WS_WIN) + (size_t)l * INW * D);
            pg8::EpiInProj E{proj, args.in[I_BIN] + l * INW, 0.125f * LOG2E, (REP_VARIANT && rep == 1) ? 1 : 0};
            pg8::gemm_phase<pg8::EpiInProj, pg8::DenseOrder, GEMM_ALIGN>(lds, (const char*)hbuf, D, S, E);
            if (rep + 1 < REPS(0)) GRID_BAR(); }
            if (BOTH(pb + 0)) GRID_BAR();
        }
        if ((PH_MASK & 8) && IN(pb + 1)) {
            PH_BEGIN
            _Pragma("unroll 1") for (int rep = 0; rep < REPS(1); ++rep) {
            for (int u = blk; u < 256; u += G) attn_unit(proj, (bf16_t*)(ws + WS_ATTN), args.in[I_SINK] + l * 16, u, lds, tid);
            if (!(REP_VARIANT == 1 && rep == 1)) for (int u = blk; u < 256; u += G) { const int g = u >> 3, b = (u >> 2) & 1, q = u & 3;
                ssm_s1_unit(proj, (const bf16_t*)(ws + WS_SSM + (size_t)(l * 32 + g) * SSM_STRIDE + SSM_E), (float*)(ws + WS_SLOC), g, b, q, lds, tid); }
            if (rep + 1 < REPS(1)) GRID_BAR(); }
            if (BOTH(pb + 1)) GRID_BAR();
        }
        if ((PH_MASK & 16) && IN(pb + 2)) {
            PH_BEGIN
            _Pragma("unroll 1") for (int rep = 0; rep < REPS(2); ++rep) {
            if (!(REP_VARIANT == 1 && rep == 1)) for (int u = blk; u < 256; u += G) { const int g = u >> 3, b = (u >> 2) & 1, q = u & 3;
                ssm_s2_unit(proj, ws + WS_SSM + (size_t)(l * 32 + g) * SSM_STRIDE, (const float*)(ws + WS_SLOC), args.in[I_SD] + l * 512, (bf16_t*)(ws + WS_Y), g, b, q, lds, tid); }
            pg8::DenseOrder S; S.init(T, D, 1024, G, blk, (bf16_t*)(ws + WS_WO) + (size_t)l * D * 1024);
            pg8::EpiAttnProj E{proj, (bf16_t*)(ws + WS_MIXED)};
            pg8::gemm_phase<pg8::EpiAttnProj, pg8::DenseOrder>(lds, (const char*)(ws + WS_ATTN), 1024, S, E);
            if (rep + 1 < REPS(2)) GRID_BAR(); }
            if (BOTH(pb + 2)) GRID_BAR();
        }
        if ((PH_MASK & 32) && IN(pb + 3)) {
            PH_BEGIN
            const int nrep = REPS(3);
            _Pragma("unroll 1") for (int rep = 0; rep < nrep; ++rep) {
            pg8::DenseOrder S; S.init(T, 4096, 512, G, blk, (bf16_t*)(ws + WS_WGLU) + (size_t)l * 4096 * 512);
            pg8::EpiGlu E{proj, (const bf16_t*)(ws + WS_MIXED), (bf16_t*)(ws + WS_MIXED2)};
            pg8::gemm_phase<pg8::EpiGlu, pg8::DenseOrder, GEMM_ALIGN>(lds, (const char*)(ws + WS_Y), 512, S, E);
            if (rep + 1 < nrep) GRID_BAR(); }
            if (BOTH(pb + 3)) GRID_BAR();
        }
        if ((PH_MASK & 64) && IN(pb + 4)) {
            PH_BEGIN
            const int nrep = (l == 0 ? REPS(4) : 1);
            _Pragma("unroll 1") for (int rep = 0; rep < nrep; ++rep) {
            pg8::DenseOrder S; S.init(T, D, D, G, blk, (bf16_t*)(ws + WS_WMIX) + (size_t)l * D * D);
            pg8::EpiMixOut E{l == 0 ? args.in[I_X] : (const float*)nullptr, (const bf16_t*)(ws + WS_XB), (bf16_t*)(ws + WS_XB), mod + (size_t)l * 2 * 12288 + 2 * 2048};
            pg8::gemm_phase<pg8::EpiMixOut, pg8::DenseOrder>(lds, (const char*)(ws + WS_MIXED2), D, S, E);
            if (rep + 1 < nrep) GRID_BAR(); }
            if (BOTH(pb + 4)) GRID_BAR();
        }
        if ((PH_MASK & 128) && IN(pb + 5)) {
            PH_BEGIN
            const int nrep = REPS(5);
            _Pragma("unroll 1") for (int rep = 0; rep < nrep; ++rep) {
            const float* modl = mod + (size_t)l * 2 * 12288;
            int* ltok = (int*)(ws + WS_LTOK); int* ldst = (int*)(ws + WS_LDST); float* lw = (float*)(ws + WS_LW);
            LAS unsigned long long* selmask = (LAS unsigned long long*)(lds + SEL_OFF);
            LAS float* selw = (LAS float*)(lds + SEL_OFF + 256);
            const float* wrt = args.in[I_WR] + (size_t)l * D * NE; const float brt = args.in[I_BR][l * NE + lane];
            for (int rb = blk; rb < T / 32; rb += G) {
                const int bb = (rb * 32) / SEQ; const float* sh2 = modl + bb * 12288 + 3 * 2048; const float* sc2 = sh2 + 2048;
#pragma unroll 1
                for (int it = 0; it < 2; ++it) {
                    {
                        f32x4 v[2][4][2]; float ss[2] = {0.f, 0.f};
                        u32x4 xw[2][4]; f32x4 gsc[4][2], gsh[4][2], sc1[4][2];
#pragma unroll
                        for (int rr = 0; rr < 2; ++rr) { const bf16_t* xr = (const bf16_t*)(ws + WS_XB) + (size_t)(rb * 32 + it * 16 + 2 * wave + rr) * D;
#pragma unroll
                            for (int j = 0; j < 4; ++j) xw[rr][j] = *(const GAS u32x4*)(xr + 8 * (lane + 64 * j)); }
#pragma unroll
                        for (int j = 0; j < 4; ++j)
#pragma unroll
                            for (int h = 0; h < 2; ++h) { const int c = 8 * (lane + 64 * j) + 4 * h;
                                gsc[j][h] = *(const GAS f32x4*)(args.in[I_NFFN] + l * D + c); sc1[j][h] = *(const GAS f32x4*)(sc2 + c); gsh[j][h] = *(const GAS f32x4*)(sh2 + c); }
#pragma unroll
                        for (int rr = 0; rr < 2; ++rr) asm volatile("" : "+v"(xw[rr][0]), "+v"(xw[rr][1]), "+v"(xw[rr][2]), "+v"(xw[rr][3]) :: "memory");
#pragma unroll
                        for (int j = 0; j < 4; ++j) asm volatile("" : "+v"(gsc[j][0]), "+v"(gsc[j][1]), "+v"(sc1[j][0]), "+v"(sc1[j][1]), "+v"(gsh[j][0]), "+v"(gsh[j][1]) :: "memory");
#pragma unroll
                        for (int rr = 0; rr < 2; ++rr)
#pragma unroll
                            for (int j = 0; j < 4; ++j) pg8::unpack8(xw[rr][j], v[rr][j][0], v[rr][j][1]);
#pragma unroll
                        for (int j = 0; j < 4; ++j)
#pragma unroll
                            for (int h = 0; h < 2; ++h) gsc[j][h] = gsc[j][h] * (sc1[j][h] + 1.0f);
#pragma unroll
                        for (int rr = 0; rr < 2; ++rr)
#pragma unroll
                            for (int j = 0; j < 4; ++j)
#pragma unroll
                                for (int h = 0; h < 2; ++h) ss[rr] += v[rr][j][h][0] * v[rr][j][h][0] + v[rr][j][h][1] * v[rr][j][h][1] + v[rr][j][h][2] * v[rr][j][h][2] + v[rr][j][h][3] * v[rr][j][h][3];
#pragma unroll
                        for (int rr = 0; rr < 2; ++rr) { const int lr = 2 * wave + rr, row = rb * 32 + it * 16 + lr;
                            const float rstd = 1.0f / sqrtf(wave_sum(ss[rr]) * (1.0f / D) + NORM_EPS);
                            unsigned char* hrow8 = (unsigned char*)hbuf + (size_t)row * D;
#pragma unroll
                            for (int j = 0; j < 4; ++j) { const int c = 8 * (lane + 64 * j); f32x4 o[2];
#pragma unroll
                                for (int h = 0; h < 2; ++h) o[h] = v[rr][j][h] * rstd * gsc[j][h] + gsh[j][h];
                                const u32x4 hiw = pg8::pack8(o[0], o[1]); *(GAS u32x2*)(hrow8 + c) = (u32x2){pg8::pk_fp8x4(o[0]), pg8::pk_fp8x4(o[1])};
                                f32x4 h0, h1; pg8::unpack8(hiw, h0, h1); const u32x4 low = pg8::pack8(o[0] - h0, o[1] - h1);
                                const int so = lr * 4096 + (((lane + 64 * j) ^ lr) << 4);
                                *(LAS u32x4*)(lds + so) = hiw; *(LAS u32x4*)(lds + 65536 + so) = low; } }
                    }
                    f32x4 racc[4];
                    {
                        const GAS bf16_t* whi = (const GAS bf16_t*)(ws + WS_WRT) + (size_t)(l * 2) * 64 * 2048 + 256 * wave; const GAS bf16_t* wlo = whi + 64 * 2048;
                        const int lop = opaque(lane), r16 = lop & 15, q4 = lop >> 4;
#pragma unroll
                        for (int nt = 0; nt < 4; ++nt) racc[nt] = (f32x4){0.f, 0.f, 0.f, 0.f};
                        auto ldB = [&](int kp, bf16x8 (&bh)[2][4], bf16x8 (&bl)[2][4]) {
#pragma unroll
                            for (int k2 = 0; k2 < 2; ++k2)
#pragma unroll
                                for (int nt = 0; nt < 4; ++nt) { const size_t wo = (size_t)(16 * nt + r16) * 2048 + 32 * (2 * kp + k2) + 8 * q4; bh[k2][nt] = *(const GAS bf16x8*)(whi + wo); bl[k2][nt] = *(const GAS bf16x8*)(wlo + wo); } };
                        auto mm = [&](int kp, const bf16x8 (&bh)[2][4], const bf16x8 (&bl)[2][4]) {
#pragma unroll
                            for (int k2 = 0; k2 < 2; ++k2) { const int chunk = 32 * wave + 4 * (2 * kp + k2) + q4, so = r16 * 4096 + ((chunk ^ r16) << 4);
                                const bf16x8 ah = *(const LAS bf16x8*)(lds + so), al = *(const LAS bf16x8*)(lds + 65536 + so);
#pragma unroll
                                for (int nt = 0; nt < 4; ++nt) {
                                    racc[nt] = __builtin_amdgcn_mfma_f32_16x16x32_bf16(ah, bh[k2][nt], racc[nt], 0, 0, 0);
                                    racc[nt] = __builtin_amdgcn_mfma_f32_16x16x32_bf16(al, bh[k2][nt], racc[nt], 0, 0, 0);
                                    racc[nt] = __builtin_amdgcn_mfma_f32_16x16x32_bf16(ah, bl[k2][nt], racc[nt], 0, 0, 0); } } };
#define RT_FENCE() asm volatile("" ::: "memory")
#define RT_PIN() asm volatile("" : "+v"(racc[0]), "+v"(racc[1]), "+v"(racc[2]), "+v"(racc[3]) :: "memory")
                        bf16x8 bhA[2][4], blA[2][4], bhB[2][4], blB[2][4];
                        RT_FENCE(); ldB(0, bhA, blA); ldB(1, bhB, blB); RT_FENCE();
                        __syncthreads();
                        mm(0, bhA, blA); RT_PIN(); ldB(2, bhA, blA); RT_FENCE();
                        mm(1, bhB, blB); RT_PIN(); ldB(3, bhB, blB); RT_FENCE();
                        mm(2, bhA, blA); mm(3, bhB, blB);
#undef RT_FENCE
#undef RT_PIN
                    }
                    __syncthreads();
                    LAS float* part = (LAS float*)lds;
#pragma unroll
                    for (int nt = 0; nt < 4; ++nt)
#pragma unroll
                        for (int r = 0; r < 4; ++r) part[(wave * 16 + 4 * (lane >> 4) + r) * 64 + 16 * nt + (lane & 15)] = racc[nt][r];
                    __syncthreads();
#pragma unroll 1
                    for (int rr = 0; rr < 2; ++rr) { const int lr = 2 * wave + rr; float logit = 0.f;
#pragma unroll
                        for (int w8 = 0; w8 < 8; ++w8) logit += part[(w8 * 16 + lr) * 64 + lane];
                        const float score = 1.0f / (1.0f + __expf(-logit)); const float sel = score + brt;
                        float m1 = sel; m1 = fmaxf(m1, __shfl_xor(m1, 1)); m1 = fmaxf(m1, __shfl_xor(m1, 2)); m1 = fmaxf(m1, __shfl_xor(m1, 4));
                        const unsigned long long bm = __ballot(sel == m1); const unsigned gb = (unsigned)(bm >> (lane & 56)) & 0xffu; const int first = __builtin_ctz(gb);
                        float v2 = ((lane & 7) == first) ? -3.0e38f : sel; v2 = fmaxf(v2, __shfl_xor(v2, 1)); v2 = fmaxf(v2, __shfl_xor(v2, 2)); v2 = fmaxf(v2, __shfl_xor(v2, 4));
                        const float gs = m1 + v2; int grank = 0; const int mygrp = lane >> 3;
#pragma unroll
                        for (int gg = 0; gg < 8; ++gg) { const float o = __shfl(gs, gg * 8); grank += (o > gs || (o == gs && gg < mygrp)) ? 1 : 0; }
                        float val = grank < 4 ? sel : -3.0e38f; unsigned long long cm = 0ull;
#pragma unroll
                        for (int pick = 0; pick < 8; ++pick) {
                            float mxv = val;
#pragma unroll
                            for (int o = 1; o < 64; o <<= 1) mxv = fmaxf(mxv, __shfl_xor(mxv, o));
                            const unsigned long long bmx = __ballot(val == mxv); const int sl = __builtin_ctzll(bmx);
                            cm |= 1ull << sl; if (lane == sl) val = -3.4e38f; }
                        const bool chosen = (cm >> lane) & 1ull; const float sw = wave_sum(chosen ? score : 0.f);
                        const int gr = it * 16 + lr;
                        selw[gr * 64 + lane] = chosen ? score / sw * 2.5f : 0.f;
                        if (lane == 0) selmask[gr] = cm; }
                    __syncthreads();
                }
                if (wave == 0 && rep + 1 == nrep) {
                    int cntl = 0;
                    for (int r = 0; r < 32; ++r) cntl += (int)((selmask[r] >> lane) & 1ull);
                    int pos = cntl ? (int)atomicAdd(ctl + CW_CNT + l * 64 + opaque(lane), (unsigned)cntl) : 0;
                    for (int r = 0; r < 32; ++r) { const unsigned long long m = selmask[r];
                        if ((m >> lane) & 1ull) { const int k = __builtin_popcountll(m & ((1ull << lane) - 1ull)); const int tok = rb * 32 + r; const int li = lane * 8192 + pos;
                            ltok[li] = tok; ldst[li] = tok * NSLOT + k; ((float*)(ws + WS_TOKW))[tok * 8 + k] = selw[r * 64 + lane]; ++pos; } }
                }
                __syncthreads();
            }
            if (rep + 1 < nrep) GRID_BAR(); }
            if (BOTH(pb + 5)) GRID_BAR();
        }
        if ((PH_MASK & 256) && IN(pb + 6)) {
            PH_BEGIN
            _Pragma("unroll 1") for (int rep = 0; rep < REPS(6); ++rep) {
            LAS int* tpre = (LAS int*)(lds + MOE_OFF); LAS int* ebase = tpre + 65; LAS int* ecnt = ebase + 65; LAS int* utab = (LAS int*)(lds + MOE_OFF + 1024);
            pg8::moe_build<4, true>(tpre, ebase, ecnt, utab, ctl + CW_CNT + l * 64, G, blk, tid);
            pg8::MoeOrder<4, true> S{utab, (const char*)(ws + WS_WGU + (size_t)l * 65 * 1024 * 2048), (size_t)1024 * 2048, (size_t)256 * 2048, (const int*)(ws + WS_LTOK)};
            pg8::EpiGateUp E{(unsigned char*)(ws + WS_HID)};
            pg8::gemm_phase<pg8::EpiGateUp, pg8::MoeOrder<4, true>, GEMM_ALIGN, GEMM_SP2, true>(lds, (const char*)hbuf, D / 2, S, E);
            if (rep + 1 < REPS(6)) GRID_BAR(); }
            if (BOTH(pb + 6)) GRID_BAR();
        }
        if ((PH_MASK & 512) && IN(pb + 7)) {
            PH_BEGIN
            _Pragma("unroll 1") for (int rep = 0; rep < REPS(7); ++rep) {
            LAS int* tpre = (LAS int*)(lds + MOE_OFF); LAS int* ebase = tpre + 65; LAS int* ecnt = ebase + 65; LAS int* utab = (LAS int*)(lds + MOE_OFF + 1024);
            pg8::moe_build<8, false>(tpre, ebase, ecnt, utab, ctl + CW_CNT + l * 64, G, blk, tid);
            constexpr size_t DB = DOWN_F8 ? 1 : 2;
            pg8::MoeOrder<8, false> S{utab, (const char*)(ws + WS_WD + (size_t)l * 65 * 2048 * 512 * DB), (size_t)2048 * 512 * DB, (size_t)256 * 512 * DB, (const int*)(ws + WS_LTOK)};
            pg8::EpiDown E{(unsigned char*)(ws + WS_YSLOT), (const int*)(ws + WS_LDST), (LAS int*)(lds + SEL_OFF), (REP_VARIANT && rep == 1) ? 1 : 0};
            pg8::gemm_phase<pg8::EpiDown, pg8::MoeOrder<8, false>, GEMM_ALIGN, GEMM_SP2, DOWN_F8 != 0>(lds, (const char*)(ws + WS_HID), DOWN_F8 ? 256 : 512, S, E);
            if (rep + 1 < REPS(7)) GRID_BAR(); }
            if (BOTH(pb + 7)) GRID_BAR();
        }
        if ((PH_MASK & 1024) && IN(pb + 8)) {
            PH_BEGIN
            const int nrep = REPS(8);
            _Pragma("unroll 1") for (int rep = 0; rep < nrep; ++rep) {
            const float* modl = mod + (size_t)l * 2 * 12288;
            const unsigned char* yslot = (const unsigned char*)(ws + WS_YSLOT);
            for (int run = blk * NWAVES + wave; run < T / 4; run += G * NWAVES) {
                const int bb = (run * 4) / SEQ; const float* gt2 = modl + bb * 12288 + 5 * 2048;
                const float* m1 = mod + (size_t)2 * 12288 + bb * 12288;
                f32x4 gtv[2][4];
#pragma unroll
                for (int jj = 0; jj < 2; ++jj)
#pragma unroll
                    for (int q = 0; q < 4; ++q) { const int c = 16 * (lane + 64 * jj) + 4 * q; gtv[jj][q] = *(const GAS f32x4*)(gt2 + c) * pg8::YS_INV; }
#pragma unroll 1
                for (int pr = 0; pr < 2; ++pr) {
                    f32x4 v[2][2][4]; float ss[2] = {0.f, 0.f};
                    const int rowb = run * 4 + pr * 2;
                    f32x4 tw[2][2];
#pragma unroll
                    for (int rr = 0; rr < 2; ++rr) { tw[rr][0] = *(const GAS f32x4*)((const float*)(ws + WS_TOKW) + (rowb + rr) * 8); tw[rr][1] = *(const GAS f32x4*)((const float*)(ws + WS_TOKW) + (rowb + rr) * 8 + 4); }
                    auto issue = [&](int rr, int jj, u32x4 (&w)[NSLOT], u32x4 (&xq)[2]) {
                        const int c = 16 * (lane + 64 * jj); const unsigned char* ys = yslot + (size_t)(rowb + rr) * NSLOT * D + c;
#pragma unroll
                        for (int k = 0; k < NSLOT; ++k) w[k] = *(const GAS u32x4*)(ys + (size_t)k * D);
                        const bf16_t* xr = (const bf16_t*)(ws + WS_XB) + (size_t)(rowb + rr) * D + c; xq[0] = *(const GAS u32x4*)xr; xq[1] = *(const GAS u32x4*)(xr + 8); };
                    auto consume = [&](int rr, int jj, const u32x4 (&w)[NSLOT], const u32x4 (&xq)[2]) {
                        f32x4 a[4];
#pragma unroll
                        for (int q = 0; q < 4; ++q) a[q] = (f32x4){0.f, 0.f, 0.f, 0.f};
#pragma unroll
                        for (int k = 0; k < NSLOT; ++k) { const float wk = k < 8 ? tw[rr][k >> 2][k & 3] : 1.0f;
#pragma unroll
                            for (int q = 0; q < 4; ++q) { const f32x2 lo = __builtin_amdgcn_cvt_pk_f32_fp8((int)w[k][q], false), hi = __builtin_amdgcn_cvt_pk_f32_fp8((int)w[k][q], true); a[q] += (f32x4){lo.x, lo.y, hi.x, hi.y} * wk; } }
                        f32x4 xv[4]; pg8::unpack8(xq[0], xv[0], xv[1]); pg8::unpack8(xq[1], xv[2], xv[3]);
#pragma unroll
                        for (int q = 0; q < 4; ++q) { v[rr][jj][q] = xv[q] + gtv[jj][q] * a[q];
                            ss[rr] += v[rr][jj][q][0] * v[rr][jj][q][0] + v[rr][jj][q][1] * v[rr][jj][q][1] + v[rr][jj][q][2] * v[rr][jj][q][2] + v[rr][jj][q][3] * v[rr][jj][q][3]; } };
                    {
                        u32x4 wA[NSLOT], xA[2], wB[NSLOT], xB[2];
#define CMB_FENCE() asm volatile("" ::: "memory")
#define CMB_PIN(x) asm volatile("" : "+v"(x) :: "memory")
                        issue(0, 0, wA, xA); issue(0, 1, wB, xB); CMB_FENCE();
                        consume(0, 0, wA, xA); CMB_PIN(ss[0]); issue(1, 0, wA, xA); CMB_FENCE();
                        consume(0, 1, wB, xB); CMB_PIN(ss[0]); issue(1, 1, wB, xB); CMB_FENCE();
                        consume(1, 0, wA, xA); consume(1, 1, wB, xB); CMB_PIN(ss[1]);
#undef CMB_FENCE
#undef CMB_PIN
                    }
                    f32x4 gs[2][4], gh[2][4];
                    if (l == 0) {
#pragma unroll
                        for (int jj = 0; jj < 2; ++jj)
#pragma unroll
                            for (int q = 0; q < 4; ++q) { const int c = 16 * (lane + 64 * jj) + 4 * q;
                                gs[jj][q] = *(const GAS f32x4*)(args.in[I_NMIX] + D + c) * (*(const GAS f32x4*)(m1 + 2048 + c) + 1.0f); gh[jj][q] = *(const GAS f32x4*)(m1 + c); }
                    } else {
#pragma unroll
                        for (int jj = 0; jj < 2; ++jj)
#pragma unroll
                            for (int q = 0; q < 4; ++q) { const int c = 16 * (lane + 64 * jj) + 4 * q; gs[jj][q] = *(const GAS f32x4*)(args.in[I_NFIN] + c); gh[jj][q] = (f32x4){0.f, 0.f, 0.f, 0.f}; }
                    }
#pragma unroll
                    for (int rr = 0; rr < 2; ++rr) { const int row = rowb + rr;
                        const float rstd = 1.0f / sqrtf(wave_sum(ss[rr]) * (1.0f / D) + NORM_EPS);
                        float* xw = (rep + 1 == nrep) ? xbuf + (size_t)row * D : (float*)(ws + WS_HID) + (size_t)row * D; bf16_t* hw = (rep + 1 == nrep) ? hbuf + (size_t)row * D : (bf16_t*)(ws + WS_MIXED2) + (size_t)row * D;
                        bf16_t* xbw = (rep + 1 == nrep) ? (bf16_t*)(ws + WS_XB) + (size_t)row * D : (bf16_t*)(ws + WS_MIXED) + (size_t)row * D;
                        if (l == 0) {
#pragma unroll
                            for (int jj = 0; jj < 2; ++jj) { const int c = 16 * (lane + 64 * jj); f32x4 o[4];
                                *(GAS u32x4*)(xbw + c) = pg8::pack8(v[rr][jj][0], v[rr][jj][1]); *(GAS u32x4*)(xbw + c + 8) = pg8::pack8(v[rr][jj][2], v[rr][jj][3]);
#pragma unroll
                                for (int q = 0; q < 4; ++q) o[q] = v[rr][jj][q] * rstd * gs[jj][q] + gh[jj][q];
                                *(GAS u32x4*)(hw + c) = pg8::pack8(o[0], o[1]); *(GAS u32x4*)(hw + c + 8) = pg8::pack8(o[2], o[3]); }
                        } else {
#pragma unroll
                            for (int jj = 0; jj < 2; ++jj) { const int c = 16 * (lane + 64 * jj);
#pragma unroll
                                for (int q = 0; q < 4; ++q) *(GAS f32x4*)(xw + c + 4 * q) = v[rr][jj][q] * rstd * gs[jj][q]; }
                        } }
                }
            }
            if (rep + 1 < nrep) GRID_BAR(); }
            if (BOTH(pb + 8)) GRID_BAR();
        }
    }
#undef IN
#undef BOTH
#undef GRID_BAR
}

extern "C" void kernel_launch(void* const* d_in, const int* in_sizes, int n_in, void* d_out, int out_size, void* d_ws, size_t ws_size, hipStream_t stream) {
    static int grid = 0;
    if (grid == 0) {
        if (n_in != 29 || out_size != T * D || ws_size < WS_END) { fprintf(stderr, "kernel_launch: unexpected shapes (n_in %d out %d ws %zu)\n", n_in, out_size, ws_size); grid = -1; return; }
        int dev = 0, cus = 0, per_cu = 0;
        if (hipGetDevice(&dev) != hipSuccess || hipDeviceGetAttribute(&cus, hipDeviceAttributeMultiprocessorCount, dev) != hipSuccess) { grid = -1; return; }
        if (hipFuncSetAttribute((const void*)mega_fwd, hipFuncAttributeMaxDynamicSharedMemorySize, LDS_BYTES) != hipSuccess) { fprintf(stderr, "kernel_launch: hipFuncSetAttribute failed\n"); grid = -1; return; }
        if (hipOccupancyMaxActiveBlocksPerMultiprocessor(&per_cu, (const void*)mega_fwd, NWAVES * 64, LDS_BYTES) != hipSuccess || per_cu < 1) { fprintf(stderr, "kernel_launch: occupancy query says %d\n", per_cu); }
        (void)hipGetLastError();
        grid = cus & ~7;
    }
    if (grid < 0) return;
    (void)hipMemsetAsync((char*)d_ws + WS_CTL, 0, CTL_ZERO_BYTES, stream);
    Args a{};
    for (int i = 0; i < 29; ++i) a.in[i] = (const float*)d_in[i];
    a.out = (float*)d_out; a.ws = (unsigned char*)d_ws;
    if (N_LAUNCHES == 1) { a.ph_lo = 0; a.ph_hi = 20; hipLaunchKernelGGL(mega_fwd, dim3(grid), dim3(NWAVES * 64), LDS_BYTES, stream, a); }
    else { for (int p = 0; p < 20; ++p) { a.ph_lo = p; a.ph_hi = p + 1; hipLaunchKernelGGL(mega_fwd, dim3(grid), dim3(NWAVES * 64), LDS_BYTES, stream, a); } }
}
```

```cpp
#include <hip/hip_runtime.h>
#include <cstdio>
#include <cstdint>

#ifndef N_LAUNCHES
#define N_LAUNCHES 1
#endif
#ifndef GEMM_ALIGN
#define GEMM_ALIGN true
#endif
#ifndef GEMM_SP2
#define GEMM_SP2 true
#endif
#ifndef MOE_XCD
#define MOE_XCD 0
#endif
#ifndef F8_PIN
#define F8_PIN 1
#endif
#if F8_PIN == 1
#define F8_PIN_ASM(x) asm volatile("" : "+v"(x))
#elif F8_PIN == 2
#define F8_PIN_ASM(x) asm volatile("" : "+a"(x))
#else
#define F8_PIN_ASM(x) do {} while (0)
#endif
#ifndef DOWN_PRE
#define DOWN_PRE 1
#endif
#ifndef DOWN_F8
#define DOWN_F8 1
#endif

#define LAS __attribute__((address_space(3)))
#define GAS __attribute__((address_space(1)))
typedef unsigned short bf16_t;
typedef short bf16x8 __attribute__((ext_vector_type(8)));
typedef float f32x4 __attribute__((ext_vector_type(4)));
typedef float f32x2 __attribute__((ext_vector_type(2)));
typedef unsigned u32x4 __attribute__((ext_vector_type(4)));
typedef unsigned u32x2 __attribute__((ext_vector_type(2)));
typedef int i32x4 __attribute__((ext_vector_type(4)));
typedef int i32x8 __attribute__((ext_vector_type(8)));

constexpr int T = 8192, D = 2048, SEQ = 4096, DEPTH = 2;
constexpr int INW = 6144, O_Q = 0, O_K = 1024, O_V = 1280, O_U = 1536, O_GA = 2048, O_GS = 4096;
constexpr int NE = 64, NSLOT = 9;
constexpr float NORM_EPS = 1e-6f;
constexpr float LOG2E = 1.4426950408889634f;

constexpr size_t MiB = 1u << 20;
constexpr size_t WS_CTL = 0, CTL_ZERO_BYTES = 1 * MiB;
constexpr size_t WS_MODP = 1 * MiB;
constexpr size_t WS_MOD = 3 * MiB;
constexpr size_t WS_SSM = 4 * MiB;
constexpr size_t SSM_STRIDE = 640 * 1024, SSM_E = 0, SSM_F = 256 * 1024, SSM_KT = 512 * 1024, SSM_P = 560 * 1024;
constexpr size_t WS_WIN = 44 * MiB;
constexpr size_t WS_WO = 92 * MiB;
constexpr size_t WS_WGLU = 100 * MiB;
constexpr size_t WS_WMIX = 108 * MiB;
constexpr size_t WS_WGU = 124 * MiB;
constexpr size_t WS_WD = 644 * MiB;
constexpr size_t WS_H = 904 * MiB;
constexpr size_t WS_PROJ = 936 * MiB;
constexpr size_t WS_ATTN = 1032 * MiB;
constexpr size_t WS_SLOC = 1048 * MiB;
constexpr size_t WS_Y = 1050 * MiB;
constexpr size_t WS_MIXED = 1058 * MiB;
constexpr size_t WS_HID = 1090 * MiB;
constexpr size_t WS_YSLOT = 1163 * MiB;
constexpr size_t WS_LTOK = 1451 * MiB, WS_LDST = 1453 * MiB, WS_LW = 1455 * MiB;
constexpr size_t WS_MIXED2 = 1457 * MiB;
constexpr size_t WS_WRT = 1489 * MiB;
constexpr size_t WS_XB = 1490 * MiB;
constexpr size_t WS_TOKW = 1522 * MiB;
constexpr size_t WS_END = 1523 * MiB;
constexpr int CW_TMO = 0, CW_BAR = 4096, CW_CNT = 8192;

constexpr int RING_BYTES = 131072, LDSCTL_OFF = RING_BYTES, MISC_OFF = LDSCTL_OFF + 320;
constexpr int SEL_OFF = LDSCTL_OFF + 1024;
constexpr int MOE_OFF = LDSCTL_OFF + 10240;
constexpr int LDS_BYTES = 147456;
constexpr int NWAVES = 8;

__device__ __forceinline__ unsigned cvt_pk_bf16(float lo, float hi) { unsigned r; asm("v_cvt_pk_bf16_f32 %0, %1, %2" : "=v"(r) : "v"(lo), "v"(hi)); return r; }
__device__ __forceinline__ float bf_lo(unsigned w) { return __uint_as_float(w << 16); }
__device__ __forceinline__ float bf_hi(unsigned w) { return __uint_as_float(w & 0xffff0000u); }
__device__ __forceinline__ float bf1(bf16_t h) { return __uint_as_float(((unsigned)h) << 16); }
__device__ __forceinline__ float fast_sigmoid(float x) { return __builtin_amdgcn_rcpf(1.0f + __builtin_amdgcn_exp2f(-x * LOG2E)); }
__device__ __forceinline__ float wave_sum(float v) {
#pragma unroll
    for (int o = 1; o < 64; o <<= 1) v += __shfl_xor(v, o);
    return v;
}
__device__ __forceinline__ int opaque(int v) { asm volatile("" : "+v"(v)); return v; }
__device__ __forceinline__ int lane_now() { int l; asm volatile("v_mbcnt_lo_u32_b32 %0, -1, 0\n\tv_mbcnt_hi_u32_b32 %0, -1, %0" : "=v"(l)); return l; }
#define LDS_WAIT() asm volatile("s_waitcnt lgkmcnt(0)" ::: "memory")
#define VM_WAIT() asm volatile("s_waitcnt vmcnt(0)" ::: "memory")

#define XB_TMO      128
#define XB_XCNT(j)  (256  + 64 * (j))
#define XB_XSUB(j)  (1280 + 64 * (j))
#define XB_XGEN(j)  (2304 + 64 * (j))
#define XB_TOP      3328
#define XB_TOPGEN   3392
#define XCD_BAR_WORDS 3456
#define XB_SPIN_CAP (1u << 18)
__device__ __forceinline__ unsigned xb_ld(unsigned* p)              { return __hip_atomic_load(p, __ATOMIC_RELAXED, __HIP_MEMORY_SCOPE_AGENT); }
__device__ __forceinline__ unsigned xb_add(unsigned* p, unsigned v) { return __hip_atomic_fetch_add(p, v, __ATOMIC_RELAXED, __HIP_MEMORY_SCOPE_AGENT); }
__device__ __forceinline__ unsigned xb_xcc_id() { return (unsigned)__builtin_amdgcn_s_getreg((3 << 11) | 20) & 0xFu; }
#define XB_SPIN(cond, bar) do { unsigned _sp = 0; while (cond) { __builtin_amdgcn_s_sleep(1); \
    if ((++_sp & 255u) == 0u) { if (xb_ld(&(bar)[XB_TMO])) break; if (_sp > XB_SPIN_CAP) { atomicAdd(&(bar)[XB_TMO], 1u); break; } } } } while (0)
struct XcdBarrier { unsigned* bar; unsigned x; volatile LAS unsigned* st; int wv; };
__device__ __forceinline__ XcdBarrier xcd_barrier_post(unsigned* bar, volatile LAS unsigned* st) {
    XcdBarrier b; b.bar = bar; b.x = xb_xcc_id(); b.st = st; b.wv = __builtin_amdgcn_readfirstlane((int)threadIdx.x >> 6);
    if (threadIdx.x == 0) (void)xb_add(&bar[XB_XCNT(b.x)], 1u);
    return b;
}
__device__ __forceinline__ void xcd_barrier_complete(unsigned* bar, unsigned x, unsigned& nloc, unsigned& nx) {
    const unsigned G = gridDim.x * gridDim.y * gridDim.z;
    unsigned sum, cnt, mine, sp = 0u;
    for (;;) {
        sum = 0u; cnt = 0u; mine = 0u;
#pragma unroll
        for (unsigned j = 0; j < 16; ++j) { const unsigned c = xb_ld(&bar[XB_XCNT(j)]); sum += c; cnt += (c > 0u) ? 1u : 0u; mine = (j == x) ? c : mine; }
        if (sum == G) break;
        __builtin_amdgcn_s_sleep(1);
        if ((++sp & 255u) == 0u) { if (xb_ld(&bar[XB_TMO])) break; if (sp > XB_SPIN_CAP) { atomicAdd(&bar[XB_TMO], 1u); break; } }
    }
    nloc = mine > 0u ? mine : 1u; nx = cnt > 0u ? cnt : 1u;
}
__device__ __forceinline__ void xcd_barrier(const XcdBarrier& b) {
    asm volatile("s_waitcnt vmcnt(0)" ::: "memory");
    __syncthreads();
    if (lane_now() + 64 * b.wv == 0) {
        unsigned* bar = b.bar; asm volatile("" : "+s"(bar));
        __builtin_amdgcn_s_waitcnt(0);
        unsigned nloc = b.st[0], nx = b.st[1];
        if (nloc == 0u) { xcd_barrier_complete(bar, b.x, nloc, nx); b.st[0] = nloc; b.st[1] = nx; }
        const unsigned old = xb_add(&bar[XB_XSUB(b.x)], 1u);
        const unsigned gen = old / nloc;
        if (old + 1u == (gen + 1u) * nloc) {
            __builtin_amdgcn_fence(__ATOMIC_RELEASE, "agent");
            asm volatile("s_waitcnt vmcnt(0)" ::: "memory");
            const unsigned og = xb_add(&bar[XB_TOP], 1u);
            const unsigned tg = og / nx;
            if (og + 1u == (tg + 1u) * nx) xb_add(&bar[XB_TOPGEN], 1u);
            else XB_SPIN(xb_ld(&bar[XB_TOPGEN]) == tg, bar);
            __builtin_amdgcn_fence(__ATOMIC_ACQUIRE, "agent");
            xb_add(&bar[XB_XGEN(b.x)], 1u);
            asm volatile("s_waitcnt vmcnt(0)" ::: "memory");
        } else {
            XB_SPIN(xb_ld(&bar[XB_XGEN(b.x)]) == gen, bar);
            __builtin_amdgcn_fence(__ATOMIC_ACQUIRE, "agent");
            asm volatile("s_waitcnt vmcnt(0)" ::: "memory");
        }
    }
    __syncthreads();
}

namespace pg8 {
constexpr int BM = 256, BK = 64, HALF = 128, HTB = HALF * BK * 2, STAGE_BYTES = 8 * HTB, NXCD = 8, WGM = 8;
__host__ __device__ __forceinline__ int lds_byte(int r, int c) { const int st = (r >> 4) * 2 + (c >> 5), rr = r & 15, cc = c & 31, ob = rr * 64 + cc * 2; return st * 1024 + (ob ^ (((ob >> 9) & 1) << 5)); }
__host__ __device__ __forceinline__ void stage_rc(int b, int& R, int& C) { const int st = b / 1024, sb = b % 1024, swz = sb ^ (((sb >> 9) & 1) << 5); R = (st >> 1) * 16 + swz / 64; C = (st & 1) * 32 + (swz % 64) / 2; }
__host__ __device__ __forceinline__ int perm32(int rho) { const int n = rho >> 4, i = rho & 15; return 8 * (i >> 2) + 4 * n + (i & 3); }

struct Unit { int pm, pn, e, n, r0, x; };

struct DenseOrder {
    static constexpr bool GATHER = false;
    int nM, nN, nwg, G, c; const char* Bt; size_t tstepB;
    __device__ void init(int M, int N, int K, int G_, int c_, const void* Bt_) { nM = M / BM; nN = N / BM; nwg = nM * nN; G = G_; c = c_; Bt = (const char*)Bt_; tstepB = (size_t)BM * K * 2; }
    __device__ __forceinline__ bool next(int i, Unit& u) const {
        const long L = (long)i * G + c; if (L >= nwg) return false;
        int wgid = (int)L; { const int q = nwg / NXCD, r = nwg % NXCD, xcd = wgid % NXCD, off = wgid / NXCD; wgid = (xcd < r ? xcd * (q + 1) : r * (q + 1) + (xcd - r) * q) + off; }
        const int nig = WGM * nN, gid = wgid / nig, fm = gid * WGM, gsz = (nM - fm) < WGM ? (nM - fm) : WGM;
        u.pm = fm + ((wgid % nig) % gsz); u.pn = (wgid % nig) / gsz; u.e = -1; u.n = 256; u.r0 = u.pm * BM; u.x = u.pm * BM; return true;
    }
    __device__ __forceinline__ int a_row(const Unit& u, int R) const { return u.r0 + R; }
    __device__ __forceinline__ void a_row_issue(const Unit& u, int R, int& out) const { out = u.r0 + R; }
    __device__ __forceinline__ int a_row_fix(const Unit& u, int R, int loaded) const { return loaded; }
    __device__ __forceinline__ const char* b_tile(const Unit& u) const { return Bt + (size_t)u.pn * tstepB; }
};
template <int NPN, bool GATHER_> struct MoeOrder {
    static constexpr bool GATHER = GATHER_;
    const LAS int* utab; const char* Wbase; size_t wstepE, tstepB; const int* ltok;
    __device__ __forceinline__ bool next(int i, Unit& u) const {
        if (i >= 64) return false;
        const LAS int* p = utab + i * 8;
        const int pm = __builtin_amdgcn_readfirstlane(p[0]); if (pm < 0) return false;
        u.pm = pm; u.pn = __builtin_amdgcn_readfirstlane(p[1]); u.e = __builtin_amdgcn_readfirstlane(p[2]); u.n = __builtin_amdgcn_readfirstlane(p[3]);
        u.r0 = __builtin_amdgcn_readfirstlane(p[4]); u.x = __builtin_amdgcn_readfirstlane(p[5]); return true;
    }
    __device__ __forceinline__ int a_row(const Unit& u, int R) const {
        if (!GATHER) return u.r0 + R;
        if (u.e == 64) return u.r0 + R;
        const int rr = R < u.n ? R : u.n - 1; return ((const GAS int*)ltok)[u.r0 + rr];
    }
    __device__ __forceinline__ void a_row_issue(const Unit& u, int R, int& out) const {
        const int rr = R < u.n ? R : u.n - 1; const GAS int* p = (const GAS int*)ltok + (u.e == 64 ? 0 : u.r0 + rr);
        asm volatile("global_load_dword %0, %1, off" : "=v"(out) : "v"(p) : "memory");
    }
    __device__ __forceinline__ int a_row_fix(const Unit& u, int R, int loaded) const { return u.e == 64 ? u.r0 + R : loaded; }
    __device__ __forceinline__ const char* b_tile(const Unit& u) const { return Wbase + (size_t)u.e * wstepE + (size_t)u.pn * tstepB; }
};
template <int NPN, bool GATHER> __device__ __forceinline__ void moe_build(LAS int* tpre, LAS int* ebase, LAS int* ecnt, LAS int* utab, const unsigned* counts, int G, int c, int tid) {
    if (tid < 64) ecnt[tid] = (int)__hip_atomic_load(counts + tid, __ATOMIC_RELAXED, __HIP_MEMORY_SCOPE_AGENT);
    __syncthreads();
    if (tid == 0) { int tp = 0, eb = 0; for (int e = 0; e < 64; ++e) { tpre[e] = tp; ebase[e] = eb; tp += (ecnt[e] + 255) >> 8; eb += ecnt[e]; } tpre[64] = tp; ebase[64] = eb; }
    __syncthreads();
#if MOE_XCD
    if (tid < 64) {
        int pm = -1, pn = 0, e = 64, n = 256;
        const int xc = c & 7; int idx = (c >> 3) + (G >> 3) * tid;
        if (idx < 4 * NPN) { pm = xc + 8 * (idx / NPN); pn = idx % NPN; }
        else { idx -= 4 * NPN;
#pragma unroll 1
            for (int j = 0; j < 8; ++j) { const int ee = xc + 8 * j, nu = ((ecnt[ee] + 255) >> 8) * NPN;
                if (pm < 0) { if (idx < nu) { e = ee; pm = idx / NPN; pn = idx % NPN; } else idx -= nu; } }
            if (pm >= 0) { const int rem = ecnt[e] - pm * BM; n = rem < BM ? rem : BM; } }
        const int hb = (e == 64 ? 65536 : ebase[e]) + pm * BM;
        const int r0 = GATHER ? (e == 64 ? pm * BM : e * 8192 + pm * BM) : hb, x = hb;
#else
    if (tid < 64) {
        int pm = -1, pn = 0, e = 64, n = 256;
        const int vc = ((G & 7) == 0) ? (c & 7) * (G >> 3) + (c >> 3) : c;
        int L = tid * G + vc; const int shared_units = 32 * NPN, tot = shared_units + NPN * tpre[64];
        if (L < tot) {
            if (L < shared_units) { pm = L / NPN; pn = L % NPN; }
            else { L -= shared_units; const int tile = L / NPN; pn = L % NPN; e = 0;
#pragma unroll 1
                for (int j = 1; j <= 64; ++j) e += (tpre[j] <= tile) ? 1 : 0;
                pm = tile - tpre[e]; const int rem = ecnt[e] - pm * BM; n = rem < BM ? rem : BM; } }
        const int hb = (e == 64 ? 65536 : ebase[e]) + pm * BM;
        const int r0 = GATHER ? (e == 64 ? pm * BM : e * 8192 + pm * BM) : hb, x = hb;
#endif
        LAS int* p = utab + tid * 8; p[0] = pm; p[1] = pn; p[2] = e; p[3] = n; p[4] = r0; p[5] = x;
    }
    __syncthreads();
}

template <class Epi, class Sched, bool ALIGN_EPI = false, bool SP2 = GEMM_SP2, bool F8 = false>
__device__ __forceinline__ void gemm_phase(LAS unsigned char* lds, const char* Abase, const int K, const Sched& S, const Epi& E, const int wave_s) {
    int tid = lane_now() + 64 * wave_s; asm volatile("" : "+v"(tid));
    const int wid = wave_s, lane = tid & 63, wr = wid >> 2, wc = wid & 3, fr = lane & 15, fq = lane >> 4;
    const int nt = K / BK;
    constexpr bool GA = Sched::GATHER;
    unsigned voffA[2], voffB[2];
#pragma unroll
    for (int i = 0; i < 2; ++i) { int R, C; stage_rc(tid * 16 + i * 8192, R, C); const int Rb = Epi::PERM ? ((R & ~31) + perm32(R & 31)) : R; voffA[i] = (unsigned)(R * K + C) * 2u; voffB[i] = (unsigned)(Rb * K + C) * 2u; }
    const size_t kstep = (size_t)(BK * 2);
    const size_t hstep = (size_t)HALF * K * 2;
    const unsigned ldsw = (unsigned)wid * 1024u;
    const int aoff = lds_byte(wr * 64 + fr, fq * 8), boff = lds_byte(wc * 32 + fr, fq * 8);
#define PG8_SA(b, h) (((b) * 2 + (h)) * HTB)
#define PG8_SB(b, h) ((4 + (b) * 2 + (h)) * HTB)
#define PG8_STB(bufoff, gbase) do { const char* _sb = (const char*)(gbase); asm volatile("" : "+s"(_sb)); _Pragma("unroll") for (int _i = 0; _i < 2; ++_i) \
        { unsigned _vo = voffB[_i]; asm volatile("" : "+v"(_vo)); __builtin_amdgcn_global_load_lds((const unsigned*)(_sb + _vo), (LAS unsigned*)(lds + (bufoff) + ldsw + _i * 8192), 16, 0, 0); } } while (0)
#define PG8_STA(bufoff, h, kb) do { const char* _sa = GA ? (Abase + (kb)) : (cA + (kb) + (h) * hstep); asm volatile("" : "+s"(_sa)); _Pragma("unroll") for (int _i = 0; _i < 2; ++_i) \
        { unsigned _vo = GA ? offC[h][_i] : voffA[_i]; asm volatile("" : "+v"(_vo)); __builtin_amdgcn_global_load_lds((const unsigned*)(_sa + _vo), (LAS unsigned*)(lds + (bufoff) + ldsw + _i * 8192), 16, 0, 0); } } while (0)
#define PG8_LDA(dst, b, h) do { _Pragma("unroll") for (int m = 0; m < 4; ++m) _Pragma("unroll") for (int k = 0; k < 2; ++k) dst[m][k] = *(const LAS bf16x8*)(lds + PG8_SA(b, h) + aoff + m * 2048 + k * 1024); } while (0)
#define PG8_LDB(dst, b, h) do { _Pragma("unroll") for (int n = 0; n < 2; ++n) _Pragma("unroll") for (int k = 0; k < 2; ++k) dst[n][k] = *(const LAS bf16x8*)(lds + PG8_SB(b, h) + boff + n * 2048 + k * 1024); } while (0)
#define PG8_CAT8(x, y) __builtin_shufflevector(__builtin_bit_cast(i32x4, x), __builtin_bit_cast(i32x4, y), 0, 1, 2, 3, 4, 5, 6, 7)
#define PG8_MMA(ai, bj, At, Bt) do { __builtin_amdgcn_s_setprio(1); _Pragma("unroll") for (int m = 0; m < 4; ++m) _Pragma("unroll") for (int n = 0; n < 2; ++n) { \
        if constexpr (F8) acc[ai][bj][m][n] = __builtin_amdgcn_mfma_scale_f32_16x16x128_f8f6f4(PG8_CAT8(Bt[n][0], Bt[n][1]), PG8_CAT8(At[m][0], At[m][1]), acc[ai][bj][m][n], 0, 0, 0, 0, 0, 0); \
        else { _Pragma("unroll") for (int k = 0; k < 2; ++k) acc[ai][bj][m][n] = __builtin_amdgcn_mfma_f32_16x16x32_bf16(Bt[n][k], At[m][k], acc[ai][bj][m][n], 0, 0, 0); } } \
        __builtin_amdgcn_s_setprio(0); } while (0)
#define PG8_WAIT_V(n) asm volatile("s_waitcnt vmcnt(" #n ")" ::: "memory")
#define PG8_WAIT_L(n) asm volatile("s_waitcnt lgkmcnt(" #n ")" ::: "memory")
#define PG8_BAR __builtin_amdgcn_s_barrier()
#define PG8_SCHED __builtin_amdgcn_sched_barrier(0)
#define PG8_AOFF(dst, u) do { if constexpr (GA) { _Pragma("unroll") for (int _h = 0; _h < 2; ++_h) _Pragma("unroll") for (int _i = 0; _i < 2; ++_i) { int _R, _C; stage_rc(tid * 16 + _i * 8192, _R, _C); \
        dst[_h][_i] = (unsigned)(S.a_row(u, _h * HALF + _R) * K + _C) * 2u; } } } while (0)
    Unit cur, nxt; int ui = 0;
    if (!S.next(0, cur)) return;
    f32x4 acc[2][2][4][2];
#pragma unroll
    for (int a = 0; a < 2; ++a)
#pragma unroll
        for (int b = 0; b < 2; ++b)
#pragma unroll
            for (int m = 0; m < 4; ++m)
#pragma unroll
                for (int n = 0; n < 2; ++n) { acc[a][b][m][n] = (f32x4){0.f, 0.f, 0.f, 0.f}; if constexpr (F8) F8_PIN_ASM(acc[a][b][m][n]); }
    bf16x8 At[4][2], B0[2][2], B1[2][2];
    unsigned offC[2][2];
    PG8_AOFF(offC, cur);
    const char* cB = S.b_tile(cur);
    const char* cA = GA ? Abase : Abase + (size_t)S.a_row(cur, 0) * K * 2;
    if constexpr (SP2) {
        PG8_STB(PG8_SB(0, 0), cB); PG8_STB(PG8_SB(0, 1), cB + hstep); PG8_STA(PG8_SA(0, 0), 0, 0); PG8_STA(PG8_SA(0, 1), 1, 0);
        if (wr == 1) PG8_BAR;
        PG8_WAIT_V(2); PG8_BAR;
        PG8_STB(PG8_SB(1, 0), cB + kstep); PG8_STA(PG8_SA(1, 0), 0, kstep); PG8_STB(PG8_SB(1, 1), cB + hstep + kstep);
        PG8_WAIT_V(6); PG8_BAR;
    } else {
    PG8_STB(PG8_SB(0, 0), cB); PG8_STA(PG8_SA(0, 0), 0, 0); PG8_STB(PG8_SB(0, 1), cB + hstep); PG8_STA(PG8_SA(0, 1), 1, 0);
    if (wr == 1) PG8_BAR;
    PG8_WAIT_V(4); PG8_BAR;
    PG8_STB(PG8_SB(1, 0), cB + kstep); PG8_STA(PG8_SA(1, 0), 0, kstep); PG8_STB(PG8_SB(1, 1), cB + hstep + kstep);
    PG8_WAIT_V(6); PG8_BAR;
    }
    for (;;) {
        int pre_v0, pre_v1; if constexpr (Epi::PRE) E.pre_issue(cur, wr, opaque(lane_now()), pre_v0, pre_v1);
        const bool has_next = S.next(ui + 1, nxt);
        const char* nB = has_next ? S.b_tile(nxt) : cB;
        const char* nA = (!GA && has_next) ? Abase + (size_t)S.a_row(nxt, 0) * K * 2 : cA;
        int rowN[2][2];
        if constexpr (GA) { const Unit un = has_next ? nxt : cur;
#pragma unroll
            for (int h = 0; h < 2; ++h)
#pragma unroll
                for (int i = 0; i < 2; ++i) { int R_, C_; stage_rc(tid * 16 + i * 8192, R_, C_); S.a_row_issue(un, h * HALF + R_, rowN[h][i]); } }
#pragma unroll 1
        for (int t = 0; t < nt; t += 2) {
            const bool last = (t == nt - 2);
            const size_t kb1 = (size_t)(t + 1) * kstep;
            const size_t kb2 = last ? 0 : (size_t)(t + 2) * kstep, kb3 = kb2 + kstep;
            const char* b2 = last ? nB : cB + (size_t)(t + 2) * kstep; const char* b3 = b2 + kstep;
            if constexpr (SP2) {
            PG8_LDB(B0, 0, 0); PG8_LDB(B1, 0, 1); PG8_SCHED; PG8_LDA(At, 0, 0); PG8_STA(PG8_SA(1, 1), 1, kb1);
            if (last) { if constexpr (GA) { if (has_next) {
#pragma unroll
                for (int h = 0; h < 2; ++h)
#pragma unroll
                    for (int i = 0; i < 2; ++i) { int R_, C_; stage_rc(tid * 16 + i * 8192, R_, C_); int rl = rowN[h][i]; asm volatile("" : "+v"(rl));
                        offC[h][i] = (unsigned)(S.a_row_fix(nxt, h * HALF + R_, rl) * K + C_) * 2u; } } } else cA = nA; }
            PG8_WAIT_V(8); PG8_WAIT_L(0); PG8_BAR; PG8_MMA(0, 0, At, B0); PG8_MMA(0, 1, At, B1); PG8_BAR; PG8_SCHED;
            PG8_LDA(At, 0, 1); PG8_STB(PG8_SB(0, 0), b2); PG8_STB(PG8_SB(0, 1), b2 + hstep); PG8_STA(PG8_SA(0, 0), 0, kb2);
            PG8_WAIT_V(8); PG8_WAIT_L(0); PG8_BAR; PG8_MMA(1, 0, At, B0); PG8_MMA(1, 1, At, B1); PG8_BAR; PG8_SCHED;
            PG8_LDB(B0, 1, 0); PG8_LDB(B1, 1, 1); PG8_SCHED; PG8_LDA(At, 1, 0); PG8_STA(PG8_SA(0, 1), 1, kb2);
            PG8_WAIT_V(8); PG8_WAIT_L(0); PG8_BAR; PG8_MMA(0, 0, At, B0); PG8_MMA(0, 1, At, B1); PG8_BAR; PG8_SCHED;
            PG8_LDA(At, 1, 1); PG8_STB(PG8_SB(1, 0), b3); PG8_STB(PG8_SB(1, 1), b3 + hstep); PG8_STA(PG8_SA(1, 0), 0, kb3);
            PG8_WAIT_V(8); PG8_WAIT_L(0); PG8_BAR; PG8_MMA(1, 0, At, B0); PG8_MMA(1, 1, At, B1); PG8_BAR; PG8_SCHED;
            } else {
            PG8_LDB(B0, 0, 0); PG8_SCHED; PG8_LDA(At, 0, 0); PG8_STA(PG8_SA(1, 1), 1, kb1);
            if (last) { if constexpr (GA) { if (has_next) {
#pragma unroll
                for (int h = 0; h < 2; ++h)
#pragma unroll
                    for (int i = 0; i < 2; ++i) { int R_, C_; stage_rc(tid * 16 + i * 8192, R_, C_); int rl = rowN[h][i]; asm volatile("" : "+v"(rl));
                        offC[h][i] = (unsigned)(S.a_row_fix(nxt, h * HALF + R_, rl) * K + C_) * 2u; } } } else cA = nA; }
            PG8_WAIT_L(8); PG8_BAR; PG8_WAIT_L(0); PG8_MMA(0, 0, At, B0); PG8_BAR; PG8_SCHED;
            PG8_LDB(B1, 0, 1); PG8_STB(PG8_SB(0, 0), b2);
            PG8_BAR; PG8_WAIT_L(0); PG8_MMA(0, 1, At, B1); PG8_BAR;
            PG8_LDA(At, 0, 1); PG8_STA(PG8_SA(0, 0), 0, kb2);
            PG8_BAR; PG8_WAIT_L(0); PG8_MMA(1, 0, At, B0); PG8_BAR; PG8_SCHED;
            PG8_STB(PG8_SB(0, 1), b2 + hstep);
            PG8_WAIT_V(6); PG8_BAR; PG8_MMA(1, 1, At, B1); PG8_BAR;
            PG8_LDB(B0, 1, 0); PG8_SCHED; PG8_LDA(At, 1, 0); PG8_STA(PG8_SA(0, 1), 1, kb2);
            PG8_WAIT_L(8); PG8_BAR; PG8_WAIT_L(0); PG8_MMA(0, 0, At, B0); PG8_BAR; PG8_SCHED;
            PG8_LDB(B1, 1, 1); PG8_STB(PG8_SB(1, 0), b3);
            PG8_BAR; PG8_WAIT_L(0); PG8_MMA(0, 1, At, B1); PG8_BAR;
            PG8_LDA(At, 1, 1); PG8_STA(PG8_SA(1, 0), 0, kb3);
            PG8_BAR; PG8_WAIT_L(0); PG8_MMA(1, 0, At, B0); PG8_BAR; PG8_SCHED;
            PG8_STB(PG8_SB(1, 1), b3 + hstep);
            PG8_WAIT_V(6); PG8_BAR; PG8_MMA(1, 1, At, B1); PG8_BAR;
            }
        }
        if constexpr (ALIGN_EPI) { if (wr == 0) PG8_BAR; }
        const int tq = opaque(lane_now() + 64 * wid);
        if constexpr (Epi::PRE) { asm volatile("" : "+v"(pre_v0), "+v"(pre_v1)); E.pre_commit(pre_v0, pre_v1, wid, tq & 63); }
        E(acc, cur, wr, wc, tq & 15, (tq >> 4) & 3);
        if (!has_next) break;
#pragma unroll
        for (int a = 0; a < 2; ++a)
#pragma unroll
            for (int b = 0; b < 2; ++b)
#pragma unroll
                for (int m = 0; m < 4; ++m)
#pragma unroll
                    for (int n = 0; n < 2; ++n) { acc[a][b][m][n] = (f32x4){0.f, 0.f, 0.f, 0.f}; if constexpr (F8) F8_PIN_ASM(acc[a][b][m][n]); }
        cur = nxt; cB = nB; ++ui;
        if constexpr (ALIGN_EPI) { if (wr == 1) PG8_BAR; }
    }
    PG8_WAIT_V(0);
    if constexpr (!ALIGN_EPI) { if (wr == 0) PG8_BAR; }
    PG8_BAR;
#undef PG8_SA
#undef PG8_SB
#undef PG8_STB
#undef PG8_STA
#undef PG8_LDA
#undef PG8_LDB
#undef PG8_MMA
#undef PG8_CAT8
#undef PG8_WAIT_V
#undef PG8_WAIT_L
#undef PG8_BAR
#undef PG8_SCHED
#undef PG8_AOFF
}

typedef const f32x4 (&AccRef)[2][2][4][2];
__device__ __forceinline__ u32x4 pack8(const f32x4& a, const f32x4& b) { u32x4 w; w.x = cvt_pk_bf16(a[0], a[1]); w.y = cvt_pk_bf16(a[2], a[3]); w.z = cvt_pk_bf16(b[0], b[1]); w.w = cvt_pk_bf16(b[2], b[3]); return w; }
__device__ __forceinline__ void unpack8(const u32x4 w, f32x4& a, f32x4& b) { a = (f32x4){bf_lo(w.x), bf_hi(w.x), bf_lo(w.y), bf_hi(w.y)}; b = (f32x4){bf_lo(w.z), bf_hi(w.z), bf_lo(w.w), bf_hi(w.w)}; }

struct EpiInProj {
    static constexpr bool PERM = true; static constexpr bool PRE = false;
    bf16_t* O; const float* bias; float qscale; int nostore;
    __device__ __forceinline__ void operator()(AccRef acc, const Unit& u, int wr, int wc, int fr, int fq) const {
        if (nostore) return;
        const int row0 = u.pm * BM + wr * 64 + fr, colb = u.pn * BM + wc * 32 + 8 * fq;
        const int mode = u.pn < 4 ? 1 : (u.pn >= 8 ? 2 : 0);
        f32x4 bv[2][2];
#pragma unroll
        for (int bj = 0; bj < 2; ++bj)
#pragma unroll
            for (int n = 0; n < 2; ++n) bv[bj][n] = *(const GAS f32x4*)(bias + colb + bj * HALF + 4 * n);
#pragma unroll
        for (int ai = 0; ai < 2; ++ai)
#pragma unroll
            for (int m = 0; m < 4; ++m) { bf16_t* rowp = O + (size_t)(row0 + ai * HALF + m * 16) * INW + colb;
#pragma unroll
                for (int bj = 0; bj < 2; ++bj) { f32x4 v0 = acc[ai][bj][m][0] + bv[bj][0], v1 = acc[ai][bj][m][1] + bv[bj][1];
                    if (mode == 1) { v0 = v0 * qscale; v1 = v1 * qscale; }
                    if (mode == 2) {
#pragma unroll
                        for (int j = 0; j < 4; ++j) { v0[j] = fast_sigmoid(v0[j]); v1[j] = fast_sigmoid(v1[j]); } }
                    *(GAS u32x4*)(rowp + bj * HALF) = pack8(v0, v1); } }
    }
};
struct EpiAttnProj {
    static constexpr bool PERM = true; static constexpr bool PRE = false;
    const bf16_t* proj; bf16_t* mixed;
    __device__ __forceinline__ void operator()(AccRef acc, const Unit& u, int wr, int wc, int fr, int fq) const {
        const int row0 = u.pm * BM + wr * 64 + fr, colb = u.pn * BM + wc * 32 + 8 * fq;
#pragma unroll
        for (int ai = 0; ai < 2; ++ai) {
            u32x4 gw[4][2];
#pragma unroll
            for (int m = 0; m < 4; ++m)
#pragma unroll
                for (int bj = 0; bj < 2; ++bj) gw[m][bj] = *(const GAS u32x4*)(proj + (size_t)(row0 + ai * HALF + m * 16) * INW + O_GA + colb + bj * HALF);
#pragma unroll
            for (int m = 0; m < 4; ++m) { const size_t row = (size_t)(row0 + ai * HALF + m * 16);
#pragma unroll
                for (int bj = 0; bj < 2; ++bj) { f32x4 g0, g1; unpack8(gw[m][bj], g0, g1);
                    *(GAS u32x4*)(mixed + row * D + colb + bj * HALF) = pack8(g0 * acc[ai][bj][m][0], g1 * acc[ai][bj][m][1]); } } }
    }
};
struct EpiGlu {
    static constexpr bool PERM = true; static constexpr bool PRE = false;
    const bf16_t* proj; const bf16_t* mixed; bf16_t* mixed2;
    __device__ __forceinline__ void operator()(AccRef acc, const Unit& u, int wr, int wc, int fr, int fq) const {
        const int row0 = u.pm * BM + wr * 64 + fr, col = u.pn * HALF + wc * 32 + 8 * fq;
#pragma unroll
        for (int ai = 0; ai < 2; ++ai) {
            u32x4 gw[4], pw[4];
#pragma unroll
            for (int m = 0; m < 4; ++m) { const size_t row = (size_t)(row0 + ai * HALF + m * 16);
                gw[m] = *(const GAS u32x4*)(proj + row * INW + O_GS + col); pw[m] = *(const GAS u32x4*)(mixed + row * D + col); }
#pragma unroll
            for (int m = 0; m < 4; ++m) { const size_t row = (size_t)(row0 + ai * HALF + m * 16);
                f32x4 g0, g1, p0, p1; unpack8(gw[m], g0, g1); unpack8(pw[m], p0, p1);
                const f32x4 za0 = acc[ai][0][m][0], za1 = acc[ai][0][m][1], zb0 = acc[ai][1][m][0], zb1 = acc[ai][1][m][1];
#pragma unroll
                for (int j = 0; j < 4; ++j) { p0[j] += g0[j] * za0[j] * fast_sigmoid(zb0[j]); p1[j] += g1[j] * za1[j] * fast_sigmoid(zb1[j]); }
                *(GAS u32x4*)(mixed2 + row * D + col) = pack8(p0, p1); } }
    }
};
struct EpiMixOut {
    static constexpr bool PERM = true; static constexpr bool PRE = false;
    const float* xin; const bf16_t* xsrc; bf16_t* xdst; const float* gt;
    __device__ __forceinline__ void operator()(AccRef acc, const Unit& u, int wr, int wc, int fr, int fq) const {
        const int row0 = u.pm * BM + wr * 64 + fr, colb = u.pn * BM + wc * 32 + 8 * fq;
        const float* g = gt + (u.pm >= 16 ? 12288 : 0);
        f32x4 gv[2][2];
#pragma unroll
        for (int bj = 0; bj < 2; ++bj)
#pragma unroll
            for (int n = 0; n < 2; ++n) gv[bj][n] = *(const GAS f32x4*)(g + colb + bj * HALF + 4 * n);
        if (xin) {
#pragma unroll
            for (int ai = 0; ai < 2; ++ai)
#pragma unroll
                for (int mp = 0; mp < 2; ++mp) { f32x4 xv[2][2][2];
#pragma unroll
                    for (int mm = 0; mm < 2; ++mm)
#pragma unroll
                        for (int bj = 0; bj < 2; ++bj) { const size_t off = (size_t)(row0 + ai * HALF + (2 * mp + mm) * 16) * D + colb + bj * HALF;
                            xv[mm][bj][0] = *(const GAS f32x4*)(xin + off); xv[mm][bj][1] = *(const GAS f32x4*)(xin + off + 4); }
#pragma unroll
                    for (int mm = 0; mm < 2; ++mm)
#pragma unroll
                        for (int bj = 0; bj < 2; ++bj) { const int m = 2 * mp + mm; const size_t off = (size_t)(row0 + ai * HALF + m * 16) * D + colb + bj * HALF;
                            *(GAS u32x4*)(xdst + off) = pack8(xv[mm][bj][0] + gv[bj][0] * acc[ai][bj][m][0], xv[mm][bj][1] + gv[bj][1] * acc[ai][bj][m][1]); } }
        } else {
#pragma unroll
            for (int ai = 0; ai < 2; ++ai) { u32x4 xw[4][2];
#pragma unroll
                for (int m = 0; m < 4; ++m)
#pragma unroll
                    for (int bj = 0; bj < 2; ++bj) xw[m][bj] = *(const GAS u32x4*)(xsrc + (size_t)(row0 + ai * HALF + m * 16) * D + colb + bj * HALF);
#pragma unroll
                for (int m = 0; m < 4; ++m)
#pragma unroll
                    for (int bj = 0; bj < 2; ++bj) { f32x4 x0, x1; unpack8(xw[m][bj], x0, x1);
                        *(GAS u32x4*)(xdst + (size_t)(row0 + ai * HALF + m * 16) * D + colb + bj * HALF) = pack8(x0 + gv[bj][0] * acc[ai][bj][m][0], x1 + gv[bj][1] * acc[ai][bj][m][1]); } }
        }
    }
};
constexpr float WGU_SCALE = 64.0f, WD_SCALE = 32.0f;
__device__ __forceinline__ unsigned pk_fp8x4(const f32x4& a) {
    int w = 0; w = __builtin_amdgcn_cvt_pk_fp8_f32(a[0], a[1], w, false); w = __builtin_amdgcn_cvt_pk_fp8_f32(a[2], a[3], w, true); return (unsigned)w; }
struct EpiGateUp {
    static constexpr bool PERM = true; static constexpr bool PRE = false;
    unsigned char* hid;
    __device__ __forceinline__ void operator()(AccRef acc, const Unit& u, int wr, int wc, int fr, int fq) const {
        const int r0 = wr * 64 + fr, col = u.pn * HALF + wc * 32 + 8 * fq;
        float dq = 1.0f / WGU_SCALE; asm volatile("" : "+s"(dq));
#pragma unroll
        for (int ai = 0; ai < 2; ++ai)
#pragma unroll
            for (int m = 0; m < 4; ++m) { const int r = r0 + ai * HALF + m * 16;
                f32x4 g0 = acc[ai][0][m][0] * dq, g1 = acc[ai][0][m][1] * dq, u0 = acc[ai][1][m][0] * dq, u1 = acc[ai][1][m][1] * dq;
#pragma unroll
                for (int j = 0; j < 4; ++j) { g0[j] = g0[j] * fast_sigmoid(g0[j]) * u0[j]; g1[j] = g1[j] * fast_sigmoid(g1[j]) * u1[j]; }
                if (r < u.n) { if constexpr (DOWN_F8 != 0) *(GAS u32x2*)(hid + (size_t)(u.x + r) * 512 + col) = (u32x2){pk_fp8x4(g0), pk_fp8x4(g1)};
                               else *(GAS u32x4*)(hid + ((size_t)(u.x + r) * 512 + col) * 2) = pack8(g0, g1); } }
    }
};
constexpr float YS_SCALE = 8.0f, YS_INV = 1.0f / 8.0f, YS_ACC = DOWN_F8 ? YS_SCALE / WD_SCALE : YS_SCALE;
struct EpiDown {
    static constexpr bool PERM = true; static constexpr bool PRE = (DOWN_PRE != 0);
    unsigned char* ys; const int* ldst; LAS int* dstl; int nostore;
    __device__ __forceinline__ void pre_issue(const Unit& u, int wr, int lane, int& v0, int& v1) const {
        const int ra = 64 * wr + lane, rb = ra + 128; const GAS int* p = (const GAS int*)ldst + (u.e == 64 ? 0 : u.e * 8192 + u.pm * BM);
        const GAS int* pa = p + ((u.e != 64 && ra < u.n) ? ra : 0); const GAS int* pb = p + ((u.e != 64 && rb < u.n) ? rb : 0);
        asm volatile("global_load_dword %0, %1, off" : "=v"(v0) : "v"(pa) : "memory");
        asm volatile("global_load_dword %0, %1, off" : "=v"(v1) : "v"(pb) : "memory");
    }
    __device__ __forceinline__ void pre_commit(int v0, int v1, int wid, int lane_) const { const int lane = opaque(lane_); dstl[wid * 128 + lane] = v0; dstl[wid * 128 + 64 + lane] = v1; }
    __device__ __forceinline__ void operator()(AccRef acc, const Unit& u, int wr, int wc, int fr_, int fq_) const {
        const int fr = opaque(fr_), fq = opaque(fq_);
        const int r0 = wr * 64 + fr, colb = u.pn * BM + 16 * (4 * wc + fq);
#pragma unroll
        for (int ai = 0; ai < 2; ++ai)
#pragma unroll
            for (int m = 0; m < 4; ++m) { const int r = r0 + ai * HALF + m * 16;
                int dst;
                if constexpr (PRE) dst = (u.e == 64) ? (u.pm * BM + r) * NSLOT + 8 : dstl[(wr * 4 + wc) * 128 + ai * 64 + m * 16 + fr];
                else dst = (u.e == 64) ? (u.pm * BM + r) * NSLOT + 8 : ((const GAS int*)ldst)[u.e * 8192 + u.pm * BM + (r < u.n ? r : 0)];
                if (r < u.n && !nostore)
                    *(GAS u32x4*)(ys + (size_t)dst * D + colb) = (u32x4){pk_fp8x4(acc[ai][0][m][0] * YS_ACC), pk_fp8x4(acc[ai][0][m][1] * YS_ACC), pk_fp8x4(acc[ai][1][m][0] * YS_ACC), pk_fp8x4(acc[ai][1][m][1] * YS_ACC)}; }
    }
};
}

struct Args { const float* in[29]; float* out; unsigned char* ws; int ph_lo, ph_hi; };
typedef const __attribute__((address_space(4))) Args KArgs;
__device__ __forceinline__ const float* arg_in(int which) {
#if defined(__HIP_DEVICE_COMPILE__)
    KArgs* p = (KArgs*)__builtin_amdgcn_kernarg_segment_ptr(); return p->in[which];
#else
    (void)which; return nullptr;
#endif
}
enum { I_X = 0, I_C, I_WADA, I_BADA, I_NMIX, I_WIN, I_BIN, I_SINK, I_WO, I_ARE, I_AIM, I_LDT, I_BRE, I_BIM, I_CRE, I_CIM, I_SD, I_WGLU, I_WMIX, I_NFFN, I_WR, I_BR, I_WEG, I_WEU, I_WED, I_WSG, I_WSU, I_WSD, I_NFIN };

struct TDesc { const float* src; bf16_t* dst; int N, K, cc0; float f8s; };
__device__ __forceinline__ void tr_load(const TDesc& d, int lane, f32x4 (&v)[16]) {
    const int kr = lane >> 4, nq = lane & 15;
    const GAS float* p = (const GAS float*)d.src + (size_t)kr * d.N + 4 * nq; const size_t step = (size_t)4 * d.N;
#pragma unroll
    for (int i = 0; i < 16; ++i) { v[i] = __builtin_nontemporal_load((const GAS f32x4*)p); p += step; }
}
__device__ __forceinline__ void tr_finish(const TDesc& d, int lane, LAS float* scr, const f32x4 (&v)[16]) {
    const int kr = lane >> 4, nq = lane & 15;
#pragma unroll
    for (int i = 0; i < 16; ++i) { const int k = 4 * i + kr;
#pragma unroll
        for (int e = 0; e < 4; ++e) scr[k * 64 + ((4 * nq + e) ^ k)] = v[i][e]; }
    LDS_WAIT();
    const int c = lane & 7;
#pragma unroll
    for (int j = 0; j < 8; ++j) { const int n = (lane >> 3) + 8 * j; float s[8];
#pragma unroll
        for (int i = 0; i < 8; ++i) { const int k = 8 * c + i; s[i] = scr[k * 64 + (n ^ k)]; }
        u32x4 o; o.x = cvt_pk_bf16(s[0], s[1]); o.y = cvt_pk_bf16(s[2], s[3]); o.z = cvt_pk_bf16(s[4], s[5]); o.w = cvt_pk_bf16(s[6], s[7]);
        const int cc = d.cc0 + n, drow = d.cc0 >= 0 ? (128 * ((cc & 15) >> 3) + 8 * (cc >> 4) + (cc & 7)) : n;
        if (d.f8s != 0.f) { const f32x4 sa = (f32x4){s[0], s[1], s[2], s[3]} * d.f8s, sb = (f32x4){s[4], s[5], s[6], s[7]} * d.f8s;
            __builtin_nontemporal_store((u32x2){pg8::pk_fp8x4(sa), pg8::pk_fp8x4(sb)}, (GAS u32x2*)((unsigned char*)d.dst + (size_t)drow * d.K + 8 * c)); }
        else __builtin_nontemporal_store(o, (GAS u32x4*)(d.dst + (size_t)drow * d.K + 8 * c)); }
    LDS_WAIT();
}
constexpr int IT_WIN = 3072, IT_WO = 512, IT_WGLU = 512, IT_WMIX = 1024, IT_EXP = 16384, IT_SH = 256;
constexpr int IT_LAYER = IT_WIN + IT_WO + IT_WGLU + IT_WMIX + 3 * IT_EXP + 3 * IT_SH;
constexpr int IT_MOD = 768;
constexpr int IT_TR = 2 * IT_LAYER;

__device__ __forceinline__ TDesc tr_desc(const float* W, int K, int N, bf16_t* WT, int kb, int nb, int drow0) {
    TDesc d; d.src = W + (size_t)(64 * kb) * N + 64 * nb; d.dst = WT + (size_t)drow0 * K + 64 * kb; d.N = N; d.K = K; d.cc0 = -1; d.f8s = 0.f; return d;
}
__device__ __forceinline__ TDesc tr_desc8(const float* W, int K, int N, unsigned char* WT, int kb, int nb, int drow0, float scale) {
    TDesc d; d.src = W + (size_t)(64 * kb) * N + 64 * nb; d.dst = (bf16_t*)(WT + (size_t)drow0 * K + 64 * kb); d.N = N; d.K = K; d.cc0 = -1; d.f8s = scale; return d;
}
__device__ __forceinline__ TDesc tr_decode(unsigned char* ws, int it) {
    const int l = 1 - it / IT_LAYER; int r = it % IT_LAYER;
    int which, K, N, kb, nb, drow0, cc0 = -1, es = 2; size_t soff, dbyte; float f8s = 0.f;
    if (r < IT_WIN) { which = I_WIN; soff = (size_t)l * 2048 * 6144; K = 2048; N = 6144; dbyte = WS_WIN + (size_t)l * 6144 * 2048 * 2; kb = r / 96; nb = r % 96; drow0 = 64 * nb; }
    else if ((r -= IT_WIN) < IT_WO) { which = I_WO; soff = (size_t)l * 1024 * 2048; K = 1024; N = 2048; dbyte = WS_WO + (size_t)l * 2048 * 1024 * 2; kb = r / 32; nb = r % 32; drow0 = 64 * nb; }
    else if ((r -= IT_WO) < IT_WGLU) { which = I_WGLU; soff = (size_t)l * 512 * 4096; K = 512; N = 4096; dbyte = WS_WGLU + (size_t)l * 4096 * 512 * 2; kb = r / 64; nb = r % 64; const int n0 = 64 * nb;
        drow0 = n0 < 2048 ? 256 * (n0 / 128) + (n0 % 128) : 256 * ((n0 - 2048) / 128) + 128 + (n0 % 128); }
    else if ((r -= IT_WGLU) < IT_WMIX) { which = I_WMIX; soff = (size_t)l * 2048 * 2048; K = 2048; N = 2048; dbyte = WS_WMIX + (size_t)l * 2048 * 2048 * 2; kb = r / 32; nb = r % 32; drow0 = 64 * nb; }
    else { r -= IT_WMIX;
        const size_t wgu = WS_WGU + (size_t)l * 65 * 1024 * 2048;
        constexpr int DES = DOWN_F8 ? 1 : 2; const size_t wd = WS_WD + (size_t)l * 65 * 2048 * 512 * DES;
        if (r < 2 * IT_EXP) { const int up = r >= IT_EXP; r -= up * IT_EXP; const int e = r / 256, q = r % 256; kb = q / 8; nb = q % 8; const int n0 = 64 * nb;
            which = up ? I_WEU : I_WEG; soff = ((size_t)l * 64 + e) * 2048 * 512; K = 2048; N = 512; dbyte = wgu + (size_t)e * 1024 * 2048; es = 1; f8s = pg8::WGU_SCALE; drow0 = 256 * (n0 / 128) + (n0 % 128) + 128 * up; }
        else if ((r -= 2 * IT_EXP) < IT_EXP) { const int e = r / 256, q = r % 256; kb = q / 32; nb = q % 32;
            which = I_WED; soff = ((size_t)l * 64 + e) * 512 * 2048; K = 512; N = 2048; dbyte = wd + (size_t)e * 2048 * 512 * DES; es = DES; f8s = DOWN_F8 ? pg8::WD_SCALE : 0.f; drow0 = 256 * (nb / 4); cc0 = 64 * (nb % 4); }
        else if ((r -= IT_EXP) < 2 * IT_SH) { const int up = r >= IT_SH; r -= up * IT_SH; kb = r / 8; nb = r % 8; const int n0 = 64 * nb;
            which = up ? I_WSU : I_WSG; soff = (size_t)l * 2048 * 512; K = 2048; N = 512; dbyte = wgu + (size_t)64 * 1024 * 2048; es = 1; f8s = pg8::WGU_SCALE; drow0 = 256 * (n0 / 128) + (n0 % 128) + 128 * up; }
        else { r -= 2 * IT_SH; kb = r / 32; nb = r % 32;
            which = I_WSD; soff = (size_t)l * 512 * 2048; K = 512; N = 2048; dbyte = wd + (size_t)64 * 2048 * 512 * DES; es = DES; f8s = DOWN_F8 ? pg8::WD_SCALE : 0.f; drow0 = 256 * (nb / 4); cc0 = 64 * (nb % 4); } }
    TDesc d; d.src = arg_in(which) + soff + (size_t)(64 * kb) * N + 64 * nb; d.dst = (bf16_t*)(ws + dbyte + ((size_t)drow0 * K + 64 * kb) * es); d.N = N; d.K = K; d.cc0 = cc0; d.f8s = f8s; return d;
}
__device__ __forceinline__ void mod_item(const Args& a, int it, int tid, LAS unsigned char* lds) {
    const int lane = tid & 63, wave = tid >> 6;
    const int l = it / 384, r = it % 384, ks = r / 48, cc = r % 48;
    const float* W = a.in[I_WADA] + (size_t)l * 2048 * 12288 + (size_t)(256 * ks + 32 * wave) * 12288 + 256 * cc + 4 * lane;
    const float* c0 = a.in[I_C] + 256 * ks + 32 * wave, *c1 = c0 + 2048;
    f32x4 a0 = {0.f, 0.f, 0.f, 0.f}, a1 = {0.f, 0.f, 0.f, 0.f};
#pragma unroll 1
    for (int h = 0; h < 2; ++h) { f32x4 w[16]; const GAS float* wp = (const GAS float*)W + (size_t)(16 * h) * 12288;
#pragma unroll
        for (int i = 0; i < 16; ++i) { w[i] = __builtin_nontemporal_load((const GAS f32x4*)wp); wp += 12288; }
#pragma unroll
        for (int i = 0; i < 16; ++i) { const float x0 = c0[16 * h + i], x1 = c1[16 * h + i]; const float s0 = x0 * fast_sigmoid(x0), s1 = x1 * fast_sigmoid(x1); a0 += w[i] * s0; a1 += w[i] * s1; } }
    LAS f32x4* red = (LAS f32x4*)lds;
    red[(wave * 2 + 0) * 64 + lane] = a0; red[(wave * 2 + 1) * 64 + lane] = a1;
    __syncthreads();
    { const int b = tid >> 8, col = tid & 255; LAS float* rf = (LAS float*)lds; float s = 0.f;
#pragma unroll
        for (int w8 = 0; w8 < 8; ++w8) s += rf[((w8 * 2 + b) * 64) * 4 + col];
        ((float*)(a.ws + WS_MODP))[((size_t)(ks * 2 + l) * 2 + b) * 12288 + 256 * cc + col] = s; }
    __syncthreads();
}
__device__ __forceinline__ void p0_items(const Args& a, int gw, int ngw, LAS float* scr, int lane) {
#pragma unroll 1
    for (int it = gw; it < IT_TR; it += ngw) { f32x4 v[16]; const TDesc d = tr_decode(a.ws, it); tr_load(d, lane, v); tr_finish(d, lane, scr, v); }
}

__device__ __forceinline__ void cpow(float are, float aim, float dt, int n, float& pr, float& pi) {
    const float mag = __builtin_amdgcn_exp2f((float)n * dt * are * LOG2E);
    const double turns = (double)n * ((double)dt * (double)aim * 0.15915494309189535);
    const float fr = (float)(turns - __builtin_rint(turns));
    pr = mag * __builtin_amdgcn_cosf(fr); pi = mag * __builtin_amdgcn_sinf(fr);
}
__device__ __forceinline__ void ssm_tables(const Args& a, int l, int g, LAS unsigned char* lds, int tid) {
    LAS f32x2* Apow = (LAS f32x2*)lds;
    LAS f32x2* Bb = (LAS f32x2*)(lds + 65 * 64 * 8);
    LAS f32x2* Cc = (LAS f32x2*)(lds + 65 * 64 * 8 + 64 * 16 * 8);
    const int lg = l * 32 + g;
    const float* are_p = a.in[I_ARE] + lg * 64; const float* aim_p = a.in[I_AIM] + lg * 64;
    const float dt = __expf(a.in[I_LDT][lg]);
    unsigned char* tb = a.ws + WS_SSM + (size_t)lg * SSM_STRIDE;
    bf16_t* Et = (bf16_t*)(tb + SSM_E); bf16_t* Ft = (bf16_t*)(tb + SSM_F); bf16_t* Kt = (bf16_t*)(tb + SSM_KT); GAS f32x2* Pt = (GAS f32x2*)(tb + SSM_P);
    for (int idx = tid; idx < 65 * 64; idx += 512) { const int n = idx >> 6, p = idx & 63; float pr, pi; cpow(are_p[p], aim_p[p], dt, n, pr, pi); Apow[idx] = (f32x2){pr, pi}; }
    for (int idx = tid; idx < 64 * 64; idx += 512) { const int m = idx >> 6, p = idx & 63; float pr, pi; cpow(are_p[p], aim_p[p], dt, 64 * m, pr, pi); Pt[idx] = (f32x2){pr, pi}; }
    for (int idx = tid; idx < 64 * 16; idx += 512) { const int p = idx >> 4, c = idx & 15;
        const float ar = are_p[p], ai = aim_p[p]; float br, bi; cpow(ar, ai, dt, 1, br, bi);
        const float nr = br - 1.0f, ni = bi, den = ar * ar + ai * ai; const float fr = (nr * ar + ni * ai) / den, fi = (ni * ar - nr * ai) / den;
        const float b_r = a.in[I_BRE][(size_t)lg * 1024 + idx], b_i = a.in[I_BIM][(size_t)lg * 1024 + idx];
        Bb[idx] = (f32x2){fr * b_r - fi * b_i, fr * b_i + fi * b_r}; }
    for (int idx = tid; idx < 16 * 64; idx += 512) Cc[idx] = (f32x2){a.in[I_CRE][(size_t)lg * 1024 + idx], a.in[I_CIM][(size_t)lg * 1024 + idx]};
    __syncthreads();
    for (int idx = tid; idx < 128 * 128; idx += 512) { const int n = idx >> 7, k8 = idx & 127, ri = n >> 6, p = n & 63, s = k8 >> 1, c0 = (k8 & 1) * 8;
        const f32x2 ap = Apow[(63 - s) * 64 + p]; float v[8];
#pragma unroll
        for (int j = 0; j < 8; ++j) { const f32x2 b = Bb[p * 16 + c0 + j]; v[j] = ri ? (ap.x * b.y + ap.y * b.x) : (ap.x * b.x - ap.y * b.y); }
        u32x4 o; o.x = cvt_pk_bf16(v[0], v[1]); o.y = cvt_pk_bf16(v[2], v[3]); o.z = cvt_pk_bf16(v[4], v[5]); o.w = cvt_pk_bf16(v[6], v[7]);
        *(GAS u32x4*)(Et + (size_t)n * 1024 + k8 * 8) = o; }
    for (int idx = tid; idx < 1024 * 16; idx += 512) { const int n = idx >> 4, k8 = idx & 15, t = n >> 4, c = n & 15, ri = k8 >> 3, p0 = (k8 & 7) * 8; float v[8];
#pragma unroll
        for (int j = 0; j < 8; ++j) { const f32x2 ap = Apow[(t + 1) * 64 + p0 + j], cc = Cc[c * 64 + p0 + j]; v[j] = ri ? -(cc.x * ap.y + cc.y * ap.x) : (cc.x * ap.x - cc.y * ap.y); }
        u32x4 o; o.x = cvt_pk_bf16(v[0], v[1]); o.y = cvt_pk_bf16(v[2], v[3]); o.z = cvt_pk_bf16(v[4], v[5]); o.w = cvt_pk_bf16(v[6], v[7]);
        *(GAS u32x4*)(Ft + (size_t)n * 128 + k8 * 8) = o; }
    for (int idx = tid; idx < 65 * 16 * 2; idx += 512) { const int t1 = idx >> 5, c = (idx >> 1) & 15, c0 = (idx & 1) * 8; float v[8];
#pragma unroll
        for (int j = 0; j < 8; ++j) v[j] = 0.f;
        if (t1 > 0) for (int p = 0; p < 64; ++p) { const f32x2 ap = Apow[(t1 - 1) * 64 + p], cc = Cc[c * 64 + p]; const float cr = cc.x * ap.x - cc.y * ap.y, ci = cc.x * ap.y + cc.y * ap.x;
#pragma unroll
            for (int j = 0; j < 8; ++j) { const f32x2 b = Bb[p * 16 + c0 + j]; v[j] += cr * b.x - ci * b.y; } }
        u32x4 o; o.x = cvt_pk_bf16(v[0], v[1]); o.y = cvt_pk_bf16(v[2], v[3]); o.z = cvt_pk_bf16(v[4], v[5]); o.w = cvt_pk_bf16(v[6], v[7]);
        *(GAS u32x4*)(Kt + (size_t)(t1 * 16 + c) * 16 + c0) = o; }
    __syncthreads();
}

__device__ __forceinline__ void attn_unit(const bf16_t* __restrict__ proj, bf16_t* __restrict__ attn, const float* sinks, int unit, LAS unsigned char* lds, int tid_) {
    const int tid = opaque(tid_);
    const int b = unit >> 7, hk = (unit >> 5) & 3, nb = unit & 31;
    const int wave = __builtin_amdgcn_readfirstlane(tid >> 6), lane = tid & 63, r16 = lane & 15, q4 = lane >> 4;
    LAS unsigned char* Kl = lds;
    LAS unsigned char* Vt = lds + 36864;
    const int gh0 = wave >> 1, half0 = wave & 1, qh0 = hk * 4 + gh0;
    bf16x8 qfa[4][2];
#pragma unroll
    for (int pass = 0; pass < 4; ++pass)
#pragma unroll
        for (int s = 0; s < 2; ++s) qfa[pass][s] = *(const GAS bf16x8*)(proj + (size_t)(b * SEQ + nb * 128 + 16 * (half0 * 4 + pass) + r16) * INW + O_Q + qh0 * 64 + 32 * s + 8 * q4);
#pragma unroll
    for (int i = 0; i < 4; ++i) { const int id = tid + 512 * i, key = id >> 3, ch = id & 7; const int tp = nb * 128 - 128 + key;
        u32x4 kv = {0u, 0u, 0u, 0u}, vv = {0u, 0u, 0u, 0u};
        if (tp >= 0) { const bf16_t* src = proj + (size_t)(b * SEQ + tp) * INW + hk * 64 + ch * 8; kv = *(const GAS u32x4*)(src + O_K); vv = *(const GAS u32x4*)(src + O_V); }
        *(LAS u32x4*)(Kl + key * 144 + ch * 16) = kv;
        LAS bf16_t* vd = (LAS bf16_t*)(Vt + (ch * 8) * 528 + key * 2);
        vd[0 * 264] = (bf16_t)(vv.x & 0xffff); vd[1 * 264] = (bf16_t)(vv.x >> 16); vd[2 * 264] = (bf16_t)(vv.y & 0xffff); vd[3 * 264] = (bf16_t)(vv.y >> 16);
        vd[4 * 264] = (bf16_t)(vv.z & 0xffff); vd[5 * 264] = (bf16_t)(vv.z >> 16); vd[6 * 264] = (bf16_t)(vv.w & 0xffff); vd[7 * 264] = (bf16_t)(vv.w >> 16); }
    __syncthreads();
    const int gh = wave >> 1, half = wave & 1, qh = hk * 4 + gh;
    const float sink = sinks[qh] * LOG2E;
#pragma unroll
    for (int pass = 0; pass < 4; ++pass) {
        const int kt0 = half * 4 + pass, i0 = 16 * kt0, iabs = i0 + r16; const size_t qtok = (size_t)(b * SEQ + nb * 128 + iabs);
        bf16x8 qf[2];
#pragma unroll
        for (int s = 0; s < 2; ++s) qf[s] = qfa[pass][s];
        __builtin_amdgcn_sched_barrier(0);
        f32x4 st[10];
        const LAS unsigned char* kbase = Kl + (16 * kt0 + r16) * 144 + (8 * q4) * 2;
#pragma unroll
        for (int i = 0; i < 9; ++i) { st[i] = (f32x4){0.f, 0.f, 0.f, 0.f};
#pragma unroll
            for (int s = 0; s < 2; ++s) { const bf16x8 kf = *(const LAS bf16x8*)(kbase + i * 16 * 144 + s * 64);
                st[i] = __builtin_amdgcn_mfma_f32_16x16x32_bf16(kf, qf[s], st[i], 0, 0, 0); } }
        st[9] = (f32x4){0.f, 0.f, 0.f, 0.f};
        float mx = sink;
#pragma unroll
        for (int i = 0; i < 9; ++i)
#pragma unroll
            for (int r = 0; r < 4; ++r) { const int jj = 16 * i + 4 * q4 + r; const bool ok = (jj > r16) && (jj <= r16 + 128) && (nb > 0 || jj + i0 >= 128);
                st[i][r] = ok ? st[i][r] : -1e30f; mx = fmaxf(mx, st[i][r]); }
        mx = fmaxf(mx, __shfl_xor(mx, 16)); mx = fmaxf(mx, __shfl_xor(mx, 32));
        float sum = 0.f;
#pragma unroll
        for (int i = 0; i < 9; ++i)
#pragma unroll
            for (int r = 0; r < 4; ++r) { const float p = __builtin_amdgcn_exp2f(st[i][r] - mx); st[i][r] = p; sum += p; }
        sum += __shfl_xor(sum, 16); sum += __shfl_xor(sum, 32);
        const float inv = __builtin_amdgcn_rcpf(sum + __builtin_amdgcn_exp2f(sink - mx));
        f32x4 ot[4];
#pragma unroll
        for (int dt = 0; dt < 4; ++dt) ot[dt] = (f32x4){0.f, 0.f, 0.f, 0.f};
#pragma unroll
        for (int kk = 0; kk < 5; ++kk) {
            u32x4 pw; pw.x = cvt_pk_bf16(st[2 * kk][0], st[2 * kk][1]); pw.y = cvt_pk_bf16(st[2 * kk][2], st[2 * kk][3]); pw.z = cvt_pk_bf16(st[2 * kk + 1][0], st[2 * kk + 1][1]); pw.w = cvt_pk_bf16(st[2 * kk + 1][2], st[2 * kk + 1][3]);
            const bf16x8 pf = __builtin_bit_cast(bf16x8, pw);
            const int t0 = kt0 + 2 * kk, t1 = (t0 + 1) < 15 ? (t0 + 1) : 15;
#pragma unroll
            for (int dt = 0; dt < 4; ++dt) { const LAS unsigned char* vp = Vt + (16 * dt + r16) * 528 + (4 * q4) * 2;
                const u32x2 lo = *(const LAS u32x2*)(vp + t0 * 32), hi = *(const LAS u32x2*)(vp + t1 * 32);
                const u32x4 vw = {lo.x, lo.y, hi.x, hi.y};
                ot[dt] = __builtin_amdgcn_mfma_f32_16x16x32_bf16(__builtin_bit_cast(bf16x8, vw), pf, ot[dt], 0, 0, 0); } }
#pragma unroll
        for (int dt = 0; dt < 4; ++dt) { u32x2 o; o.x = cvt_pk_bf16(ot[dt][0] * inv, ot[dt][1] * inv); o.y = cvt_pk_bf16(ot[dt][2] * inv, ot[dt][3] * inv);
            *(GAS u32x2*)(attn + qtok * 1024 + qh * 64 + 16 * dt + 4 * q4) = o; }
    }
    __syncthreads();
}

constexpr int UPITCH = 2064;
__device__ __forceinline__ void stage_u_issue(const bf16_t* __restrict__ proj, int g, int b, int q, int tid, u32x4 (&uu)[4]) {
#pragma unroll
    for (int i = 0; i < 4; ++i) { const int id = tid + 512 * i, tl = id >> 1, half = id & 1, chunk = tl >> 6, s = tl & 63;
        uu[i] = *(const GAS u32x4*)(proj + (size_t)(b * SEQ + (16 * q + chunk) * 64 + s) * INW + O_U + g * 16 + 8 * half); }
}
__device__ __forceinline__ void stage_u_commit(LAS unsigned char* Al, int tid, u32x4 (&uu)[4]) {
    asm volatile("" : "+v"(uu[0]), "+v"(uu[1]), "+v"(uu[2]), "+v"(uu[3]) :: "memory");
#pragma unroll
    for (int i = 0; i < 4; ++i) { const int id = tid + 512 * i, tl = id >> 1, half = id & 1, chunk = tl >> 6, s = tl & 63;
        *(LAS u32x4*)(Al + chunk * UPITCH + (s * 16 + 8 * half) * 2) = uu[i]; }
}
__device__ __forceinline__ void ssm_s1_unit(const bf16_t* __restrict__ proj, const bf16_t* __restrict__ Et, float* __restrict__ sloc, int g, int b, int q, LAS unsigned char* lds, int tid_) {
    const int tid = opaque(tid_);
    const int wave = __builtin_amdgcn_readfirstlane(tid >> 6), lane = tid & 63, r16 = lane & 15, q4 = lane >> 4;
    const bf16_t* eb = Et + (size_t)(16 * wave + r16) * 1024 + 8 * q4;
    u32x4 uu[4]; stage_u_issue(proj, g, b, q, tid, uu);
    bf16x8 bf[32];
#pragma unroll
    for (int ks = 0; ks < 32; ++ks) bf[ks] = *(const GAS bf16x8*)(eb + 32 * ks);
    stage_u_commit(lds, tid, uu);
    __syncthreads();
    f32x4 acc = {0.f, 0.f, 0.f, 0.f};
#pragma unroll
    for (int ks = 0; ks < 32; ++ks) { const bf16x8 af = *(const LAS bf16x8*)(lds + r16 * UPITCH + (32 * ks + 8 * q4) * 2);
        acc = __builtin_amdgcn_mfma_f32_16x16x32_bf16(af, bf[ks], acc, 0, 0, 0); }
#pragma unroll
    for (int r = 0; r < 4; ++r) sloc[((size_t)(b * 64 + 16 * q + 4 * q4 + r) * 32 + g) * 128 + 16 * wave + r16] = acc[r];
    __syncthreads();
}

__device__ __forceinline__ void ssm_s2_unit(const bf16_t* __restrict__ proj, const unsigned char* __restrict__ tb, const float* __restrict__ sloc, const float* __restrict__ dskip, bf16_t* __restrict__ ybuf,
                                            int g, int b, int q, LAS unsigned char* lds, int tid_) {
    const int tid = opaque(tid_);
    const int wave = __builtin_amdgcn_readfirstlane(tid >> 6), lane = tid & 63, r16 = lane & 15, q4 = lane >> 4;
    LAS unsigned char* Ktl = lds;
    LAS bf16_t* x0l = (LAS bf16_t*)(lds + 33280);
    LAS unsigned char* Al = lds + 49152;
    const bf16_t* Ft = (const bf16_t*)(tb + SSM_F); const GAS f32x2* Pt = (const GAS f32x2*)(tb + SSM_P);
    const int p = tid & 63, part = tid >> 6, j0 = 16 * q;
    f32x2 Pp[6]; float srp[6], sip[6];
#pragma unroll
    for (int ii = 0; ii < 6; ++ii) { const int i = part + 8 * ii; const bool ok = i < j0; const int ic = ok ? i : 0, pc = ok ? (j0 - 1 - i) : 0;
        Pp[ii] = Pt[pc * 64 + p]; const GAS float* sp = (const GAS float*)(sloc + ((size_t)(b * 64 + ic) * 32 + g) * 128); srp[ii] = sp[p]; sip[ii] = sp[64 + p]; }
    u32x4 kt[5];
    { const GAS u32x4* src = (const GAS u32x4*)(tb + SSM_KT);
#pragma unroll
      for (int j = 0; j < 5; ++j) { const int i = tid + 512 * j; kt[j] = src[i < 33280 / 16 ? i : 33280 / 16 - 1]; } }
    u32x4 uu[4]; stage_u_issue(proj, g, b, q, tid, uu);
    const f32x2 A64 = Pt[64 + p];
    float sr[15], si[15];
#pragma unroll
    for (int jq = 0; jq < 15; ++jq) { const GAS float* sp = (const GAS float*)(sloc + ((size_t)(b * 64 + j0 + jq) * 32 + g) * 128); sr[jq] = sp[p]; si[jq] = sp[64 + p]; }
    bf16x8 ff[4][8];
#pragma unroll
    for (int k2 = 0; k2 < 4; ++k2)
#pragma unroll
        for (int tt = 0; tt < 8; ++tt) ff[k2][tt] = *(const GAS bf16x8*)(Ft + (size_t)((wave + 8 * tt) * 16 + r16) * 128 + 32 * k2 + 8 * q4);
    {
        LAS f32x2* red = (LAS f32x2*)(lds + 40960);
        asm volatile("" : "+v"(Pp[0]), "+v"(Pp[1]), "+v"(Pp[2]), "+v"(Pp[3]), "+v"(Pp[4]), "+v"(Pp[5]) :: "memory");
        asm volatile("" : "+v"(srp[0]), "+v"(srp[1]), "+v"(srp[2]), "+v"(srp[3]), "+v"(srp[4]), "+v"(srp[5]), "+v"(sip[0]), "+v"(sip[1]), "+v"(sip[2]), "+v"(sip[3]), "+v"(sip[4]), "+v"(sip[5]) :: "memory");
        float xr = 0.f, xi = 0.f;
#pragma unroll
        for (int ii = 0; ii < 6; ++ii) { const bool ok = part + 8 * ii < j0; const float pr = ok ? Pp[ii].x : 0.f, pi = ok ? Pp[ii].y : 0.f;
            xr += pr * srp[ii] - pi * sip[ii]; xi += pr * sip[ii] + pi * srp[ii]; }
        red[part * 64 + p] = (f32x2){xr, xi};
        asm volatile("" : "+v"(kt[0]), "+v"(kt[1]), "+v"(kt[2]), "+v"(kt[3]), "+v"(kt[4]) :: "memory");
#pragma unroll
        for (int j = 0; j < 5; ++j) { const int i = tid + 512 * j; if (i < 33280 / 16) *(LAS u32x4*)(Ktl + i * 16) = kt[j]; }
        stage_u_commit(Al, tid, uu);
        __syncthreads();
        if (part == 0) {
            float ar = 0.f, ai = 0.f;
#pragma unroll
            for (int w8 = 0; w8 < 8; ++w8) { const f32x2 t = red[w8 * 64 + p]; ar += t.x; ai += t.y; }
#pragma unroll
            for (int jq = 0; jq < 16; ++jq) {
                x0l[jq * 136 + p] = (bf16_t)(cvt_pk_bf16(ar, 0.f) & 0xffff); x0l[jq * 136 + 64 + p] = (bf16_t)(cvt_pk_bf16(ai, 0.f) & 0xffff);
                if (jq < 15) { const float nr = A64.x * ar - A64.y * ai + sr[jq], ni = A64.x * ai + A64.y * ar + si[jq]; ar = nr; ai = ni; } }
        }
    }
    __syncthreads();
    f32x4 acc[8];
#pragma unroll
    for (int tt = 0; tt < 8; ++tt) acc[tt] = (f32x4){0.f, 0.f, 0.f, 0.f};
#pragma unroll 2
    for (int ks = 0; ks < 32; ++ks) { const int s = 2 * ks + (q4 >> 1);
        const bf16x8 af = *(const LAS bf16x8*)(Al + r16 * UPITCH + (32 * ks + 8 * q4) * 2);
#pragma unroll
        for (int tt = 0; tt < 8; ++tt) { const int t = wave + 8 * tt;
            const int tau1 = t - s + 1, tc = tau1 > 0 ? tau1 : 0;
            const bf16x8 bf = *(const LAS bf16x8*)(Ktl + ((tc * 16 + r16) * 16 + 8 * (q4 & 1)) * 2);
            acc[tt] = __builtin_amdgcn_mfma_f32_16x16x32_bf16(af, bf, acc[tt], 0, 0, 0); }
        __builtin_amdgcn_sched_barrier(0); }
#pragma unroll
    for (int k2 = 0; k2 < 4; ++k2) { const bf16x8 ax = *(const LAS bf16x8*)(x0l + r16 * 136 + 32 * k2 + 8 * q4);
#pragma unroll
        for (int tt = 0; tt < 8; ++tt) acc[tt] = __builtin_amdgcn_mfma_f32_16x16x32_bf16(ax, ff[k2][tt], acc[tt], 0, 0, 0); }
    const float dsk = dskip[g * 16 + r16];
#pragma unroll
    for (int tt = 0; tt < 8; ++tt) { const int t = wave + 8 * tt;
#pragma unroll
        for (int r = 0; r < 4; ++r) { const int jq = 4 * q4 + r; const size_t tok = (size_t)(b * SEQ + (16 * q + jq) * 64 + t);
            const float uv = bf1(*(const LAS bf16_t*)(Al + jq * UPITCH + (t * 16 + r16) * 2)); const float y = acc[tt][r] + dsk * uv;
            const float z = 0.7978845608028654f * (y + 0.044715f * y * y * y); const float gl = y * fast_sigmoid(2.0f * z);
            ybuf[tok * 512 + g * 16 + r16] = (bf16_t)(cvt_pk_bf16(gl, 0.f) & 0xffff); } }
    __syncthreads();
}

__device__ __forceinline__ unsigned char* opaque_p(unsigned char* p) { asm volatile("" : "+s"(p)); return p; }
__device__ __forceinline__ int opaque_si(int v) { asm volatile("" : "+s"(v)); return v; }
__device__ __forceinline__ Args load_args() {
#if defined(__HIP_DEVICE_COMPILE__)
    KArgs* p = (KArgs*)__builtin_amdgcn_kernarg_segment_ptr(); asm volatile("" : "+s"(p)); Args a;
#pragma unroll
    for (int i = 0; i < 29; ++i) a.in[i] = p->in[i];
    a.out = p->out; a.ws = p->ws; a.ph_lo = p->ph_lo; a.ph_hi = p->ph_hi; return a;
#else
    return Args{};
#endif
}
#define PH_BEGIN const Args args = load_args(); const int G = opaque_si(G_k), blk = opaque_si(blk_k); const int wave = opaque_si(wave_k); const int tid = opaque(lane_now() + 64 * wave), lane = tid & 63; unsigned char* const ws = opaque_p(args.ws); (void)lane; (void)wave; \
    bf16_t* const hbuf = (bf16_t*)(ws + WS_H); bf16_t* const proj = (bf16_t*)(ws + WS_PROJ); float* const mod = (float*)(ws + WS_MOD); float* const xbuf = args.out; unsigned* const ctl = (unsigned*)(ws + WS_CTL); \
    (void)hbuf; (void)proj; (void)mod; (void)xbuf; (void)ctl;

__global__ void __launch_bounds__(NWAVES * 64, 2) mega_fwd(Args args) {
    extern __shared__ __attribute__((aligned(16))) unsigned char lds_raw[];
    LAS unsigned char* lds = (LAS unsigned char*)lds_raw;
    const int wave_k = __builtin_amdgcn_readfirstlane((int)threadIdx.x >> 6);
    const int G_k = gridDim.x, blk_k = blockIdx.x;
    XcdBarrier bar;
    {
        volatile LAS unsigned* MISC = (volatile LAS unsigned*)(lds + MISC_OFF);
        unsigned* ctl0 = (unsigned*)(args.ws + WS_CTL);
        for (int u = threadIdx.x; u < (LDS_BYTES - LDSCTL_OFF) / 4; u += NWAVES * 64) ((LAS unsigned*)(lds + LDSCTL_OFF))[u] = 0u;
        __syncthreads();
        bar.bar = ctl0 + CW_BAR; bar.x = 0; bar.st = nullptr; bar.wv = wave_k;
        if (N_LAUNCHES == 1) bar = xcd_barrier_post(ctl0 + CW_BAR, MISC + 8);
    }
#define GRID_BAR() do { if (N_LAUNCHES == 1) xcd_barrier(bar); } while (0)
    const int lo = args.ph_lo, hi = args.ph_hi;
#ifndef PH_MASK
#define PH_MASK 0x7ff
#endif
#ifndef REP_MASK
#define REP_MASK 0
#endif
#ifndef REP_VARIANT
#define REP_VARIANT 0
#endif
#define REPS(bit) (((REP_MASK) >> (bit)) & 1 ? 2 : 1)
#define IN(k) (lo <= (k) && (k) < hi)
#define BOTH(k) (IN(k) && IN((k) + 1))

    if ((PH_MASK & 1) && IN(0)) {
        PH_BEGIN
            _Pragma("unroll 1") for (int rep = 0; rep < REPS(9); ++rep) {
        if (blk < 64) ssm_tables(args, blk >> 5, blk & 31, lds, tid);
        LAS float* scr = (LAS float*)(lds + wave * 16384);
        for (int idx = blk * 512 + tid; idx < 2 * 64 * 256; idx += G * 512) {
            const int e = idx & 63, kc = (idx >> 6) & 255, l = idx >> 14; const float* wsrc = args.in[I_WR] + (size_t)l * D * NE + (size_t)(8 * kc) * NE + e;
            float w[8], lo[8]; unsigned hi[4];
#pragma unroll
            for (int i = 0; i < 8; ++i) w[i] = wsrc[i * NE];
#pragma unroll
            for (int i = 0; i < 4; ++i) { hi[i] = cvt_pk_bf16(w[2 * i], w[2 * i + 1]); lo[2 * i] = w[2 * i] - bf_lo(hi[i]); lo[2 * i + 1] = w[2 * i + 1] - bf_hi(hi[i]); }
            bf16_t* dsth = (bf16_t*)(ws + WS_WRT) + ((size_t)(l * 2) * 64 + e) * 2048 + 8 * kc;
            *(GAS u32x4*)dsth = (u32x4){hi[0], hi[1], hi[2], hi[3]};
            *(GAS u32x4*)(dsth + 64 * 2048) = (u32x4){cvt_pk_bf16(lo[0], lo[1]), cvt_pk_bf16(lo[2], lo[3]), cvt_pk_bf16(lo[4], lo[5]), cvt_pk_bf16(lo[6], lo[7])}; }
        for (int it = blk; it < IT_MOD; it += G) mod_item(args, it, tid, lds);
        p0_items(args, blk * NWAVES + wave, G * NWAVES, scr, lane);
            if (rep + 1 < REPS(9)) GRID_BAR(); }
        if (BOTH(0)) GRID_BAR();
    }
    if ((PH_MASK & 2) && IN(1)) {
        PH_BEGIN
        const float* modp = (const float*)(ws + WS_MODP);
        for (int idx = blk * 512 + tid; idx < 2 * 2 * 12288; idx += G * 512) { const int l = idx / 24576, c = idx % 12288; float s = args.in[I_BADA][l * 12288 + c];
#pragma unroll
            for (int ks = 0; ks < 8; ++ks) s += modp[(size_t)ks * 49152 + idx];
            mod[idx] = s; }
        for (int rb = blk; rb < T / 32; rb += G) {
            const int bb = (rb * 32) / SEQ;
            LAS float* shl = (LAS float*)lds; LAS float* scl = shl + 2048;
            for (int c = tid; c < 4096; c += 512) { float s = args.in[I_BADA][c];
#pragma unroll
                for (int ks = 0; ks < 8; ++ks) s += modp[(size_t)ks * 49152 + bb * 12288 + c];
                shl[c] = s; }
            __syncthreads();
#pragma unroll 1
            for (int pr = 0; pr < 2; ++pr) {
                f32x4 v[2][4][2]; float ss[2] = {0.f, 0.f};
#pragma unroll
                for (int rr = 0; rr < 2; ++rr) { const float* xr = args.in[I_X] + (size_t)(rb * 32 + wave * 4 + pr * 2 + rr) * D;
#pragma unroll
                    for (int j = 0; j < 4; ++j)
#pragma unroll
                        for (int h = 0; h < 2; ++h) v[rr][j][h] = *(const GAS f32x4*)(xr + 8 * (lane + 64 * j) + 4 * h); }
#pragma unroll
                for (int rr = 0; rr < 2; ++rr)
#pragma unroll
                    for (int j = 0; j < 4; ++j)
#pragma unroll
                        for (int h = 0; h < 2; ++h) ss[rr] += v[rr][j][h][0] * v[rr][j][h][0] + v[rr][j][h][1] * v[rr][j][h][1] + v[rr][j][h][2] * v[rr][j][h][2] + v[rr][j][h][3] * v[rr][j][h][3];
#pragma unroll
                for (int rr = 0; rr < 2; ++rr) { const int row = rb * 32 + wave * 4 + pr * 2 + rr;
                    const float rstd = 1.0f / sqrtf(wave_sum(ss[rr]) * (1.0f / D) + NORM_EPS);
                    bf16_t* hrow = hbuf + (size_t)row * D;
#pragma unroll
                    for (int j = 0; j < 4; ++j) { const int c = 8 * (lane + 64 * j); f32x4 o[2];
#pragma unroll
                        for (int h = 0; h < 2; ++h) { const f32x4 g = *(const GAS f32x4*)(args.in[I_NMIX] + c + 4 * h); const f32x4 s1 = *(const LAS f32x4*)(scl + c + 4 * h), s0 = *(const LAS f32x4*)(shl + c + 4 * h);
                            o[h] = v[rr][j][h] * rstd * g * (s1 + 1.0f) + s0; }
                        *(GAS u32x4*)(hrow + c) = pg8::pack8(o[0], o[1]); } } }
            __syncthreads();
        }
        if (BOTH(1)) GRID_BAR();
    }

#pragma unroll 1
    for (int l = 0; l < DEPTH; ++l) {
        const int pb = 2 + 9 * l;
        if ((PH_MASK & 4) && IN(pb + 0)) {
            PH_BEGIN
            _Pragma("unroll 1") for (int rep = 0; rep < REPS(0); ++rep) {
            pg8::DenseOrder S; S.init(T, INW, D, G, blk, (bf16_t*)(ws + WS_WIN) + (size_t)l * INW * D);
            pg8::EpiInProj E{proj, args.in[I_BIN] + l * INW, 0.125f * LOG2E, (REP_VARIANT && rep == 1) ? 1 : 0};
            pg8::gemm_phase<pg8::EpiInProj, pg8::DenseOrder, GEMM_ALIGN>(lds, (const char*)hbuf, D, S, E, wave);
            if (rep + 1 < REPS(0)) GRID_BAR(); }
            if (BOTH(pb + 0)) GRID_BAR();
        }
        if ((PH_MASK & 8) && IN(pb + 1)) {
            PH_BEGIN
            _Pragma("unroll 1") for (int rep = 0; rep < REPS(1); ++rep) {
            for (int u = blk; u < 256; u += G) attn_unit(proj, (bf16_t*)(ws + WS_ATTN), args.in[I_SINK] + l * 16, u, lds, tid);
            if (!(REP_VARIANT == 1 && rep == 1)) for (int u = blk; u < 256; u += G) { const int g = u >> 3, b = (u >> 2) & 1, q = u & 3;
                ssm_s1_unit(proj, (const bf16_t*)(ws + WS_SSM + (size_t)(l * 32 + g) * SSM_STRIDE + SSM_E), (float*)(ws + WS_SLOC), g, b, q, lds, tid); }
            if (rep + 1 < REPS(1)) GRID_BAR(); }
            if (BOTH(pb + 1)) GRID_BAR();
        }
        if ((PH_MASK & 16) && IN(pb + 2)) {
            PH_BEGIN
            _Pragma("unroll 1") for (int rep = 0; rep < REPS(2); ++rep) {
            if (!(REP_VARIANT == 1 && rep == 1)) for (int u = blk; u < 256; u += G) { const int g = u >> 3, b = (u >> 2) & 1, q = u & 3;
                ssm_s2_unit(proj, ws + WS_SSM + (size_t)(l * 32 + g) * SSM_STRIDE, (const float*)(ws + WS_SLOC), args.in[I_SD] + l * 512, (bf16_t*)(ws + WS_Y), g, b, q, lds, tid); }
            pg8::DenseOrder S; S.init(T, D, 1024, G, blk, (bf16_t*)(ws + WS_WO) + (size_t)l * D * 1024);
            pg8::EpiAttnProj E{proj, (bf16_t*)(ws + WS_MIXED)};
            pg8::gemm_phase<pg8::EpiAttnProj, pg8::DenseOrder>(lds, (const char*)(ws + WS_ATTN), 1024, S, E, wave);
            if (rep + 1 < REPS(2)) GRID_BAR(); }
            if (BOTH(pb + 2)) GRID_BAR();
        }
        if ((PH_MASK & 32) && IN(pb + 3)) {
            PH_BEGIN
            const int nrep = REPS(3);
            _Pragma("unroll 1") for (int rep = 0; rep < nrep; ++rep) {
            pg8::DenseOrder S; S.init(T, 4096, 512, G, blk, (bf16_t*)(ws + WS_WGLU) + (size_t)l * 4096 * 512);
            pg8::EpiGlu E{proj, (const bf16_t*)(ws + WS_MIXED), (bf16_t*)(ws + WS_MIXED2)};
            pg8::gemm_phase<pg8::EpiGlu, pg8::DenseOrder, GEMM_ALIGN>(lds, (const char*)(ws + WS_Y), 512, S, E, wave);
            if (rep + 1 < nrep) GRID_BAR(); }
            if (BOTH(pb + 3)) GRID_BAR();
        }
        if ((PH_MASK & 64) && IN(pb + 4)) {
            PH_BEGIN
            const int nrep = (l == 0 ? REPS(4) : 1);
            _Pragma("unroll 1") for (int rep = 0; rep < nrep; ++rep) {
            pg8::DenseOrder S; S.init(T, D, D, G, blk, (bf16_t*)(ws + WS_WMIX) + (size_t)l * D * D);
            pg8::EpiMixOut E{l == 0 ? args.in[I_X] : (const float*)nullptr, (const bf16_t*)(ws + WS_XB), (bf16_t*)(ws + WS_XB), mod + (size_t)l * 2 * 12288 + 2 * 2048};
            pg8::gemm_phase<pg8::EpiMixOut, pg8::DenseOrder>(lds, (const char*)(ws + WS_MIXED2), D, S, E, wave);
            if (rep + 1 < nrep) GRID_BAR(); }
            if (BOTH(pb + 4)) GRID_BAR();
        }
        if ((PH_MASK & 128) && IN(pb + 5)) {
            PH_BEGIN
            const int nrep = REPS(5);
            _Pragma("unroll 1") for (int rep = 0; rep < nrep; ++rep) {
            const float* modl = mod + (size_t)l * 2 * 12288;
            int* ltok = (int*)(ws + WS_LTOK); int* ldst = (int*)(ws + WS_LDST); float* lw = (float*)(ws + WS_LW);
            LAS unsigned long long* selmask = (LAS unsigned long long*)(lds + SEL_OFF);
            LAS float* selw = (LAS float*)(lds + SEL_OFF + 256);
            const float* wrt = args.in[I_WR] + (size_t)l * D * NE; const float brt = args.in[I_BR][l * NE + lane];
            for (int rb = blk; rb < T / 32; rb += G) {
                const int bb = (rb * 32) / SEQ; const float* sh2 = modl + bb * 12288 + 3 * 2048; const float* sc2 = sh2 + 2048;
#pragma unroll 1
                for (int it = 0; it < 2; ++it) {
                    {
                        f32x4 v[2][4][2]; float ss[2] = {0.f, 0.f};
                        u32x4 xw[2][4]; f32x4 gsc[4][2], gsh[4][2], sc1[4][2];
#pragma unroll
                        for (int rr = 0; rr < 2; ++rr) { const bf16_t* xr = (const bf16_t*)(ws + WS_XB) + (size_t)(rb * 32 + it * 16 + 2 * wave + rr) * D;
#pragma unroll
                            for (int j = 0; j < 4; ++j) xw[rr][j] = *(const GAS u32x4*)(xr + 8 * (lane + 64 * j)); }
#pragma unroll
                        for (int j = 0; j < 4; ++j)
#pragma unroll
                            for (int h = 0; h < 2; ++h) { const int c = 8 * (lane + 64 * j) + 4 * h;
                                gsc[j][h] = *(const GAS f32x4*)(args.in[I_NFFN] + l * D + c); sc1[j][h] = *(const GAS f32x4*)(sc2 + c); gsh[j][h] = *(const GAS f32x4*)(sh2 + c); }
#pragma unroll
                        for (int rr = 0; rr < 2; ++rr) asm volatile("" : "+v"(xw[rr][0]), "+v"(xw[rr][1]), "+v"(xw[rr][2]), "+v"(xw[rr][3]) :: "memory");
#pragma unroll
                        for (int j = 0; j < 4; ++j) asm volatile("" : "+v"(gsc[j][0]), "+v"(gsc[j][1]), "+v"(sc1[j][0]), "+v"(sc1[j][1]), "+v"(gsh[j][0]), "+v"(gsh[j][1]) :: "memory");
#pragma unroll
                        for (int rr = 0; rr < 2; ++rr)
#pragma unroll
                            for (int j = 0; j < 4; ++j) pg8::unpack8(xw[rr][j], v[rr][j][0], v[rr][j][1]);
#pragma unroll
                        for (int j = 0; j < 4; ++j)
#pragma unroll
                            for (int h = 0; h < 2; ++h) gsc[j][h] = gsc[j][h] * (sc1[j][h] + 1.0f);
#pragma unroll
                        for (int rr = 0; rr < 2; ++rr)
#pragma unroll
                            for (int j = 0; j < 4; ++j)
#pragma unroll
                                for (int h = 0; h < 2; ++h) ss[rr] += v[rr][j][h][0] * v[rr][j][h][0] + v[rr][j][h][1] * v[rr][j][h][1] + v[rr][j][h][2] * v[rr][j][h][2] + v[rr][j][h][3] * v[rr][j][h][3];
#pragma unroll
                        for (int rr = 0; rr < 2; ++rr) { const int lr = 2 * wave + rr, row = rb * 32 + it * 16 + lr;
                            const float rstd = 1.0f / sqrtf(wave_sum(ss[rr]) * (1.0f / D) + NORM_EPS);
                            unsigned char* hrow8 = (unsigned char*)hbuf + (size_t)row * D;
#pragma unroll
                            for (int j = 0; j < 4; ++j) { const int c = 8 * (lane + 64 * j); f32x4 o[2];
#pragma unroll
                                for (int h = 0; h < 2; ++h) o[h] = v[rr][j][h] * rstd * gsc[j][h] + gsh[j][h];
                                const u32x4 hiw = pg8::pack8(o[0], o[1]); *(GAS u32x2*)(hrow8 + c) = (u32x2){pg8::pk_fp8x4(o[0]), pg8::pk_fp8x4(o[1])};
                                f32x4 h0, h1; pg8::unpack8(hiw, h0, h1); const u32x4 low = pg8::pack8(o[0] - h0, o[1] - h1);
                                const int so = lr * 4096 + (((lane + 64 * j) ^ lr) << 4);
                                *(LAS u32x4*)(lds + so) = hiw; *(LAS u32x4*)(lds + 65536 + so) = low; } }
                    }
                    f32x4 racc[4];
                    {
                        const GAS bf16_t* whi = (const GAS bf16_t*)(ws + WS_WRT) + (size_t)(l * 2) * 64 * 2048 + 256 * wave; const GAS bf16_t* wlo = whi + 64 * 2048;
                        const int lop = opaque(lane), r16 = lop & 15, q4 = lop >> 4;
#pragma unroll
                        for (int nt = 0; nt < 4; ++nt) racc[nt] = (f32x4){0.f, 0.f, 0.f, 0.f};
                        auto ldB = [&](int kp, bf16x8 (&bh)[2][4], bf16x8 (&bl)[2][4]) {
#pragma unroll
                            for (int k2 = 0; k2 < 2; ++k2)
#pragma unroll
                                for (int nt = 0; nt < 4; ++nt) { const size_t wo = (size_t)(16 * nt + r16) * 2048 + 32 * (2 * kp + k2) + 8 * q4; bh[k2][nt] = *(const GAS bf16x8*)(whi + wo); bl[k2][nt] = *(const GAS bf16x8*)(wlo + wo); } };
                        auto mm = [&](int kp, const bf16x8 (&bh)[2][4], const bf16x8 (&bl)[2][4]) {
#pragma unroll
                            for (int k2 = 0; k2 < 2; ++k2) { const int chunk = 32 * wave + 4 * (2 * kp + k2) + q4, so = r16 * 4096 + ((chunk ^ r16) << 4);
                                const bf16x8 ah = *(const LAS bf16x8*)(lds + so), al = *(const LAS bf16x8*)(lds + 65536 + so);
#pragma unroll
                                for (int nt = 0; nt < 4; ++nt) {
                                    racc[nt] = __builtin_amdgcn_mfma_f32_16x16x32_bf16(ah, bh[k2][nt], racc[nt], 0, 0, 0);
                                    racc[nt] = __builtin_amdgcn_mfma_f32_16x16x32_bf16(al, bh[k2][nt], racc[nt], 0, 0, 0);
                                    racc[nt] = __builtin_amdgcn_mfma_f32_16x16x32_bf16(ah, bl[k2][nt], racc[nt], 0, 0, 0); } } };
#define RT_FENCE() asm volatile("" ::: "memory")
#define RT_PIN() asm volatile("" : "+v"(racc[0]), "+v"(racc[1]), "+v"(racc[2]), "+v"(racc[3]) :: "memory")
                        bf16x8 bhA[2][4], blA[2][4], bhB[2][4], blB[2][4];
                        RT_FENCE(); ldB(0, bhA, blA); ldB(1, bhB, blB); RT_FENCE();
                        __syncthreads();
                        mm(0, bhA, blA); RT_PIN(); ldB(2, bhA, blA); RT_FENCE();
                        mm(1, bhB, blB); RT_PIN(); ldB(3, bhB, blB); RT_FENCE();
                        mm(2, bhA, blA); mm(3, bhB, blB);
#undef RT_FENCE
#undef RT_PIN
                    }
                    __syncthreads();
                    LAS float* part = (LAS float*)lds;
#pragma unroll
                    for (int nt = 0; nt < 4; ++nt)
#pragma unroll
                        for (int r = 0; r < 4; ++r) part[(wave * 16 + 4 * (lane >> 4) + r) * 64 + 16 * nt + (lane & 15)] = racc[nt][r];
                    __syncthreads();
#pragma unroll 1
                    for (int rr = 0; rr < 2; ++rr) { const int lr = 2 * wave + rr; float logit = 0.f;
#pragma unroll
                        for (int w8 = 0; w8 < 8; ++w8) logit += part[(w8 * 16 + lr) * 64 + lane];
                        const float score = 1.0f / (1.0f + __expf(-logit)); const float sel = score + brt;
                        float m1 = sel; m1 = fmaxf(m1, __shfl_xor(m1, 1)); m1 = fmaxf(m1, __shfl_xor(m1, 2)); m1 = fmaxf(m1, __shfl_xor(m1, 4));
                        const unsigned long long bm = __ballot(sel == m1); const unsigned gb = (unsigned)(bm >> (lane & 56)) & 0xffu; const int first = __builtin_ctz(gb);
                        float v2 = ((lane & 7) == first) ? -3.0e38f : sel; v2 = fmaxf(v2, __shfl_xor(v2, 1)); v2 = fmaxf(v2, __shfl_xor(v2, 2)); v2 = fmaxf(v2, __shfl_xor(v2, 4));
                        const float gs = m1 + v2; int grank = 0; const int mygrp = lane >> 3;
#pragma unroll
                        for (int gg = 0; gg < 8; ++gg) { const float o = __shfl(gs, gg * 8); grank += (o > gs || (o == gs && gg < mygrp)) ? 1 : 0; }
                        float val = grank < 4 ? sel : -3.0e38f; unsigned long long cm = 0ull;
#pragma unroll
                        for (int pick = 0; pick < 8; ++pick) {
                            float mxv = val;
#pragma unroll
                            for (int o = 1; o < 64; o <<= 1) mxv = fmaxf(mxv, __shfl_xor(mxv, o));
                            const unsigned long long bmx = __ballot(val == mxv); const int sl = __builtin_ctzll(bmx);
                            cm |= 1ull << sl; if (lane == sl) val = -3.4e38f; }
                        const bool chosen = (cm >> lane) & 1ull; const float sw = wave_sum(chosen ? score : 0.f);
                        const int gr = it * 16 + lr;
                        selw[gr * 64 + lane] = chosen ? score / sw * 2.5f : 0.f;
                        if (lane == 0) selmask[gr] = cm; }
                    __syncthreads();
                }
                if (wave == 0 && rep + 1 == nrep) {
                    int cntl = 0;
                    for (int r = 0; r < 32; ++r) cntl += (int)((selmask[r] >> lane) & 1ull);
                    int pos = cntl ? (int)atomicAdd(ctl + CW_CNT + l * 64 + opaque(lane), (unsigned)cntl) : 0;
                    for (int r = 0; r < 32; ++r) { const unsigned long long m = selmask[r];
                        if ((m >> lane) & 1ull) { const int k = __builtin_popcountll(m & ((1ull << lane) - 1ull)); const int tok = rb * 32 + r; const int li = lane * 8192 + pos;
                            ltok[li] = tok; ldst[li] = tok * NSLOT + k; ((float*)(ws + WS_TOKW))[tok * 8 + k] = selw[r * 64 + lane]; ++pos; } }
                }
                __syncthreads();
            }
            if (rep + 1 < nrep) GRID_BAR(); }
            if (BOTH(pb + 5)) GRID_BAR();
        }
        if ((PH_MASK & 256) && IN(pb + 6)) {
            PH_BEGIN
            _Pragma("unroll 1") for (int rep = 0; rep < REPS(6); ++rep) {
            LAS int* tpre = (LAS int*)(lds + MOE_OFF); LAS int* ebase = tpre + 65; LAS int* ecnt = ebase + 65; LAS int* utab = (LAS int*)(lds + MOE_OFF + 1024);
            pg8::moe_build<4, true>(tpre, ebase, ecnt, utab, ctl + CW_CNT + l * 64, G, blk, tid);
            pg8::MoeOrder<4, true> S{utab, (const char*)(ws + WS_WGU + (size_t)l * 65 * 1024 * 2048), (size_t)1024 * 2048, (size_t)256 * 2048, (const int*)(ws + WS_LTOK)};
            pg8::EpiGateUp E{(unsigned char*)(ws + WS_HID)};
            pg8::gemm_phase<pg8::EpiGateUp, pg8::MoeOrder<4, true>, GEMM_ALIGN, GEMM_SP2, true>(lds, (const char*)hbuf, D / 2, S, E, wave);
            if (rep + 1 < REPS(6)) GRID_BAR(); }
            if (BOTH(pb + 6)) GRID_BAR();
        }
        if ((PH_MASK & 512) && IN(pb + 7)) {
            PH_BEGIN
            _Pragma("unroll 1") for (int rep = 0; rep < REPS(7); ++rep) {
            LAS int* tpre = (LAS int*)(lds + MOE_OFF); LAS int* ebase = tpre + 65; LAS int* ecnt = ebase + 65; LAS int* utab = (LAS int*)(lds + MOE_OFF + 1024);
            pg8::moe_build<8, false>(tpre, ebase, ecnt, utab, ctl + CW_CNT + l * 64, G, blk, tid);
            constexpr size_t DB = DOWN_F8 ? 1 : 2;
            pg8::MoeOrder<8, false> S{utab, (const char*)(ws + WS_WD + (size_t)l * 65 * 2048 * 512 * DB), (size_t)2048 * 512 * DB, (size_t)256 * 512 * DB, (const int*)(ws + WS_LTOK)};
            pg8::EpiDown E{(unsigned char*)(ws + WS_YSLOT), (const int*)(ws + WS_LDST), (LAS int*)(lds + SEL_OFF), (REP_VARIANT && rep == 1) ? 1 : 0};
            pg8::gemm_phase<pg8::EpiDown, pg8::MoeOrder<8, false>, GEMM_ALIGN, GEMM_SP2, DOWN_F8 != 0>(lds, (const char*)(ws + WS_HID), DOWN_F8 ? 256 : 512, S, E, wave);
            if (rep + 1 < REPS(7)) GRID_BAR(); }
            if (BOTH(pb + 7)) GRID_BAR();
        }
        if ((PH_MASK & 1024) && IN(pb + 8)) {
            PH_BEGIN
            const int nrep = REPS(8);
            _Pragma("unroll 1") for (int rep = 0; rep < nrep; ++rep) {
            const float* modl = mod + (size_t)l * 2 * 12288;
            const unsigned char* yslot = (const unsigned char*)(ws + WS_YSLOT);
            for (int run = blk * NWAVES + wave; run < T / 4; run += G * NWAVES) {
                const int bb = (run * 4) / SEQ; const float* gt2 = modl + bb * 12288 + 5 * 2048;
                const float* m1 = mod + (size_t)2 * 12288 + bb * 12288;
                f32x4 gtv[2][4];
#pragma unroll
                for (int jj = 0; jj < 2; ++jj)
#pragma unroll
                    for (int q = 0; q < 4; ++q) { const int c = 16 * (lane + 64 * jj) + 4 * q; gtv[jj][q] = *(const GAS f32x4*)(gt2 + c) * pg8::YS_INV; }
#pragma unroll 1
                for (int pr = 0; pr < 2; ++pr) {
                    f32x4 v[2][2][4]; float ss[2] = {0.f, 0.f};
                    const int rowb = run * 4 + pr * 2;
                    f32x4 tw[2][2];
#pragma unroll
                    for (int rr = 0; rr < 2; ++rr) { tw[rr][0] = *(const GAS f32x4*)((const float*)(ws + WS_TOKW) + (rowb + rr) * 8); tw[rr][1] = *(const GAS f32x4*)((const float*)(ws + WS_TOKW) + (rowb + rr) * 8 + 4); }
                    auto issue = [&](int rr, int jj, u32x4 (&w)[NSLOT], u32x4 (&xq)[2]) {
                        const int c = 16 * (lane + 64 * jj); const unsigned char* ys = yslot + (size_t)(rowb + rr) * NSLOT * D + c;
#pragma unroll
                        for (int k = 0; k < NSLOT; ++k) w[k] = *(const GAS u32x4*)(ys + (size_t)k * D);
                        const bf16_t* xr = (const bf16_t*)(ws + WS_XB) + (size_t)(rowb + rr) * D + c; xq[0] = *(const GAS u32x4*)xr; xq[1] = *(const GAS u32x4*)(xr + 8); };
                    auto consume = [&](int rr, int jj, const u32x4 (&w)[NSLOT], const u32x4 (&xq)[2]) {
                        f32x4 a[4];
#pragma unroll
                        for (int q = 0; q < 4; ++q) a[q] = (f32x4){0.f, 0.f, 0.f, 0.f};
#pragma unroll
                        for (int k = 0; k < NSLOT; ++k) { const float wk = k < 8 ? tw[rr][k >> 2][k & 3] : 1.0f;
#pragma unroll
                            for (int q = 0; q < 4; ++q) { const f32x2 lo = __builtin_amdgcn_cvt_pk_f32_fp8((int)w[k][q], false), hi = __builtin_amdgcn_cvt_pk_f32_fp8((int)w[k][q], true); a[q] += (f32x4){lo.x, lo.y, hi.x, hi.y} * wk; } }
                        f32x4 xv[4]; pg8::unpack8(xq[0], xv[0], xv[1]); pg8::unpack8(xq[1], xv[2], xv[3]);
#pragma unroll
                        for (int q = 0; q < 4; ++q) { v[rr][jj][q] = xv[q] + gtv[jj][q] * a[q];
                            ss[rr] += v[rr][jj][q][0] * v[rr][jj][q][0] + v[rr][jj][q][1] * v[rr][jj][q][1] + v[rr][jj][q][2] * v[rr][jj][q][2] + v[rr][jj][q][3] * v[rr][jj][q][3]; } };
                    {
                        u32x4 wA[NSLOT], xA[2], wB[NSLOT], xB[2];
#define CMB_FENCE() asm volatile("" ::: "memory")
#define CMB_PIN(x) asm volatile("" : "+v"(x) :: "memory")
                        issue(0, 0, wA, xA); issue(0, 1, wB, xB); CMB_FENCE();
                        consume(0, 0, wA, xA); CMB_PIN(ss[0]); issue(1, 0, wA, xA); CMB_FENCE();
                        consume(0, 1, wB, xB); CMB_PIN(ss[0]); issue(1, 1, wB, xB); CMB_FENCE();
                        consume(1, 0, wA, xA); consume(1, 1, wB, xB); CMB_PIN(ss[1]);
#undef CMB_FENCE
#undef CMB_PIN
                    }
                    f32x4 gs[2][4], gh[2][4];
                    if (l == 0) {
#pragma unroll
                        for (int jj = 0; jj < 2; ++jj)
#pragma unroll
                            for (int q = 0; q < 4; ++q) { const int c = 16 * (lane + 64 * jj) + 4 * q;
                                gs[jj][q] = *(const GAS f32x4*)(args.in[I_NMIX] + D + c) * (*(const GAS f32x4*)(m1 + 2048 + c) + 1.0f); gh[jj][q] = *(const GAS f32x4*)(m1 + c); }
                    } else {
#pragma unroll
                        for (int jj = 0; jj < 2; ++jj)
#pragma unroll
                            for (int q = 0; q < 4; ++q) { const int c = 16 * (lane + 64 * jj) + 4 * q; gs[jj][q] = *(const GAS f32x4*)(args.in[I_NFIN] + c); gh[jj][q] = (f32x4){0.f, 0.f, 0.f, 0.f}; }
                    }
#pragma unroll
                    for (int rr = 0; rr < 2; ++rr) { const int row = rowb + rr;
                        const float rstd = 1.0f / sqrtf(wave_sum(ss[rr]) * (1.0f / D) + NORM_EPS);
                        float* xw = (rep + 1 == nrep) ? xbuf + (size_t)row * D : (float*)(ws + WS_HID) + (size_t)row * D; bf16_t* hw = (rep + 1 == nrep) ? hbuf + (size_t)row * D : (bf16_t*)(ws + WS_MIXED2) + (size_t)row * D;
                        bf16_t* xbw = (rep + 1 == nrep) ? (bf16_t*)(ws + WS_XB) + (size_t)row * D : (bf16_t*)(ws + WS_MIXED) + (size_t)row * D;
                        if (l == 0) {
#pragma unroll
                            for (int jj = 0; jj < 2; ++jj) { const int c = 16 * (lane + 64 * jj); f32x4 o[4];
                                *(GAS u32x4*)(xbw + c) = pg8::pack8(v[rr][jj][0], v[rr][jj][1]); *(GAS u32x4*)(xbw + c + 8) = pg8::pack8(v[rr][jj][2], v[rr][jj][3]);
#pragma unroll
                                for (int q = 0; q < 4; ++q) o[q] = v[rr][jj][q] * rstd * gs[jj][q] + gh[jj][q];
                                *(GAS u32x4*)(hw + c) = pg8::pack8(o[0], o[1]); *(GAS u32x4*)(hw + c + 8) = pg8::pack8(o[2], o[3]); }
                        } else {
#pragma unroll
                            for (int jj = 0; jj < 2; ++jj) { const int c = 16 * (lane + 64 * jj);
#pragma unroll
                                for (int q = 0; q < 4; ++q) *(GAS f32x4*)(xw + c + 4 * q) = v[rr][jj][q] * rstd * gs[jj][q]; }
                        } }
                }
            }
            if (rep + 1 < nrep) GRID_BAR(); }
            if (BOTH(pb + 8)) GRID_BAR();
        }
    }
#undef IN
#undef BOTH
#undef GRID_BAR
}

extern "C" void kernel_launch(void* const* d_in, const int* in_sizes, int n_in, void* d_out, int out_size, void* d_ws, size_t ws_size, hipStream_t stream) {
    static int grid = 0;
    if (grid == 0) {
        if (n_in != 29 || out_size != T * D || ws_size < WS_END) { fprintf(stderr, "kernel_launch: unexpected shapes (n_in %d out %d ws %zu)\n", n_in, out_size, ws_size); grid = -1; return; }
        int dev = 0, cus = 0, per_cu = 0;
        if (hipGetDevice(&dev) != hipSuccess || hipDeviceGetAttribute(&cus, hipDeviceAttributeMultiprocessorCount, dev) != hipSuccess) { grid = -1; return; }
        if (hipFuncSetAttribute((const void*)mega_fwd, hipFuncAttributeMaxDynamicSharedMemorySize, LDS_BYTES) != hipSuccess) { fprintf(stderr, "kernel_launch: hipFuncSetAttribute failed\n"); grid = -1; return; }
        if (hipOccupancyMaxActiveBlocksPerMultiprocessor(&per_cu, (const void*)mega_fwd, NWAVES * 64, LDS_BYTES) != hipSuccess || per_cu < 1) { fprintf(stderr, "kernel_launch: occupancy query says %d\n", per_cu); }
        (void)hipGetLastError();
        grid = cus & ~7;
    }
    if (grid < 0) return;
    (void)hipMemsetAsync((char*)d_ws + WS_CTL, 0, CTL_ZERO_BYTES, stream);
    Args a{};
    for (int i = 0; i < 29; ++i) a.in[i] = (const float*)d_in[i];
    a.out = (float*)d_out; a.ws = (unsigned char*)d_ws;
    if (N_LAUNCHES == 1) { a.ph_lo = 0; a.ph_hi = 20; hipLaunchKernelGGL(mega_fwd, dim3(grid), dim3(NWAVES * 64), LDS_BYTES, stream, a); }
    else { for (int p = 0; p < 20; ++p) { a.ph_lo = p; a.ph_hi = p + 1; hipLaunchKernelGGL(mega_fwd, dim3(grid), dim3(NWAVES * 64), LDS_BYTES, stream, a); } }
}
```

```cpp
#include <hip/hip_runtime.h>
#include <cstdio>
#include <cstdint>

#ifndef N_LAUNCHES
#define N_LAUNCHES 1
#endif
#ifndef GEMM_ALIGN
#define GEMM_ALIGN true
#endif
#ifndef GEMM_SP2
#define GEMM_SP2 true
#endif
#ifndef MOE_XCD
#define MOE_XCD 0
#endif
#ifndef F8_PIN
#define F8_PIN 1
#endif
#if F8_PIN == 1
#define F8_PIN_ASM(x) asm volatile("" : "+v"(x))
#elif F8_PIN == 2
#define F8_PIN_ASM(x) asm volatile("" : "+a"(x))
#else
#define F8_PIN_ASM(x) do {} while (0)
#endif
#ifndef DOWN_PRE
#define DOWN_PRE 1
#endif
#ifndef DOWN_F8
#define DOWN_F8 1
#endif

#define LAS __attribute__((address_space(3)))
#define GAS __attribute__((address_space(1)))
typedef unsigned short bf16_t;
typedef short bf16x8 __attribute__((ext_vector_type(8)));
typedef float f32x4 __attribute__((ext_vector_type(4)));
typedef float f32x2 __attribute__((ext_vector_type(2)));
typedef unsigned u32x4 __attribute__((ext_vector_type(4)));
typedef unsigned u32x2 __attribute__((ext_vector_type(2)));
typedef int i32x4 __attribute__((ext_vector_type(4)));
typedef int i32x8 __attribute__((ext_vector_type(8)));

constexpr int T = 8192, D = 2048, SEQ = 4096, DEPTH = 2;
constexpr int INW = 6144, O_Q = 0, O_K = 1024, O_V = 1280, O_U = 1536, O_GA = 2048, O_GS = 4096;
constexpr int NE = 64, NSLOT = 9;
constexpr float NORM_EPS = 1e-6f;
constexpr float LOG2E = 1.4426950408889634f;

constexpr size_t MiB = 1u << 20;
constexpr size_t WS_CTL = 0, CTL_ZERO_BYTES = 1 * MiB;
constexpr size_t WS_MODP = 1 * MiB;
constexpr size_t WS_MOD = 3 * MiB;
constexpr size_t WS_SSM = 4 * MiB;
constexpr size_t SSM_STRIDE = 640 * 1024, SSM_E = 0, SSM_F = 256 * 1024, SSM_KT = 512 * 1024, SSM_P = 560 * 1024;
constexpr size_t WS_WIN = 44 * MiB;
constexpr size_t WS_WO = 92 * MiB;
constexpr size_t WS_WGLU = 100 * MiB;
constexpr size_t WS_WMIX = 108 * MiB;
constexpr size_t WS_WGU = 124 * MiB;
constexpr size_t WS_WD = 644 * MiB;
constexpr size_t WS_H = 904 * MiB;
constexpr size_t WS_PROJ = 936 * MiB;
constexpr size_t WS_ATTN = 1032 * MiB;
constexpr size_t WS_SLOC = 1048 * MiB;
constexpr size_t WS_Y = 1050 * MiB;
constexpr size_t WS_MIXED = 1058 * MiB;
constexpr size_t WS_HID = 1090 * MiB;
constexpr size_t WS_YSLOT = 1163 * MiB;
constexpr size_t WS_LTOK = 1451 * MiB, WS_LDST = 1453 * MiB, WS_LW = 1455 * MiB;
constexpr size_t WS_MIXED2 = 1457 * MiB;
constexpr size_t WS_WRT = 1489 * MiB;
constexpr size_t WS_XB = 1490 * MiB;
constexpr size_t WS_TOKW = 1522 * MiB;
constexpr size_t WS_END = 1523 * MiB;
constexpr int CW_TMO = 0, CW_BAR = 4096, CW_CNT = 8192;

constexpr int RING_BYTES = 131072, LDSCTL_OFF = RING_BYTES, MISC_OFF = LDSCTL_OFF + 320;
constexpr int SEL_OFF = LDSCTL_OFF + 1024;
constexpr int MOE_OFF = LDSCTL_OFF + 10240;
constexpr int LDS_BYTES = 147456;
constexpr int NWAVES = 8;

__device__ __forceinline__ unsigned cvt_pk_bf16(float lo, float hi) { unsigned r; asm("v_cvt_pk_bf16_f32 %0, %1, %2" : "=v"(r) : "v"(lo), "v"(hi)); return r; }
__device__ __forceinline__ float bf_lo(unsigned w) { return __uint_as_float(w << 16); }
__device__ __forceinline__ float bf_hi(unsigned w) { return __uint_as_float(w & 0xffff0000u); }
__device__ __forceinline__ float bf1(bf16_t h) { return __uint_as_float(((unsigned)h) << 16); }
__device__ __forceinline__ float fast_sigmoid(float x) { return __builtin_amdgcn_rcpf(1.0f + __builtin_amdgcn_exp2f(-x * LOG2E)); }
__device__ __forceinline__ float wave_sum(float v) {
#pragma unroll
    for (int o = 1; o < 64; o <<= 1) v += __shfl_xor(v, o);
    return v;
}
__device__ __forceinline__ int opaque(int v) { asm volatile("" : "+v"(v)); return v; }
__device__ __forceinline__ int lane_now() { int l; asm volatile("v_mbcnt_lo_u32_b32 %0, -1, 0\n\tv_mbcnt_hi_u32_b32 %0, -1, %0" : "=v"(l)); return l; }
#define LDS_WAIT() asm volatile("s_waitcnt lgkmcnt(0)" ::: "memory")
#define VM_WAIT() asm volatile("s_waitcnt vmcnt(0)" ::: "memory")

#define XB_TMO      128
#define XB_XCNT(j)  (256  + 64 * (j))
#define XB_XSUB(j)  (1280 + 64 * (j))
#define XB_XGEN(j)  (2304 + 64 * (j))
#define XB_TOP      3328
#define XB_TOPGEN   3392
#define XCD_BAR_WORDS 3456
#define XB_SPIN_CAP (1u << 18)
__device__ __forceinline__ unsigned xb_ld(unsigned* p)              { return __hip_atomic_load(p, __ATOMIC_RELAXED, __HIP_MEMORY_SCOPE_AGENT); }
__device__ __forceinline__ unsigned xb_add(unsigned* p, unsigned v) { return __hip_atomic_fetch_add(p, v, __ATOMIC_RELAXED, __HIP_MEMORY_SCOPE_AGENT); }
__device__ __forceinline__ unsigned xb_xcc_id() { return (unsigned)__builtin_amdgcn_s_getreg((3 << 11) | 20) & 0xFu; }
#define XB_SPIN(cond, bar) do { unsigned _sp = 0; while (cond) { __builtin_amdgcn_s_sleep(1); \
    if ((++_sp & 255u) == 0u) { if (xb_ld(&(bar)[XB_TMO])) break; if (_sp > XB_SPIN_CAP) { atomicAdd(&(bar)[XB_TMO], 1u); break; } } } } while (0)
struct XcdBarrier { unsigned* bar; unsigned x; volatile LAS unsigned* st; int wv; };
__device__ __forceinline__ XcdBarrier xcd_barrier_post(unsigned* bar, volatile LAS unsigned* st) {
    XcdBarrier b; b.bar = bar; b.x = xb_xcc_id(); b.st = st; b.wv = __builtin_amdgcn_readfirstlane((int)threadIdx.x >> 6);
    if (threadIdx.x == 0) (void)xb_add(&bar[XB_XCNT(b.x)], 1u);
    return b;
}
__device__ __forceinline__ void xcd_barrier_complete(unsigned* bar, unsigned x, unsigned& nloc, unsigned& nx) {
    const unsigned G = gridDim.x * gridDim.y * gridDim.z;
    unsigned sum, cnt, mine, sp = 0u;
    for (;;) {
        sum = 0u; cnt = 0u; mine = 0u;
#pragma unroll
        for (unsigned j = 0; j < 16; ++j) { const unsigned c = xb_ld(&bar[XB_XCNT(j)]); sum += c; cnt += (c > 0u) ? 1u : 0u; mine = (j == x) ? c : mine; }
        if (sum == G) break;
        __builtin_amdgcn_s_sleep(1);
        if ((++sp & 255u) == 0u) { if (xb_ld(&bar[XB_TMO])) break; if (sp > XB_SPIN_CAP) { atomicAdd(&bar[XB_TMO], 1u); break; } }
    }
    nloc = mine > 0u ? mine : 1u; nx = cnt > 0u ? cnt : 1u;
}
__device__ __forceinline__ void xcd_barrier(const XcdBarrier& b) {
    asm volatile("s_waitcnt vmcnt(0)" ::: "memory");
    __syncthreads();
    if (lane_now() + 64 * b.wv == 0) {
        unsigned* bar = b.bar; asm volatile("" : "+s"(bar));
        __builtin_amdgcn_s_waitcnt(0);
        unsigned nloc = b.st[0], nx = b.st[1];
        if (nloc == 0u) { xcd_barrier_complete(bar, b.x, nloc, nx); b.st[0] = nloc; b.st[1] = nx; }
        const unsigned old = xb_add(&bar[XB_XSUB(b.x)], 1u);
        const unsigned gen = old / nloc;
        if (old + 1u == (gen + 1u) * nloc) {
            __builtin_amdgcn_fence(__ATOMIC_RELEASE, "agent");
            asm volatile("s_waitcnt vmcnt(0)" ::: "memory");
            const unsigned og = xb_add(&bar[XB_TOP], 1u);
            const unsigned tg = og / nx;
            if (og + 1u == (tg + 1u) * nx) xb_add(&bar[XB_TOPGEN], 1u);
            else XB_SPIN(xb_ld(&bar[XB_TOPGEN]) == tg, bar);
            __builtin_amdgcn_fence(__ATOMIC_ACQUIRE, "agent");
            xb_add(&bar[XB_XGEN(b.x)], 1u);
            asm volatile("s_waitcnt vmcnt(0)" ::: "memory");
        } else {
            XB_SPIN(xb_ld(&bar[XB_XGEN(b.x)]) == gen, bar);
            __builtin_amdgcn_fence(__ATOMIC_ACQUIRE, "agent");
            asm volatile("s_waitcnt vmcnt(0)" ::: "memory");
        }
    }
    __syncthreads();
}

namespace pg8 {
constexpr int BM = 256, BK = 64, HALF = 128, HTB = HALF * BK * 2, STAGE_BYTES = 8 * HTB, NXCD = 8, WGM = 8;
__host__ __device__ __forceinline__ int lds_byte(int r, int c) { const int st = (r >> 4) * 2 + (c >> 5), rr = r & 15, cc = c & 31, ob = rr * 64 + cc * 2; return st * 1024 + (ob ^ (((ob >> 9) & 1) << 5)); }
__host__ __device__ __forceinline__ void stage_rc(int b, int& R, int& C) { const int st = b / 1024, sb = b % 1024, swz = sb ^ (((sb >> 9) & 1) << 5); R = (st >> 1) * 16 + swz / 64; C = (st & 1) * 32 + (swz % 64) / 2; }
__host__ __device__ __forceinline__ int perm32(int rho) { const int n = rho >> 4, i = rho & 15; return 8 * (i >> 2) + 4 * n + (i & 3); }

struct Unit { int pm, pn, e, n, r0, x; };

struct DenseOrder {
    static constexpr bool GATHER = false;
    int nM, nN, nwg, G, c; const char* Bt; size_t tstepB;
    __device__ void init(int M, int N, int K, int G_, int c_, const void* Bt_) { nM = M / BM; nN = N / BM; nwg = nM * nN; G = G_; c = c_; Bt = (const char*)Bt_; tstepB = (size_t)BM * K * 2; }
    __device__ __forceinline__ bool next(int i, Unit& u) const {
        const long L = (long)i * G + c; if (L >= nwg) return false;
        int wgid = (int)L; { const int q = nwg / NXCD, r = nwg % NXCD, xcd = wgid % NXCD, off = wgid / NXCD; wgid = (xcd < r ? xcd * (q + 1) : r * (q + 1) + (xcd - r) * q) + off; }
        const int nig = WGM * nN, gid = wgid / nig, fm = gid * WGM, gsz = (nM - fm) < WGM ? (nM - fm) : WGM;
        u.pm = fm + ((wgid % nig) % gsz); u.pn = (wgid % nig) / gsz; u.e = -1; u.n = 256; u.r0 = u.pm * BM; u.x = u.pm * BM; return true;
    }
    __device__ __forceinline__ int a_row(const Unit& u, int R) const { return u.r0 + R; }
    __device__ __forceinline__ void a_row_issue(const Unit& u, int R, int& out) const { out = u.r0 + R; }
    __device__ __forceinline__ int a_row_fix(const Unit& u, int R, int loaded) const { return loaded; }
    __device__ __forceinline__ const char* b_tile(const Unit& u) const { return Bt + (size_t)u.pn * tstepB; }
};
template <int NPN, bool GATHER_> struct MoeOrder {
    static constexpr bool GATHER = GATHER_;
    const LAS int* utab; const char* Wbase; size_t wstepE, tstepB; const int* ltok;
    __device__ __forceinline__ bool next(int i, Unit& u) const {
        if (i >= 64) return false;
        const LAS int* p = utab + i * 8;
        const int pm = __builtin_amdgcn_readfirstlane(p[0]); if (pm < 0) return false;
        u.pm = pm; u.pn = __builtin_amdgcn_readfirstlane(p[1]); u.e = __builtin_amdgcn_readfirstlane(p[2]); u.n = __builtin_amdgcn_readfirstlane(p[3]);
        u.r0 = __builtin_amdgcn_readfirstlane(p[4]); u.x = __builtin_amdgcn_readfirstlane(p[5]); return true;
    }
    __device__ __forceinline__ int a_row(const Unit& u, int R) const {
        if (!GATHER) return u.r0 + R;
        if (u.e == 64) return u.r0 + R;
        const int rr = R < u.n ? R : u.n - 1; return ((const GAS int*)ltok)[u.r0 + rr];
    }
    __device__ __forceinline__ void a_row_issue(const Unit& u, int R, int& out) const {
        const int rr = R < u.n ? R : u.n - 1; const GAS int* p = (const GAS int*)ltok + (u.e == 64 ? 0 : u.r0 + rr);
        asm volatile("global_load_dword %0, %1, off" : "=v"(out) : "v"(p) : "memory");
    }
    __device__ __forceinline__ int a_row_fix(const Unit& u, int R, int loaded) const { return u.e == 64 ? u.r0 + R : loaded; }
    __device__ __forceinline__ const char* b_tile(const Unit& u) const { return Wbase + (size_t)u.e * wstepE + (size_t)u.pn * tstepB; }
};
template <int NPN, bool GATHER> __device__ __forceinline__ void moe_build(LAS int* tpre, LAS int* ebase, LAS int* ecnt, LAS int* utab, const unsigned* counts, int G, int c, int tid) {
    if (tid < 64) ecnt[tid] = (int)__hip_atomic_load(counts + tid, __ATOMIC_RELAXED, __HIP_MEMORY_SCOPE_AGENT);
    __syncthreads();
    if (tid == 0) { int tp = 0, eb = 0; for (int e = 0; e < 64; ++e) { tpre[e] = tp; ebase[e] = eb; tp += (ecnt[e] + 255) >> 8; eb += ecnt[e]; } tpre[64] = tp; ebase[64] = eb; }
    __syncthreads();
#if MOE_XCD
    if (tid < 64) {
        int pm = -1, pn = 0, e = 64, n = 256;
        const int xc = c & 7; int idx = (c >> 3) + (G >> 3) * tid;
        if (idx < 4 * NPN) { pm = xc + 8 * (idx / NPN); pn = idx % NPN; }
        else { idx -= 4 * NPN;
#pragma unroll 1
            for (int j = 0; j < 8; ++j) { const int ee = xc + 8 * j, nu = ((ecnt[ee] + 255) >> 8) * NPN;
                if (pm < 0) { if (idx < nu) { e = ee; pm = idx / NPN; pn = idx % NPN; } else idx -= nu; } }
            if (pm >= 0) { const int rem = ecnt[e] - pm * BM; n = rem < BM ? rem : BM; } }
        const int hb = (e == 64 ? 65536 : ebase[e]) + pm * BM;
        const int r0 = GATHER ? (e == 64 ? pm * BM : e * 8192 + pm * BM) : hb, x = hb;
#else
    if (tid < 64) {
        int pm = -1, pn = 0, e = 64, n = 256;
        const int vc = ((G & 7) == 0) ? (c & 7) * (G >> 3) + (c >> 3) : c;
        int L = tid * G + vc; const int shared_units = 32 * NPN, tot = shared_units + NPN * tpre[64];
        if (L < tot) {
            if (L < shared_units) { pm = L / NPN; pn = L % NPN; }
            else { L -= shared_units; const int tile = L / NPN; pn = L % NPN; e = 0;
#pragma unroll 1
                for (int j = 1; j <= 64; ++j) e += (tpre[j] <= tile) ? 1 : 0;
                pm = tile - tpre[e]; const int rem = ecnt[e] - pm * BM; n = rem < BM ? rem : BM; } }
        const int hb = (e == 64 ? 65536 : ebase[e]) + pm * BM;
        const int r0 = GATHER ? (e == 64 ? pm * BM : e * 8192 + pm * BM) : hb, x = hb;
#endif
        LAS int* p = utab + tid * 8; p[0] = pm; p[1] = pn; p[2] = e; p[3] = n; p[4] = r0; p[5] = x;
    }
    __syncthreads();
}

template <class Epi, class Sched, bool ALIGN_EPI = false, bool SP2 = GEMM_SP2, bool F8 = false>
__device__ __forceinline__ void gemm_phase(LAS unsigned char* lds, const char* Abase, const int K, const Sched& S, const Epi& E, const int wave_s) {
    int tid = lane_now() + 64 * wave_s; asm volatile("" : "+v"(tid));
    const int wid = wave_s, lane = tid & 63, wr = wid >> 2, wc = wid & 3, fr = lane & 15, fq = lane >> 4;
    const int nt = K / BK;
    constexpr bool GA = Sched::GATHER;
    unsigned voffA[2], voffB[2];
#pragma unroll
    for (int i = 0; i < 2; ++i) { int R, C; stage_rc(tid * 16 + i * 8192, R, C); const int Rb = Epi::PERM ? ((R & ~31) + perm32(R & 31)) : R; voffA[i] = (unsigned)(R * K + C) * 2u; voffB[i] = (unsigned)(Rb * K + C) * 2u; }
    const size_t kstep = (size_t)(BK * 2);
    const size_t hstep = (size_t)HALF * K * 2;
    const unsigned ldsw = (unsigned)wid * 1024u;
    const int aoff = lds_byte(wr * 64 + fr, fq * 8), boff = lds_byte(wc * 32 + fr, fq * 8);
#define PG8_SA(b, h) (((b) * 2 + (h)) * HTB)
#define PG8_SB(b, h) ((4 + (b) * 2 + (h)) * HTB)
#define PG8_STB(bufoff, gbase) do { const char* _sb = (const char*)(gbase); asm volatile("" : "+s"(_sb)); _Pragma("unroll") for (int _i = 0; _i < 2; ++_i) \
        { unsigned _vo = voffB[_i]; asm volatile("" : "+v"(_vo)); __builtin_amdgcn_global_load_lds((const unsigned*)(_sb + _vo), (LAS unsigned*)(lds + (bufoff) + ldsw + _i * 8192), 16, 0, 0); } } while (0)
#define PG8_STA(bufoff, h, kb) do { const char* _sa = GA ? (Abase + (kb)) : (cA + (kb) + (h) * hstep); asm volatile("" : "+s"(_sa)); _Pragma("unroll") for (int _i = 0; _i < 2; ++_i) \
        { unsigned _vo = GA ? offC[h][_i] : voffA[_i]; asm volatile("" : "+v"(_vo)); __builtin_amdgcn_global_load_lds((const unsigned*)(_sa + _vo), (LAS unsigned*)(lds + (bufoff) + ldsw + _i * 8192), 16, 0, 0); } } while (0)
#define PG8_LDA(dst, b, h) do { _Pragma("unroll") for (int m = 0; m < 4; ++m) _Pragma("unroll") for (int k = 0; k < 2; ++k) dst[m][k] = *(const LAS bf16x8*)(lds + PG8_SA(b, h) + aoff + m * 2048 + k * 1024); } while (0)
#define PG8_LDB(dst, b, h) do { _Pragma("unroll") for (int n = 0; n < 2; ++n) _Pragma("unroll") for (int k = 0; k < 2; ++k) dst[n][k] = *(const LAS bf16x8*)(lds + PG8_SB(b, h) + boff + n * 2048 + k * 1024); } while (0)
#define PG8_CAT8(x, y) __builtin_shufflevector(__builtin_bit_cast(i32x4, x), __builtin_bit_cast(i32x4, y), 0, 1, 2, 3, 4, 5, 6, 7)
#define PG8_MMA(ai, bj, At, Bt) do { __builtin_amdgcn_s_setprio(1); _Pragma("unroll") for (int m = 0; m < 4; ++m) _Pragma("unroll") for (int n = 0; n < 2; ++n) { \
        if constexpr (F8) acc[ai][bj][m][n] = __builtin_amdgcn_mfma_scale_f32_16x16x128_f8f6f4(PG8_CAT8(Bt[n][0], Bt[n][1]), PG8_CAT8(At[m][0], At[m][1]), acc[ai][bj][m][n], 0, 0, 0, 0, 0, 0); \
        else { _Pragma("unroll") for (int k = 0; k < 2; ++k) acc[ai][bj][m][n] = __builtin_amdgcn_mfma_f32_16x16x32_bf16(Bt[n][k], At[m][k], acc[ai][bj][m][n], 0, 0, 0); } } \
        __builtin_amdgcn_s_setprio(0); } while (0)
#define PG8_WAIT_V(n) asm volatile("s_waitcnt vmcnt(" #n ")" ::: "memory")
#define PG8_WAIT_L(n) asm volatile("s_waitcnt lgkmcnt(" #n ")" ::: "memory")
#define PG8_BAR __builtin_amdgcn_s_barrier()
#define PG8_SCHED __builtin_amdgcn_sched_barrier(0)
#define PG8_AOFF(dst, u) do { if constexpr (GA) { _Pragma("unroll") for (int _h = 0; _h < 2; ++_h) _Pragma("unroll") for (int _i = 0; _i < 2; ++_i) { int _R, _C; stage_rc(tid * 16 + _i * 8192, _R, _C); \
        dst[_h][_i] = (unsigned)(S.a_row(u, _h * HALF + _R) * K + _C) * 2u; } } } while (0)
    Unit cur, nxt; int ui = 0;
    if (!S.next(0, cur)) return;
    f32x4 acc[2][2][4][2];
#pragma unroll
    for (int a = 0; a < 2; ++a)
#pragma unroll
        for (int b = 0; b < 2; ++b)
#pragma unroll
            for (int m = 0; m < 4; ++m)
#pragma unroll
                for (int n = 0; n < 2; ++n) { acc[a][b][m][n] = (f32x4){0.f, 0.f, 0.f, 0.f}; if constexpr (F8) F8_PIN_ASM(acc[a][b][m][n]); }
    bf16x8 At[4][2], B0[2][2], B1[2][2];
    unsigned offC[2][2];
    PG8_AOFF(offC, cur);
    const char* cB = S.b_tile(cur);
    const char* cA = GA ? Abase : Abase + (size_t)S.a_row(cur, 0) * K * 2;
    if constexpr (SP2) {
        PG8_STB(PG8_SB(0, 0), cB); PG8_STB(PG8_SB(0, 1), cB + hstep); PG8_STA(PG8_SA(0, 0), 0, 0); PG8_STA(PG8_SA(0, 1), 1, 0);
        if (wr == 1) PG8_BAR;
        PG8_WAIT_V(2); PG8_BAR;
        PG8_STB(PG8_SB(1, 0), cB + kstep); PG8_STA(PG8_SA(1, 0), 0, kstep); PG8_STB(PG8_SB(1, 1), cB + hstep + kstep);
        PG8_WAIT_V(6); PG8_BAR;
    } else {
    PG8_STB(PG8_SB(0, 0), cB); PG8_STA(PG8_SA(0, 0), 0, 0); PG8_STB(PG8_SB(0, 1), cB + hstep); PG8_STA(PG8_SA(0, 1), 1, 0);
    if (wr == 1) PG8_BAR;
    PG8_WAIT_V(4); PG8_BAR;
    PG8_STB(PG8_SB(1, 0), cB + kstep); PG8_STA(PG8_SA(1, 0), 0, kstep); PG8_STB(PG8_SB(1, 1), cB + hstep + kstep);
    PG8_WAIT_V(6); PG8_BAR;
    }
    for (;;) {
        int pre_v0, pre_v1; if constexpr (Epi::PRE) E.pre_issue(cur, wr, opaque(lane_now()), pre_v0, pre_v1);
        const bool has_next = S.next(ui + 1, nxt);
        const char* nB = has_next ? S.b_tile(nxt) : cB;
        const char* nA = (!GA && has_next) ? Abase + (size_t)S.a_row(nxt, 0) * K * 2 : cA;
        int rowN[2][2];
        if constexpr (GA) { const Unit un = has_next ? nxt : cur;
#pragma unroll
            for (int h = 0; h < 2; ++h)
#pragma unroll
                for (int i = 0; i < 2; ++i) { int R_, C_; stage_rc(tid * 16 + i * 8192, R_, C_); S.a_row_issue(un, h * HALF + R_, rowN[h][i]); } }
#pragma unroll 1
        for (int t = 0; t < nt; t += 2) {
            const bool last = (t == nt - 2);
            const size_t kb1 = (size_t)(t + 1) * kstep;
            const size_t kb2 = last ? 0 : (size_t)(t + 2) * kstep, kb3 = kb2 + kstep;
            const char* b2 = last ? nB : cB + (size_t)(t + 2) * kstep; const char* b3 = b2 + kstep;
            if constexpr (SP2) {
            PG8_LDB(B0, 0, 0); PG8_LDB(B1, 0, 1); PG8_SCHED; PG8_LDA(At, 0, 0); PG8_STA(PG8_SA(1, 1), 1, kb1);
            if (last) { if constexpr (GA) { if (has_next) {
#pragma unroll
                for (int h = 0; h < 2; ++h)
#pragma unroll
                    for (int i = 0; i < 2; ++i) { int R_, C_; stage_rc(tid * 16 + i * 8192, R_, C_); int rl = rowN[h][i]; asm volatile("" : "+v"(rl));
                        offC[h][i] = (unsigned)(S.a_row_fix(nxt, h * HALF + R_, rl) * K + C_) * 2u; } } } else cA = nA; }
            PG8_WAIT_V(8); PG8_WAIT_L(0); PG8_BAR; PG8_MMA(0, 0, At, B0); PG8_MMA(0, 1, At, B1); PG8_BAR; PG8_SCHED;
            PG8_LDA(At, 0, 1); PG8_STB(PG8_SB(0, 0), b2); PG8_STB(PG8_SB(0, 1), b2 + hstep); PG8_STA(PG8_SA(0, 0), 0, kb2);
            PG8_WAIT_V(8); PG8_WAIT_L(0); PG8_BAR; PG8_MMA(1, 0, At, B0); PG8_MMA(1, 1, At, B1); PG8_BAR; PG8_SCHED;
            PG8_LDB(B0, 1, 0); PG8_LDB(B1, 1, 1); PG8_SCHED; PG8_LDA(At, 1, 0); PG8_STA(PG8_SA(0, 1), 1, kb2);
            PG8_WAIT_V(8); PG8_WAIT_L(0); PG8_BAR; PG8_MMA(0, 0, At, B0); PG8_MMA(0, 1, At, B1); PG8_BAR; PG8_SCHED;
            PG8_LDA(At, 1, 1); PG8_STB(PG8_SB(1, 0), b3); PG8_STB(PG8_SB(1, 1), b3 + hstep); PG8_STA(PG8_SA(1, 0), 0, kb3);
            PG8_WAIT_V(8); PG8_WAIT_L(0); PG8_BAR; PG8_MMA(1, 0, At, B0); PG8_MMA(1, 1, At, B1); PG8_BAR; PG8_SCHED;
            } else {
            PG8_LDB(B0, 0, 0); PG8_SCHED; PG8_LDA(At, 0, 0); PG8_STA(PG8_SA(1, 1), 1, kb1);
            if (last) { if constexpr (GA) { if (has_next) {
#pragma unroll
                for (int h = 0; h < 2; ++h)
#pragma unroll
                    for (int i = 0; i < 2; ++i) { int R_, C_; stage_rc(tid * 16 + i * 8192, R_, C_); int rl = rowN[h][i]; asm volatile("" : "+v"(rl));
                        offC[h][i] = (unsigned)(S.a_row_fix(nxt, h * HALF + R_, rl) * K + C_) * 2u; } } } else cA = nA; }
            PG8_WAIT_L(8); PG8_BAR; PG8_WAIT_L(0); PG8_MMA(0, 0, At, B0); PG8_BAR; PG8_SCHED;
            PG8_LDB(B1, 0, 1); PG8_STB(PG8_SB(0, 0), b2);
            PG8_BAR; PG8_WAIT_L(0); PG8_MMA(0, 1, At, B1); PG8_BAR;
            PG8_LDA(At, 0, 1); PG8_STA(PG8_SA(0, 0), 0, kb2);
            PG8_BAR; PG8_WAIT_L(0); PG8_MMA(1, 0, At, B0); PG8_BAR; PG8_SCHED;
            PG8_STB(PG8_SB(0, 1), b2 + hstep);
            PG8_WAIT_V(6); PG8_BAR; PG8_MMA(1, 1, At, B1); PG8_BAR;
            PG8_LDB(B0, 1, 0); PG8_SCHED; PG8_LDA(At, 1, 0); PG8_STA(PG8_SA(0, 1), 1, kb2);
            PG8_WAIT_L(8); PG8_BAR; PG8_WAIT_L(0); PG8_MMA(0, 0, At, B0); PG8_BAR; PG8_SCHED;
            PG8_LDB(B1, 1, 1); PG8_STB(PG8_SB(1, 0), b3);
            PG8_BAR; PG8_WAIT_L(0); PG8_MMA(0, 1, At, B1); PG8_BAR;
            PG8_LDA(At, 1, 1); PG8_STA(PG8_SA(1, 0), 0, kb3);
            PG8_BAR; PG8_WAIT_L(0); PG8_MMA(1, 0, At, B0); PG8_BAR; PG8_SCHED;
            PG8_STB(PG8_SB(1, 1), b3 + hstep);
            PG8_WAIT_V(6); PG8_BAR; PG8_MMA(1, 1, At, B1); PG8_BAR;
            }
        }
        if constexpr (ALIGN_EPI) { if (wr == 0) PG8_BAR; }
        const int tq = opaque(lane_now() + 64 * wid);
        if constexpr (Epi::PRE) { asm volatile("" : "+v"(pre_v0), "+v"(pre_v1)); E.pre_commit(pre_v0, pre_v1, wid, tq & 63); }
        E(acc, cur, wr, wc, tq & 15, (tq >> 4) & 3);
        if (!has_next) break;
#pragma unroll
        for (int a = 0; a < 2; ++a)
#pragma unroll
            for (int b = 0; b < 2; ++b)
#pragma unroll
                for (int m = 0; m < 4; ++m)
#pragma unroll
                    for (int n = 0; n < 2; ++n) { acc[a][b][m][n] = (f32x4){0.f, 0.f, 0.f, 0.f}; if constexpr (F8) F8_PIN_ASM(acc[a][b][m][n]); }
        cur = nxt; cB = nB; ++ui;
        if constexpr (ALIGN_EPI) { if (wr == 1) PG8_BAR; }
    }
    PG8_WAIT_V(0);
    if constexpr (!ALIGN_EPI) { if (wr == 0) PG8_BAR; }
    PG8_BAR;
#undef PG8_SA
#undef PG8_SB
#undef PG8_STB
#undef PG8_STA
#undef PG8_LDA
#undef PG8_LDB
#undef PG8_MMA
#undef PG8_CAT8
#undef PG8_WAIT_V
#undef PG8_WAIT_L
#undef PG8_BAR
#undef PG8_SCHED
#undef PG8_AOFF
}

typedef const f32x4 (&AccRef)[2][2][4][2];
__device__ __forceinline__ u32x4 pack8(const f32x4& a, const f32x4& b) { u32x4 w; w.x = cvt_pk_bf16(a[0], a[1]); w.y = cvt_pk_bf16(a[2], a[3]); w.z = cvt_pk_bf16(b[0], b[1]); w.w = cvt_pk_bf16(b[2], b[3]); return w; }
__device__ __forceinline__ void unpack8(const u32x4 w, f32x4& a, f32x4& b) { a = (f32x4){bf_lo(w.x), bf_hi(w.x), bf_lo(w.y), bf_hi(w.y)}; b = (f32x4){bf_lo(w.z), bf_hi(w.z), bf_lo(w.w), bf_hi(w.w)}; }

struct EpiInProj {
    static constexpr bool PERM = true; static constexpr bool PRE = false;
    bf16_t* O; const float* bias; float qscale; int nostore;
    __device__ __forceinline__ void operator()(AccRef acc, const Unit& u, int wr, int wc, int fr, int fq) const {
        if (nostore) return;
        const int row0 = u.pm * BM + wr * 64 + fr, colb = u.pn * BM + wc * 32 + 8 * fq;
        const int mode = u.pn < 4 ? 1 : (u.pn >= 8 ? 2 : 0);
        f32x4 bv[2][2];
#pragma unroll
        for (int bj = 0; bj < 2; ++bj)
#pragma unroll
            for (int n = 0; n < 2; ++n) bv[bj][n] = *(const GAS f32x4*)(bias + colb + bj * HALF + 4 * n);
#pragma unroll
        for (int ai = 0; ai < 2; ++ai)
#pragma unroll
            for (int m = 0; m < 4; ++m) { bf16_t* rowp = O + (size_t)(row0 + ai * HALF + m * 16) * INW + colb;
#pragma unroll
                for (int bj = 0; bj < 2; ++bj) { f32x4 v0 = acc[ai][bj][m][0] + bv[bj][0], v1 = acc[ai][bj][m][1] + bv[bj][1];
                    if (mode == 1) { v0 = v0 * qscale; v1 = v1 * qscale; }
                    if (mode == 2) {
#pragma unroll
                        for (int j = 0; j < 4; ++j) { v0[j] = fast_sigmoid(v0[j]); v1[j] = fast_sigmoid(v1[j]); } }
                    *(GAS u32x4*)(rowp + bj * HALF) = pack8(v0, v1); } }
    }
};
struct EpiAttnProj {
    static constexpr bool PERM = true; static constexpr bool PRE = false;
    const bf16_t* proj; bf16_t* mixed;
    __device__ __forceinline__ void operator()(AccRef acc, const Unit& u, int wr, int wc, int fr, int fq) const {
        const int row0 = u.pm * BM + wr * 64 + fr, colb = u.pn * BM + wc * 32 + 8 * fq;
#pragma unroll
        for (int ai = 0; ai < 2; ++ai) {
            u32x4 gw[4][2];
#pragma unroll
            for (int m = 0; m < 4; ++m)
#pragma unroll
                for (int bj = 0; bj < 2; ++bj) gw[m][bj] = *(const GAS u32x4*)(proj + (size_t)(row0 + ai * HALF + m * 16) * INW + O_GA + colb + bj * HALF);
#pragma unroll
            for (int m = 0; m < 4; ++m) { const size_t row = (size_t)(row0 + ai * HALF + m * 16);
#pragma unroll
                for (int bj = 0; bj < 2; ++bj) { f32x4 g0, g1; unpack8(gw[m][bj], g0, g1);
                    *(GAS u32x4*)(mixed + row * D + colb + bj * HALF) = pack8(g0 * acc[ai][bj][m][0], g1 * acc[ai][bj][m][1]); } } }
    }
};
struct EpiGlu {
    static constexpr bool PERM = true; static constexpr bool PRE = false;
    const bf16_t* proj; const bf16_t* mixed; bf16_t* mixed2;
    __device__ __forceinline__ void operator()(AccRef acc, const Unit& u, int wr, int wc, int fr, int fq) const {
        const int row0 = u.pm * BM + wr * 64 + fr, col = u.pn * HALF + wc * 32 + 8 * fq;
#pragma unroll
        for (int ai = 0; ai < 2; ++ai) {
            u32x4 gw[4], pw[4];
#pragma unroll
            for (int m = 0; m < 4; ++m) { const size_t row = (size_t)(row0 + ai * HALF + m * 16);
                gw[m] = *(const GAS u32x4*)(proj + row * INW + O_GS + col); pw[m] = *(const GAS u32x4*)(mixed + row * D + col); }
#pragma unroll
            for (int m = 0; m < 4; ++m) { const size_t row = (size_t)(row0 + ai * HALF + m * 16);
                f32x4 g0, g1, p0, p1; unpack8(gw[m], g0, g1); unpack8(pw[m], p0, p1);
                const f32x4 za0 = acc[ai][0][m][0], za1 = acc[ai][0][m][1], zb0 = acc[ai][1][m][0], zb1 = acc[ai][1][m][1];
#pragma unroll
                for (int j = 0; j < 4; ++j) { p0[j] += g0[j] * za0[j] * fast_sigmoid(zb0[j]); p1[j] += g1[j] * za1[j] * fast_sigmoid(zb1[j]); }
                *(GAS u32x4*)(mixed2 + row * D + col) = pack8(p0, p1); } }
    }
};
struct EpiMixOut {
    static constexpr bool PERM = true; static constexpr bool PRE = false;
    const float* xin; const bf16_t* xsrc; bf16_t* xdst; const float* gt;
    __device__ __forceinline__ void operator()(AccRef acc, const Unit& u, int wr, int wc, int fr, int fq) const {
        const int row0 = u.pm * BM + wr * 64 + fr, colb = u.pn * BM + wc * 32 + 8 * fq;
        const float* g = gt + (u.pm >= 16 ? 12288 : 0);
        f32x4 gv[2][2];
#pragma unroll
        for (int bj = 0; bj < 2; ++bj)
#pragma unroll
            for (int n = 0; n < 2; ++n) gv[bj][n] = *(const GAS f32x4*)(g + colb + bj * HALF + 4 * n);
        if (xin) {
#pragma unroll
            for (int ai = 0; ai < 2; ++ai)
#pragma unroll
                for (int mp = 0; mp < 2; ++mp) { f32x4 xv[2][2][2];
#pragma unroll
                    for (int mm = 0; mm < 2; ++mm)
#pragma unroll
                        for (int bj = 0; bj < 2; ++bj) { const size_t off = (size_t)(row0 + ai * HALF + (2 * mp + mm) * 16) * D + colb + bj * HALF;
                            xv[mm][bj][0] = *(const GAS f32x4*)(xin + off); xv[mm][bj][1] = *(const GAS f32x4*)(xin + off + 4); }
#pragma unroll
                    for (int mm = 0; mm < 2; ++mm)
#pragma unroll
                        for (int bj = 0; bj < 2; ++bj) { const int m = 2 * mp + mm; const size_t off = (size_t)(row0 + ai * HALF + m * 16) * D + colb + bj * HALF;
                            *(GAS u32x4*)(xdst + off) = pack8(xv[mm][bj][0] + gv[bj][0] * acc[ai][bj][m][0], xv[mm][bj][1] + gv[bj][1] * acc[ai][bj][m][1]); } }
        } else {
#pragma unroll
            for (int ai = 0; ai < 2; ++ai) { u32x4 xw[4][2];
#pragma unroll
                for (int m = 0; m < 4; ++m)
#pragma unroll
                    for (int bj = 0; bj < 2; ++bj) xw[m][bj] = *(const GAS u32x4*)(xsrc + (size_t)(row0 + ai * HALF + m * 16) * D + colb + bj * HALF);
#pragma unroll
                for (int m = 0; m < 4; ++m)
#pragma unroll
                    for (int bj = 0; bj < 2; ++bj) { f32x4 x0, x1; unpack8(xw[m][bj], x0, x1);
                        *(GAS u32x4*)(xdst + (size_t)(row0 + ai * HALF + m * 16) * D + colb + bj * HALF) = pack8(x0 + gv[bj][0] * acc[ai][bj][m][0], x1 + gv[bj][1] * acc[ai][bj][m][1]); } }
        }
    }
};
constexpr float WGU_SCALE = 64.0f, WD_SCALE = 32.0f;
__device__ __forceinline__ unsigned pk_fp8x4(const f32x4& a) {
    int w = 0; w = __builtin_amdgcn_cvt_pk_fp8_f32(a[0], a[1], w, false); w = __builtin_amdgcn_cvt_pk_fp8_f32(a[2], a[3], w, true); return (unsigned)w; }
struct EpiGateUp {
    static constexpr bool PERM = true; static constexpr bool PRE = false;
    unsigned char* hid;
    __device__ __forceinline__ void operator()(AccRef acc, const Unit& u, int wr, int wc, int fr, int fq) const {
        const int r0 = wr * 64 + fr, col = u.pn * HALF + wc * 32 + 8 * fq;
        float dq = 1.0f / WGU_SCALE; asm volatile("" : "+s"(dq));
#pragma unroll
        for (int ai = 0; ai < 2; ++ai)
#pragma unroll
            for (int m = 0; m < 4; ++m) { const int r = r0 + ai * HALF + m * 16;
                f32x4 g0 = acc[ai][0][m][0] * dq, g1 = acc[ai][0][m][1] * dq, u0 = acc[ai][1][m][0] * dq, u1 = acc[ai][1][m][1] * dq;
#pragma unroll
                for (int j = 0; j < 4; ++j) { g0[j] = g0[j] * fast_sigmoid(g0[j]) * u0[j]; g1[j] = g1[j] * fast_sigmoid(g1[j]) * u1[j]; }
                if (r < u.n) { if constexpr (DOWN_F8 != 0) *(GAS u32x2*)(hid + (size_t)(u.x + r) * 512 + col) = (u32x2){pk_fp8x4(g0), pk_fp8x4(g1)};
                               else *(GAS u32x4*)(hid + ((size_t)(u.x + r) * 512 + col) * 2) = pack8(g0, g1); } }
    }
};
constexpr float YS_SCALE = 8.0f, YS_INV = 1.0f / 8.0f, YS_ACC = DOWN_F8 ? YS_SCALE / WD_SCALE : YS_SCALE;
struct EpiDown {
    static constexpr bool PERM = true; static constexpr bool PRE = (DOWN_PRE != 0);
    unsigned char* ys; const int* ldst; LAS int* dstl; int nostore;
    __device__ __forceinline__ void pre_issue(const Unit& u, int wr, int lane, int& v0, int& v1) const {
        const int ra = 64 * wr + lane, rb = ra + 128; const GAS int* p = (const GAS int*)ldst + (u.e == 64 ? 0 : u.e * 8192 + u.pm * BM);
        const GAS int* pa = p + ((u.e != 64 && ra < u.n) ? ra : 0); const GAS int* pb = p + ((u.e != 64 && rb < u.n) ? rb : 0);
        asm volatile("global_load_dword %0, %1, off" : "=v"(v0) : "v"(pa) : "memory");
        asm volatile("global_load_dword %0, %1, off" : "=v"(v1) : "v"(pb) : "memory");
    }
    __device__ __forceinline__ void pre_commit(int v0, int v1, int wid, int lane_) const { const int lane = opaque(lane_); dstl[wid * 128 + lane] = v0; dstl[wid * 128 + 64 + lane] = v1; }
    __device__ __forceinline__ void operator()(AccRef acc, const Unit& u, int wr, int wc, int fr_, int fq_) const {
        const int fr = opaque(fr_), fq = opaque(fq_);
        const int r0 = wr * 64 + fr, colb = u.pn * BM + 16 * (4 * wc + fq);
#pragma unroll
        for (int ai = 0; ai < 2; ++ai)
#pragma unroll
            for (int m = 0; m < 4; ++m) { const int r = r0 + ai * HALF + m * 16;
                int dst;
                if constexpr (PRE) dst = (u.e == 64) ? (u.pm * BM + r) * NSLOT + 8 : dstl[(wr * 4 + wc) * 128 + ai * 64 + m * 16 + fr];
                else dst = (u.e == 64) ? (u.pm * BM + r) * NSLOT + 8 : ((const GAS int*)ldst)[u.e * 8192 + u.pm * BM + (r < u.n ? r : 0)];
                if (r < u.n && !nostore)
                    *(GAS u32x4*)(ys + (size_t)dst * D + colb) = (u32x4){pk_fp8x4(acc[ai][0][m][0] * YS_ACC), pk_fp8x4(acc[ai][0][m][1] * YS_ACC), pk_fp8x4(acc[ai][1][m][0] * YS_ACC), pk_fp8x4(acc[ai][1][m][1] * YS_ACC)}; }
    }
};
}

struct Args { const float* in[29]; float* out; unsigned char* ws; int ph_lo, ph_hi; };
typedef const __attribute__((address_space(4))) Args KArgs;
__device__ __forceinline__ const float* arg_in(int which) {
#if defined(__HIP_DEVICE_COMPILE__)
    KArgs* p = (KArgs*)__builtin_amdgcn_kernarg_segment_ptr(); return p->in[which];
#else
    (void)which; return nullptr;
#endif
}
enum { I_X = 0, I_C, I_WADA, I_BADA, I_NMIX, I_WIN, I_BIN, I_SINK, I_WO, I_ARE, I_AIM, I_LDT, I_BRE, I_BIM, I_CRE, I_CIM, I_SD, I_WGLU, I_WMIX, I_NFFN, I_WR, I_BR, I_WEG, I_WEU, I_WED, I_WSG, I_WSU, I_WSD, I_NFIN };

struct TDesc { const float* src; bf16_t* dst; int N, K, cc0; float f8s; };
__device__ __forceinline__ void tr_load(const TDesc& d, int lane, f32x4 (&v)[16]) {
    const int kr = lane >> 4, nq = lane & 15;
    const GAS float* p = (const GAS float*)d.src + (size_t)kr * d.N + 4 * nq; const size_t step = (size_t)4 * d.N;
#pragma unroll
    for (int i = 0; i < 16; ++i) { v[i] = __builtin_nontemporal_load((const GAS f32x4*)p); p += step; }
}
__device__ __forceinline__ void tr_finish(const TDesc& d, int lane_, LAS float* scr, const f32x4 (&v)[16]) {
    const int lane = opaque(lane_);
    const int kr = lane >> 4, nq = lane & 15;
#pragma unroll
    for (int i = 0; i < 16; ++i) { const int k = 4 * i + kr;
#pragma unroll
        for (int e = 0; e < 4; ++e) scr[k * 64 + ((4 * nq + e) ^ k)] = v[i][e]; }
    LDS_WAIT();
    const int c = lane & 7;
#pragma unroll
    for (int j = 0; j < 8; ++j) { const int n = (lane >> 3) + 8 * j; float s[8];
#pragma unroll
        for (int i = 0; i < 8; ++i) { const int k = 8 * c + i; s[i] = scr[k * 64 + (n ^ k)]; }
        u32x4 o; o.x = cvt_pk_bf16(s[0], s[1]); o.y = cvt_pk_bf16(s[2], s[3]); o.z = cvt_pk_bf16(s[4], s[5]); o.w = cvt_pk_bf16(s[6], s[7]);
        const int cc = d.cc0 + n, drow = d.cc0 >= 0 ? (128 * ((cc & 15) >> 3) + 8 * (cc >> 4) + (cc & 7)) : n;
        if (d.f8s != 0.f) { const f32x4 sa = (f32x4){s[0], s[1], s[2], s[3]} * d.f8s, sb = (f32x4){s[4], s[5], s[6], s[7]} * d.f8s;
            __builtin_nontemporal_store((u32x2){pg8::pk_fp8x4(sa), pg8::pk_fp8x4(sb)}, (GAS u32x2*)((unsigned char*)d.dst + (size_t)drow * d.K + 8 * c)); }
        else __builtin_nontemporal_store(o, (GAS u32x4*)(d.dst + (size_t)drow * d.K + 8 * c)); }
    LDS_WAIT();
}
__device__ __forceinline__ void tr_half8(const TDesc& d, int lane_, LAS float* scr, const f32x4 (&v)[16], u32x2 (&o)[8]) {
    const int lane = opaque(lane_);
    const int kr = lane >> 4, nq = lane & 15;
#pragma unroll
    for (int i = 0; i < 16; ++i) { const int k = 4 * i + kr;
#pragma unroll
        for (int e = 0; e < 4; ++e) scr[k * 64 + ((4 * nq + e) ^ k)] = v[i][e]; }
    LDS_WAIT();
    const int c = lane & 7;
#pragma unroll
    for (int j = 0; j < 8; ++j) { const int n = (lane >> 3) + 8 * j; float s[8];
#pragma unroll
        for (int i = 0; i < 8; ++i) { const int k = 8 * c + i; s[i] = scr[k * 64 + (n ^ k)]; }
        const f32x4 sa = (f32x4){s[0], s[1], s[2], s[3]} * d.f8s, sb = (f32x4){s[4], s[5], s[6], s[7]} * d.f8s;
        o[j] = (u32x2){pg8::pk_fp8x4(sa), pg8::pk_fp8x4(sb)}; }
    LDS_WAIT();
}
__device__ __forceinline__ void tr_store8(const TDesc& d, int lane, const u32x2 (&o0)[8], const u32x2 (&o1)[8]) {
    const int c = lane & 7;
#pragma unroll
    for (int j = 0; j < 8; ++j) { const int n = (lane >> 3) + 8 * j; const int cc = d.cc0 + n, drow = d.cc0 >= 0 ? (128 * ((cc & 15) >> 3) + 8 * (cc >> 4) + (cc & 7)) : n;
        unsigned char* p = (unsigned char*)d.dst + (size_t)drow * d.K + 8 * c;
        __builtin_nontemporal_store(o0[j], (GAS u32x2*)p); __builtin_nontemporal_store(o1[j], (GAS u32x2*)(p + 64)); }
}
constexpr int IT_WIN = 3072, IT_WO = 512, IT_WGLU = 512, IT_WMIX = 1024, IT_EXP = 64 * 128, IT_SH = 128, IT_EXPD = DOWN_F8 ? 64 * 128 : 64 * 256, IT_SHD = DOWN_F8 ? 128 : 256;
constexpr int IT_LAYER = IT_WIN + IT_WO + IT_WGLU + IT_WMIX + 2 * IT_EXP + IT_EXPD + 2 * IT_SH + IT_SHD;
constexpr int IT_MOD = 768;
constexpr int IT_TR = 2 * IT_LAYER;

__device__ __forceinline__ TDesc tr_desc(const float* W, int K, int N, bf16_t* WT, int kb, int nb, int drow0) {
    TDesc d; d.src = W + (size_t)(64 * kb) * N + 64 * nb; d.dst = WT + (size_t)drow0 * K + 64 * kb; d.N = N; d.K = K; d.cc0 = -1; d.f8s = 0.f; return d;
}
__device__ __forceinline__ TDesc tr_desc8(const float* W, int K, int N, unsigned char* WT, int kb, int nb, int drow0, float scale) {
    TDesc d; d.src = W + (size_t)(64 * kb) * N + 64 * nb; d.dst = (bf16_t*)(WT + (size_t)drow0 * K + 64 * kb); d.N = N; d.K = K; d.cc0 = -1; d.f8s = scale; return d;
}
__device__ __forceinline__ TDesc tr_decode(unsigned char* ws, int it) {
    const int l = 1 - it / IT_LAYER; int r = it % IT_LAYER;
    int which, K, N, kb, nb, drow0, cc0 = -1, es = 2; size_t soff, dbyte; float f8s = 0.f;
    if (r < IT_WIN) { which = I_WIN; soff = (size_t)l * 2048 * 6144; K = 2048; N = 6144; dbyte = WS_WIN + (size_t)l * 6144 * 2048 * 2; kb = r / 96; nb = r % 96; drow0 = 64 * nb; }
    else if ((r -= IT_WIN) < IT_WO) { which = I_WO; soff = (size_t)l * 1024 * 2048; K = 1024; N = 2048; dbyte = WS_WO + (size_t)l * 2048 * 1024 * 2; kb = r / 32; nb = r % 32; drow0 = 64 * nb; }
    else if ((r -= IT_WO) < IT_WGLU) { which = I_WGLU; soff = (size_t)l * 512 * 4096; K = 512; N = 4096; dbyte = WS_WGLU + (size_t)l * 4096 * 512 * 2; kb = r / 64; nb = r % 64; const int n0 = 64 * nb;
        drow0 = n0 < 2048 ? 256 * (n0 / 128) + (n0 % 128) : 256 * ((n0 - 2048) / 128) + 128 + (n0 % 128); }
    else if ((r -= IT_WGLU) < IT_WMIX) { which = I_WMIX; soff = (size_t)l * 2048 * 2048; K = 2048; N = 2048; dbyte = WS_WMIX + (size_t)l * 2048 * 2048 * 2; kb = r / 32; nb = r % 32; drow0 = 64 * nb; }
    else { r -= IT_WMIX;
        const size_t wgu = WS_WGU + (size_t)l * 65 * 1024 * 2048;
        constexpr int DES = DOWN_F8 ? 1 : 2; const size_t wd = WS_WD + (size_t)l * 65 * 2048 * 512 * DES;
        if (r < 2 * IT_EXP) { const int up = r >= IT_EXP; r -= up * IT_EXP; const int e = r / 128, q = r % 128; kb = q / 8; nb = q % 8; const int n0 = 64 * nb;
            which = up ? I_WEU : I_WEG; soff = ((size_t)l * 64 + e) * 2048 * 512; K = 2048; N = 512; dbyte = wgu + (size_t)e * 1024 * 2048; es = 1; f8s = pg8::WGU_SCALE; drow0 = 256 * (n0 / 128) + (n0 % 128) + 128 * up; }
        else if ((r -= 2 * IT_EXP) < IT_EXPD) { constexpr int QD = DOWN_F8 ? 128 : 256; const int e = r / QD, q = r % QD; kb = q / 32; nb = q % 32;
            which = I_WED; soff = ((size_t)l * 64 + e) * 512 * 2048; K = 512; N = 2048; dbyte = wd + (size_t)e * 2048 * 512 * DES; es = DES; f8s = DOWN_F8 ? pg8::WD_SCALE : 0.f; drow0 = 256 * (nb / 4); cc0 = 64 * (nb % 4); }
        else if ((r -= IT_EXPD) < 2 * IT_SH) { const int up = r >= IT_SH; r -= up * IT_SH; kb = r / 8; nb = r % 8; const int n0 = 64 * nb;
            which = up ? I_WSU : I_WSG; soff = (size_t)l * 2048 * 512; K = 2048; N = 512; dbyte = wgu + (size_t)64 * 1024 * 2048; es = 1; f8s = pg8::WGU_SCALE; drow0 = 256 * (n0 / 128) + (n0 % 128) + 128 * up; }
        else { r -= 2 * IT_SH; kb = r / 32; nb = r % 32;
            which = I_WSD; soff = (size_t)l * 512 * 2048; K = 512; N = 2048; dbyte = wd + (size_t)64 * 2048 * 512 * DES; es = DES; f8s = DOWN_F8 ? pg8::WD_SCALE : 0.f; drow0 = 256 * (nb / 4); cc0 = 64 * (nb % 4); } }
    const int kr = f8s != 0.f ? 128 : 64;
    TDesc d; d.src = arg_in(which) + soff + (size_t)(kr * kb) * N + 64 * nb; d.dst = (bf16_t*)(ws + dbyte + ((size_t)drow0 * K + kr * kb) * es); d.N = N; d.K = K; d.cc0 = cc0; d.f8s = f8s; return d;
}
__device__ __forceinline__ void mod_item(const Args& a, int it, int tid, LAS unsigned char* lds) {
    const int lane = tid & 63, wave = tid >> 6;
    const int l = it / 384, r = it % 384, ks = r / 48, cc = r % 48;
    const float* W = a.in[I_WADA] + (size_t)l * 2048 * 12288 + (size_t)(256 * ks + 32 * wave) * 12288 + 256 * cc + 4 * lane;
    const float* c0 = a.in[I_C] + 256 * ks + 32 * wave, *c1 = c0 + 2048;
    f32x4 a0 = {0.f, 0.f, 0.f, 0.f}, a1 = {0.f, 0.f, 0.f, 0.f};
#pragma unroll 1
    for (int h = 0; h < 2; ++h) { f32x4 w[16]; const GAS float* wp = (const GAS float*)W + (size_t)(16 * h) * 12288;
#pragma unroll
        for (int i = 0; i < 16; ++i) { w[i] = __builtin_nontemporal_load((const GAS f32x4*)wp); wp += 12288; }
#pragma unroll
        for (int i = 0; i < 16; ++i) { const float x0 = c0[16 * h + i], x1 = c1[16 * h + i]; const float s0 = x0 * fast_sigmoid(x0), s1 = x1 * fast_sigmoid(x1); a0 += w[i] * s0; a1 += w[i] * s1; } }
    LAS f32x4* red = (LAS f32x4*)lds;
    red[(wave * 2 + 0) * 64 + lane] = a0; red[(wave * 2 + 1) * 64 + lane] = a1;
    __syncthreads();
    { const int b = tid >> 8, col = tid & 255; LAS float* rf = (LAS float*)lds; float s = 0.f;
#pragma unroll
        for (int w8 = 0; w8 < 8; ++w8) s += rf[((w8 * 2 + b) * 64) * 4 + col];
        ((float*)(a.ws + WS_MODP))[((size_t)(ks * 2 + l) * 2 + b) * 12288 + 256 * cc + col] = s; }
    __syncthreads();
}
__device__ __forceinline__ void p0_items(const Args& a, int gw, int ngw, LAS float* scr, int lane) {
#pragma unroll 1
    for (int it = gw; it < IT_TR; it += ngw) { f32x4 v[16]; const TDesc d = tr_decode(a.ws, it);
        if (d.f8s != 0.f) { u32x2 o0[8], o1[8]; f32x4 w[16]; TDesc d2 = d; d2.src += (size_t)64 * d.N; tr_load(d, lane, v); tr_load(d2, lane, w);
            tr_half8(d, lane, scr, v, o0); tr_half8(d, lane, scr, w, o1); tr_store8(d, lane, o0, o1); }
        else { tr_load(d, lane, v); tr_finish(d, lane, scr, v); } }
}

__device__ __forceinline__ void cpow(float are, float aim, float dt, int n, float& pr, float& pi) {
    const float mag = __builtin_amdgcn_exp2f((float)n * dt * are * LOG2E);
    const double turns = (double)n * ((double)dt * (double)aim * 0.15915494309189535);
    const float fr = (float)(turns - __builtin_rint(turns));
    pr = mag * __builtin_amdgcn_cosf(fr); pi = mag * __builtin_amdgcn_sinf(fr);
}
__device__ __forceinline__ void ssm_tables(const Args& a, int l, int g, LAS unsigned char* lds, int tid) {
    LAS f32x2* Apow = (LAS f32x2*)lds;
    LAS f32x2* Bb = (LAS f32x2*)(lds + 65 * 64 * 8);
    LAS f32x2* Cc = (LAS f32x2*)(lds + 65 * 64 * 8 + 64 * 16 * 8);
    const int lg = l * 32 + g;
    const float* are_p = a.in[I_ARE] + lg * 64; const float* aim_p = a.in[I_AIM] + lg * 64;
    const float dt = __expf(a.in[I_LDT][lg]);
    unsigned char* tb = a.ws + WS_SSM + (size_t)lg * SSM_STRIDE;
    bf16_t* Et = (bf16_t*)(tb + SSM_E); bf16_t* Ft = (bf16_t*)(tb + SSM_F); bf16_t* Kt = (bf16_t*)(tb + SSM_KT); GAS f32x2* Pt = (GAS f32x2*)(tb + SSM_P);
    for (int idx = tid; idx < 65 * 64; idx += 512) { const int n = idx >> 6, p = idx & 63; float pr, pi; cpow(are_p[p], aim_p[p], dt, n, pr, pi); Apow[idx] = (f32x2){pr, pi}; }
    for (int idx = tid; idx < 64 * 64; idx += 512) { const int m = idx >> 6, p = idx & 63; float pr, pi; cpow(are_p[p], aim_p[p], dt, 64 * m, pr, pi); Pt[idx] = (f32x2){pr, pi}; }
    for (int idx = tid; idx < 64 * 16; idx += 512) { const int p = idx >> 4, c = idx & 15;
        const float ar = are_p[p], ai = aim_p[p]; float br, bi; cpow(ar, ai, dt, 1, br, bi);
        const float nr = br - 1.0f, ni = bi, den = ar * ar + ai * ai; const float fr = (nr * ar + ni * ai) / den, fi = (ni * ar - nr * ai) / den;
        const float b_r = a.in[I_BRE][(size_t)lg * 1024 + idx], b_i = a.in[I_BIM][(size_t)lg * 1024 + idx];
        Bb[idx] = (f32x2){fr * b_r - fi * b_i, fr * b_i + fi * b_r}; }
    for (int idx = tid; idx < 16 * 64; idx += 512) Cc[idx] = (f32x2){a.in[I_CRE][(size_t)lg * 1024 + idx], a.in[I_CIM][(size_t)lg * 1024 + idx]};
    __syncthreads();
    for (int idx = tid; idx < 128 * 128; idx += 512) { const int n = idx >> 7, k8 = idx & 127, ri = n >> 6, p = n & 63, s = k8 >> 1, c0 = (k8 & 1) * 8;
        const f32x2 ap = Apow[(63 - s) * 64 + p]; float v[8];
#pragma unroll
        for (int j = 0; j < 8; ++j) { const f32x2 b = Bb[p * 16 + c0 + j]; v[j] = ri ? (ap.x * b.y + ap.y * b.x) : (ap.x * b.x - ap.y * b.y); }
        u32x4 o; o.x = cvt_pk_bf16(v[0], v[1]); o.y = cvt_pk_bf16(v[2], v[3]); o.z = cvt_pk_bf16(v[4], v[5]); o.w = cvt_pk_bf16(v[6], v[7]);
        *(GAS u32x4*)(Et + (size_t)n * 1024 + k8 * 8) = o; }
    for (int idx = tid; idx < 1024 * 16; idx += 512) { const int n = idx >> 4, k8 = idx & 15, t = n >> 4, c = n & 15, ri = k8 >> 3, p0 = (k8 & 7) * 8; float v[8];
#pragma unroll
        for (int j = 0; j < 8; ++j) { const f32x2 ap = Apow[(t + 1) * 64 + p0 + j], cc = Cc[c * 64 + p0 + j]; v[j] = ri ? -(cc.x * ap.y + cc.y * ap.x) : (cc.x * ap.x - cc.y * ap.y); }
        u32x4 o; o.x = cvt_pk_bf16(v[0], v[1]); o.y = cvt_pk_bf16(v[2], v[3]); o.z = cvt_pk_bf16(v[4], v[5]); o.w = cvt_pk_bf16(v[6], v[7]);
        *(GAS u32x4*)(Ft + (size_t)n * 128 + k8 * 8) = o; }
    for (int idx = tid; idx < 65 * 16 * 2; idx += 512) { const int t1 = idx >> 5, c = (idx >> 1) & 15, c0 = (idx & 1) * 8; float v[8];
#pragma unroll
        for (int j = 0; j < 8; ++j) v[j] = 0.f;
        if (t1 > 0) for (int p = 0; p < 64; ++p) { const f32x2 ap = Apow[(t1 - 1) * 64 + p], cc = Cc[c * 64 + p]; const float cr = cc.x * ap.x - cc.y * ap.y, ci = cc.x * ap.y + cc.y * ap.x;
#pragma unroll
            for (int j = 0; j < 8; ++j) { const f32x2 b = Bb[p * 16 + c0 + j]; v[j] += cr * b.x - ci * b.y; } }
        u32x4 o; o.x = cvt_pk_bf16(v[0], v[1]); o.y = cvt_pk_bf16(v[2], v[3]); o.z = cvt_pk_bf16(v[4], v[5]); o.w = cvt_pk_bf16(v[6], v[7]);
        *(GAS u32x4*)(Kt + (size_t)(t1 * 16 + c) * 16 + c0) = o; }
    __syncthreads();
}

__device__ __forceinline__ void attn_unit(const bf16_t* __restrict__ proj, bf16_t* __restrict__ attn, const float* sinks, int unit, LAS unsigned char* lds, int tid_) {
    const int tid = opaque(tid_);
    const int b = unit >> 7, hk = (unit >> 5) & 3, nb = unit & 31;
    const int wave = __builtin_amdgcn_readfirstlane(tid >> 6), lane = tid & 63, r16 = lane & 15, q4 = lane >> 4;
    LAS unsigned char* Kl = lds;
    LAS unsigned char* Vt = lds + 36864;
    const int gh0 = wave >> 1, half0 = wave & 1, qh0 = hk * 4 + gh0;
    bf16x8 qfa[4][2];
#pragma unroll
    for (int pass = 0; pass < 4; ++pass)
#pragma unroll
        for (int s = 0; s < 2; ++s) qfa[pass][s] = *(const GAS bf16x8*)(proj + (size_t)(b * SEQ + nb * 128 + 16 * (half0 * 4 + pass) + r16) * INW + O_Q + qh0 * 64 + 32 * s + 8 * q4);
#pragma unroll
    for (int i = 0; i < 4; ++i) { const int id = tid + 512 * i, key = id >> 3, ch = id & 7; const int tp = nb * 128 - 128 + key;
        u32x4 kv = {0u, 0u, 0u, 0u}, vv = {0u, 0u, 0u, 0u};
        if (tp >= 0) { const bf16_t* src = proj + (size_t)(b * SEQ + tp) * INW + hk * 64 + ch * 8; kv = *(const GAS u32x4*)(src + O_K); vv = *(const GAS u32x4*)(src + O_V); }
        *(LAS u32x4*)(Kl + key * 144 + ch * 16) = kv;
        LAS bf16_t* vd = (LAS bf16_t*)(Vt + (ch * 8) * 528 + key * 2);
        vd[0 * 264] = (bf16_t)(vv.x & 0xffff); vd[1 * 264] = (bf16_t)(vv.x >> 16); vd[2 * 264] = (bf16_t)(vv.y & 0xffff); vd[3 * 264] = (bf16_t)(vv.y >> 16);
        vd[4 * 264] = (bf16_t)(vv.z & 0xffff); vd[5 * 264] = (bf16_t)(vv.z >> 16); vd[6 * 264] = (bf16_t)(vv.w & 0xffff); vd[7 * 264] = (bf16_t)(vv.w >> 16); }
    __syncthreads();
    const int gh = wave >> 1, half = wave & 1, qh = hk * 4 + gh;
    const float sink = sinks[qh] * LOG2E;
#pragma unroll
    for (int pass = 0; pass < 4; ++pass) {
        const int kt0 = half * 4 + pass, i0 = 16 * kt0, iabs = i0 + r16; const size_t qtok = (size_t)(b * SEQ + nb * 128 + iabs);
        bf16x8 qf[2];
#pragma unroll
        for (int s = 0; s < 2; ++s) qf[s] = qfa[pass][s];
        __builtin_amdgcn_sched_barrier(0);
        f32x4 st[10];
        const LAS unsigned char* kbase = Kl + (16 * kt0 + r16) * 144 + (8 * q4) * 2;
#pragma unroll
        for (int i = 0; i < 9; ++i) { st[i] = (f32x4){0.f, 0.f, 0.f, 0.f};
#pragma unroll
            for (int s = 0; s < 2; ++s) { const bf16x8 kf = *(const LAS bf16x8*)(kbase + i * 16 * 144 + s * 64);
                st[i] = __builtin_amdgcn_mfma_f32_16x16x32_bf16(kf, qf[s], st[i], 0, 0, 0); } }
        st[9] = (f32x4){0.f, 0.f, 0.f, 0.f};
        float mx = sink;
#pragma unroll
        for (int i = 0; i < 9; ++i)
#pragma unroll
            for (int r = 0; r < 4; ++r) { const int jj = 16 * i + 4 * q4 + r; const bool ok = (jj > r16) && (jj <= r16 + 128) && (nb > 0 || jj + i0 >= 128);
                st[i][r] = ok ? st[i][r] : -1e30f; mx = fmaxf(mx, st[i][r]); }
        mx = fmaxf(mx, __shfl_xor(mx, 16)); mx = fmaxf(mx, __shfl_xor(mx, 32));
        float sum = 0.f;
#pragma unroll
        for (int i = 0; i < 9; ++i)
#pragma unroll
            for (int r = 0; r < 4; ++r) { const float p = __builtin_amdgcn_exp2f(st[i][r] - mx); st[i][r] = p; sum += p; }
        sum += __shfl_xor(sum, 16); sum += __shfl_xor(sum, 32);
        const float inv = __builtin_amdgcn_rcpf(sum + __builtin_amdgcn_exp2f(sink - mx));
        f32x4 ot[4];
#pragma unroll
        for (int dt = 0; dt < 4; ++dt) ot[dt] = (f32x4){0.f, 0.f, 0.f, 0.f};
#pragma unroll
        for (int kk = 0; kk < 5; ++kk) {
            u32x4 pw; pw.x = cvt_pk_bf16(st[2 * kk][0], st[2 * kk][1]); pw.y = cvt_pk_bf16(st[2 * kk][2], st[2 * kk][3]); pw.z = cvt_pk_bf16(st[2 * kk + 1][0], st[2 * kk + 1][1]); pw.w = cvt_pk_bf16(st[2 * kk + 1][2], st[2 * kk + 1][3]);
            const bf16x8 pf = __builtin_bit_cast(bf16x8, pw);
            const int t0 = kt0 + 2 * kk, t1 = (t0 + 1) < 15 ? (t0 + 1) : 15;
#pragma unroll
            for (int dt = 0; dt < 4; ++dt) { const LAS unsigned char* vp = Vt + (16 * dt + r16) * 528 + (4 * q4) * 2;
                const u32x2 lo = *(const LAS u32x2*)(vp + t0 * 32), hi = *(const LAS u32x2*)(vp + t1 * 32);
                const u32x4 vw = {lo.x, lo.y, hi.x, hi.y};
                ot[dt] = __builtin_amdgcn_mfma_f32_16x16x32_bf16(__builtin_bit_cast(bf16x8, vw), pf, ot[dt], 0, 0, 0); } }
#pragma unroll
        for (int dt = 0; dt < 4; ++dt) { u32x2 o; o.x = cvt_pk_bf16(ot[dt][0] * inv, ot[dt][1] * inv); o.y = cvt_pk_bf16(ot[dt][2] * inv, ot[dt][3] * inv);
            *(GAS u32x2*)(attn + qtok * 1024 + qh * 64 + 16 * dt + 4 * q4) = o; }
    }
    __syncthreads();
}

constexpr int UPITCH = 2064;
__device__ __forceinline__ void stage_u_issue(const bf16_t* __restrict__ proj, int g, int b, int q, int tid, u32x4 (&uu)[4]) {
#pragma unroll
    for (int i = 0; i < 4; ++i) { const int id = tid + 512 * i, tl = id >> 1, half = id & 1, chunk = tl >> 6, s = tl & 63;
        uu[i] = *(const GAS u32x4*)(proj + (size_t)(b * SEQ + (16 * q + chunk) * 64 + s) * INW + O_U + g * 16 + 8 * half); }
}
__device__ __forceinline__ void stage_u_commit(LAS unsigned char* Al, int tid, u32x4 (&uu)[4]) {
    asm volatile("" : "+v"(uu[0]), "+v"(uu[1]), "+v"(uu[2]), "+v"(uu[3]) :: "memory");
#pragma unroll
    for (int i = 0; i < 4; ++i) { const int id = tid + 512 * i, tl = id >> 1, half = id & 1, chunk = tl >> 6, s = tl & 63;
        *(LAS u32x4*)(Al + chunk * UPITCH + (s * 16 + 8 * half) * 2) = uu[i]; }
}
__device__ __forceinline__ void ssm_s1_unit(const bf16_t* __restrict__ proj, const bf16_t* __restrict__ Et, float* __restrict__ sloc, int g, int b, int q, LAS unsigned char* lds, int tid_) {
    const int tid = opaque(tid_);
    const int wave = __builtin_amdgcn_readfirstlane(tid >> 6), lane = tid & 63, r16 = lane & 15, q4 = lane >> 4;
    const bf16_t* eb = Et + (size_t)(16 * wave + r16) * 1024 + 8 * q4;
    u32x4 uu[4]; stage_u_issue(proj, g, b, q, tid, uu);
    bf16x8 bf[32];
#pragma unroll
    for (int ks = 0; ks < 32; ++ks) bf[ks] = *(const GAS bf16x8*)(eb + 32 * ks);
    stage_u_commit(lds, tid, uu);
    __syncthreads();
    f32x4 acc = {0.f, 0.f, 0.f, 0.f};
#pragma unroll
    for (int ks = 0; ks < 32; ++ks) { const bf16x8 af = *(const LAS bf16x8*)(lds + r16 * UPITCH + (32 * ks + 8 * q4) * 2);
        acc = __builtin_amdgcn_mfma_f32_16x16x32_bf16(af, bf[ks], acc, 0, 0, 0); }
#pragma unroll
    for (int r = 0; r < 4; ++r) sloc[((size_t)(b * 64 + 16 * q + 4 * q4 + r) * 32 + g) * 128 + 16 * wave + r16] = acc[r];
    __syncthreads();
}

__device__ __forceinline__ void ssm_s2_unit(const bf16_t* __restrict__ proj, const unsigned char* __restrict__ tb, const float* __restrict__ sloc, const float* __restrict__ dskip, bf16_t* __restrict__ ybuf,
                                            int g, int b, int q, LAS unsigned char* lds, int tid_, int nostore = 0) {
    const int tid = opaque(tid_);
    const int wave = __builtin_amdgcn_readfirstlane(tid >> 6), lane = tid & 63, r16 = lane & 15, q4 = lane >> 4;
    LAS unsigned char* Ktl = lds;
    LAS bf16_t* x0l = (LAS bf16_t*)(lds + 33280);
    LAS unsigned char* Al = lds + 49152;
    const bf16_t* Ft = (const bf16_t*)(tb + SSM_F); const GAS f32x2* Pt = (const GAS f32x2*)(tb + SSM_P);
    const int p = tid & 63, part = tid >> 6, j0 = 16 * q;
    f32x2 Pp[6]; float srp[6], sip[6];
#pragma unroll
    for (int ii = 0; ii < 6; ++ii) { const int i = part + 8 * ii; const bool ok = i < j0; const int ic = ok ? i : 0, pc = ok ? (j0 - 1 - i) : 0;
        Pp[ii] = Pt[pc * 64 + p]; const GAS float* sp = (const GAS float*)(sloc + ((size_t)(b * 64 + ic) * 32 + g) * 128); srp[ii] = sp[p]; sip[ii] = sp[64 + p]; }
    u32x4 kt[5];
    { const GAS u32x4* src = (const GAS u32x4*)(tb + SSM_KT);
#pragma unroll
      for (int j = 0; j < 5; ++j) { const int i = tid + 512 * j; kt[j] = src[i < 33280 / 16 ? i : 33280 / 16 - 1]; } }
    u32x4 uu[4]; stage_u_issue(proj, g, b, q, tid, uu);
    const f32x2 A64 = Pt[64 + p];
    float sr[15], si[15];
#pragma unroll
    for (int jq = 0; jq < 15; ++jq) { const GAS float* sp = (const GAS float*)(sloc + ((size_t)(b * 64 + j0 + jq) * 32 + g) * 128); sr[jq] = sp[p]; si[jq] = sp[64 + p]; }
    bf16x8 ff[4][8];
#pragma unroll
    for (int k2 = 0; k2 < 4; ++k2)
#pragma unroll
        for (int tt = 0; tt < 8; ++tt) ff[k2][tt] = *(const GAS bf16x8*)(Ft + (size_t)((wave + 8 * tt) * 16 + r16) * 128 + 32 * k2 + 8 * q4);
    {
        LAS f32x2* red = (LAS f32x2*)(lds + 40960);
        asm volatile("" : "+v"(Pp[0]), "+v"(Pp[1]), "+v"(Pp[2]), "+v"(Pp[3]), "+v"(Pp[4]), "+v"(Pp[5]) :: "memory");
        asm volatile("" : "+v"(srp[0]), "+v"(srp[1]), "+v"(srp[2]), "+v"(srp[3]), "+v"(srp[4]), "+v"(srp[5]), "+v"(sip[0]), "+v"(sip[1]), "+v"(sip[2]), "+v"(sip[3]), "+v"(sip[4]), "+v"(sip[5]) :: "memory");
        float xr = 0.f, xi = 0.f;
#pragma unroll
        for (int ii = 0; ii < 6; ++ii) { const bool ok = part + 8 * ii < j0; const float pr = ok ? Pp[ii].x : 0.f, pi = ok ? Pp[ii].y : 0.f;
            xr += pr * srp[ii] - pi * sip[ii]; xi += pr * sip[ii] + pi * srp[ii]; }
        red[part * 64 + p] = (f32x2){xr, xi};
        asm volatile("" : "+v"(kt[0]), "+v"(kt[1]), "+v"(kt[2]), "+v"(kt[3]), "+v"(kt[4]) :: "memory");
#pragma unroll
        for (int j = 0; j < 5; ++j) { const int i = tid + 512 * j; if (i < 33280 / 16) *(LAS u32x4*)(Ktl + i * 16) = kt[j]; }
        stage_u_commit(Al, tid, uu);
        __syncthreads();
        if (part == 0) {
            float ar = 0.f, ai = 0.f;
#pragma unroll
            for (int w8 = 0; w8 < 8; ++w8) { const f32x2 t = red[w8 * 64 + p]; ar += t.x; ai += t.y; }
#pragma unroll
            for (int jq = 0; jq < 16; ++jq) {
                x0l[jq * 136 + p] = (bf16_t)(cvt_pk_bf16(ar, 0.f) & 0xffff); x0l[jq * 136 + 64 + p] = (bf16_t)(cvt_pk_bf16(ai, 0.f) & 0xffff);
                if (jq < 15) { const float nr = A64.x * ar - A64.y * ai + sr[jq], ni = A64.x * ai + A64.y * ar + si[jq]; ar = nr; ai = ni; } }
        }
    }
    __syncthreads();
    f32x4 acc[8];
#pragma unroll
    for (int tt = 0; tt < 8; ++tt) acc[tt] = (f32x4){0.f, 0.f, 0.f, 0.f};
#pragma unroll 2
    for (int ks = 0; ks < 32; ++ks) { const int s = 2 * ks + (q4 >> 1);
        const bf16x8 af = *(const LAS bf16x8*)(Al + r16 * UPITCH + (32 * ks + 8 * q4) * 2);
#pragma unroll
        for (int tt = 0; tt < 8; ++tt) { const int t = wave + 8 * tt;
            const int tau1 = t - s + 1, tc = tau1 > 0 ? tau1 : 0;
            const bf16x8 bf = *(const LAS bf16x8*)(Ktl + ((tc * 16 + r16) * 16 + 8 * (q4 & 1)) * 2);
            acc[tt] = __builtin_amdgcn_mfma_f32_16x16x32_bf16(af, bf, acc[tt], 0, 0, 0); }
        __builtin_amdgcn_sched_barrier(0); }
#pragma unroll
    for (int k2 = 0; k2 < 4; ++k2) { const bf16x8 ax = *(const LAS bf16x8*)(x0l + r16 * 136 + 32 * k2 + 8 * q4);
#pragma unroll
        for (int tt = 0; tt < 8; ++tt) acc[tt] = __builtin_amdgcn_mfma_f32_16x16x32_bf16(ax, ff[k2][tt], acc[tt], 0, 0, 0); }
    const float dsk = dskip[g * 16 + r16];
#pragma unroll
    for (int tt = 0; tt < 8; ++tt) { const int t = wave + 8 * tt;
#pragma unroll
        for (int r = 0; r < 4; ++r) { const int jq = 4 * q4 + r; const size_t tok = (size_t)(b * SEQ + (16 * q + jq) * 64 + t);
            const float uv = bf1(*(const LAS bf16_t*)(Al + jq * UPITCH + (t * 16 + r16) * 2)); const float y = acc[tt][r] + dsk * uv;
            const float z = 0.7978845608028654f * (y + 0.044715f * y * y * y); const float gl = y * fast_sigmoid(2.0f * z);
            if (!nostore) ybuf[tok * 512 + g * 16 + r16] = (bf16_t)(cvt_pk_bf16(gl, 0.f) & 0xffff); } }
    __syncthreads();
}

__device__ __forceinline__ unsigned char* opaque_p(unsigned char* p) { asm volatile("" : "+s"(p)); return p; }
__device__ __forceinline__ int opaque_si(int v) { asm volatile("" : "+s"(v)); return v; }
__device__ __forceinline__ Args load_args() {
#if defined(__HIP_DEVICE_COMPILE__)
    KArgs* p = (KArgs*)__builtin_amdgcn_kernarg_segment_ptr(); asm volatile("" : "+s"(p)); Args a;
#pragma unroll
    for (int i = 0; i < 29; ++i) a.in[i] = p->in[i];
    a.out = p->out; a.ws = p->ws; a.ph_lo = p->ph_lo; a.ph_hi = p->ph_hi; return a;
#else
    return Args{};
#endif
}
#define PH_BEGIN const unsigned long long ph_t0 = (TIME_MASK) ? __builtin_amdgcn_s_memtime() : 0ull; (void)ph_t0; const Args args = load_args(); const int G = opaque_si(G_k), blk = opaque_si(blk_k); const int wave = opaque_si(wave_k); const int tid = opaque(lane_now() + 64 * wave), lane = tid & 63; unsigned char* const ws = opaque_p(args.ws); (void)lane; (void)wave; \
    bf16_t* const hbuf = (bf16_t*)(ws + WS_H); bf16_t* const proj = (bf16_t*)(ws + WS_PROJ); float* const mod = (float*)(ws + WS_MOD); float* const xbuf = args.out; unsigned* const ctl = (unsigned*)(ws + WS_CTL); \
    (void)hbuf; (void)proj; (void)mod; (void)xbuf; (void)ctl;

__global__ void __launch_bounds__(NWAVES * 64, 2) mega_fwd(Args args) {
    extern __shared__ __attribute__((aligned(16))) unsigned char lds_raw[];
    LAS unsigned char* lds = (LAS unsigned char*)lds_raw;
    const int wave_k = __builtin_amdgcn_readfirstlane((int)threadIdx.x >> 6);
    const int G_k = gridDim.x, blk_k = blockIdx.x;
    XcdBarrier bar;
    {
        volatile LAS unsigned* MISC = (volatile LAS unsigned*)(lds + MISC_OFF);
        unsigned* ctl0 = (unsigned*)(args.ws + WS_CTL);
        for (int u = threadIdx.x; u < (LDS_BYTES - LDSCTL_OFF) / 4; u += NWAVES * 64) ((LAS unsigned*)(lds + LDSCTL_OFF))[u] = 0u;
        __syncthreads();
        bar.bar = ctl0 + CW_BAR; bar.x = 0; bar.st = nullptr; bar.wv = wave_k;
        if (N_LAUNCHES == 1) bar = xcd_barrier_post(ctl0 + CW_BAR, MISC + 8);
    }
#define GRID_BAR() do { if (N_LAUNCHES == 1) xcd_barrier(bar); } while (0)
    const int lo = args.ph_lo, hi = args.ph_hi;
#ifndef PH_MASK
#define PH_MASK 0x7ff
#endif
#ifndef REP_MASK
#define REP_MASK 0
#endif
#ifndef REP_VARIANT
#define REP_VARIANT 0
#endif
#define REPS(bit) (((REP_MASK) >> (bit)) & 1 ? 2 : 1)
#ifndef TIME_MASK
#define TIME_MASK 0
#endif
#define PH_END(bit) if ((TIME_MASK >> (bit)) & 1) { asm volatile("s_waitcnt vmcnt(0) lgkmcnt(0)" ::: "memory"); const unsigned long long t1_ = __builtin_amdgcn_s_memtime(); \
    while (__builtin_amdgcn_s_memtime() - t1_ < t1_ - ph_t0) __builtin_amdgcn_s_sleep(8); }
#define IN(k) (lo <= (k) && (k) < hi)
#define BOTH(k) (IN(k) && IN((k) + 1))

    if ((PH_MASK & 1) && IN(0)) {
        PH_BEGIN
            _Pragma("unroll 1") for (int rep = 0; rep < REPS(9); ++rep) {
        if (blk < 64) ssm_tables(args, blk >> 5, blk & 31, lds, tid);
        LAS float* scr = (LAS float*)(lds + wave * 16384);
        for (int idx = blk * 512 + tid; idx < 2 * 64 * 256; idx += G * 512) {
            const int e = idx & 63, kc = (idx >> 6) & 255, l = idx >> 14; const float* wsrc = args.in[I_WR] + (size_t)l * D * NE + (size_t)(8 * kc) * NE + e;
            float w[8], lo[8]; unsigned hi[4];
#pragma unroll
            for (int i = 0; i < 8; ++i) w[i] = wsrc[i * NE];
#pragma unroll
            for (int i = 0; i < 4; ++i) { hi[i] = cvt_pk_bf16(w[2 * i], w[2 * i + 1]); lo[2 * i] = w[2 * i] - bf_lo(hi[i]); lo[2 * i + 1] = w[2 * i + 1] - bf_hi(hi[i]); }
            bf16_t* dsth = (bf16_t*)(ws + WS_WRT) + ((size_t)(l * 2) * 64 + e) * 2048 + 8 * kc;
            *(GAS u32x4*)dsth = (u32x4){hi[0], hi[1], hi[2], hi[3]};
            *(GAS u32x4*)(dsth + 64 * 2048) = (u32x4){cvt_pk_bf16(lo[0], lo[1]), cvt_pk_bf16(lo[2], lo[3]), cvt_pk_bf16(lo[4], lo[5]), cvt_pk_bf16(lo[6], lo[7])}; }
        for (int it = blk; it < IT_MOD; it += G) mod_item(args, it, tid, lds);
        p0_items(args, blk * NWAVES + wave, G * NWAVES, scr, lane);
            if (rep + 1 < REPS(9)) GRID_BAR(); }
        PH_END(9) if (BOTH(0)) GRID_BAR();
    }
    if ((PH_MASK & 2) && IN(1)) {
        PH_BEGIN
        const float* modp = (const float*)(ws + WS_MODP);
        for (int idx = blk * 512 + tid; idx < 2 * 2 * 12288; idx += G * 512) { const int l = idx / 24576, c = idx % 12288; float s = args.in[I_BADA][l * 12288 + c];
#pragma unroll
            for (int ks = 0; ks < 8; ++ks) s += modp[(size_t)ks * 49152 + idx];
            mod[idx] = s; }
        for (int rb = blk; rb < T / 32; rb += G) {
            const int bb = (rb * 32) / SEQ;
            LAS float* shl = (LAS float*)lds; LAS float* scl = shl + 2048;
            for (int c = tid; c < 4096; c += 512) { float s = args.in[I_BADA][c];
#pragma unroll
                for (int ks = 0; ks < 8; ++ks) s += modp[(size_t)ks * 49152 + bb * 12288 + c];
                shl[c] = s; }
            __syncthreads();
#pragma unroll 1
            for (int pr = 0; pr < 2; ++pr) {
                f32x4 v[2][4][2]; float ss[2] = {0.f, 0.f};
#pragma unroll
                for (int rr = 0; rr < 2; ++rr) { const float* xr = args.in[I_X] + (size_t)(rb * 32 + wave * 4 + pr * 2 + rr) * D;
#pragma unroll
                    for (int j = 0; j < 4; ++j)
#pragma unroll
                        for (int h = 0; h < 2; ++h) v[rr][j][h] = *(const GAS f32x4*)(xr + 8 * (lane + 64 * j) + 4 * h); }
#pragma unroll
                for (int rr = 0; rr < 2; ++rr)
#pragma unroll
                    for (int j = 0; j < 4; ++j)
#pragma unroll
                        for (int h = 0; h < 2; ++h) ss[rr] += v[rr][j][h][0] * v[rr][j][h][0] + v[rr][j][h][1] * v[rr][j][h][1] + v[rr][j][h][2] * v[rr][j][h][2] + v[rr][j][h][3] * v[rr][j][h][3];
#pragma unroll
                for (int rr = 0; rr < 2; ++rr) { const int row = rb * 32 + wave * 4 + pr * 2 + rr;
                    const float rstd = 1.0f / sqrtf(wave_sum(ss[rr]) * (1.0f / D) + NORM_EPS);
                    bf16_t* hrow = hbuf + (size_t)row * D;
#pragma unroll
                    for (int j = 0; j < 4; ++j) { const int c = 8 * (lane + 64 * j); f32x4 o[2];
#pragma unroll
                        for (int h = 0; h < 2; ++h) { const f32x4 g = *(const GAS f32x4*)(args.in[I_NMIX] + c + 4 * h); const f32x4 s1 = *(const LAS f32x4*)(scl + c + 4 * h), s0 = *(const LAS f32x4*)(shl + c + 4 * h);
                            o[h] = v[rr][j][h] * rstd * g * (s1 + 1.0f) + s0; }
                        *(GAS u32x4*)(hrow + c) = pg8::pack8(o[0], o[1]); } } }
            __syncthreads();
        }
        PH_END(10) if (BOTH(1)) GRID_BAR();
    }

#pragma unroll 1
    for (int l = 0; l < DEPTH; ++l) {
        const int pb = 2 + 9 * l;
        if ((PH_MASK & 4) && IN(pb + 0)) {
            PH_BEGIN
            _Pragma("unroll 1") for (int rep = 0; rep < REPS(0); ++rep) {
            pg8::DenseOrder S; S.init(T, INW, D, G, blk, (bf16_t*)(ws + WS_WIN) + (size_t)l * INW * D);
            pg8::EpiInProj E{proj, args.in[I_BIN] + l * INW, 0.125f * LOG2E, (REP_VARIANT && rep == 1) ? 1 : 0};
            pg8::gemm_phase<pg8::EpiInProj, pg8::DenseOrder, GEMM_ALIGN>(lds, (const char*)hbuf, D, S, E, wave);
            if (rep + 1 < REPS(0)) GRID_BAR(); }
            PH_END(0) if (BOTH(pb + 0)) GRID_BAR();
        }
        if ((PH_MASK & 8) && IN(pb + 1)) {
            PH_BEGIN
            _Pragma("unroll 1") for (int rep = 0; rep < REPS(1); ++rep) {
            for (int u = blk; u < 256; u += G) attn_unit(proj, (bf16_t*)(ws + WS_ATTN), args.in[I_SINK] + l * 16, u, lds, tid);
            if (!(REP_VARIANT == 1 && rep == 1)) for (int u = blk; u < 256; u += G) { const int g = u >> 3, b = (u >> 2) & 1, q = u & 3;
                ssm_s1_unit(proj, (const bf16_t*)(ws + WS_SSM + (size_t)(l * 32 + g) * SSM_STRIDE + SSM_E), (float*)(ws + WS_SLOC), g, b, q, lds, tid); }
            if (rep + 1 < REPS(1)) GRID_BAR(); }
            PH_END(1) if (BOTH(pb + 1)) GRID_BAR();
        }
        if ((PH_MASK & 16) && IN(pb + 2)) {
            PH_BEGIN
            _Pragma("unroll 1") for (int rep = 0; rep < REPS(2); ++rep) {
            if (!(REP_VARIANT == 1 && rep == 1)) for (int u = blk; u < 256; u += G) { const int g = u >> 3, b = (u >> 2) & 1, q = u & 3;
                ssm_s2_unit(proj, ws + WS_SSM + (size_t)(l * 32 + g) * SSM_STRIDE, (const float*)(ws + WS_SLOC), args.in[I_SD] + l * 512, (bf16_t*)(ws + WS_Y), g, b, q, lds, tid, (REP_VARIANT == 2 && rep == 1) ? 1 : 0); }
            pg8::DenseOrder S; S.init(T, D, 1024, G, blk, (bf16_t*)(ws + WS_WO) + (size_t)l * D * 1024);
            pg8::EpiAttnProj E{proj, (bf16_t*)(ws + WS_MIXED)};
            pg8::gemm_phase<pg8::EpiAttnProj, pg8::DenseOrder>(lds, (const char*)(ws + WS_ATTN), 1024, S, E, wave);
            if (rep + 1 < REPS(2)) GRID_BAR(); }
            PH_END(2) if (BOTH(pb + 2)) GRID_BAR();
        }
        if ((PH_MASK & 32) && IN(pb + 3)) {
            PH_BEGIN
            const int nrep = REPS(3);
            _Pragma("unroll 1") for (int rep = 0; rep < nrep; ++rep) {
            pg8::DenseOrder S; S.init(T, 4096, 512, G, blk, (bf16_t*)(ws + WS_WGLU) + (size_t)l * 4096 * 512);
            pg8::EpiGlu E{proj, (const bf16_t*)(ws + WS_MIXED), (bf16_t*)(ws + WS_MIXED2)};
            pg8::gemm_phase<pg8::EpiGlu, pg8::DenseOrder, GEMM_ALIGN>(lds, (const char*)(ws + WS_Y), 512, S, E, wave);
            if (rep + 1 < nrep) GRID_BAR(); }
            PH_END(3) if (BOTH(pb + 3)) GRID_BAR();
        }
        if ((PH_MASK & 64) && IN(pb + 4)) {
            PH_BEGIN
            const int nrep = (l == 0 ? REPS(4) : 1);
            _Pragma("unroll 1") for (int rep = 0; rep < nrep; ++rep) {
            pg8::DenseOrder S; S.init(T, D, D, G, blk, (bf16_t*)(ws + WS_WMIX) + (size_t)l * D * D);
            pg8::EpiMixOut E{l == 0 ? args.in[I_X] : (const float*)nullptr, (const bf16_t*)(ws + WS_XB), (bf16_t*)(ws + WS_XB), mod + (size_t)l * 2 * 12288 + 2 * 2048};
            pg8::gemm_phase<pg8::EpiMixOut, pg8::DenseOrder>(lds, (const char*)(ws + WS_MIXED2), D, S, E, wave);
            if (rep + 1 < nrep) GRID_BAR(); }
            PH_END(4) if (BOTH(pb + 4)) GRID_BAR();
        }
        if ((PH_MASK & 128) && IN(pb + 5)) {
            PH_BEGIN
            const int nrep = REPS(5);
            _Pragma("unroll 1") for (int rep = 0; rep < nrep; ++rep) {
            const float* modl = mod + (size_t)l * 2 * 12288;
            int* ltok = (int*)(ws + WS_LTOK); int* ldst = (int*)(ws + WS_LDST); float* lw = (float*)(ws + WS_LW);
            LAS unsigned long long* selmask = (LAS unsigned long long*)(lds + SEL_OFF);
            LAS float* selw = (LAS float*)(lds + SEL_OFF + 256);
            const float* wrt = args.in[I_WR] + (size_t)l * D * NE; const float brt = args.in[I_BR][l * NE + lane];
            for (int rb = blk; rb < T / 32; rb += G) {
                const int bb = (rb * 32) / SEQ; const float* sh2 = modl + bb * 12288 + 3 * 2048; const float* sc2 = sh2 + 2048;
#pragma unroll 1
                for (int it = 0; it < 2; ++it) {
                    {
                        f32x4 v[2][4][2]; float ss[2] = {0.f, 0.f};
                        u32x4 xw[2][4]; f32x4 gsc[4][2], gsh[4][2], sc1[4][2];
#pragma unroll
                        for (int rr = 0; rr < 2; ++rr) { const bf16_t* xr = (const bf16_t*)(ws + WS_XB) + (size_t)(rb * 32 + it * 16 + 2 * wave + rr) * D;
#pragma unroll
                            for (int j = 0; j < 4; ++j) xw[rr][j] = *(const GAS u32x4*)(xr + 8 * (lane + 64 * j)); }
#pragma unroll
                        for (int j = 0; j < 4; ++j)
#pragma unroll
                            for (int h = 0; h < 2; ++h) { const int c = 8 * (lane + 64 * j) + 4 * h;
                                gsc[j][h] = *(const GAS f32x4*)(args.in[I_NFFN] + l * D + c); sc1[j][h] = *(const GAS f32x4*)(sc2 + c); gsh[j][h] = *(const GAS f32x4*)(sh2 + c); }
#pragma unroll
                        for (int rr = 0; rr < 2; ++rr) asm volatile("" : "+v"(xw[rr][0]), "+v"(xw[rr][1]), "+v"(xw[rr][2]), "+v"(xw[rr][3]) :: "memory");
#pragma unroll
                        for (int j = 0; j < 4; ++j) asm volatile("" : "+v"(gsc[j][0]), "+v"(gsc[j][1]), "+v"(sc1[j][0]), "+v"(sc1[j][1]), "+v"(gsh[j][0]), "+v"(gsh[j][1]) :: "memory");
#pragma unroll
                        for (int rr = 0; rr < 2; ++rr)
#pragma unroll
                            for (int j = 0; j < 4; ++j) pg8::unpack8(xw[rr][j], v[rr][j][0], v[rr][j][1]);
#pragma unroll
                        for (int j = 0; j < 4; ++j)
#pragma unroll
                            for (int h = 0; h < 2; ++h) gsc[j][h] = gsc[j][h] * (sc1[j][h] + 1.0f);
#pragma unroll
                        for (int rr = 0; rr < 2; ++rr)
#pragma unroll
                            for (int j = 0; j < 4; ++j)
#pragma unroll
                                for (int h = 0; h < 2; ++h) ss[rr] += v[rr][j][h][0] * v[rr][j][h][0] + v[rr][j][h][1] * v[rr][j][h][1] + v[rr][j][h][2] * v[rr][j][h][2] + v[rr][j][h][3] * v[rr][j][h][3];
#pragma unroll
                        for (int rr = 0; rr < 2; ++rr) { const int lr = 2 * wave + rr, row = rb * 32 + it * 16 + lr;
                            const float rstd = 1.0f / sqrtf(wave_sum(ss[rr]) * (1.0f / D) + NORM_EPS);
                            unsigned char* hrow8 = (unsigned char*)hbuf + (size_t)row * D;
#pragma unroll
                            for (int j = 0; j < 4; ++j) { const int c = 8 * (lane + 64 * j); f32x4 o[2];
#pragma unroll
                                for (int h = 0; h < 2; ++h) o[h] = v[rr][j][h] * rstd * gsc[j][h] + gsh[j][h];
                                const u32x4 hiw = pg8::pack8(o[0], o[1]); *(GAS u32x2*)(hrow8 + c) = (u32x2){pg8::pk_fp8x4(o[0]), pg8::pk_fp8x4(o[1])};
                                f32x4 h0, h1; pg8::unpack8(hiw, h0, h1); const u32x4 low = pg8::pack8(o[0] - h0, o[1] - h1);
                                const int so = lr * 4096 + (((lane + 64 * j) ^ lr) << 4);
                                *(LAS u32x4*)(lds + so) = hiw; *(LAS u32x4*)(lds + 65536 + so) = low; } }
                    }
                    f32x4 racc[4];
                    {
                        const GAS bf16_t* whi = (const GAS bf16_t*)(ws + WS_WRT) + (size_t)(l * 2) * 64 * 2048 + 256 * wave; const GAS bf16_t* wlo = whi + 64 * 2048;
                        const int lop = opaque(lane), r16 = lop & 15, q4 = lop >> 4;
#pragma unroll
                        for (int nt = 0; nt < 4; ++nt) racc[nt] = (f32x4){0.f, 0.f, 0.f, 0.f};
                        auto ldB = [&](int kp, bf16x8 (&bh)[2][4], bf16x8 (&bl)[2][4]) {
#pragma unroll
                            for (int k2 = 0; k2 < 2; ++k2)
#pragma unroll
                                for (int nt = 0; nt < 4; ++nt) { const size_t wo = (size_t)(16 * nt + r16) * 2048 + 32 * (2 * kp + k2) + 8 * q4; bh[k2][nt] = *(const GAS bf16x8*)(whi + wo); bl[k2][nt] = *(const GAS bf16x8*)(wlo + wo); } };
                        auto mm = [&](int kp, const bf16x8 (&bh)[2][4], const bf16x8 (&bl)[2][4]) {
#pragma unroll
                            for (int k2 = 0; k2 < 2; ++k2) { const int chunk = 32 * wave + 4 * (2 * kp + k2) + q4, so = r16 * 4096 + ((chunk ^ r16) << 4);
                                const bf16x8 ah = *(const LAS bf16x8*)(lds + so), al = *(const LAS bf16x8*)(lds + 65536 + so);
#pragma unroll
                                for (int nt = 0; nt < 4; ++nt) {
                                    racc[nt] = __builtin_amdgcn_mfma_f32_16x16x32_bf16(ah, bh[k2][nt], racc[nt], 0, 0, 0);
                                    racc[nt] = __builtin_amdgcn_mfma_f32_16x16x32_bf16(al, bh[k2][nt], racc[nt], 0, 0, 0);
                                    racc[nt] = __builtin_amdgcn_mfma_f32_16x16x32_bf16(ah, bl[k2][nt], racc[nt], 0, 0, 0); } } };
#define RT_FENCE() asm volatile("" ::: "memory")
#define RT_PIN() asm volatile("" : "+v"(racc[0]), "+v"(racc[1]), "+v"(racc[2]), "+v"(racc[3]) :: "memory")
                        bf16x8 bhA[2][4], blA[2][4], bhB[2][4], blB[2][4];
                        RT_FENCE(); ldB(0, bhA, blA); ldB(1, bhB, blB); RT_FENCE();
                        __syncthreads();
                        mm(0, bhA, blA); RT_PIN(); ldB(2, bhA, blA); RT_FENCE();
                        mm(1, bhB, blB); RT_PIN(); ldB(3, bhB, blB); RT_FENCE();
                        mm(2, bhA, blA); mm(3, bhB, blB);
#undef RT_FENCE
#undef RT_PIN
                    }
                    __syncthreads();
                    LAS float* part = (LAS float*)lds;
#pragma unroll
                    for (int nt = 0; nt < 4; ++nt)
#pragma unroll
                        for (int r = 0; r < 4; ++r) part[(wave * 16 + 4 * (lane >> 4) + r) * 64 + 16 * nt + (lane & 15)] = racc[nt][r];
                    __syncthreads();
#pragma unroll 1
                    for (int rr = 0; rr < 2; ++rr) { const int lr = 2 * wave + rr; float logit = 0.f;
#pragma unroll
                        for (int w8 = 0; w8 < 8; ++w8) logit += part[(w8 * 16 + lr) * 64 + lane];
                        const float score = 1.0f / (1.0f + __expf(-logit)); const float sel = score + brt;
                        float m1 = sel; m1 = fmaxf(m1, __shfl_xor(m1, 1)); m1 = fmaxf(m1, __shfl_xor(m1, 2)); m1 = fmaxf(m1, __shfl_xor(m1, 4));
                        const unsigned long long bm = __ballot(sel == m1); const unsigned gb = (unsigned)(bm >> (lane & 56)) & 0xffu; const int first = __builtin_ctz(gb);
                        float v2 = ((lane & 7) == first) ? -3.0e38f : sel; v2 = fmaxf(v2, __shfl_xor(v2, 1)); v2 = fmaxf(v2, __shfl_xor(v2, 2)); v2 = fmaxf(v2, __shfl_xor(v2, 4));
                        const float gs = m1 + v2; int grank = 0; const int mygrp = lane >> 3;
#pragma unroll
                        for (int gg = 0; gg < 8; ++gg) { const float o = __shfl(gs, gg * 8); grank += (o > gs || (o == gs && gg < mygrp)) ? 1 : 0; }
                        float val = grank < 4 ? sel : -3.0e38f; unsigned long long cm = 0ull;
#pragma unroll
                        for (int pick = 0; pick < 8; ++pick) {
                            float mxv = val;
#pragma unroll
                            for (int o = 1; o < 64; o <<= 1) mxv = fmaxf(mxv, __shfl_xor(mxv, o));
                            const unsigned long long bmx = __ballot(val == mxv); const int sl = __builtin_ctzll(bmx);
                            cm |= 1ull << sl; if (lane == sl) val = -3.4e38f; }
                        const bool chosen = (cm >> lane) & 1ull; const float sw = wave_sum(chosen ? score : 0.f);
                        const int gr = it * 16 + lr;
                        selw[gr * 64 + lane] = chosen ? score / sw * 2.5f : 0.f;
                        if (lane == 0) selmask[gr] = cm; }
                    __syncthreads();
                }
                if (wave == 0 && rep + 1 == nrep) {
                    int cntl = 0;
                    for (int r = 0; r < 32; ++r) cntl += (int)((selmask[r] >> lane) & 1ull);
                    int pos = cntl ? (int)atomicAdd(ctl + CW_CNT + l * 64 + opaque(lane), (unsigned)cntl) : 0;
                    for (int r = 0; r < 32; ++r) { const unsigned long long m = selmask[r];
                        if ((m >> lane) & 1ull) { const int k = __builtin_popcountll(m & ((1ull << lane) - 1ull)); const int tok = rb * 32 + r; const int li = lane * 8192 + pos;
                            ltok[li] = tok; ldst[li] = tok * NSLOT + k; ((float*)(ws + WS_TOKW))[tok * 8 + k] = selw[r * 64 + lane]; ++pos; } }
                }
                __syncthreads();
            }
            if (rep + 1 < nrep) GRID_BAR(); }
            PH_END(5) if (BOTH(pb + 5)) GRID_BAR();
        }
        if ((PH_MASK & 256) && IN(pb + 6)) {
            PH_BEGIN
            _Pragma("unroll 1") for (int rep = 0; rep < REPS(6); ++rep) {
            LAS int* tpre = (LAS int*)(lds + MOE_OFF); LAS int* ebase = tpre + 65; LAS int* ecnt = ebase + 65; LAS int* utab = (LAS int*)(lds + MOE_OFF + 1024);
            pg8::moe_build<4, true>(tpre, ebase, ecnt, utab, ctl + CW_CNT + l * 64, G, blk, tid);
            pg8::MoeOrder<4, true> S{utab, (const char*)(ws + WS_WGU + (size_t)l * 65 * 1024 * 2048), (size_t)1024 * 2048, (size_t)256 * 2048, (const int*)(ws + WS_LTOK)};
            pg8::EpiGateUp E{(unsigned char*)(ws + WS_HID)};
            pg8::gemm_phase<pg8::EpiGateUp, pg8::MoeOrder<4, true>, GEMM_ALIGN, GEMM_SP2, true>(lds, (const char*)hbuf, D / 2, S, E, wave);
            if (rep + 1 < REPS(6)) GRID_BAR(); }
            PH_END(6) if (BOTH(pb + 6)) GRID_BAR();
        }
        if ((PH_MASK & 512) && IN(pb + 7)) {
            PH_BEGIN
            _Pragma("unroll 1") for (int rep = 0; rep < REPS(7); ++rep) {
            LAS int* tpre = (LAS int*)(lds + MOE_OFF); LAS int* ebase = tpre + 65; LAS int* ecnt = ebase + 65; LAS int* utab = (LAS int*)(lds + MOE_OFF + 1024);
            pg8::moe_build<8, false>(tpre, ebase, ecnt, utab, ctl + CW_CNT + l * 64, G, blk, tid);
            constexpr size_t DB = DOWN_F8 ? 1 : 2;
            pg8::MoeOrder<8, false> S{utab, (const char*)(ws + WS_WD + (size_t)l * 65 * 2048 * 512 * DB), (size_t)2048 * 512 * DB, (size_t)256 * 512 * DB, (const int*)(ws + WS_LTOK)};
            pg8::EpiDown E{(unsigned char*)(ws + WS_YSLOT), (const int*)(ws + WS_LDST), (LAS int*)(lds + SEL_OFF), (REP_VARIANT && rep == 1) ? 1 : 0};
            pg8::gemm_phase<pg8::EpiDown, pg8::MoeOrder<8, false>, GEMM_ALIGN, GEMM_SP2, DOWN_F8 != 0>(lds, (const char*)(ws + WS_HID), DOWN_F8 ? 256 : 512, S, E, wave);
            if (rep + 1 < REPS(7)) GRID_BAR(); }
            PH_END(7) if (BOTH(pb + 7)) GRID_BAR();
        }
        if ((PH_MASK & 1024) && IN(pb + 8)) {
            PH_BEGIN
            const int nrep = REPS(8);
            _Pragma("unroll 1") for (int rep = 0; rep < nrep; ++rep) {
            const float* modl = mod + (size_t)l * 2 * 12288;
            const unsigned char* yslot = (const unsigned char*)(ws + WS_YSLOT);
            for (int run = blk * NWAVES + wave; run < T / 4; run += G * NWAVES) {
                const int bb = (run * 4) / SEQ; const float* gt2 = modl + bb * 12288 + 5 * 2048;
                const float* m1 = mod + (size_t)2 * 12288 + bb * 12288;
                f32x4 gtv[2][4];
#pragma unroll
                for (int jj = 0; jj < 2; ++jj)
#pragma unroll
                    for (int q = 0; q < 4; ++q) { const int c = 16 * (lane + 64 * jj) + 4 * q; gtv[jj][q] = *(const GAS f32x4*)(gt2 + c) * pg8::YS_INV; }
#pragma unroll 1
                for (int pr = 0; pr < 2; ++pr) {
                    f32x4 v[2][2][4]; float ss[2] = {0.f, 0.f};
                    const int rowb = run * 4 + pr * 2;
                    f32x4 tw[2][2];
#pragma unroll
                    for (int rr = 0; rr < 2; ++rr) { tw[rr][0] = *(const GAS f32x4*)((const float*)(ws + WS_TOKW) + (rowb + rr) * 8); tw[rr][1] = *(const GAS f32x4*)((const float*)(ws + WS_TOKW) + (rowb + rr) * 8 + 4); }
                    auto issue = [&](int rr, int jj, u32x4 (&w)[NSLOT], u32x4 (&xq)[2]) {
                        const int c = 16 * (lane + 64 * jj); const unsigned char* ys = yslot + (size_t)(rowb + rr) * NSLOT * D + c;
#pragma unroll
                        for (int k = 0; k < NSLOT; ++k) w[k] = *(const GAS u32x4*)(ys + (size_t)k * D);
                        const bf16_t* xr = (const bf16_t*)(ws + WS_XB) + (size_t)(rowb + rr) * D + c; xq[0] = *(const GAS u32x4*)xr; xq[1] = *(const GAS u32x4*)(xr + 8); };
                    auto consume = [&](int rr, int jj, const u32x4 (&w)[NSLOT], const u32x4 (&xq)[2]) {
                        f32x4 a[4];
#pragma unroll
                        for (int q = 0; q < 4; ++q) a[q] = (f32x4){0.f, 0.f, 0.f, 0.f};
#pragma unroll
                        for (int k = 0; k < NSLOT; ++k) { const float wk = k < 8 ? tw[rr][k >> 2][k & 3] : 1.0f;
#pragma unroll
                            for (int q = 0; q < 4; ++q) { const f32x2 lo = __builtin_amdgcn_cvt_pk_f32_fp8((int)w[k][q], false), hi = __builtin_amdgcn_cvt_pk_f32_fp8((int)w[k][q], true); a[q] += (f32x4){lo.x, lo.y, hi.x, hi.y} * wk; } }
                        f32x4 xv[4]; pg8::unpack8(xq[0], xv[0], xv[1]); pg8::unpack8(xq[1], xv[2], xv[3]);
#pragma unroll
                        for (int q = 0; q < 4; ++q) { v[rr][jj][q] = xv[q] + gtv[jj][q] * a[q];
                            ss[rr] += v[rr][jj][q][0] * v[rr][jj][q][0] + v[rr][jj][q][1] * v[rr][jj][q][1] + v[rr][jj][q][2] * v[rr][jj][q][2] + v[rr][jj][q][3] * v[rr][jj][q][3]; } };
                    {
                        u32x4 wA[NSLOT], xA[2], wB[NSLOT], xB[2];
#define CMB_FENCE() asm volatile("" ::: "memory")
#define CMB_PIN(x) asm volatile("" : "+v"(x) :: "memory")
                        issue(0, 0, wA, xA); issue(0, 1, wB, xB); CMB_FENCE();
                        consume(0, 0, wA, xA); CMB_PIN(ss[0]); issue(1, 0, wA, xA); CMB_FENCE();
                        consume(0, 1, wB, xB); CMB_PIN(ss[0]); issue(1, 1, wB, xB); CMB_FENCE();
                        consume(1, 0, wA, xA); consume(1, 1, wB, xB); CMB_PIN(ss[1]);
#undef CMB_FENCE
#undef CMB_PIN
                    }
                    f32x4 gs[2][4], gh[2][4];
                    if (l == 0) {
#pragma unroll
                        for (int jj = 0; jj < 2; ++jj)
#pragma unroll
                            for (int q = 0; q < 4; ++q) { const int c = 16 * (lane + 64 * jj) + 4 * q;
                                gs[jj][q] = *(const GAS f32x4*)(args.in[I_NMIX] + D + c) * (*(const GAS f32x4*)(m1 + 2048 + c) + 1.0f); gh[jj][q] = *(const GAS f32x4*)(m1 + c); }
                    } else {
#pragma unroll
                        for (int jj = 0; jj < 2; ++jj)
#pragma unroll
                            for (int q = 0; q < 4; ++q) { const int c = 16 * (lane + 64 * jj) + 4 * q; gs[jj][q] = *(const GAS f32x4*)(args.in[I_NFIN] + c); gh[jj][q] = (f32x4){0.f, 0.f, 0.f, 0.f}; }
                    }
#pragma unroll
                    for (int rr = 0; rr < 2; ++rr) { const int row = rowb + rr;
                        const float rstd = 1.0f / sqrtf(wave_sum(ss[rr]) * (1.0f / D) + NORM_EPS);
                        float* xw = (rep + 1 == nrep) ? xbuf + (size_t)row * D : (float*)(ws + WS_HID) + (size_t)row * D; bf16_t* hw = (rep + 1 == nrep) ? hbuf + (size_t)row * D : (bf16_t*)(ws + WS_MIXED2) + (size_t)row * D;
                        bf16_t* xbw = (rep + 1 == nrep) ? (bf16_t*)(ws + WS_XB) + (size_t)row * D : (bf16_t*)(ws + WS_MIXED) + (size_t)row * D;
                        if (l == 0) {
#pragma unroll
                            for (int jj = 0; jj < 2; ++jj) { const int c = 16 * (lane + 64 * jj); f32x4 o[4];
                                *(GAS u32x4*)(xbw + c) = pg8::pack8(v[rr][jj][0], v[rr][jj][1]); *(GAS u32x4*)(xbw + c + 8) = pg8::pack8(v[rr][jj][2], v[rr][jj][3]);
#pragma unroll
                                for (int q = 0; q < 4; ++q) o[q] = v[rr][jj][q] * rstd * gs[jj][q] + gh[jj][q];
                                *(GAS u32x4*)(hw + c) = pg8::pack8(o[0], o[1]); *(GAS u32x4*)(hw + c + 8) = pg8::pack8(o[2], o[3]); }
                        } else {
#pragma unroll
                            for (int jj = 0; jj < 2; ++jj) { const int c = 16 * (lane + 64 * jj);
#pragma unroll
                                for (int q = 0; q < 4; ++q) *(GAS f32x4*)(xw + c + 4 * q) = v[rr][jj][q] * rstd * gs[jj][q]; }
                        } }
                }
            }
            if (rep + 1 < nrep) GRID_BAR(); }
            PH_END(8) if (BOTH(pb + 8)) GRID_BAR();
        }
    }
#undef IN
#undef BOTH
#undef GRID_BAR
}

extern "C" void kernel_launch(void* const* d_in, const int* in_sizes, int n_in, void* d_out, int out_size, void* d_ws, size_t ws_size, hipStream_t stream) {
    static int grid = 0;
    if (grid == 0) {
        if (n_in != 29 || out_size != T * D || ws_size < WS_END) { fprintf(stderr, "kernel_launch: unexpected shapes (n_in %d out %d ws %zu)\n", n_in, out_size, ws_size); grid = -1; return; }
        int dev = 0, cus = 0, per_cu = 0;
        if (hipGetDevice(&dev) != hipSuccess || hipDeviceGetAttribute(&cus, hipDeviceAttributeMultiprocessorCount, dev) != hipSuccess) { grid = -1; return; }
        if (hipFuncSetAttribute((const void*)mega_fwd, hipFuncAttributeMaxDynamicSharedMemorySize, LDS_BYTES) != hipSuccess) { fprintf(stderr, "kernel_launch: hipFuncSetAttribute failed\n"); grid = -1; return; }
        if (hipOccupancyMaxActiveBlocksPerMultiprocessor(&per_cu, (const void*)mega_fwd, NWAVES * 64, LDS_BYTES) != hipSuccess || per_cu < 1) { fprintf(stderr, "kernel_launch: occupancy query says %d\n", per_cu); }
        (void)hipGetLastError();
        grid = cus & ~7;
    }
    if (grid < 0) return;
    (void)hipMemsetAsync((char*)d_ws + WS_CTL, 0, CTL_ZERO_BYTES, stream);
    Args a{};
    for (int i = 0; i < 29; ++i) a.in[i] = (const float*)d_in[i];
    a.out = (float*)d_out; a.ws = (unsigned char*)d_ws;
    if (N_LAUNCHES == 1) { a.ph_lo = 0; a.ph_hi = 20; hipLaunchKernelGGL(mega_fwd, dim3(grid), dim3(NWAVES * 64), LDS_BYTES, stream, a); }
    else { for (int p = 0; p < 20; ++p) { a.ph_lo = p; a.ph_hi = p + 1; hipLaunchKernelGGL(mega_fwd, dim3(grid), dim3(NWAVES * 64), LDS_BYTES, stream, a); } }
}
```

```cpp
#include <hip/hip_runtime.h>
#include <cstdio>
#include <cstdint>

#ifndef N_LAUNCHES
#define N_LAUNCHES 1
#endif
#ifndef GEMM_ALIGN
#define GEMM_ALIGN true
#endif
#ifndef GEMM_SP2
#define GEMM_SP2 true
#endif
#ifndef MOE_XCD
#define MOE_XCD 0
#endif
#ifndef F8_PIN
#define F8_PIN 1
#endif
#if F8_PIN == 1
#define F8_PIN_ASM(x) asm volatile("" : "+v"(x))
#elif F8_PIN == 2
#define F8_PIN_ASM(x) asm volatile("" : "+a"(x))
#else
#define F8_PIN_ASM(x) do {} while (0)
#endif
#ifndef DOWN_PRE
#define DOWN_PRE 1
#endif
#ifndef DOWN_F8
#define DOWN_F8 1
#endif
#ifndef MIX_F8
#define MIX_F8 1
#endif

#define LAS __attribute__((address_space(3)))
#define GAS __attribute__((address_space(1)))
typedef unsigned short bf16_t;
typedef short bf16x8 __attribute__((ext_vector_type(8)));
typedef float f32x4 __attribute__((ext_vector_type(4)));
typedef float f32x2 __attribute__((ext_vector_type(2)));
typedef unsigned u32x4 __attribute__((ext_vector_type(4)));
typedef unsigned u32x2 __attribute__((ext_vector_type(2)));
typedef int i32x4 __attribute__((ext_vector_type(4)));
typedef int i32x8 __attribute__((ext_vector_type(8)));

constexpr int T = 8192, D = 2048, SEQ = 4096, DEPTH = 2;
constexpr int INW = 6144, O_Q = 0, O_K = 1024, O_V = 1280, O_U = 1536, O_GA = 2048, O_GS = 4096;
constexpr int NE = 64, NSLOT = 9;
constexpr float NORM_EPS = 1e-6f;
constexpr float LOG2E = 1.4426950408889634f;

constexpr size_t MiB = 1u << 20;
constexpr size_t WS_CTL = 0, CTL_ZERO_BYTES = 1 * MiB;
constexpr size_t WS_MODP = 1 * MiB;
constexpr size_t WS_MOD = 3 * MiB;
constexpr size_t WS_SSM = 4 * MiB;
constexpr size_t SSM_STRIDE = 640 * 1024, SSM_E = 0, SSM_F = 256 * 1024, SSM_KT = 512 * 1024, SSM_P = 560 * 1024;
constexpr size_t WS_WIN = 44 * MiB;
constexpr size_t WS_WO = 92 * MiB;
constexpr size_t WS_WGLU = 100 * MiB;
constexpr size_t WS_WMIX = 108 * MiB;
constexpr size_t WS_WGU = 124 * MiB;
constexpr size_t WS_WD = 644 * MiB;
constexpr size_t WS_H = 904 * MiB;
constexpr size_t WS_PROJ = 936 * MiB;
constexpr size_t WS_ATTN = 1032 * MiB;
constexpr size_t WS_SLOC = 1048 * MiB;
constexpr size_t WS_Y = 1050 * MiB;
constexpr size_t WS_MIXED = 1058 * MiB;
constexpr size_t WS_HID = 1090 * MiB;
constexpr size_t WS_YSLOT = 1163 * MiB;
constexpr size_t WS_LTOK = 1451 * MiB, WS_LDST = 1453 * MiB, WS_LW = 1455 * MiB;
constexpr size_t WS_MIXED2 = 1457 * MiB;
constexpr size_t WS_WRT = 1489 * MiB;
constexpr size_t WS_XB = 1490 * MiB;
constexpr size_t WS_TOKW = 1522 * MiB;
constexpr size_t WS_END = 1523 * MiB;
constexpr int CW_TMO = 0, CW_BAR = 4096, CW_CNT = 8192;

constexpr int RING_BYTES = 131072, LDSCTL_OFF = RING_BYTES, MISC_OFF = LDSCTL_OFF + 320;
constexpr int SEL_OFF = LDSCTL_OFF + 1024;
constexpr int MOE_OFF = LDSCTL_OFF + 10240;
constexpr int LDS_BYTES = 147456;
constexpr int NWAVES = 8;

__device__ __forceinline__ unsigned cvt_pk_bf16(float lo, float hi) { unsigned r; asm("v_cvt_pk_bf16_f32 %0, %1, %2" : "=v"(r) : "v"(lo), "v"(hi)); return r; }
__device__ __forceinline__ float bf_lo(unsigned w) { return __uint_as_float(w << 16); }
__device__ __forceinline__ float bf_hi(unsigned w) { return __uint_as_float(w & 0xffff0000u); }
__device__ __forceinline__ float bf1(bf16_t h) { return __uint_as_float(((unsigned)h) << 16); }
__device__ __forceinline__ float fast_sigmoid(float x) { return __builtin_amdgcn_rcpf(1.0f + __builtin_amdgcn_exp2f(-x * LOG2E)); }
__device__ __forceinline__ float wave_sum(float v) {
#pragma unroll
    for (int o = 1; o < 64; o <<= 1) v += __shfl_xor(v, o);
    return v;
}
__device__ __forceinline__ int opaque(int v) { asm volatile("" : "+v"(v)); return v; }
__device__ __forceinline__ int lane_now() { int l; asm volatile("v_mbcnt_lo_u32_b32 %0, -1, 0\n\tv_mbcnt_hi_u32_b32 %0, -1, %0" : "=v"(l)); return l; }
#define LDS_WAIT() asm volatile("s_waitcnt lgkmcnt(0)" ::: "memory")
#define VM_WAIT() asm volatile("s_waitcnt vmcnt(0)" ::: "memory")

#define XB_TMO      128
#define XB_XCNT(j)  (256  + 64 * (j))
#define XB_XSUB(j)  (1280 + 64 * (j))
#define XB_XGEN(j)  (2304 + 64 * (j))
#define XB_TOP      3328
#define XB_TOPGEN   3392
#define XCD_BAR_WORDS 3456
#define XB_SPIN_CAP (1u << 18)
__device__ __forceinline__ unsigned xb_ld(unsigned* p)              { return __hip_atomic_load(p, __ATOMIC_RELAXED, __HIP_MEMORY_SCOPE_AGENT); }
__device__ __forceinline__ unsigned xb_add(unsigned* p, unsigned v) { return __hip_atomic_fetch_add(p, v, __ATOMIC_RELAXED, __HIP_MEMORY_SCOPE_AGENT); }
__device__ __forceinline__ unsigned xb_xcc_id() { return (unsigned)__builtin_amdgcn_s_getreg((3 << 11) | 20) & 0xFu; }
#define XB_SPIN(cond, bar) do { unsigned _sp = 0; while (cond) { __builtin_amdgcn_s_sleep(1); \
    if ((++_sp & 255u) == 0u) { if (xb_ld(&(bar)[XB_TMO])) break; if (_sp > XB_SPIN_CAP) { atomicAdd(&(bar)[XB_TMO], 1u); break; } } } } while (0)
struct XcdBarrier { unsigned* bar; unsigned x; volatile LAS unsigned* st; int wv; };
__device__ __forceinline__ XcdBarrier xcd_barrier_post(unsigned* bar, volatile LAS unsigned* st) {
    XcdBarrier b; b.bar = bar; b.x = xb_xcc_id(); b.st = st; b.wv = __builtin_amdgcn_readfirstlane((int)threadIdx.x >> 6);
    if (threadIdx.x == 0) (void)xb_add(&bar[XB_XCNT(b.x)], 1u);
    return b;
}
__device__ __forceinline__ void xcd_barrier_complete(unsigned* bar, unsigned x, unsigned& nloc, unsigned& nx) {
    const unsigned G = gridDim.x * gridDim.y * gridDim.z;
    unsigned sum, cnt, mine, sp = 0u;
    for (;;) {
        sum = 0u; cnt = 0u; mine = 0u;
#pragma unroll
        for (unsigned j = 0; j < 16; ++j) { const unsigned c = xb_ld(&bar[XB_XCNT(j)]); sum += c; cnt += (c > 0u) ? 1u : 0u; mine = (j == x) ? c : mine; }
        if (sum == G) break;
        __builtin_amdgcn_s_sleep(1);
        if ((++sp & 255u) == 0u) { if (xb_ld(&bar[XB_TMO])) break; if (sp > XB_SPIN_CAP) { atomicAdd(&bar[XB_TMO], 1u); break; } }
    }
    nloc = mine > 0u ? mine : 1u; nx = cnt > 0u ? cnt : 1u;
}
__device__ __forceinline__ void xcd_barrier(const XcdBarrier& b) {
    asm volatile("s_waitcnt vmcnt(0)" ::: "memory");
    __syncthreads();
    if (lane_now() + 64 * b.wv == 0) {
        unsigned* bar = b.bar; asm volatile("" : "+s"(bar));
        __builtin_amdgcn_s_waitcnt(0);
        unsigned nloc = b.st[0], nx = b.st[1];
        if (nloc == 0u) { xcd_barrier_complete(bar, b.x, nloc, nx); b.st[0] = nloc; b.st[1] = nx; }
        const unsigned old = xb_add(&bar[XB_XSUB(b.x)], 1u);
        const unsigned gen = old / nloc;
        if (old + 1u == (gen + 1u) * nloc) {
            __builtin_amdgcn_fence(__ATOMIC_RELEASE, "agent");
            asm volatile("s_waitcnt vmcnt(0)" ::: "memory");
            const unsigned og = xb_add(&bar[XB_TOP], 1u);
            const unsigned tg = og / nx;
            if (og + 1u == (tg + 1u) * nx) xb_add(&bar[XB_TOPGEN], 1u);
            else XB_SPIN(xb_ld(&bar[XB_TOPGEN]) == tg, bar);
            __builtin_amdgcn_fence(__ATOMIC_ACQUIRE, "agent");
            xb_add(&bar[XB_XGEN(b.x)], 1u);
            asm volatile("s_waitcnt vmcnt(0)" ::: "memory");
        } else {
            XB_SPIN(xb_ld(&bar[XB_XGEN(b.x)]) == gen, bar);
            __builtin_amdgcn_fence(__ATOMIC_ACQUIRE, "agent");
            asm volatile("s_waitcnt vmcnt(0)" ::: "memory");
        }
    }
    __syncthreads();
}

namespace pg8 {
constexpr int BM = 256, BK = 64, HALF = 128, HTB = HALF * BK * 2, STAGE_BYTES = 8 * HTB, NXCD = 8, WGM = 8;
__host__ __device__ __forceinline__ int lds_byte(int r, int c) { const int st = (r >> 4) * 2 + (c >> 5), rr = r & 15, cc = c & 31, ob = rr * 64 + cc * 2; return st * 1024 + (ob ^ (((ob >> 9) & 1) << 5)); }
__host__ __device__ __forceinline__ void stage_rc(int b, int& R, int& C) { const int st = b / 1024, sb = b % 1024, swz = sb ^ (((sb >> 9) & 1) << 5); R = (st >> 1) * 16 + swz / 64; C = (st & 1) * 32 + (swz % 64) / 2; }
__host__ __device__ __forceinline__ int perm32(int rho) { const int n = rho >> 4, i = rho & 15; return 8 * (i >> 2) + 4 * n + (i & 3); }

struct Unit { int pm, pn, e, n, r0, x; };

struct DenseOrder {
    static constexpr bool GATHER = false;
    int nM, nN, nwg, G, c; const char* Bt; size_t tstepB;
    __device__ void init(int M, int N, int K, int G_, int c_, const void* Bt_) { nM = M / BM; nN = N / BM; nwg = nM * nN; G = G_; c = c_; Bt = (const char*)Bt_; tstepB = (size_t)BM * K * 2; }
    __device__ __forceinline__ bool next(int i, Unit& u) const {
        const long L = (long)i * G + c; if (L >= nwg) return false;
        int wgid = (int)L; { const int q = nwg / NXCD, r = nwg % NXCD, xcd = wgid % NXCD, off = wgid / NXCD; wgid = (xcd < r ? xcd * (q + 1) : r * (q + 1) + (xcd - r) * q) + off; }
        const int nig = WGM * nN, gid = wgid / nig, fm = gid * WGM, gsz = (nM - fm) < WGM ? (nM - fm) : WGM;
        u.pm = fm + ((wgid % nig) % gsz); u.pn = (wgid % nig) / gsz; u.e = -1; u.n = 256; u.r0 = u.pm * BM; u.x = u.pm * BM; return true;
    }
    __device__ __forceinline__ int a_row(const Unit& u, int R) const { return u.r0 + R; }
    __device__ __forceinline__ void a_row_issue(const Unit& u, int R, int& out) const { out = u.r0 + R; }
    __device__ __forceinline__ int a_row_fix(const Unit& u, int R, int loaded) const { return loaded; }
    __device__ __forceinline__ const char* b_tile(const Unit& u) const { return Bt + (size_t)u.pn * tstepB; }
};
template <int NPN, bool GATHER_> struct MoeOrder {
    static constexpr bool GATHER = GATHER_;
    const LAS int* utab; const char* Wbase; size_t wstepE, tstepB; const int* ltok;
    __device__ __forceinline__ bool next(int i, Unit& u) const {
        if (i >= 64) return false;
        const LAS int* p = utab + i * 8;
        const int pm = __builtin_amdgcn_readfirstlane(p[0]); if (pm < 0) return false;
        u.pm = pm; u.pn = __builtin_amdgcn_readfirstlane(p[1]); u.e = __builtin_amdgcn_readfirstlane(p[2]); u.n = __builtin_amdgcn_readfirstlane(p[3]);
        u.r0 = __builtin_amdgcn_readfirstlane(p[4]); u.x = __builtin_amdgcn_readfirstlane(p[5]); return true;
    }
    __device__ __forceinline__ int a_row(const Unit& u, int R) const {
        if (!GATHER) return u.r0 + R;
        if (u.e == 64) return u.r0 + R;
        const int rr = R < u.n ? R : u.n - 1; return ((const GAS int*)ltok)[u.r0 + rr];
    }
    __device__ __forceinline__ void a_row_issue(const Unit& u, int R, int& out) const {
        const int rr = R < u.n ? R : u.n - 1; const GAS int* p = (const GAS int*)ltok + (u.e == 64 ? 0 : u.r0 + rr);
        asm volatile("global_load_dword %0, %1, off" : "=v"(out) : "v"(p) : "memory");
    }
    __device__ __forceinline__ int a_row_fix(const Unit& u, int R, int loaded) const { return u.e == 64 ? u.r0 + R : loaded; }
    __device__ __forceinline__ const char* b_tile(const Unit& u) const { return Wbase + (size_t)u.e * wstepE + (size_t)u.pn * tstepB; }
};
template <int NPN, bool GATHER> __device__ __forceinline__ void moe_build(LAS int* tpre, LAS int* ebase, LAS int* ecnt, LAS int* utab, const unsigned* counts, int G, int c, int tid) {
    if (tid < 64) ecnt[tid] = (int)__hip_atomic_load(counts + tid, __ATOMIC_RELAXED, __HIP_MEMORY_SCOPE_AGENT);
    __syncthreads();
    if (tid == 0) { int tp = 0, eb = 0; for (int e = 0; e < 64; ++e) { tpre[e] = tp; ebase[e] = eb; tp += (ecnt[e] + 255) >> 8; eb += ecnt[e]; } tpre[64] = tp; ebase[64] = eb; }
    __syncthreads();
#if MOE_XCD
    if (tid < 64) {
        int pm = -1, pn = 0, e = 64, n = 256;
        const int xc = c & 7; int idx = (c >> 3) + (G >> 3) * tid;
        if (idx < 4 * NPN) { pm = xc + 8 * (idx / NPN); pn = idx % NPN; }
        else { idx -= 4 * NPN;
#pragma unroll 1
            for (int j = 0; j < 8; ++j) { const int ee = xc + 8 * j, nu = ((ecnt[ee] + 255) >> 8) * NPN;
                if (pm < 0) { if (idx < nu) { e = ee; pm = idx / NPN; pn = idx % NPN; } else idx -= nu; } }
            if (pm >= 0) { const int rem = ecnt[e] - pm * BM; n = rem < BM ? rem : BM; } }
        const int hb = (e == 64 ? 65536 : ebase[e]) + pm * BM;
        const int r0 = GATHER ? (e == 64 ? pm * BM : e * 8192 + pm * BM) : hb, x = hb;
#else
    if (tid < 64) {
        int pm = -1, pn = 0, e = 64, n = 256;
        const int vc = ((G & 7) == 0) ? (c & 7) * (G >> 3) + (c >> 3) : c;
        int L = tid * G + vc; const int shared_units = 32 * NPN, tot = shared_units + NPN * tpre[64];
        if (L < tot) {
            if (L < shared_units) { pm = L / NPN; pn = L % NPN; }
            else { L -= shared_units; const int tile = L / NPN; pn = L % NPN; e = 0;
#pragma unroll 1
                for (int j = 1; j <= 64; ++j) e += (tpre[j] <= tile) ? 1 : 0;
                pm = tile - tpre[e]; const int rem = ecnt[e] - pm * BM; n = rem < BM ? rem : BM; } }
        const int hb = (e == 64 ? 65536 : ebase[e]) + pm * BM;
        const int r0 = GATHER ? (e == 64 ? pm * BM : e * 8192 + pm * BM) : hb, x = hb;
#endif
        LAS int* p = utab + tid * 8; p[0] = pm; p[1] = pn; p[2] = e; p[3] = n; p[4] = r0; p[5] = x;
    }
    __syncthreads();
}

template <class Epi, class Sched, bool ALIGN_EPI = false, bool SP2 = GEMM_SP2, bool F8 = false>
__device__ __forceinline__ void gemm_phase(LAS unsigned char* lds, const char* Abase, const int K, const Sched& S, const Epi& E, const int wave_s) {
    int tid = lane_now() + 64 * wave_s; asm volatile("" : "+v"(tid));
    const int wid = wave_s, lane = tid & 63, wr = wid >> 2, wc = wid & 3, fr = lane & 15, fq = lane >> 4;
    const int nt = K / BK;
    constexpr bool GA = Sched::GATHER;
    unsigned voffA[2], voffB[2];
#pragma unroll
    for (int i = 0; i < 2; ++i) { int R, C; stage_rc(tid * 16 + i * 8192, R, C); const int Rb = Epi::PERM ? ((R & ~31) + perm32(R & 31)) : R; voffA[i] = (unsigned)(R * K + C) * 2u; voffB[i] = (unsigned)(Rb * K + C) * 2u; }
    const size_t kstep = (size_t)(BK * 2);
    const size_t hstep = (size_t)HALF * K * 2;
    const unsigned ldsw = (unsigned)wid * 1024u;
    const int aoff = lds_byte(wr * 64 + fr, fq * 8), boff = lds_byte(wc * 32 + fr, fq * 8);
#define PG8_SA(b, h) (((b) * 2 + (h)) * HTB)
#define PG8_SB(b, h) ((4 + (b) * 2 + (h)) * HTB)
#define PG8_STB(bufoff, gbase) do { const char* _sb = (const char*)(gbase); asm volatile("" : "+s"(_sb)); _Pragma("unroll") for (int _i = 0; _i < 2; ++_i) \
        { unsigned _vo = voffB[_i]; asm volatile("" : "+v"(_vo)); __builtin_amdgcn_global_load_lds((const unsigned*)(_sb + _vo), (LAS unsigned*)(lds + (bufoff) + ldsw + _i * 8192), 16, 0, 0); } } while (0)
#define PG8_STA(bufoff, h, kb) do { const char* _sa = GA ? (Abase + (kb)) : (cA + (kb) + (h) * hstep); asm volatile("" : "+s"(_sa)); _Pragma("unroll") for (int _i = 0; _i < 2; ++_i) \
        { unsigned _vo = GA ? offC[h][_i] : voffA[_i]; asm volatile("" : "+v"(_vo)); __builtin_amdgcn_global_load_lds((const unsigned*)(_sa + _vo), (LAS unsigned*)(lds + (bufoff) + ldsw + _i * 8192), 16, 0, 0); } } while (0)
#define PG8_LDA(dst, b, h) do { _Pragma("unroll") for (int m = 0; m < 4; ++m) _Pragma("unroll") for (int k = 0; k < 2; ++k) dst[m][k] = *(const LAS bf16x8*)(lds + PG8_SA(b, h) + aoff + m * 2048 + k * 1024); } while (0)
#define PG8_LDB(dst, b, h) do { _Pragma("unroll") for (int n = 0; n < 2; ++n) _Pragma("unroll") for (int k = 0; k < 2; ++k) dst[n][k] = *(const LAS bf16x8*)(lds + PG8_SB(b, h) + boff + n * 2048 + k * 1024); } while (0)
#define PG8_CAT8(x, y) __builtin_shufflevector(__builtin_bit_cast(i32x4, x), __builtin_bit_cast(i32x4, y), 0, 1, 2, 3, 4, 5, 6, 7)
#define PG8_MMA(ai, bj, At, Bt) do { __builtin_amdgcn_s_setprio(1); _Pragma("unroll") for (int m = 0; m < 4; ++m) _Pragma("unroll") for (int n = 0; n < 2; ++n) { \
        if constexpr (F8) acc[ai][bj][m][n] = __builtin_amdgcn_mfma_scale_f32_16x16x128_f8f6f4(PG8_CAT8(Bt[n][0], Bt[n][1]), PG8_CAT8(At[m][0], At[m][1]), acc[ai][bj][m][n], 0, 0, 0, 0, 0, 0); \
        else { _Pragma("unroll") for (int k = 0; k < 2; ++k) acc[ai][bj][m][n] = __builtin_amdgcn_mfma_f32_16x16x32_bf16(Bt[n][k], At[m][k], acc[ai][bj][m][n], 0, 0, 0); } } \
        __builtin_amdgcn_s_setprio(0); } while (0)
#define PG8_WAIT_V(n) asm volatile("s_waitcnt vmcnt(" #n ")" ::: "memory")
#define PG8_WAIT_L(n) asm volatile("s_waitcnt lgkmcnt(" #n ")" ::: "memory")
#define PG8_BAR __builtin_amdgcn_s_barrier()
#define PG8_SCHED __builtin_amdgcn_sched_barrier(0)
#define PG8_AOFF(dst, u) do { if constexpr (GA) { _Pragma("unroll") for (int _h = 0; _h < 2; ++_h) _Pragma("unroll") for (int _i = 0; _i < 2; ++_i) { int _R, _C; stage_rc(tid * 16 + _i * 8192, _R, _C); \
        dst[_h][_i] = (unsigned)(S.a_row(u, _h * HALF + _R) * K + _C) * 2u; } } } while (0)
    Unit cur, nxt; int ui = 0;
    if (!S.next(0, cur)) return;
    f32x4 acc[2][2][4][2];
#pragma unroll
    for (int a = 0; a < 2; ++a)
#pragma unroll
        for (int b = 0; b < 2; ++b)
#pragma unroll
            for (int m = 0; m < 4; ++m)
#pragma unroll
                for (int n = 0; n < 2; ++n) { acc[a][b][m][n] = (f32x4){0.f, 0.f, 0.f, 0.f}; if constexpr (F8) F8_PIN_ASM(acc[a][b][m][n]); }
    bf16x8 At[4][2], B0[2][2], B1[2][2];
    unsigned offC[2][2];
    PG8_AOFF(offC, cur);
    const char* cB = S.b_tile(cur);
    const char* cA = GA ? Abase : Abase + (size_t)S.a_row(cur, 0) * K * 2;
    if constexpr (SP2) {
        PG8_STB(PG8_SB(0, 0), cB); PG8_STB(PG8_SB(0, 1), cB + hstep); PG8_STA(PG8_SA(0, 0), 0, 0); PG8_STA(PG8_SA(0, 1), 1, 0);
        if (wr == 1) PG8_BAR;
        PG8_WAIT_V(2); PG8_BAR;
        PG8_STB(PG8_SB(1, 0), cB + kstep); PG8_STA(PG8_SA(1, 0), 0, kstep); PG8_STB(PG8_SB(1, 1), cB + hstep + kstep);
        PG8_WAIT_V(6); PG8_BAR;
    } else {
    PG8_STB(PG8_SB(0, 0), cB); PG8_STA(PG8_SA(0, 0), 0, 0); PG8_STB(PG8_SB(0, 1), cB + hstep); PG8_STA(PG8_SA(0, 1), 1, 0);
    if (wr == 1) PG8_BAR;
    PG8_WAIT_V(4); PG8_BAR;
    PG8_STB(PG8_SB(1, 0), cB + kstep); PG8_STA(PG8_SA(1, 0), 0, kstep); PG8_STB(PG8_SB(1, 1), cB + hstep + kstep);
    PG8_WAIT_V(6); PG8_BAR;
    }
    for (;;) {
        int pre_v0, pre_v1; if constexpr (Epi::PRE) E.pre_issue(cur, wr, opaque(lane_now()), pre_v0, pre_v1);
        const bool has_next = S.next(ui + 1, nxt);
        const char* nB = has_next ? S.b_tile(nxt) : cB;
        const char* nA = (!GA && has_next) ? Abase + (size_t)S.a_row(nxt, 0) * K * 2 : cA;
        int rowN[2][2];
        if constexpr (GA) { const Unit un = has_next ? nxt : cur;
#pragma unroll
            for (int h = 0; h < 2; ++h)
#pragma unroll
                for (int i = 0; i < 2; ++i) { int R_, C_; stage_rc(tid * 16 + i * 8192, R_, C_); S.a_row_issue(un, h * HALF + R_, rowN[h][i]); } }
#pragma unroll 1
        for (int t = 0; t < nt; t += 2) {
            const bool last = (t == nt - 2);
            const size_t kb1 = (size_t)(t + 1) * kstep;
            const size_t kb2 = last ? 0 : (size_t)(t + 2) * kstep, kb3 = kb2 + kstep;
            const char* b2 = last ? nB : cB + (size_t)(t + 2) * kstep; const char* b3 = b2 + kstep;
            if constexpr (SP2) {
            PG8_LDB(B0, 0, 0); PG8_LDB(B1, 0, 1); PG8_SCHED; PG8_LDA(At, 0, 0); PG8_STA(PG8_SA(1, 1), 1, kb1);
            if (last) { if constexpr (GA) { if (has_next) {
#pragma unroll
                for (int h = 0; h < 2; ++h)
#pragma unroll
                    for (int i = 0; i < 2; ++i) { int R_, C_; stage_rc(tid * 16 + i * 8192, R_, C_); int rl = rowN[h][i]; asm volatile("" : "+v"(rl));
                        offC[h][i] = (unsigned)(S.a_row_fix(nxt, h * HALF + R_, rl) * K + C_) * 2u; } } } else cA = nA; }
            PG8_WAIT_V(8); PG8_WAIT_L(0); PG8_BAR; PG8_MMA(0, 0, At, B0); PG8_MMA(0, 1, At, B1); PG8_BAR; PG8_SCHED;
            PG8_LDA(At, 0, 1); PG8_STB(PG8_SB(0, 0), b2); PG8_STB(PG8_SB(0, 1), b2 + hstep); PG8_STA(PG8_SA(0, 0), 0, kb2);
            PG8_WAIT_V(8); PG8_WAIT_L(0); PG8_BAR; PG8_MMA(1, 0, At, B0); PG8_MMA(1, 1, At, B1); PG8_BAR; PG8_SCHED;
            PG8_LDB(B0, 1, 0); PG8_LDB(B1, 1, 1); PG8_SCHED; PG8_LDA(At, 1, 0); PG8_STA(PG8_SA(0, 1), 1, kb2);
            PG8_WAIT_V(8); PG8_WAIT_L(0); PG8_BAR; PG8_MMA(0, 0, At, B0); PG8_MMA(0, 1, At, B1); PG8_BAR; PG8_SCHED;
            PG8_LDA(At, 1, 1); PG8_STB(PG8_SB(1, 0), b3); PG8_STB(PG8_SB(1, 1), b3 + hstep); PG8_STA(PG8_SA(1, 0), 0, kb3);
            PG8_WAIT_V(8); PG8_WAIT_L(0); PG8_BAR; PG8_MMA(1, 0, At, B0); PG8_MMA(1, 1, At, B1); PG8_BAR; PG8_SCHED;
            } else {
            PG8_LDB(B0, 0, 0); PG8_SCHED; PG8_LDA(At, 0, 0); PG8_STA(PG8_SA(1, 1), 1, kb1);
            if (last) { if constexpr (GA) { if (has_next) {
#pragma unroll
                for (int h = 0; h < 2; ++h)
#pragma unroll
                    for (int i = 0; i < 2; ++i) { int R_, C_; stage_rc(tid * 16 + i * 8192, R_, C_); int rl = rowN[h][i]; asm volatile("" : "+v"(rl));
                        offC[h][i] = (unsigned)(S.a_row_fix(nxt, h * HALF + R_, rl) * K + C_) * 2u; } } } else cA = nA; }
            PG8_WAIT_L(8); PG8_BAR; PG8_WAIT_L(0); PG8_MMA(0, 0, At, B0); PG8_BAR; PG8_SCHED;
            PG8_LDB(B1, 0, 1); PG8_STB(PG8_SB(0, 0), b2);
            PG8_BAR; PG8_WAIT_L(0); PG8_MMA(0, 1, At, B1); PG8_BAR;
            PG8_LDA(At, 0, 1); PG8_STA(PG8_SA(0, 0), 0, kb2);
            PG8_BAR; PG8_WAIT_L(0); PG8_MMA(1, 0, At, B0); PG8_BAR; PG8_SCHED;
            PG8_STB(PG8_SB(0, 1), b2 + hstep);
            PG8_WAIT_V(6); PG8_BAR; PG8_MMA(1, 1, At, B1); PG8_BAR;
            PG8_LDB(B0, 1, 0); PG8_SCHED; PG8_LDA(At, 1, 0); PG8_STA(PG8_SA(0, 1), 1, kb2);
            PG8_WAIT_L(8); PG8_BAR; PG8_WAIT_L(0); PG8_MMA(0, 0, At, B0); PG8_BAR; PG8_SCHED;
            PG8_LDB(B1, 1, 1); PG8_STB(PG8_SB(1, 0), b3);
            PG8_BAR; PG8_WAIT_L(0); PG8_MMA(0, 1, At, B1); PG8_BAR;
            PG8_LDA(At, 1, 1); PG8_STA(PG8_SA(1, 0), 0, kb3);
            PG8_BAR; PG8_WAIT_L(0); PG8_MMA(1, 0, At, B0); PG8_BAR; PG8_SCHED;
            PG8_STB(PG8_SB(1, 1), b3 + hstep);
            PG8_WAIT_V(6); PG8_BAR; PG8_MMA(1, 1, At, B1); PG8_BAR;
            }
        }
        if constexpr (ALIGN_EPI) { if (wr == 0) PG8_BAR; }
        const int tq = opaque(lane_now() + 64 * wid);
        if constexpr (Epi::PRE) { asm volatile("" : "+v"(pre_v0), "+v"(pre_v1)); E.pre_commit(pre_v0, pre_v1, wid, tq & 63); }
        E(acc, cur, wr, wc, tq & 15, (tq >> 4) & 3);
        if (!has_next) break;
#pragma unroll
        for (int a = 0; a < 2; ++a)
#pragma unroll
            for (int b = 0; b < 2; ++b)
#pragma unroll
                for (int m = 0; m < 4; ++m)
#pragma unroll
                    for (int n = 0; n < 2; ++n) { acc[a][b][m][n] = (f32x4){0.f, 0.f, 0.f, 0.f}; if constexpr (F8) F8_PIN_ASM(acc[a][b][m][n]); }
        cur = nxt; cB = nB; ++ui;
        if constexpr (ALIGN_EPI) { if (wr == 1) PG8_BAR; }
    }
    PG8_WAIT_V(0);
    if constexpr (!ALIGN_EPI) { if (wr == 0) PG8_BAR; }
    PG8_BAR;
#undef PG8_SA
#undef PG8_SB
#undef PG8_STB
#undef PG8_STA
#undef PG8_LDA
#undef PG8_LDB
#undef PG8_MMA
#undef PG8_CAT8
#undef PG8_WAIT_V
#undef PG8_WAIT_L
#undef PG8_BAR
#undef PG8_SCHED
#undef PG8_AOFF
}

typedef const f32x4 (&AccRef)[2][2][4][2];
__device__ __forceinline__ u32x4 pack8(const f32x4& a, const f32x4& b) { u32x4 w; w.x = cvt_pk_bf16(a[0], a[1]); w.y = cvt_pk_bf16(a[2], a[3]); w.z = cvt_pk_bf16(b[0], b[1]); w.w = cvt_pk_bf16(b[2], b[3]); return w; }
__device__ __forceinline__ void unpack8(const u32x4 w, f32x4& a, f32x4& b) { a = (f32x4){bf_lo(w.x), bf_hi(w.x), bf_lo(w.y), bf_hi(w.y)}; b = (f32x4){bf_lo(w.z), bf_hi(w.z), bf_lo(w.w), bf_hi(w.w)}; }

constexpr float WGU_SCALE = 64.0f, WD_SCALE = 32.0f;
__device__ __forceinline__ unsigned pk_fp8x4(const f32x4& a) {
    int w = 0; w = __builtin_amdgcn_cvt_pk_fp8_f32(a[0], a[1], w, false); w = __builtin_amdgcn_cvt_pk_fp8_f32(a[2], a[3], w, true); return (unsigned)w; }
struct EpiInProj {
    static constexpr bool PERM = true; static constexpr bool PRE = false;
    bf16_t* O; const float* bias; float qscale; int nostore;
    __device__ __forceinline__ void operator()(AccRef acc, const Unit& u, int wr, int wc, int fr, int fq) const {
        if (nostore) return;
        const int row0 = u.pm * BM + wr * 64 + fr, colb = u.pn * BM + wc * 32 + 8 * fq;
        const int mode = u.pn < 4 ? 1 : (u.pn >= 8 ? 2 : 0);
        f32x4 bv[2][2];
#pragma unroll
        for (int bj = 0; bj < 2; ++bj)
#pragma unroll
            for (int n = 0; n < 2; ++n) bv[bj][n] = *(const GAS f32x4*)(bias + colb + bj * HALF + 4 * n);
#pragma unroll
        for (int ai = 0; ai < 2; ++ai)
#pragma unroll
            for (int m = 0; m < 4; ++m) { bf16_t* rowp = O + (size_t)(row0 + ai * HALF + m * 16) * INW + colb;
#pragma unroll
                for (int bj = 0; bj < 2; ++bj) { f32x4 v0 = acc[ai][bj][m][0] + bv[bj][0], v1 = acc[ai][bj][m][1] + bv[bj][1];
                    if (mode == 1) { v0 = v0 * qscale; v1 = v1 * qscale; }
                    if (mode == 2) {
#pragma unroll
                        for (int j = 0; j < 4; ++j) { v0[j] = fast_sigmoid(v0[j]); v1[j] = fast_sigmoid(v1[j]); } }
                    *(GAS u32x4*)(rowp + bj * HALF) = pack8(v0, v1); } }
    }
};
struct EpiAttnProj {
    static constexpr bool PERM = true; static constexpr bool PRE = false;
    const bf16_t* proj; bf16_t* mixed;
    __device__ __forceinline__ void operator()(AccRef acc, const Unit& u, int wr, int wc, int fr, int fq) const {
        const int row0 = u.pm * BM + wr * 64 + fr, colb = u.pn * BM + wc * 32 + 8 * fq;
#pragma unroll
        for (int ai = 0; ai < 2; ++ai) {
            u32x4 gw[4][2];
#pragma unroll
            for (int m = 0; m < 4; ++m)
#pragma unroll
                for (int bj = 0; bj < 2; ++bj) gw[m][bj] = *(const GAS u32x4*)(proj + (size_t)(row0 + ai * HALF + m * 16) * INW + O_GA + colb + bj * HALF);
#pragma unroll
            for (int m = 0; m < 4; ++m) { const size_t row = (size_t)(row0 + ai * HALF + m * 16);
#pragma unroll
                for (int bj = 0; bj < 2; ++bj) { f32x4 g0, g1; unpack8(gw[m][bj], g0, g1);
                    *(GAS u32x4*)(mixed + row * D + colb + bj * HALF) = pack8(g0 * acc[ai][bj][m][0], g1 * acc[ai][bj][m][1]); } } }
    }
};
struct EpiGlu {
    static constexpr bool PERM = true; static constexpr bool PRE = false;
    const bf16_t* proj; const bf16_t* mixed; bf16_t* mixed2;
    __device__ __forceinline__ void operator()(AccRef acc, const Unit& u, int wr, int wc, int fr, int fq) const {
        const int row0 = u.pm * BM + wr * 64 + fr, col = u.pn * HALF + wc * 32 + 8 * fq;
#pragma unroll
        for (int ai = 0; ai < 2; ++ai) {
            u32x4 gw[4], pw[4];
#pragma unroll
            for (int m = 0; m < 4; ++m) { const size_t row = (size_t)(row0 + ai * HALF + m * 16);
                gw[m] = *(const GAS u32x4*)(proj + row * INW + O_GS + col); pw[m] = *(const GAS u32x4*)(mixed + row * D + col); }
#pragma unroll
            for (int m = 0; m < 4; ++m) { const size_t row = (size_t)(row0 + ai * HALF + m * 16);
                f32x4 g0, g1, p0, p1; unpack8(gw[m], g0, g1); unpack8(pw[m], p0, p1);
                const f32x4 za0 = acc[ai][0][m][0], za1 = acc[ai][0][m][1], zb0 = acc[ai][1][m][0], zb1 = acc[ai][1][m][1];
#pragma unroll
                for (int j = 0; j < 4; ++j) { p0[j] += g0[j] * za0[j] * fast_sigmoid(zb0[j]); p1[j] += g1[j] * za1[j] * fast_sigmoid(zb1[j]); }
                if constexpr (MIX_F8 != 0) *(GAS u32x2*)((unsigned char*)mixed2 + row * D + col) = (u32x2){pk_fp8x4(p0), pk_fp8x4(p1)};
                else *(GAS u32x4*)(mixed2 + row * D + col) = pack8(p0, p1); } }
    }
};
struct EpiMixOut {
    static constexpr bool PERM = true; static constexpr bool PRE = false;
    const float* xin; const bf16_t* xsrc; bf16_t* xdst; const float* gt;
    __device__ __forceinline__ void operator()(AccRef acc, const Unit& u, int wr, int wc, int fr, int fq) const {
        const int row0 = u.pm * BM + wr * 64 + fr, colb = u.pn * BM + wc * 32 + 8 * fq;
        const float* g = gt + (u.pm >= 16 ? 12288 : 0);
        f32x4 gv[2][2];
#pragma unroll
        for (int bj = 0; bj < 2; ++bj)
#pragma unroll
            for (int n = 0; n < 2; ++n) gv[bj][n] = *(const GAS f32x4*)(g + colb + bj * HALF + 4 * n) * (MIX_F8 ? 1.0f / WGU_SCALE : 1.0f);
        if (xin) {
#pragma unroll
            for (int ai = 0; ai < 2; ++ai)
#pragma unroll
                for (int mp = 0; mp < 2; ++mp) { f32x4 xv[2][2][2];
#pragma unroll
                    for (int mm = 0; mm < 2; ++mm)
#pragma unroll
                        for (int bj = 0; bj < 2; ++bj) { const size_t off = (size_t)(row0 + ai * HALF + (2 * mp + mm) * 16) * D + colb + bj * HALF;
                            xv[mm][bj][0] = *(const GAS f32x4*)(xin + off); xv[mm][bj][1] = *(const GAS f32x4*)(xin + off + 4); }
#pragma unroll
                    for (int mm = 0; mm < 2; ++mm)
#pragma unroll
                        for (int bj = 0; bj < 2; ++bj) { const int m = 2 * mp + mm; const size_t off = (size_t)(row0 + ai * HALF + m * 16) * D + colb + bj * HALF;
                            *(GAS u32x4*)(xdst + off) = pack8(xv[mm][bj][0] + gv[bj][0] * acc[ai][bj][m][0], xv[mm][bj][1] + gv[bj][1] * acc[ai][bj][m][1]); } }
        } else {
#pragma unroll
            for (int ai = 0; ai < 2; ++ai) { u32x4 xw[4][2];
#pragma unroll
                for (int m = 0; m < 4; ++m)
#pragma unroll
                    for (int bj = 0; bj < 2; ++bj) xw[m][bj] = *(const GAS u32x4*)(xsrc + (size_t)(row0 + ai * HALF + m * 16) * D + colb + bj * HALF);
#pragma unroll
                for (int m = 0; m < 4; ++m)
#pragma unroll
                    for (int bj = 0; bj < 2; ++bj) { f32x4 x0, x1; unpack8(xw[m][bj], x0, x1);
                        *(GAS u32x4*)(xdst + (size_t)(row0 + ai * HALF + m * 16) * D + colb + bj * HALF) = pack8(x0 + gv[bj][0] * acc[ai][bj][m][0], x1 + gv[bj][1] * acc[ai][bj][m][1]); } }
        }
    }
};
struct EpiGateUp {
    static constexpr bool PERM = true; static constexpr bool PRE = false;
    unsigned char* hid;
    __device__ __forceinline__ void operator()(AccRef acc, const Unit& u, int wr, int wc, int fr, int fq) const {
        const int r0 = wr * 64 + fr, col = u.pn * HALF + wc * 32 + 8 * fq;
        float dq = 1.0f / WGU_SCALE; asm volatile("" : "+s"(dq));
#pragma unroll
        for (int ai = 0; ai < 2; ++ai)
#pragma unroll
            for (int m = 0; m < 4; ++m) { const int r = r0 + ai * HALF + m * 16;
                f32x4 g0 = acc[ai][0][m][0] * dq, g1 = acc[ai][0][m][1] * dq, u0 = acc[ai][1][m][0] * dq, u1 = acc[ai][1][m][1] * dq;
#pragma unroll
                for (int j = 0; j < 4; ++j) { g0[j] = g0[j] * fast_sigmoid(g0[j]) * u0[j]; g1[j] = g1[j] * fast_sigmoid(g1[j]) * u1[j]; }
                if (r < u.n) { if constexpr (DOWN_F8 != 0) *(GAS u32x2*)(hid + (size_t)(u.x + r) * 512 + col) = (u32x2){pk_fp8x4(g0), pk_fp8x4(g1)};
                               else *(GAS u32x4*)(hid + ((size_t)(u.x + r) * 512 + col) * 2) = pack8(g0, g1); } }
    }
};
constexpr float YS_SCALE = 8.0f, YS_INV = 1.0f / 8.0f, YS_ACC = DOWN_F8 ? YS_SCALE / WD_SCALE : YS_SCALE;
struct EpiDown {
    static constexpr bool PERM = true; static constexpr bool PRE = (DOWN_PRE != 0);
    unsigned char* ys; const int* ldst; LAS int* dstl; int nostore;
    __device__ __forceinline__ void pre_issue(const Unit& u, int wr, int lane, int& v0, int& v1) const {
        const int ra = 64 * wr + lane, rb = ra + 128; const GAS int* p = (const GAS int*)ldst + (u.e == 64 ? 0 : u.e * 8192 + u.pm * BM);
        const GAS int* pa = p + ((u.e != 64 && ra < u.n) ? ra : 0); const GAS int* pb = p + ((u.e != 64 && rb < u.n) ? rb : 0);
        asm volatile("global_load_dword %0, %1, off" : "=v"(v0) : "v"(pa) : "memory");
        asm volatile("global_load_dword %0, %1, off" : "=v"(v1) : "v"(pb) : "memory");
    }
    __device__ __forceinline__ void pre_commit(int v0, int v1, int wid, int lane_) const { const int lane = opaque(lane_); dstl[wid * 128 + lane] = v0; dstl[wid * 128 + 64 + lane] = v1; }
    __device__ __forceinline__ void operator()(AccRef acc, const Unit& u, int wr, int wc, int fr_, int fq_) const {
        const int fr = opaque(fr_), fq = opaque(fq_);
        const int r0 = wr * 64 + fr, colb = u.pn * BM + 16 * (4 * wc + fq);
#pragma unroll
        for (int ai = 0; ai < 2; ++ai)
#pragma unroll
            for (int m = 0; m < 4; ++m) { const int r = r0 + ai * HALF + m * 16;
                int dst;
                if constexpr (PRE) dst = (u.e == 64) ? (u.pm * BM + r) * NSLOT + 8 : dstl[(wr * 4 + wc) * 128 + ai * 64 + m * 16 + fr];
                else dst = (u.e == 64) ? (u.pm * BM + r) * NSLOT + 8 : ((const GAS int*)ldst)[u.e * 8192 + u.pm * BM + (r < u.n ? r : 0)];
                if (r < u.n && !nostore)
                    *(GAS u32x4*)(ys + (size_t)dst * D + colb) = (u32x4){pk_fp8x4(acc[ai][0][m][0] * YS_ACC), pk_fp8x4(acc[ai][0][m][1] * YS_ACC), pk_fp8x4(acc[ai][1][m][0] * YS_ACC), pk_fp8x4(acc[ai][1][m][1] * YS_ACC)}; }
    }
};
}

struct Args { const float* in[29]; float* out; unsigned char* ws; int ph_lo, ph_hi; };
typedef const __attribute__((address_space(4))) Args KArgs;
__device__ __forceinline__ const float* arg_in(int which) {
#if defined(__HIP_DEVICE_COMPILE__)
    KArgs* p = (KArgs*)__builtin_amdgcn_kernarg_segment_ptr(); return p->in[which];
#else
    (void)which; return nullptr;
#endif
}
enum { I_X = 0, I_C, I_WADA, I_BADA, I_NMIX, I_WIN, I_BIN, I_SINK, I_WO, I_ARE, I_AIM, I_LDT, I_BRE, I_BIM, I_CRE, I_CIM, I_SD, I_WGLU, I_WMIX, I_NFFN, I_WR, I_BR, I_WEG, I_WEU, I_WED, I_WSG, I_WSU, I_WSD, I_NFIN };

struct TDesc { const float* src; bf16_t* dst; int N, K, cc0; float f8s; };
__device__ __forceinline__ void tr_load(const TDesc& d, int lane, f32x4 (&v)[16]) {
    const int kr = lane >> 4, nq = lane & 15;
    const GAS float* p = (const GAS float*)d.src + (size_t)kr * d.N + 4 * nq; const size_t step = (size_t)4 * d.N;
#pragma unroll
    for (int i = 0; i < 16; ++i) { v[i] = __builtin_nontemporal_load((const GAS f32x4*)p); p += step; }
}
__device__ __forceinline__ void tr_finish(const TDesc& d, int lane_, LAS float* scr, const f32x4 (&v)[16]) {
    const int lane = opaque(lane_);
    const int kr = lane >> 4, nq = lane & 15;
#pragma unroll
    for (int i = 0; i < 16; ++i) { const int k = 4 * i + kr;
#pragma unroll
        for (int e = 0; e < 4; ++e) scr[k * 64 + ((4 * nq + e) ^ k)] = v[i][e]; }
    LDS_WAIT();
    const int c = lane & 7;
#pragma unroll
    for (int j = 0; j < 8; ++j) { const int n = (lane >> 3) + 8 * j; float s[8];
#pragma unroll
        for (int i = 0; i < 8; ++i) { const int k = 8 * c + i; s[i] = scr[k * 64 + (n ^ k)]; }
        u32x4 o; o.x = cvt_pk_bf16(s[0], s[1]); o.y = cvt_pk_bf16(s[2], s[3]); o.z = cvt_pk_bf16(s[4], s[5]); o.w = cvt_pk_bf16(s[6], s[7]);
        const int cc = d.cc0 + n, drow = d.cc0 >= 0 ? (128 * ((cc & 15) >> 3) + 8 * (cc >> 4) + (cc & 7)) : n;
        if (d.f8s != 0.f) { const f32x4 sa = (f32x4){s[0], s[1], s[2], s[3]} * d.f8s, sb = (f32x4){s[4], s[5], s[6], s[7]} * d.f8s;
            __builtin_nontemporal_store((u32x2){pg8::pk_fp8x4(sa), pg8::pk_fp8x4(sb)}, (GAS u32x2*)((unsigned char*)d.dst + (size_t)drow * d.K + 8 * c)); }
        else __builtin_nontemporal_store(o, (GAS u32x4*)(d.dst + (size_t)drow * d.K + 8 * c)); }
    LDS_WAIT();
}
__device__ __forceinline__ void tr_half8(const TDesc& d, int lane_, LAS float* scr, const f32x4 (&v)[16], u32x2 (&o)[8]) {
    const int lane = opaque(lane_);
    const int kr = lane >> 4, nq = lane & 15;
#pragma unroll
    for (int i = 0; i < 16; ++i) { const int k = 4 * i + kr;
#pragma unroll
        for (int e = 0; e < 4; ++e) scr[k * 64 + ((4 * nq + e) ^ k)] = v[i][e]; }
    LDS_WAIT();
    const int c = lane & 7;
#pragma unroll
    for (int j = 0; j < 8; ++j) { const int n = (lane >> 3) + 8 * j; float s[8];
#pragma unroll
        for (int i = 0; i < 8; ++i) { const int k = 8 * c + i; s[i] = scr[k * 64 + (n ^ k)]; }
        const f32x4 sa = (f32x4){s[0], s[1], s[2], s[3]} * d.f8s, sb = (f32x4){s[4], s[5], s[6], s[7]} * d.f8s;
        o[j] = (u32x2){pg8::pk_fp8x4(sa), pg8::pk_fp8x4(sb)}; }
    LDS_WAIT();
}
__device__ __forceinline__ void tr_store8(const TDesc& d, int lane, const u32x2 (&o0)[8], const u32x2 (&o1)[8]) {
    const int c = lane & 7;
#pragma unroll
    for (int j = 0; j < 8; ++j) { const int n = (lane >> 3) + 8 * j; const int cc = d.cc0 + n, drow = d.cc0 >= 0 ? (128 * ((cc & 15) >> 3) + 8 * (cc >> 4) + (cc & 7)) : n;
        unsigned char* p = (unsigned char*)d.dst + (size_t)drow * d.K + 8 * c;
        __builtin_nontemporal_store(o0[j], (GAS u32x2*)p); __builtin_nontemporal_store(o1[j], (GAS u32x2*)(p + 64)); }
}
constexpr int IT_WIN = 3072, IT_WO = 512, IT_WGLU = 512, IT_WMIX = MIX_F8 ? 512 : 1024, IT_EXP = 64 * 128, IT_SH = 128, IT_EXPD = DOWN_F8 ? 64 * 128 : 64 * 256, IT_SHD = DOWN_F8 ? 128 : 256;
constexpr int IT_LAYER = IT_WIN + IT_WO + IT_WGLU + IT_WMIX + 2 * IT_EXP + IT_EXPD + 2 * IT_SH + IT_SHD;
constexpr int IT_MOD = 768;
constexpr int IT_TR = 2 * IT_LAYER;

__device__ __forceinline__ TDesc tr_desc(const float* W, int K, int N, bf16_t* WT, int kb, int nb, int drow0) {
    TDesc d; d.src = W + (size_t)(64 * kb) * N + 64 * nb; d.dst = WT + (size_t)drow0 * K + 64 * kb; d.N = N; d.K = K; d.cc0 = -1; d.f8s = 0.f; return d;
}
__device__ __forceinline__ TDesc tr_desc8(const float* W, int K, int N, unsigned char* WT, int kb, int nb, int drow0, float scale) {
    TDesc d; d.src = W + (size_t)(64 * kb) * N + 64 * nb; d.dst = (bf16_t*)(WT + (size_t)drow0 * K + 64 * kb); d.N = N; d.K = K; d.cc0 = -1; d.f8s = scale; return d;
}
__device__ __forceinline__ TDesc tr_decode(unsigned char* ws, int it) {
    const int l = 1 - it / IT_LAYER; int r = it % IT_LAYER;
    int which, K, N, kb, nb, drow0, cc0 = -1, es = 2; size_t soff, dbyte; float f8s = 0.f;
    if (r < IT_WIN) { which = I_WIN; soff = (size_t)l * 2048 * 6144; K = 2048; N = 6144; dbyte = WS_WIN + (size_t)l * 6144 * 2048 * 2; kb = r / 96; nb = r % 96; drow0 = 64 * nb; }
    else if ((r -= IT_WIN) < IT_WO) { which = I_WO; soff = (size_t)l * 1024 * 2048; K = 1024; N = 2048; dbyte = WS_WO + (size_t)l * 2048 * 1024 * 2; kb = r / 32; nb = r % 32; drow0 = 64 * nb; }
    else if ((r -= IT_WO) < IT_WGLU) { which = I_WGLU; soff = (size_t)l * 512 * 4096; K = 512; N = 4096; dbyte = WS_WGLU + (size_t)l * 4096 * 512 * 2; kb = r / 64; nb = r % 64; const int n0 = 64 * nb;
        drow0 = n0 < 2048 ? 256 * (n0 / 128) + (n0 % 128) : 256 * ((n0 - 2048) / 128) + 128 + (n0 % 128); }
    else if ((r -= IT_WGLU) < IT_WMIX) { which = I_WMIX; soff = (size_t)l * 2048 * 2048; K = 2048; N = 2048; dbyte = WS_WMIX + (size_t)l * 2048 * 2048 * (MIX_F8 ? 1 : 2); kb = r / 32; nb = r % 32; drow0 = 64 * nb;
        if (MIX_F8) { es = 1; f8s = pg8::WGU_SCALE; } }
    else { r -= IT_WMIX;
        const size_t wgu = WS_WGU + (size_t)l * 65 * 1024 * 2048;
        constexpr int DES = DOWN_F8 ? 1 : 2; const size_t wd = WS_WD + (size_t)l * 65 * 2048 * 512 * DES;
        if (r < 2 * IT_EXP) { const int up = r >= IT_EXP; r -= up * IT_EXP; const int e = r / 128, q = r % 128; kb = q / 8; nb = q % 8; const int n0 = 64 * nb;
            which = up ? I_WEU : I_WEG; soff = ((size_t)l * 64 + e) * 2048 * 512; K = 2048; N = 512; dbyte = wgu + (size_t)e * 1024 * 2048; es = 1; f8s = pg8::WGU_SCALE; drow0 = 256 * (n0 / 128) + (n0 % 128) + 128 * up; }
        else if ((r -= 2 * IT_EXP) < IT_EXPD) { constexpr int QD = DOWN_F8 ? 128 : 256; const int e = r / QD, q = r % QD; kb = q / 32; nb = q % 32;
            which = I_WED; soff = ((size_t)l * 64 + e) * 512 * 2048; K = 512; N = 2048; dbyte = wd + (size_t)e * 2048 * 512 * DES; es = DES; f8s = DOWN_F8 ? pg8::WD_SCALE : 0.f; drow0 = 256 * (nb / 4); cc0 = 64 * (nb % 4); }
        else if ((r -= IT_EXPD) < 2 * IT_SH) { const int up = r >= IT_SH; r -= up * IT_SH; kb = r / 8; nb = r % 8; const int n0 = 64 * nb;
            which = up ? I_WSU : I_WSG; soff = (size_t)l * 2048 * 512; K = 2048; N = 512; dbyte = wgu + (size_t)64 * 1024 * 2048; es = 1; f8s = pg8::WGU_SCALE; drow0 = 256 * (n0 / 128) + (n0 % 128) + 128 * up; }
        else { r -= 2 * IT_SH; kb = r / 32; nb = r % 32;
            which = I_WSD; soff = (size_t)l * 512 * 2048; K = 512; N = 2048; dbyte = wd + (size_t)64 * 2048 * 512 * DES; es = DES; f8s = DOWN_F8 ? pg8::WD_SCALE : 0.f; drow0 = 256 * (nb / 4); cc0 = 64 * (nb % 4); } }
    const int kr = f8s != 0.f ? 128 : 64;
    TDesc d; d.src = arg_in(which) + soff + (size_t)(kr * kb) * N + 64 * nb; d.dst = (bf16_t*)(ws + dbyte + ((size_t)drow0 * K + kr * kb) * es); d.N = N; d.K = K; d.cc0 = cc0; d.f8s = f8s; return d;
}
__device__ __forceinline__ void mod_item(const Args& a, int it, int tid, LAS unsigned char* lds) {
    const int lane = tid & 63, wave = tid >> 6;
    const int l = it / 384, r = it % 384, ks = r / 48, cc = r % 48;
    const float* W = a.in[I_WADA] + (size_t)l * 2048 * 12288 + (size_t)(256 * ks + 32 * wave) * 12288 + 256 * cc + 4 * lane;
    const float* c0 = a.in[I_C] + 256 * ks + 32 * wave, *c1 = c0 + 2048;
    f32x4 a0 = {0.f, 0.f, 0.f, 0.f}, a1 = {0.f, 0.f, 0.f, 0.f};
#pragma unroll 1
    for (int h = 0; h < 2; ++h) { f32x4 w[16]; const GAS float* wp = (const GAS float*)W + (size_t)(16 * h) * 12288;
#pragma unroll
        for (int i = 0; i < 16; ++i) { w[i] = __builtin_nontemporal_load((const GAS f32x4*)wp); wp += 12288; }
#pragma unroll
        for (int i = 0; i < 16; ++i) { const float x0 = c0[16 * h + i], x1 = c1[16 * h + i]; const float s0 = x0 * fast_sigmoid(x0), s1 = x1 * fast_sigmoid(x1); a0 += w[i] * s0; a1 += w[i] * s1; } }
    LAS f32x4* red = (LAS f32x4*)lds;
    red[(wave * 2 + 0) * 64 + lane] = a0; red[(wave * 2 + 1) * 64 + lane] = a1;
    __syncthreads();
    { const int b = tid >> 8, col = tid & 255; LAS float* rf = (LAS float*)lds; float s = 0.f;
#pragma unroll
        for (int w8 = 0; w8 < 8; ++w8) s += rf[((w8 * 2 + b) * 64) * 4 + col];
        ((float*)(a.ws + WS_MODP))[((size_t)(ks * 2 + l) * 2 + b) * 12288 + 256 * cc + col] = s; }
    __syncthreads();
}
__device__ __forceinline__ void p0_items(const Args& a, int gw, int ngw, LAS float* scr, int lane) {
#pragma unroll 1
    for (int it = gw; it < IT_TR; it += ngw) { f32x4 v[16]; const TDesc d = tr_decode(a.ws, it);
        if (d.f8s != 0.f) { u32x2 o0[8], o1[8]; f32x4 w[16]; TDesc d2 = d; d2.src += (size_t)64 * d.N; tr_load(d, lane, v); tr_load(d2, lane, w);
            tr_half8(d, lane, scr, v, o0); tr_half8(d, lane, scr, w, o1); tr_store8(d, lane, o0, o1); }
        else { tr_load(d, lane, v); tr_finish(d, lane, scr, v); } }
}

__device__ __forceinline__ void cpow(float are, float aim, float dt, int n, float& pr, float& pi) {
    const float mag = __builtin_amdgcn_exp2f((float)n * dt * are * LOG2E);
    const double turns = (double)n * ((double)dt * (double)aim * 0.15915494309189535);
    const float fr = (float)(turns - __builtin_rint(turns));
    pr = mag * __builtin_amdgcn_cosf(fr); pi = mag * __builtin_amdgcn_sinf(fr);
}
__device__ __forceinline__ void ssm_tables(const Args& a, int l, int g, LAS unsigned char* lds, int tid) {
    LAS f32x2* Apow = (LAS f32x2*)lds;
    LAS f32x2* Bb = (LAS f32x2*)(lds + 65 * 64 * 8);
    LAS f32x2* Cc = (LAS f32x2*)(lds + 65 * 64 * 8 + 64 * 16 * 8);
    const int lg = l * 32 + g;
    const float* are_p = a.in[I_ARE] + lg * 64; const float* aim_p = a.in[I_AIM] + lg * 64;
    const float dt = __expf(a.in[I_LDT][lg]);
    unsigned char* tb = a.ws + WS_SSM + (size_t)lg * SSM_STRIDE;
    bf16_t* Et = (bf16_t*)(tb + SSM_E); bf16_t* Ft = (bf16_t*)(tb + SSM_F); bf16_t* Kt = (bf16_t*)(tb + SSM_KT); GAS f32x2* Pt = (GAS f32x2*)(tb + SSM_P);
    for (int idx = tid; idx < 65 * 64; idx += 512) { const int n = idx >> 6, p = idx & 63; float pr, pi; cpow(are_p[p], aim_p[p], dt, n, pr, pi); Apow[idx] = (f32x2){pr, pi}; }
    for (int idx = tid; idx < 64 * 64; idx += 512) { const int m = idx >> 6, p = idx & 63; float pr, pi; cpow(are_p[p], aim_p[p], dt, 64 * m, pr, pi); Pt[idx] = (f32x2){pr, pi}; }
    for (int idx = tid; idx < 64 * 16; idx += 512) { const int p = idx >> 4, c = idx & 15;
        const float ar = are_p[p], ai = aim_p[p]; float br, bi; cpow(ar, ai, dt, 1, br, bi);
        const float nr = br - 1.0f, ni = bi, den = ar * ar + ai * ai; const float fr = (nr * ar + ni * ai) / den, fi = (ni * ar - nr * ai) / den;
        const float b_r = a.in[I_BRE][(size_t)lg * 1024 + idx], b_i = a.in[I_BIM][(size_t)lg * 1024 + idx];
        Bb[idx] = (f32x2){fr * b_r - fi * b_i, fr * b_i + fi * b_r}; }
    for (int idx = tid; idx < 16 * 64; idx += 512) Cc[idx] = (f32x2){a.in[I_CRE][(size_t)lg * 1024 + idx], a.in[I_CIM][(size_t)lg * 1024 + idx]};
    __syncthreads();
    for (int idx = tid; idx < 128 * 128; idx += 512) { const int n = idx >> 7, k8 = idx & 127, ri = n >> 6, p = n & 63, s = k8 >> 1, c0 = (k8 & 1) * 8;
        const f32x2 ap = Apow[(63 - s) * 64 + p]; float v[8];
#pragma unroll
        for (int j = 0; j < 8; ++j) { const f32x2 b = Bb[p * 16 + c0 + j]; v[j] = ri ? (ap.x * b.y + ap.y * b.x) : (ap.x * b.x - ap.y * b.y); }
        u32x4 o; o.x = cvt_pk_bf16(v[0], v[1]); o.y = cvt_pk_bf16(v[2], v[3]); o.z = cvt_pk_bf16(v[4], v[5]); o.w = cvt_pk_bf16(v[6], v[7]);
        *(GAS u32x4*)(Et + (size_t)n * 1024 + k8 * 8) = o; }
    for (int idx = tid; idx < 1024 * 16; idx += 512) { const int n = idx >> 4, k8 = idx & 15, t = n >> 4, c = n & 15, ri = k8 >> 3, p0 = (k8 & 7) * 8; float v[8];
#pragma unroll
        for (int j = 0; j < 8; ++j) { const f32x2 ap = Apow[(t + 1) * 64 + p0 + j], cc = Cc[c * 64 + p0 + j]; v[j] = ri ? -(cc.x * ap.y + cc.y * ap.x) : (cc.x * ap.x - cc.y * ap.y); }
        u32x4 o; o.x = cvt_pk_bf16(v[0], v[1]); o.y = cvt_pk_bf16(v[2], v[3]); o.z = cvt_pk_bf16(v[4], v[5]); o.w = cvt_pk_bf16(v[6], v[7]);
        *(GAS u32x4*)(Ft + (size_t)n * 128 + k8 * 8) = o; }
    for (int idx = tid; idx < 65 * 16 * 2; idx += 512) { const int t1 = idx >> 5, c = (idx >> 1) & 15, c0 = (idx & 1) * 8; float v[8];
#pragma unroll
        for (int j = 0; j < 8; ++j) v[j] = 0.f;
        if (t1 > 0) for (int p = 0; p < 64; ++p) { const f32x2 ap = Apow[(t1 - 1) * 64 + p], cc = Cc[c * 64 + p]; const float cr = cc.x * ap.x - cc.y * ap.y, ci = cc.x * ap.y + cc.y * ap.x;
#pragma unroll
            for (int j = 0; j < 8; ++j) { const f32x2 b = Bb[p * 16 + c0 + j]; v[j] += cr * b.x - ci * b.y; } }
        u32x4 o; o.x = cvt_pk_bf16(v[0], v[1]); o.y = cvt_pk_bf16(v[2], v[3]); o.z = cvt_pk_bf16(v[4], v[5]); o.w = cvt_pk_bf16(v[6], v[7]);
        *(GAS u32x4*)(Kt + (size_t)(t1 * 16 + c) * 16 + c0) = o; }
    __syncthreads();
}

__device__ __forceinline__ void attn_unit(const bf16_t* __restrict__ proj, bf16_t* __restrict__ attn, const float* sinks, int unit, LAS unsigned char* lds, int tid_) {
    const int tid = opaque(tid_);
    const int b = unit >> 7, hk = (unit >> 5) & 3, nb = unit & 31;
    const int wave = __builtin_amdgcn_readfirstlane(tid >> 6), lane = tid & 63, r16 = lane & 15, q4 = lane >> 4;
    LAS unsigned char* Kl = lds;
    LAS unsigned char* Vt = lds + 36864;
    const int gh0 = wave >> 1, half0 = wave & 1, qh0 = hk * 4 + gh0;
    bf16x8 qfa[4][2];
#pragma unroll
    for (int pass = 0; pass < 4; ++pass)
#pragma unroll
        for (int s = 0; s < 2; ++s) qfa[pass][s] = *(const GAS bf16x8*)(proj + (size_t)(b * SEQ + nb * 128 + 16 * (half0 * 4 + pass) + r16) * INW + O_Q + qh0 * 64 + 32 * s + 8 * q4);
#pragma unroll
    for (int i = 0; i < 4; ++i) { const int id = tid + 512 * i, key = id >> 3, ch = id & 7; const int tp = nb * 128 - 128 + key;
        u32x4 kv = {0u, 0u, 0u, 0u}, vv = {0u, 0u, 0u, 0u};
        if (tp >= 0) { const bf16_t* src = proj + (size_t)(b * SEQ + tp) * INW + hk * 64 + ch * 8; kv = *(const GAS u32x4*)(src + O_K); vv = *(const GAS u32x4*)(src + O_V); }
        *(LAS u32x4*)(Kl + key * 144 + ch * 16) = kv;
        LAS bf16_t* vd = (LAS bf16_t*)(Vt + (ch * 8) * 528 + key * 2);
        vd[0 * 264] = (bf16_t)(vv.x & 0xffff); vd[1 * 264] = (bf16_t)(vv.x >> 16); vd[2 * 264] = (bf16_t)(vv.y & 0xffff); vd[3 * 264] = (bf16_t)(vv.y >> 16);
        vd[4 * 264] = (bf16_t)(vv.z & 0xffff); vd[5 * 264] = (bf16_t)(vv.z >> 16); vd[6 * 264] = (bf16_t)(vv.w & 0xffff); vd[7 * 264] = (bf16_t)(vv.w >> 16); }
    __syncthreads();
    const int gh = wave >> 1, half = wave & 1, qh = hk * 4 + gh;
    const float sink = sinks[qh] * LOG2E;
#pragma unroll
    for (int pass = 0; pass < 4; ++pass) {
        const int kt0 = half * 4 + pass, i0 = 16 * kt0, iabs = i0 + r16; const size_t qtok = (size_t)(b * SEQ + nb * 128 + iabs);
        bf16x8 qf[2];
#pragma unroll
        for (int s = 0; s < 2; ++s) qf[s] = qfa[pass][s];
        __builtin_amdgcn_sched_barrier(0);
        f32x4 st[10];
        const LAS unsigned char* kbase = Kl + (16 * kt0 + r16) * 144 + (8 * q4) * 2;
#pragma unroll
        for (int i = 0; i < 9; ++i) { st[i] = (f32x4){0.f, 0.f, 0.f, 0.f};
#pragma unroll
            for (int s = 0; s < 2; ++s) { const bf16x8 kf = *(const LAS bf16x8*)(kbase + i * 16 * 144 + s * 64);
                st[i] = __builtin_amdgcn_mfma_f32_16x16x32_bf16(kf, qf[s], st[i], 0, 0, 0); } }
        st[9] = (f32x4){0.f, 0.f, 0.f, 0.f};
        float mx = sink;
#pragma unroll
        for (int i = 0; i < 9; ++i)
#pragma unroll
            for (int r = 0; r < 4; ++r) { const int jj = 16 * i + 4 * q4 + r; const bool ok = (jj > r16) && (jj <= r16 + 128) && (nb > 0 || jj + i0 >= 128);
                st[i][r] = ok ? st[i][r] : -1e30f; mx = fmaxf(mx, st[i][r]); }
        mx = fmaxf(mx, __shfl_xor(mx, 16)); mx = fmaxf(mx, __shfl_xor(mx, 32));
        float sum = 0.f;
#pragma unroll
        for (int i = 0; i < 9; ++i)
#pragma unroll
            for (int r = 0; r < 4; ++r) { const float p = __builtin_amdgcn_exp2f(st[i][r] - mx); st[i][r] = p; sum += p; }
        sum += __shfl_xor(sum, 16); sum += __shfl_xor(sum, 32);
        const float inv = __builtin_amdgcn_rcpf(sum + __builtin_amdgcn_exp2f(sink - mx));
        f32x4 ot[4];
#pragma unroll
        for (int dt = 0; dt < 4; ++dt) ot[dt] = (f32x4){0.f, 0.f, 0.f, 0.f};
#pragma unroll
        for (int kk = 0; kk < 5; ++kk) {
            u32x4 pw; pw.x = cvt_pk_bf16(st[2 * kk][0], st[2 * kk][1]); pw.y = cvt_pk_bf16(st[2 * kk][2], st[2 * kk][3]); pw.z = cvt_pk_bf16(st[2 * kk + 1][0], st[2 * kk + 1][1]); pw.w = cvt_pk_bf16(st[2 * kk + 1][2], st[2 * kk + 1][3]);
            const bf16x8 pf = __builtin_bit_cast(bf16x8, pw);
            const int t0 = kt0 + 2 * kk, t1 = (t0 + 1) < 15 ? (t0 + 1) : 15;
#pragma unroll
            for (int dt = 0; dt < 4; ++dt) { const LAS unsigned char* vp = Vt + (16 * dt + r16) * 528 + (4 * q4) * 2;
                const u32x2 lo = *(const LAS u32x2*)(vp + t0 * 32), hi = *(const LAS u32x2*)(vp + t1 * 32);
                const u32x4 vw = {lo.x, lo.y, hi.x, hi.y};
                ot[dt] = __builtin_amdgcn_mfma_f32_16x16x32_bf16(__builtin_bit_cast(bf16x8, vw), pf, ot[dt], 0, 0, 0); } }
#pragma unroll
        for (int dt = 0; dt < 4; ++dt) { u32x2 o; o.x = cvt_pk_bf16(ot[dt][0] * inv, ot[dt][1] * inv); o.y = cvt_pk_bf16(ot[dt][2] * inv, ot[dt][3] * inv);
            *(GAS u32x2*)(attn + qtok * 1024 + qh * 64 + 16 * dt + 4 * q4) = o; }
    }
    __syncthreads();
}

constexpr int UPITCH = 2064;
__device__ __forceinline__ void stage_u_issue(const bf16_t* __restrict__ proj, int g, int b, int q, int tid, u32x4 (&uu)[4]) {
#pragma unroll
    for (int i = 0; i < 4; ++i) { const int id = tid + 512 * i, tl = id >> 1, half = id & 1, chunk = tl >> 6, s = tl & 63;
        uu[i] = *(const GAS u32x4*)(proj + (size_t)(b * SEQ + (16 * q + chunk) * 64 + s) * INW + O_U + g * 16 + 8 * half); }
}
__device__ __forceinline__ void stage_u_commit(LAS unsigned char* Al, int tid, u32x4 (&uu)[4]) {
    asm volatile("" : "+v"(uu[0]), "+v"(uu[1]), "+v"(uu[2]), "+v"(uu[3]) :: "memory");
#pragma unroll
    for (int i = 0; i < 4; ++i) { const int id = tid + 512 * i, tl = id >> 1, half = id & 1, chunk = tl >> 6, s = tl & 63;
        *(LAS u32x4*)(Al + chunk * UPITCH + (s * 16 + 8 * half) * 2) = uu[i]; }
}
__device__ __forceinline__ void ssm_s1_unit(const bf16_t* __restrict__ proj, const bf16_t* __restrict__ Et, float* __restrict__ sloc, int g, int b, int q, LAS unsigned char* lds, int tid_) {
    const int tid = opaque(tid_);
    const int wave = __builtin_amdgcn_readfirstlane(tid >> 6), lane = tid & 63, r16 = lane & 15, q4 = lane >> 4;
    const bf16_t* eb = Et + (size_t)(16 * wave + r16) * 1024 + 8 * q4;
    u32x4 uu[4]; stage_u_issue(proj, g, b, q, tid, uu);
    bf16x8 bf[32];
#pragma unroll
    for (int ks = 0; ks < 32; ++ks) bf[ks] = *(const GAS bf16x8*)(eb + 32 * ks);
    stage_u_commit(lds, tid, uu);
    __syncthreads();
    f32x4 acc = {0.f, 0.f, 0.f, 0.f};
#pragma unroll
    for (int ks = 0; ks < 32; ++ks) { const bf16x8 af = *(const LAS bf16x8*)(lds + r16 * UPITCH + (32 * ks + 8 * q4) * 2);
        acc = __builtin_amdgcn_mfma_f32_16x16x32_bf16(af, bf[ks], acc, 0, 0, 0); }
#pragma unroll
    for (int r = 0; r < 4; ++r) sloc[((size_t)(b * 64 + 16 * q + 4 * q4 + r) * 32 + g) * 128 + 16 * wave + r16] = acc[r];
    __syncthreads();
}

__device__ __forceinline__ void ssm_s2_unit(const bf16_t* __restrict__ proj, const unsigned char* __restrict__ tb, const float* __restrict__ sloc, const float* __restrict__ dskip, bf16_t* __restrict__ ybuf,
                                            int g, int b, int q, LAS unsigned char* lds, int tid_, int nostore = 0) {
    const int tid = opaque(tid_);
    const int wave = __builtin_amdgcn_readfirstlane(tid >> 6), lane = tid & 63, r16 = lane & 15, q4 = lane >> 4;
    LAS unsigned char* Ktl = lds;
    LAS bf16_t* x0l = (LAS bf16_t*)(lds + 33280);
    LAS unsigned char* Al = lds + 49152;
    const bf16_t* Ft = (const bf16_t*)(tb + SSM_F); const GAS f32x2* Pt = (const GAS f32x2*)(tb + SSM_P);
    const int p = tid & 63, part = tid >> 6, j0 = 16 * q;
    f32x2 Pp[6]; float srp[6], sip[6];
#pragma unroll
    for (int ii = 0; ii < 6; ++ii) { const int i = part + 8 * ii; const bool ok = i < j0; const int ic = ok ? i : 0, pc = ok ? (j0 - 1 - i) : 0;
        Pp[ii] = Pt[pc * 64 + p]; const GAS float* sp = (const GAS float*)(sloc + ((size_t)(b * 64 + ic) * 32 + g) * 128); srp[ii] = sp[p]; sip[ii] = sp[64 + p]; }
    u32x4 kt[5];
    { const GAS u32x4* src = (const GAS u32x4*)(tb + SSM_KT);
#pragma unroll
      for (int j = 0; j < 5; ++j) { const int i = tid + 512 * j; kt[j] = src[i < 33280 / 16 ? i : 33280 / 16 - 1]; } }
    u32x4 uu[4]; stage_u_issue(proj, g, b, q, tid, uu);
    const f32x2 A64 = Pt[64 + p];
    float sr[15], si[15];
#pragma unroll
    for (int jq = 0; jq < 15; ++jq) { const GAS float* sp = (const GAS float*)(sloc + ((size_t)(b * 64 + j0 + jq) * 32 + g) * 128); sr[jq] = sp[p]; si[jq] = sp[64 + p]; }
    bf16x8 ff[4][8];
#pragma unroll
    for (int k2 = 0; k2 < 4; ++k2)
#pragma unroll
        for (int tt = 0; tt < 8; ++tt) ff[k2][tt] = *(const GAS bf16x8*)(Ft + (size_t)((wave + 8 * tt) * 16 + r16) * 128 + 32 * k2 + 8 * q4);
    {
        LAS f32x2* red = (LAS f32x2*)(lds + 40960);
        asm volatile("" : "+v"(Pp[0]), "+v"(Pp[1]), "+v"(Pp[2]), "+v"(Pp[3]), "+v"(Pp[4]), "+v"(Pp[5]) :: "memory");
        asm volatile("" : "+v"(srp[0]), "+v"(srp[1]), "+v"(srp[2]), "+v"(srp[3]), "+v"(srp[4]), "+v"(srp[5]), "+v"(sip[0]), "+v"(sip[1]), "+v"(sip[2]), "+v"(sip[3]), "+v"(sip[4]), "+v"(sip[5]) :: "memory");
        float xr = 0.f, xi = 0.f;
#pragma unroll
        for (int ii = 0; ii < 6; ++ii) { const bool ok = part + 8 * ii < j0; const float pr = ok ? Pp[ii].x : 0.f, pi = ok ? Pp[ii].y : 0.f;
            xr += pr * srp[ii] - pi * sip[ii]; xi += pr * sip[ii] + pi * srp[ii]; }
        red[part * 64 + p] = (f32x2){xr, xi};
        asm volatile("" : "+v"(kt[0]), "+v"(kt[1]), "+v"(kt[2]), "+v"(kt[3]), "+v"(kt[4]) :: "memory");
#pragma unroll
        for (int j = 0; j < 5; ++j) { const int i = tid + 512 * j; if (i < 33280 / 16) *(LAS u32x4*)(Ktl + i * 16) = kt[j]; }
        stage_u_commit(Al, tid, uu);
        __syncthreads();
        if (part == 0) {
            float ar = 0.f, ai = 0.f;
#pragma unroll
            for (int w8 = 0; w8 < 8; ++w8) { const f32x2 t = red[w8 * 64 + p]; ar += t.x; ai += t.y; }
#pragma unroll
            for (int jq = 0; jq < 16; ++jq) {
                x0l[jq * 136 + p] = (bf16_t)(cvt_pk_bf16(ar, 0.f) & 0xffff); x0l[jq * 136 + 64 + p] = (bf16_t)(cvt_pk_bf16(ai, 0.f) & 0xffff);
                if (jq < 15) { const float nr = A64.x * ar - A64.y * ai + sr[jq], ni = A64.x * ai + A64.y * ar + si[jq]; ar = nr; ai = ni; } }
        }
    }
    __syncthreads();
    f32x4 acc[8];
#pragma unroll
    for (int tt = 0; tt < 8; ++tt) acc[tt] = (f32x4){0.f, 0.f, 0.f, 0.f};
#pragma unroll 2
    for (int ks = 0; ks < 32; ++ks) { const int s = 2 * ks + (q4 >> 1);
        const bf16x8 af = *(const LAS bf16x8*)(Al + r16 * UPITCH + (32 * ks + 8 * q4) * 2);
#pragma unroll
        for (int tt = 0; tt < 8; ++tt) { const int t = wave + 8 * tt;
            const int tau1 = t - s + 1, tc = tau1 > 0 ? tau1 : 0;
            const bf16x8 bf = *(const LAS bf16x8*)(Ktl + ((tc * 16 + r16) * 16 + 8 * (q4 & 1)) * 2);
            acc[tt] = __builtin_amdgcn_mfma_f32_16x16x32_bf16(af, bf, acc[tt], 0, 0, 0); }
        __builtin_amdgcn_sched_barrier(0); }
#pragma unroll
    for (int k2 = 0; k2 < 4; ++k2) { const bf16x8 ax = *(const LAS bf16x8*)(x0l + r16 * 136 + 32 * k2 + 8 * q4);
#pragma unroll
        for (int tt = 0; tt < 8; ++tt) acc[tt] = __builtin_amdgcn_mfma_f32_16x16x32_bf16(ax, ff[k2][tt], acc[tt], 0, 0, 0); }
    const float dsk = dskip[g * 16 + r16];
#pragma unroll
    for (int tt = 0; tt < 8; ++tt) { const int t = wave + 8 * tt;
#pragma unroll
        for (int r = 0; r < 4; ++r) { const int jq = 4 * q4 + r; const size_t tok = (size_t)(b * SEQ + (16 * q + jq) * 64 + t);
            const float uv = bf1(*(const LAS bf16_t*)(Al + jq * UPITCH + (t * 16 + r16) * 2)); const float y = acc[tt][r] + dsk * uv;
            const float z = 0.7978845608028654f * (y + 0.044715f * y * y * y); const float gl = y * fast_sigmoid(2.0f * z);
            if (!nostore) ybuf[tok * 512 + g * 16 + r16] = (bf16_t)(cvt_pk_bf16(gl, 0.f) & 0xffff); } }
    __syncthreads();
}

__device__ __forceinline__ unsigned char* opaque_p(unsigned char* p) { asm volatile("" : "+s"(p)); return p; }
__device__ __forceinline__ int opaque_si(int v) { asm volatile("" : "+s"(v)); return v; }
__device__ __forceinline__ Args load_args() {
#if defined(__HIP_DEVICE_COMPILE__)
    KArgs* p = (KArgs*)__builtin_amdgcn_kernarg_segment_ptr(); asm volatile("" : "+s"(p)); Args a;
#pragma unroll
    for (int i = 0; i < 29; ++i) a.in[i] = p->in[i];
    a.out = p->out; a.ws = p->ws; a.ph_lo = p->ph_lo; a.ph_hi = p->ph_hi; return a;
#else
    return Args{};
#endif
}
#define PH_BEGIN const unsigned long long ph_t0 = (TIME_MASK) ? __builtin_amdgcn_s_memtime() : 0ull; (void)ph_t0; const Args args = load_args(); const int G = opaque_si(G_k), blk = opaque_si(blk_k); const int wave = opaque_si(wave_k); const int tid = opaque(lane_now() + 64 * wave), lane = tid & 63; unsigned char* const ws = opaque_p(args.ws); (void)lane; (void)wave; \
    bf16_t* const hbuf = (bf16_t*)(ws + WS_H); bf16_t* const proj = (bf16_t*)(ws + WS_PROJ); float* const mod = (float*)(ws + WS_MOD); float* const xbuf = args.out; unsigned* const ctl = (unsigned*)(ws + WS_CTL); \
    (void)hbuf; (void)proj; (void)mod; (void)xbuf; (void)ctl;

__global__ void __launch_bounds__(NWAVES * 64, 2) mega_fwd(Args args) {
    extern __shared__ __attribute__((aligned(16))) unsigned char lds_raw[];
    LAS unsigned char* lds = (LAS unsigned char*)lds_raw;
    const int wave_k = __builtin_amdgcn_readfirstlane((int)threadIdx.x >> 6);
    const int G_k = gridDim.x, blk_k = blockIdx.x;
    XcdBarrier bar;
    {
        volatile LAS unsigned* MISC = (volatile LAS unsigned*)(lds + MISC_OFF);
        unsigned* ctl0 = (unsigned*)(args.ws + WS_CTL);
        for (int u = threadIdx.x; u < (LDS_BYTES - LDSCTL_OFF) / 4; u += NWAVES * 64) ((LAS unsigned*)(lds + LDSCTL_OFF))[u] = 0u;
        __syncthreads();
        bar.bar = ctl0 + CW_BAR; bar.x = 0; bar.st = nullptr; bar.wv = wave_k;
        if (N_LAUNCHES == 1) bar = xcd_barrier_post(ctl0 + CW_BAR, MISC + 8);
    }
#define GRID_BAR() do { if (N_LAUNCHES == 1) xcd_barrier(bar); } while (0)
    const int lo = args.ph_lo, hi = args.ph_hi;
#ifndef PH_MASK
#define PH_MASK 0x7ff
#endif
#ifndef REP_MASK
#define REP_MASK 0
#endif
#ifndef REP_VARIANT
#define REP_VARIANT 0
#endif
#define REPS(bit) (((REP_MASK) >> (bit)) & 1 ? 2 : 1)
#ifndef TIME_MASK
#define TIME_MASK 0
#endif
#define PH_END(bit) if ((TIME_MASK >> (bit)) & 1) { asm volatile("s_waitcnt vmcnt(0) lgkmcnt(0)" ::: "memory"); const unsigned long long t1_ = __builtin_amdgcn_s_memtime(); \
    while (__builtin_amdgcn_s_memtime() - t1_ < t1_ - ph_t0) __builtin_amdgcn_s_sleep(8); }
#define IN(k) (lo <= (k) && (k) < hi)
#define BOTH(k) (IN(k) && IN((k) + 1))

    if ((PH_MASK & 1) && IN(0)) {
        PH_BEGIN
            _Pragma("unroll 1") for (int rep = 0; rep < REPS(9); ++rep) {
        if (blk < 64) ssm_tables(args, blk >> 5, blk & 31, lds, tid);
        LAS float* scr = (LAS float*)(lds + wave * 16384);
        for (int idx = blk * 512 + tid; idx < 2 * 64 * 256; idx += G * 512) {
            const int e = idx & 63, kc = (idx >> 6) & 255, l = idx >> 14; const float* wsrc = args.in[I_WR] + (size_t)l * D * NE + (size_t)(8 * kc) * NE + e;
            float w[8], lo[8]; unsigned hi[4];
#pragma unroll
            for (int i = 0; i < 8; ++i) w[i] = wsrc[i * NE];
#pragma unroll
            for (int i = 0; i < 4; ++i) { hi[i] = cvt_pk_bf16(w[2 * i], w[2 * i + 1]); lo[2 * i] = w[2 * i] - bf_lo(hi[i]); lo[2 * i + 1] = w[2 * i + 1] - bf_hi(hi[i]); }
            bf16_t* dsth = (bf16_t*)(ws + WS_WRT) + ((size_t)(l * 2) * 64 + e) * 2048 + 8 * kc;
            *(GAS u32x4*)dsth = (u32x4){hi[0], hi[1], hi[2], hi[3]};
            *(GAS u32x4*)(dsth + 64 * 2048) = (u32x4){cvt_pk_bf16(lo[0], lo[1]), cvt_pk_bf16(lo[2], lo[3]), cvt_pk_bf16(lo[4], lo[5]), cvt_pk_bf16(lo[6], lo[7])}; }
        for (int it = blk; it < IT_MOD; it += G) mod_item(args, it, tid, lds);
        p0_items(args, blk * NWAVES + wave, G * NWAVES, scr, lane);
            if (rep + 1 < REPS(9)) GRID_BAR(); }
        PH_END(9) if (BOTH(0)) GRID_BAR();
    }
    if ((PH_MASK & 2) && IN(1)) {
        PH_BEGIN
        const float* modp = (const float*)(ws + WS_MODP);
        for (int idx = blk * 512 + tid; idx < 2 * 2 * 12288; idx += G * 512) { const int l = idx / 24576, c = idx % 12288; float s = args.in[I_BADA][l * 12288 + c];
#pragma unroll
            for (int ks = 0; ks < 8; ++ks) s += modp[(size_t)ks * 49152 + idx];
            mod[idx] = s; }
        for (int rb = blk; rb < T / 32; rb += G) {
            const int bb = (rb * 32) / SEQ;
            LAS float* shl = (LAS float*)lds; LAS float* scl = shl + 2048;
            for (int c = tid; c < 4096; c += 512) { float s = args.in[I_BADA][c];
#pragma unroll
                for (int ks = 0; ks < 8; ++ks) s += modp[(size_t)ks * 49152 + bb * 12288 + c];
                shl[c] = s; }
            __syncthreads();
#pragma unroll 1
            for (int pr = 0; pr < 2; ++pr) {
                f32x4 v[2][4][2]; float ss[2] = {0.f, 0.f};
#pragma unroll
                for (int rr = 0; rr < 2; ++rr) { const float* xr = args.in[I_X] + (size_t)(rb * 32 + wave * 4 + pr * 2 + rr) * D;
#pragma unroll
                    for (int j = 0; j < 4; ++j)
#pragma unroll
                        for (int h = 0; h < 2; ++h) v[rr][j][h] = *(const GAS f32x4*)(xr + 8 * (lane + 64 * j) + 4 * h); }
#pragma unroll
                for (int rr = 0; rr < 2; ++rr)
#pragma unroll
                    for (int j = 0; j < 4; ++j)
#pragma unroll
                        for (int h = 0; h < 2; ++h) ss[rr] += v[rr][j][h][0] * v[rr][j][h][0] + v[rr][j][h][1] * v[rr][j][h][1] + v[rr][j][h][2] * v[rr][j][h][2] + v[rr][j][h][3] * v[rr][j][h][3];
#pragma unroll
                for (int rr = 0; rr < 2; ++rr) { const int row = rb * 32 + wave * 4 + pr * 2 + rr;
                    const float rstd = 1.0f / sqrtf(wave_sum(ss[rr]) * (1.0f / D) + NORM_EPS);
                    bf16_t* hrow = hbuf + (size_t)row * D;
#pragma unroll
                    for (int j = 0; j < 4; ++j) { const int c = 8 * (lane + 64 * j); f32x4 o[2];
#pragma unroll
                        for (int h = 0; h < 2; ++h) { const f32x4 g = *(const GAS f32x4*)(args.in[I_NMIX] + c + 4 * h); const f32x4 s1 = *(const LAS f32x4*)(scl + c + 4 * h), s0 = *(const LAS f32x4*)(shl + c + 4 * h);
                            o[h] = v[rr][j][h] * rstd * g * (s1 + 1.0f) + s0; }
                        *(GAS u32x4*)(hrow + c) = pg8::pack8(o[0], o[1]); } } }
            __syncthreads();
        }
        PH_END(10) if (BOTH(1)) GRID_BAR();
    }

#pragma unroll 1
    for (int l = 0; l < DEPTH; ++l) {
        const int pb = 2 + 9 * l;
        if ((PH_MASK & 4) && IN(pb + 0)) {
            PH_BEGIN
            _Pragma("unroll 1") for (int rep = 0; rep < REPS(0); ++rep) {
            pg8::DenseOrder S; S.init(T, INW, D, G, blk, (bf16_t*)(ws + WS_WIN) + (size_t)l * INW * D);
            pg8::EpiInProj E{proj, args.in[I_BIN] + l * INW, 0.125f * LOG2E, (REP_VARIANT && rep == 1) ? 1 : 0};
            pg8::gemm_phase<pg8::EpiInProj, pg8::DenseOrder, GEMM_ALIGN>(lds, (const char*)hbuf, D, S, E, wave);
            if (rep + 1 < REPS(0)) GRID_BAR(); }
            PH_END(0) if (BOTH(pb + 0)) GRID_BAR();
        }
        if ((PH_MASK & 8) && IN(pb + 1)) {
            PH_BEGIN
            _Pragma("unroll 1") for (int rep = 0; rep < REPS(1); ++rep) {
            for (int u = blk; u < 256; u += G) attn_unit(proj, (bf16_t*)(ws + WS_ATTN), args.in[I_SINK] + l * 16, u, lds, tid);
            if (!(REP_VARIANT == 1 && rep == 1)) for (int u = blk; u < 256; u += G) { const int g = u >> 3, b = (u >> 2) & 1, q = u & 3;
                ssm_s1_unit(proj, (const bf16_t*)(ws + WS_SSM + (size_t)(l * 32 + g) * SSM_STRIDE + SSM_E), (float*)(ws + WS_SLOC), g, b, q, lds, tid); }
            if (rep + 1 < REPS(1)) GRID_BAR(); }
            PH_END(1) if (BOTH(pb + 1)) GRID_BAR();
        }
        if ((PH_MASK & 16) && IN(pb + 2)) {
            PH_BEGIN
            _Pragma("unroll 1") for (int rep = 0; rep < REPS(2); ++rep) {
            if (!(REP_VARIANT == 1 && rep == 1)) for (int u = blk; u < 256; u += G) { const int g = u >> 3, b = (u >> 2) & 1, q = u & 3;
                ssm_s2_unit(proj, ws + WS_SSM + (size_t)(l * 32 + g) * SSM_STRIDE, (const float*)(ws + WS_SLOC), args.in[I_SD] + l * 512, (bf16_t*)(ws + WS_Y), g, b, q, lds, tid, (REP_VARIANT == 2 && rep == 1) ? 1 : 0); }
            pg8::DenseOrder S; S.init(T, D, 1024, G, blk, (bf16_t*)(ws + WS_WO) + (size_t)l * D * 1024);
            pg8::EpiAttnProj E{proj, (bf16_t*)(ws + WS_MIXED)};
            pg8::gemm_phase<pg8::EpiAttnProj, pg8::DenseOrder>(lds, (const char*)(ws + WS_ATTN), 1024, S, E, wave);
            if (rep + 1 < REPS(2)) GRID_BAR(); }
            PH_END(2) if (BOTH(pb + 2)) GRID_BAR();
        }
        if ((PH_MASK & 32) && IN(pb + 3)) {
            PH_BEGIN
            const int nrep = REPS(3);
            _Pragma("unroll 1") for (int rep = 0; rep < nrep; ++rep) {
            pg8::DenseOrder S; S.init(T, 4096, 512, G, blk, (bf16_t*)(ws + WS_WGLU) + (size_t)l * 4096 * 512);
            pg8::EpiGlu E{proj, (const bf16_t*)(ws + WS_MIXED), (bf16_t*)(ws + WS_MIXED2)};
            pg8::gemm_phase<pg8::EpiGlu, pg8::DenseOrder, GEMM_ALIGN>(lds, (const char*)(ws + WS_Y), 512, S, E, wave);
            if (rep + 1 < nrep) GRID_BAR(); }
            PH_END(3) if (BOTH(pb + 3)) GRID_BAR();
        }
        if ((PH_MASK & 64) && IN(pb + 4)) {
            PH_BEGIN
            const int nrep = (l == 0 ? REPS(4) : 1);
            _Pragma("unroll 1") for (int rep = 0; rep < nrep; ++rep) {
            pg8::DenseOrder S; S.init(T, D, MIX_F8 ? D / 2 : D, G, blk, ws + WS_WMIX + (size_t)l * D * D * (MIX_F8 ? 1 : 2));
            pg8::EpiMixOut E{l == 0 ? args.in[I_X] : (const float*)nullptr, (const bf16_t*)(ws + WS_XB), (bf16_t*)(ws + WS_XB), mod + (size_t)l * 2 * 12288 + 2 * 2048};
            pg8::gemm_phase<pg8::EpiMixOut, pg8::DenseOrder, false, GEMM_SP2, MIX_F8 != 0>(lds, (const char*)(ws + WS_MIXED2), MIX_F8 ? D / 2 : D, S, E, wave);
            if (rep + 1 < nrep) GRID_BAR(); }
            PH_END(4) if (BOTH(pb + 4)) GRID_BAR();
        }
        if ((PH_MASK & 128) && IN(pb + 5)) {
            PH_BEGIN
            const int nrep = REPS(5);
            _Pragma("unroll 1") for (int rep = 0; rep < nrep; ++rep) {
            const float* modl = mod + (size_t)l * 2 * 12288;
            int* ltok = (int*)(ws + WS_LTOK); int* ldst = (int*)(ws + WS_LDST); float* lw = (float*)(ws + WS_LW);
            LAS unsigned long long* selmask = (LAS unsigned long long*)(lds + SEL_OFF);
            LAS float* selw = (LAS float*)(lds + SEL_OFF + 256);
            const float* wrt = args.in[I_WR] + (size_t)l * D * NE; const float brt = args.in[I_BR][l * NE + lane];
            for (int rb = blk; rb < T / 32; rb += G) {
                const int bb = (rb * 32) / SEQ; const float* sh2 = modl + bb * 12288 + 3 * 2048; const float* sc2 = sh2 + 2048;
#pragma unroll 1
                for (int it = 0; it < 2; ++it) {
                    {
                        f32x4 v[2][4][2]; float ss[2] = {0.f, 0.f};
                        u32x4 xw[2][4]; f32x4 gsc[4][2], gsh[4][2], sc1[4][2];
#pragma unroll
                        for (int rr = 0; rr < 2; ++rr) { const bf16_t* xr = (const bf16_t*)(ws + WS_XB) + (size_t)(rb * 32 + it * 16 + 2 * wave + rr) * D;
#pragma unroll
                            for (int j = 0; j < 4; ++j) xw[rr][j] = *(const GAS u32x4*)(xr + 8 * (lane + 64 * j)); }
#pragma unroll
                        for (int j = 0; j < 4; ++j)
#pragma unroll
                            for (int h = 0; h < 2; ++h) { const int c = 8 * (lane + 64 * j) + 4 * h;
                                gsc[j][h] = *(const GAS f32x4*)(args.in[I_NFFN] + l * D + c); sc1[j][h] = *(const GAS f32x4*)(sc2 + c); gsh[j][h] = *(const GAS f32x4*)(sh2 + c); }
#pragma unroll
                        for (int rr = 0; rr < 2; ++rr) asm volatile("" : "+v"(xw[rr][0]), "+v"(xw[rr][1]), "+v"(xw[rr][2]), "+v"(xw[rr][3]) :: "memory");
#pragma unroll
                        for (int j = 0; j < 4; ++j) asm volatile("" : "+v"(gsc[j][0]), "+v"(gsc[j][1]), "+v"(sc1[j][0]), "+v"(sc1[j][1]), "+v"(gsh[j][0]), "+v"(gsh[j][1]) :: "memory");
#pragma unroll
                        for (int rr = 0; rr < 2; ++rr)
#pragma unroll
                            for (int j = 0; j < 4; ++j) pg8::unpack8(xw[rr][j], v[rr][j][0], v[rr][j][1]);
#pragma unroll
                        for (int j = 0; j < 4; ++j)
#pragma unroll
                            for (int h = 0; h < 2; ++h) gsc[j][h] = gsc[j][h] * (sc1[j][h] + 1.0f);
#pragma unroll
                        for (int rr = 0; rr < 2; ++rr)
#pragma unroll
                            for (int j = 0; j < 4; ++j)
#pragma unroll
                                for (int h = 0; h < 2; ++h) ss[rr] += v[rr][j][h][0] * v[rr][j][h][0] + v[rr][j][h][1] * v[rr][j][h][1] + v[rr][j][h][2] * v[rr][j][h][2] + v[rr][j][h][3] * v[rr][j][h][3];
#pragma unroll
                        for (int rr = 0; rr < 2; ++rr) { const int lr = 2 * wave + rr, row = rb * 32 + it * 16 + lr;
                            const float rstd = 1.0f / sqrtf(wave_sum(ss[rr]) * (1.0f / D) + NORM_EPS);
                            unsigned char* hrow8 = (unsigned char*)hbuf + (size_t)row * D;
#pragma unroll
                            for (int j = 0; j < 4; ++j) { const int c = 8 * (lane + 64 * j); f32x4 o[2];
#pragma unroll
                                for (int h = 0; h < 2; ++h) o[h] = v[rr][j][h] * rstd * gsc[j][h] + gsh[j][h];
                                const u32x4 hiw = pg8::pack8(o[0], o[1]); *(GAS u32x2*)(hrow8 + c) = (u32x2){pg8::pk_fp8x4(o[0]), pg8::pk_fp8x4(o[1])};
                                f32x4 h0, h1; pg8::unpack8(hiw, h0, h1); const u32x4 low = pg8::pack8(o[0] - h0, o[1] - h1);
                                const int so = lr * 4096 + (((lane + 64 * j) ^ lr) << 4);
                                *(LAS u32x4*)(lds + so) = hiw; *(LAS u32x4*)(lds + 65536 + so) = low; } }
                    }
                    f32x4 racc[4];
                    {
                        const GAS bf16_t* whi = (const GAS bf16_t*)(ws + WS_WRT) + (size_t)(l * 2) * 64 * 2048 + 256 * wave; const GAS bf16_t* wlo = whi + 64 * 2048;
                        const int lop = opaque(lane), r16 = lop & 15, q4 = lop >> 4;
#pragma unroll
                        for (int nt = 0; nt < 4; ++nt) racc[nt] = (f32x4){0.f, 0.f, 0.f, 0.f};
                        auto ldB = [&](int kp, bf16x8 (&bh)[2][4], bf16x8 (&bl)[2][4]) {
#pragma unroll
                            for (int k2 = 0; k2 < 2; ++k2)
#pragma unroll
                                for (int nt = 0; nt < 4; ++nt) { const size_t wo = (size_t)(16 * nt + r16) * 2048 + 32 * (2 * kp + k2) + 8 * q4; bh[k2][nt] = *(const GAS bf16x8*)(whi + wo); bl[k2][nt] = *(const GAS bf16x8*)(wlo + wo); } };
                        auto mm = [&](int kp, const bf16x8 (&bh)[2][4], const bf16x8 (&bl)[2][4]) {
#pragma unroll
                            for (int k2 = 0; k2 < 2; ++k2) { const int chunk = 32 * wave + 4 * (2 * kp + k2) + q4, so = r16 * 4096 + ((chunk ^ r16) << 4);
                                const bf16x8 ah = *(const LAS bf16x8*)(lds + so), al = *(const LAS bf16x8*)(lds + 65536 + so);
#pragma unroll
                                for (int nt = 0; nt < 4; ++nt) {
                                    racc[nt] = __builtin_amdgcn_mfma_f32_16x16x32_bf16(ah, bh[k2][nt], racc[nt], 0, 0, 0);
                                    racc[nt] = __builtin_amdgcn_mfma_f32_16x16x32_bf16(al, bh[k2][nt], racc[nt], 0, 0, 0);
                                    racc[nt] = __builtin_amdgcn_mfma_f32_16x16x32_bf16(ah, bl[k2][nt], racc[nt], 0, 0, 0); } } };
#define RT_FENCE() asm volatile("" ::: "memory")
#define RT_PIN() asm volatile("" : "+v"(racc[0]), "+v"(racc[1]), "+v"(racc[2]), "+v"(racc[3]) :: "memory")
                        bf16x8 bhA[2][4], blA[2][4], bhB[2][4], blB[2][4];
                        RT_FENCE(); ldB(0, bhA, blA); ldB(1, bhB, blB); RT_FENCE();
                        __syncthreads();
                        mm(0, bhA, blA); RT_PIN(); ldB(2, bhA, blA); RT_FENCE();
                        mm(1, bhB, blB); RT_PIN(); ldB(3, bhB, blB); RT_FENCE();
                        mm(2, bhA, blA); mm(3, bhB, blB);
#undef RT_FENCE
#undef RT_PIN
                    }
                    __syncthreads();
                    LAS float* part = (LAS float*)lds;
#pragma unroll
                    for (int nt = 0; nt < 4; ++nt)
#pragma unroll
                        for (int r = 0; r < 4; ++r) part[(wave * 16 + 4 * (lane >> 4) + r) * 64 + 16 * nt + (lane & 15)] = racc[nt][r];
                    __syncthreads();
#pragma unroll 1
                    for (int rr = 0; rr < 2; ++rr) { const int lr = 2 * wave + rr; float logit = 0.f;
#pragma unroll
                        for (int w8 = 0; w8 < 8; ++w8) logit += part[(w8 * 16 + lr) * 64 + lane];
                        const float score = 1.0f / (1.0f + __expf(-logit)); const float sel = score + brt;
                        float m1 = sel; m1 = fmaxf(m1, __shfl_xor(m1, 1)); m1 = fmaxf(m1, __shfl_xor(m1, 2)); m1 = fmaxf(m1, __shfl_xor(m1, 4));
                        const unsigned long long bm = __ballot(sel == m1); const unsigned gb = (unsigned)(bm >> (lane & 56)) & 0xffu; const int first = __builtin_ctz(gb);
                        float v2 = ((lane & 7) == first) ? -3.0e38f : sel; v2 = fmaxf(v2, __shfl_xor(v2, 1)); v2 = fmaxf(v2, __shfl_xor(v2, 2)); v2 = fmaxf(v2, __shfl_xor(v2, 4));
                        const float gs = m1 + v2; int grank = 0; const int mygrp = lane >> 3;
#pragma unroll
                        for (int gg = 0; gg < 8; ++gg) { const float o = __shfl(gs, gg * 8); grank += (o > gs || (o == gs && gg < mygrp)) ? 1 : 0; }
                        float val = grank < 4 ? sel : -3.0e38f; unsigned long long cm = 0ull;
#pragma unroll
                        for (int pick = 0; pick < 8; ++pick) {
                            float mxv = val;
#pragma unroll
                            for (int o = 1; o < 64; o <<= 1) mxv = fmaxf(mxv, __shfl_xor(mxv, o));
                            const unsigned long long bmx = __ballot(val == mxv); const int sl = __builtin_ctzll(bmx);
                            cm |= 1ull << sl; if (lane == sl) val = -3.4e38f; }
                        const bool chosen = (cm >> lane) & 1ull; const float sw = wave_sum(chosen ? score : 0.f);
                        const int gr = it * 16 + lr;
                        selw[gr * 64 + lane] = chosen ? score / sw * 2.5f : 0.f;
                        if (lane == 0) selmask[gr] = cm; }
                    __syncthreads();
                }
                if (wave == 0 && rep + 1 == nrep) {
                    int cntl = 0;
                    for (int r = 0; r < 32; ++r) cntl += (int)((selmask[r] >> lane) & 1ull);
                    int pos = cntl ? (int)atomicAdd(ctl + CW_CNT + l * 64 + opaque(lane), (unsigned)cntl) : 0;
                    for (int r = 0; r < 32; ++r) { const unsigned long long m = selmask[r];
                        if ((m >> lane) & 1ull) { const int k = __builtin_popcountll(m & ((1ull << lane) - 1ull)); const int tok = rb * 32 + r; const int li = lane * 8192 + pos;
                            ltok[li] = tok; ldst[li] = tok * NSLOT + k; ((float*)(ws + WS_TOKW))[tok * 8 + k] = selw[r * 64 + lane]; ++pos; } }
                }
                __syncthreads();
            }
            if (rep + 1 < nrep) GRID_BAR(); }
            PH_END(5) if (BOTH(pb + 5)) GRID_BAR();
        }
        if ((PH_MASK & 256) && IN(pb + 6)) {
            PH_BEGIN
            _Pragma("unroll 1") for (int rep = 0; rep < REPS(6); ++rep) {
            LAS int* tpre = (LAS int*)(lds + MOE_OFF); LAS int* ebase = tpre + 65; LAS int* ecnt = ebase + 65; LAS int* utab = (LAS int*)(lds + MOE_OFF + 1024);
            pg8::moe_build<4, true>(tpre, ebase, ecnt, utab, ctl + CW_CNT + l * 64, G, blk, tid);
            pg8::MoeOrder<4, true> S{utab, (const char*)(ws + WS_WGU + (size_t)l * 65 * 1024 * 2048), (size_t)1024 * 2048, (size_t)256 * 2048, (const int*)(ws + WS_LTOK)};
            pg8::EpiGateUp E{(unsigned char*)(ws + WS_HID)};
            pg8::gemm_phase<pg8::EpiGateUp, pg8::MoeOrder<4, true>, GEMM_ALIGN, GEMM_SP2, true>(lds, (const char*)hbuf, D / 2, S, E, wave);
            if (rep + 1 < REPS(6)) GRID_BAR(); }
            PH_END(6) if (BOTH(pb + 6)) GRID_BAR();
        }
        if ((PH_MASK & 512) && IN(pb + 7)) {
            PH_BEGIN
            _Pragma("unroll 1") for (int rep = 0; rep < REPS(7); ++rep) {
            LAS int* tpre = (LAS int*)(lds + MOE_OFF); LAS int* ebase = tpre + 65; LAS int* ecnt = ebase + 65; LAS int* utab = (LAS int*)(lds + MOE_OFF + 1024);
            pg8::moe_build<8, false>(tpre, ebase, ecnt, utab, ctl + CW_CNT + l * 64, G, blk, tid);
            constexpr size_t DB = DOWN_F8 ? 1 : 2;
            pg8::MoeOrder<8, false> S{utab, (const char*)(ws + WS_WD + (size_t)l * 65 * 2048 * 512 * DB), (size_t)2048 * 512 * DB, (size_t)256 * 512 * DB, (const int*)(ws + WS_LTOK)};
            pg8::EpiDown E{(unsigned char*)(ws + WS_YSLOT), (const int*)(ws + WS_LDST), (LAS int*)(lds + SEL_OFF), (REP_VARIANT && rep == 1) ? 1 : 0};
            pg8::gemm_phase<pg8::EpiDown, pg8::MoeOrder<8, false>, GEMM_ALIGN, GEMM_SP2, DOWN_F8 != 0>(lds, (const char*)(ws + WS_HID), DOWN_F8 ? 256 : 512, S, E, wave);
            if (rep + 1 < REPS(7)) GRID_BAR(); }
            PH_END(7) if (BOTH(pb + 7)) GRID_BAR();
        }
        if ((PH_MASK & 1024) && IN(pb + 8)) {
            PH_BEGIN
            const int nrep = REPS(8);
            _Pragma("unroll 1") for (int rep = 0; rep < nrep; ++rep) {
            const float* modl = mod + (size_t)l * 2 * 12288;
            const unsigned char* yslot = (const unsigned char*)(ws + WS_YSLOT);
            for (int run = blk * NWAVES + wave; run < T / 4; run += G * NWAVES) {
                const int bb = (run * 4) / SEQ; const float* gt2 = modl + bb * 12288 + 5 * 2048;
                const float* m1 = mod + (size_t)2 * 12288 + bb * 12288;
                f32x4 gtv[2][4];
#pragma unroll
                for (int jj = 0; jj < 2; ++jj)
#pragma unroll
                    for (int q = 0; q < 4; ++q) { const int c = 16 * (lane + 64 * jj) + 4 * q; gtv[jj][q] = *(const GAS f32x4*)(gt2 + c) * pg8::YS_INV; }
#pragma unroll 1
                for (int pr = 0; pr < 2; ++pr) {
                    f32x4 v[2][2][4]; float ss[2] = {0.f, 0.f};
                    const int rowb = run * 4 + pr * 2;
                    f32x4 tw[2][2];
#pragma unroll
                    for (int rr = 0; rr < 2; ++rr) { tw[rr][0] = *(const GAS f32x4*)((const float*)(ws + WS_TOKW) + (rowb + rr) * 8); tw[rr][1] = *(const GAS f32x4*)((const float*)(ws + WS_TOKW) + (rowb + rr) * 8 + 4); }
                    auto issue = [&](int rr, int jj, u32x4 (&w)[NSLOT], u32x4 (&xq)[2]) {
                        const int c = 16 * (lane + 64 * jj); const unsigned char* ys = yslot + (size_t)(rowb + rr) * NSLOT * D + c;
#pragma unroll
                        for (int k = 0; k < NSLOT; ++k) w[k] = *(const GAS u32x4*)(ys + (size_t)k * D);
                        const bf16_t* xr = (const bf16_t*)(ws + WS_XB) + (size_t)(rowb + rr) * D + c; xq[0] = *(const GAS u32x4*)xr; xq[1] = *(const GAS u32x4*)(xr + 8); };
                    auto consume = [&](int rr, int jj, const u32x4 (&w)[NSLOT], const u32x4 (&xq)[2]) {
                        f32x4 a[4];
#pragma unroll
                        for (int q = 0; q < 4; ++q) a[q] = (f32x4){0.f, 0.f, 0.f, 0.f};
#pragma unroll
                        for (int k = 0; k < NSLOT; ++k) { const float wk = k < 8 ? tw[rr][k >> 2][k & 3] : 1.0f;
#pragma unroll
                            for (int q = 0; q < 4; ++q) { const f32x2 lo = __builtin_amdgcn_cvt_pk_f32_fp8((int)w[k][q], false), hi = __builtin_amdgcn_cvt_pk_f32_fp8((int)w[k][q], true); a[q] += (f32x4){lo.x, lo.y, hi.x, hi.y} * wk; } }
                        f32x4 xv[4]; pg8::unpack8(xq[0], xv[0], xv[1]); pg8::unpack8(xq[1], xv[2], xv[3]);
#pragma unroll
                        for (int q = 0; q < 4; ++q) { v[rr][jj][q] = xv[q] + gtv[jj][q] * a[q];
                            ss[rr] += v[rr][jj][q][0] * v[rr][jj][q][0] + v[rr][jj][q][1] * v[rr][jj][q][1] + v[rr][jj][q][2] * v[rr][jj][q][2] + v[rr][jj][q][3] * v[rr][jj][q][3]; } };
                    {
                        u32x4 wA[NSLOT], xA[2], wB[NSLOT], xB[2];
#define CMB_FENCE() asm volatile("" ::: "memory")
#define CMB_PIN(x) asm volatile("" : "+v"(x) :: "memory")
                        issue(0, 0, wA, xA); issue(0, 1, wB, xB); CMB_FENCE();
                        consume(0, 0, wA, xA); CMB_PIN(ss[0]); issue(1, 0, wA, xA); CMB_FENCE();
                        consume(0, 1, wB, xB); CMB_PIN(ss[0]); issue(1, 1, wB, xB); CMB_FENCE();
                        consume(1, 0, wA, xA); consume(1, 1, wB, xB); CMB_PIN(ss[1]);
#undef CMB_FENCE
#undef CMB_PIN
                    }
                    f32x4 gs[2][4], gh[2][4];
                    if (l == 0) {
#pragma unroll
                        for (int jj = 0; jj < 2; ++jj)
#pragma unroll
                            for (int q = 0; q < 4; ++q) { const int c = 16 * (lane + 64 * jj) + 4 * q;
                                gs[jj][q] = *(const GAS f32x4*)(args.in[I_NMIX] + D + c) * (*(const GAS f32x4*)(m1 + 2048 + c) + 1.0f); gh[jj][q] = *(const GAS f32x4*)(m1 + c); }
                    } else {
#pragma unroll
                        for (int jj = 0; jj < 2; ++jj)
#pragma unroll
                            for (int q = 0; q < 4; ++q) { const int c = 16 * (lane + 64 * jj) + 4 * q; gs[jj][q] = *(const GAS f32x4*)(args.in[I_NFIN] + c); gh[jj][q] = (f32x4){0.f, 0.f, 0.f, 0.f}; }
                    }
#pragma unroll
                    for (int rr = 0; rr < 2; ++rr) { const int row = rowb + rr;
                        const float rstd = 1.0f / sqrtf(wave_sum(ss[rr]) * (1.0f / D) + NORM_EPS);
                        float* xw = (rep + 1 == nrep) ? xbuf + (size_t)row * D : (float*)(ws + WS_HID) + (size_t)row * D; bf16_t* hw = (rep + 1 == nrep) ? hbuf + (size_t)row * D : (bf16_t*)(ws + WS_MIXED2) + (size_t)row * D;
                        bf16_t* xbw = (rep + 1 == nrep) ? (bf16_t*)(ws + WS_XB) + (size_t)row * D : (bf16_t*)(ws + WS_MIXED) + (size_t)row * D;
                        if (l == 0) {
#pragma unroll
                            for (int jj = 0; jj < 2; ++jj) { const int c = 16 * (lane + 64 * jj); f32x4 o[4];
                                *(GAS u32x4*)(xbw + c) = pg8::pack8(v[rr][jj][0], v[rr][jj][1]); *(GAS u32x4*)(xbw + c + 8) = pg8::pack8(v[rr][jj][2], v[rr][jj][3]);
#pragma unroll
                                for (int q = 0; q < 4; ++q) o[q] = v[rr][jj][q] * rstd * gs[jj][q] + gh[jj][q];
                                *(GAS u32x4*)(hw + c) = pg8::pack8(o[0], o[1]); *(GAS u32x4*)(hw + c + 8) = pg8::pack8(o[2], o[3]); }
                        } else {
#pragma unroll
                            for (int jj = 0; jj < 2; ++jj) { const int c = 16 * (lane + 64 * jj);
#pragma unroll
                                for (int q = 0; q < 4; ++q) *(GAS f32x4*)(xw + c + 4 * q) = v[rr][jj][q] * rstd * gs[jj][q]; }
                        } }
                }
            }
            if (rep + 1 < nrep) GRID_BAR(); }
            PH_END(8) if (BOTH(pb + 8)) GRID_BAR();
        }
    }
#undef IN
#undef BOTH
#undef GRID_BAR
}

extern "C" void kernel_launch(void* const* d_in, const int* in_sizes, int n_in, void* d_out, int out_size, void* d_ws, size_t ws_size, hipStream_t stream) {
    static int grid = 0;
    if (grid == 0) {
        if (n_in != 29 || out_size != T * D || ws_size < WS_END) { fprintf(stderr, "kernel_launch: unexpected shapes (n_in %d out %d ws %zu)\n", n_in, out_size, ws_size); grid = -1; return; }
        int dev = 0, cus = 0, per_cu = 0;
        if (hipGetDevice(&dev) != hipSuccess || hipDeviceGetAttribute(&cus, hipDeviceAttributeMultiprocessorCount, dev) != hipSuccess) { grid = -1; return; }
        if (hipFuncSetAttribute((const void*)mega_fwd, hipFuncAttributeMaxDynamicSharedMemorySize, LDS_BYTES) != hipSuccess) { fprintf(stderr, "kernel_launch: hipFuncSetAttribute failed\n"); grid = -1; return; }
        if (hipOccupancyMaxActiveBlocksPerMultiprocessor(&per_cu, (const void*)mega_fwd, NWAVES * 64, LDS_BYTES) != hipSuccess || per_cu < 1) { fprintf(stderr, "kernel_launch: occupancy query says %d\n", per_cu); }
        (void)hipGetLastError();
        grid = cus & ~7;
    }
    if (grid < 0) return;
    (void)hipMemsetAsync((char*)d_ws + WS_CTL, 0, CTL_ZERO_BYTES, stream);
    Args a{};
    for (int i = 0; i < 29; ++i) a.in[i] = (const float*)d_in[i];
    a.out = (float*)d_out; a.ws = (unsigned char*)d_ws;
    if (N_LAUNCHES == 1) { a.ph_lo = 0; a.ph_hi = 20; hipLaunchKernelGGL(mega_fwd, dim3(grid), dim3(NWAVES * 64), LDS_BYTES, stream, a); }
    else { for (int p = 0; p < 20; ++p) { a.ph_lo = p; a.ph_hi = p + 1; hipLaunchKernelGGL(mega_fwd, dim3(grid), dim3(NWAVES * 64), LDS_BYTES, stream, a); } }
}
```

```cpp
#include <hip/hip_runtime.h>
#include <cstdio>
#include <cstdint>

#ifndef N_LAUNCHES
#define N_LAUNCHES 1
#endif
#ifndef GEMM_ALIGN
#define GEMM_ALIGN true
#endif
#ifndef GEMM_SP2
#define GEMM_SP2 true
#endif
#ifndef MOE_XCD
#define MOE_XCD 0
#endif
#ifndef F8_PIN
#define F8_PIN 1
#endif
#if F8_PIN == 1
#define F8_PIN_ASM(x) asm volatile("" : "+v"(x))
#elif F8_PIN == 2
#define F8_PIN_ASM(x) asm volatile("" : "+a"(x))
#else
#define F8_PIN_ASM(x) do {} while (0)
#endif
#ifndef DOWN_PRE
#define DOWN_PRE 1
#endif
#ifndef DOWN_F8
#define DOWN_F8 1
#endif
#ifndef MIX_F8
#define MIX_F8 1
#endif
#ifndef INP_F8
#define INP_F8 1
#endif

#define LAS __attribute__((address_space(3)))
#define GAS __attribute__((address_space(1)))
typedef unsigned short bf16_t;
typedef short bf16x8 __attribute__((ext_vector_type(8)));
typedef float f32x4 __attribute__((ext_vector_type(4)));
typedef float f32x2 __attribute__((ext_vector_type(2)));
typedef unsigned u32x4 __attribute__((ext_vector_type(4)));
typedef unsigned u32x2 __attribute__((ext_vector_type(2)));
typedef int i32x4 __attribute__((ext_vector_type(4)));
typedef int i32x8 __attribute__((ext_vector_type(8)));

constexpr int T = 8192, D = 2048, SEQ = 4096, DEPTH = 2;
constexpr int INW = 6144, O_Q = 0, O_K = 1024, O_V = 1280, O_U = 1536, O_GA = 2048, O_GS = 4096;
constexpr int NE = 64, NSLOT = 9;
constexpr float NORM_EPS = 1e-6f;
constexpr float LOG2E = 1.4426950408889634f;

constexpr size_t MiB = 1u << 20;
constexpr size_t WS_CTL = 0, CTL_ZERO_BYTES = 1 * MiB;
constexpr size_t WS_MODP = 1 * MiB;
constexpr size_t WS_MOD = 3 * MiB;
constexpr size_t WS_SSM = 4 * MiB;
constexpr size_t SSM_STRIDE = 640 * 1024, SSM_E = 0, SSM_F = 256 * 1024, SSM_KT = 512 * 1024, SSM_P = 560 * 1024;
constexpr size_t WS_WIN = 44 * MiB;
constexpr size_t WS_WO = 92 * MiB;
constexpr size_t WS_WGLU = 100 * MiB;
constexpr size_t WS_WMIX = 108 * MiB;
constexpr size_t WS_WGU = 124 * MiB;
constexpr size_t WS_WD = 644 * MiB;
constexpr size_t WS_H = 904 * MiB;
constexpr size_t WS_PROJ = 936 * MiB;
constexpr size_t WS_ATTN = 1032 * MiB;
constexpr size_t WS_SLOC = 1048 * MiB;
constexpr size_t WS_Y = 1050 * MiB;
constexpr size_t WS_MIXED = 1058 * MiB;
constexpr size_t WS_HID = 1090 * MiB;
constexpr size_t WS_YSLOT = 1163 * MiB;
constexpr size_t WS_LTOK = 1451 * MiB, WS_LDST = 1453 * MiB, WS_LW = 1455 * MiB;
constexpr size_t WS_MIXED2 = 1457 * MiB;
constexpr size_t WS_WRT = 1489 * MiB;
constexpr size_t WS_XB = 1490 * MiB;
constexpr size_t WS_TOKW = 1522 * MiB;
constexpr size_t WS_END = 1523 * MiB;
constexpr int CW_TMO = 0, CW_BAR = 4096, CW_CNT = 8192;

constexpr int RING_BYTES = 131072, LDSCTL_OFF = RING_BYTES, MISC_OFF = LDSCTL_OFF + 320;
constexpr int SEL_OFF = LDSCTL_OFF + 1024;
constexpr int MOE_OFF = LDSCTL_OFF + 10240;
constexpr int LDS_BYTES = 147456;
constexpr int NWAVES = 8;

__device__ __forceinline__ unsigned cvt_pk_bf16(float lo, float hi) { unsigned r; asm("v_cvt_pk_bf16_f32 %0, %1, %2" : "=v"(r) : "v"(lo), "v"(hi)); return r; }
__device__ __forceinline__ float bf_lo(unsigned w) { return __uint_as_float(w << 16); }
__device__ __forceinline__ float bf_hi(unsigned w) { return __uint_as_float(w & 0xffff0000u); }
__device__ __forceinline__ float bf1(bf16_t h) { return __uint_as_float(((unsigned)h) << 16); }
__device__ __forceinline__ float fast_sigmoid(float x) { return __builtin_amdgcn_rcpf(1.0f + __builtin_amdgcn_exp2f(-x * LOG2E)); }
__device__ __forceinline__ float wave_sum(float v) {
#pragma unroll
    for (int o = 1; o < 64; o <<= 1) v += __shfl_xor(v, o);
    return v;
}
__device__ __forceinline__ int opaque(int v) { asm volatile("" : "+v"(v)); return v; }
__device__ __forceinline__ int lane_now() { int l; asm volatile("v_mbcnt_lo_u32_b32 %0, -1, 0\n\tv_mbcnt_hi_u32_b32 %0, -1, %0" : "=v"(l)); return l; }
#define LDS_WAIT() asm volatile("s_waitcnt lgkmcnt(0)" ::: "memory")
#define VM_WAIT() asm volatile("s_waitcnt vmcnt(0)" ::: "memory")

#define XB_TMO      128
#define XB_XCNT(j)  (256  + 64 * (j))
#define XB_XSUB(j)  (1280 + 64 * (j))
#define XB_XGEN(j)  (2304 + 64 * (j))
#define XB_TOP      3328
#define XB_TOPGEN   3392
#define XCD_BAR_WORDS 3456
#define XB_SPIN_CAP (1u << 18)
__device__ __forceinline__ unsigned xb_ld(unsigned* p)              { return __hip_atomic_load(p, __ATOMIC_RELAXED, __HIP_MEMORY_SCOPE_AGENT); }
__device__ __forceinline__ unsigned xb_add(unsigned* p, unsigned v) { return __hip_atomic_fetch_add(p, v, __ATOMIC_RELAXED, __HIP_MEMORY_SCOPE_AGENT); }
__device__ __forceinline__ unsigned xb_xcc_id() { return (unsigned)__builtin_amdgcn_s_getreg((3 << 11) | 20) & 0xFu; }
#define XB_SPIN(cond, bar) do { unsigned _sp = 0; while (cond) { __builtin_amdgcn_s_sleep(1); \
    if ((++_sp & 255u) == 0u) { if (xb_ld(&(bar)[XB_TMO])) break; if (_sp > XB_SPIN_CAP) { atomicAdd(&(bar)[XB_TMO], 1u); break; } } } } while (0)
struct XcdBarrier { unsigned* bar; unsigned x; volatile LAS unsigned* st; int wv; };
__device__ __forceinline__ XcdBarrier xcd_barrier_post(unsigned* bar, volatile LAS unsigned* st) {
    XcdBarrier b; b.bar = bar; b.x = xb_xcc_id(); b.st = st; b.wv = __builtin_amdgcn_readfirstlane((int)threadIdx.x >> 6);
    if (threadIdx.x == 0) (void)xb_add(&bar[XB_XCNT(b.x)], 1u);
    return b;
}
__device__ __forceinline__ void xcd_barrier_complete(unsigned* bar, unsigned x, unsigned& nloc, unsigned& nx) {
    const unsigned G = gridDim.x * gridDim.y * gridDim.z;
    unsigned sum, cnt, mine, sp = 0u;
    for (;;) {
        sum = 0u; cnt = 0u; mine = 0u;
#pragma unroll
        for (unsigned j = 0; j < 16; ++j) { const unsigned c = xb_ld(&bar[XB_XCNT(j)]); sum += c; cnt += (c > 0u) ? 1u : 0u; mine = (j == x) ? c : mine; }
        if (sum == G) break;
        __builtin_amdgcn_s_sleep(1);
        if ((++sp & 255u) == 0u) { if (xb_ld(&bar[XB_TMO])) break; if (sp > XB_SPIN_CAP) { atomicAdd(&bar[XB_TMO], 1u); break; } }
    }
    nloc = mine > 0u ? mine : 1u; nx = cnt > 0u ? cnt : 1u;
}
__device__ __forceinline__ void xcd_barrier(const XcdBarrier& b) {
    asm volatile("s_waitcnt vmcnt(0)" ::: "memory");
    __syncthreads();
    if (lane_now() + 64 * b.wv == 0) {
        unsigned* bar = b.bar; asm volatile("" : "+s"(bar));
        __builtin_amdgcn_s_waitcnt(0);
        unsigned nloc = b.st[0], nx = b.st[1];
        if (nloc == 0u) { xcd_barrier_complete(bar, b.x, nloc, nx); b.st[0] = nloc; b.st[1] = nx; }
        const unsigned old = xb_add(&bar[XB_XSUB(b.x)], 1u);
        const unsigned gen = old / nloc;
        if (old + 1u == (gen + 1u) * nloc) {
            __builtin_amdgcn_fence(__ATOMIC_RELEASE, "agent");
            asm volatile("s_waitcnt vmcnt(0)" ::: "memory");
            const unsigned og = xb_add(&bar[XB_TOP], 1u);
            const unsigned tg = og / nx;
            if (og + 1u == (tg + 1u) * nx) xb_add(&bar[XB_TOPGEN], 1u);
            else XB_SPIN(xb_ld(&bar[XB_TOPGEN]) == tg, bar);
            __builtin_amdgcn_fence(__ATOMIC_ACQUIRE, "agent");
            xb_add(&bar[XB_XGEN(b.x)], 1u);
            asm volatile("s_waitcnt vmcnt(0)" ::: "memory");
        } else {
            XB_SPIN(xb_ld(&bar[XB_XGEN(b.x)]) == gen, bar);
            __builtin_amdgcn_fence(__ATOMIC_ACQUIRE, "agent");
            asm volatile("s_waitcnt vmcnt(0)" ::: "memory");
        }
    }
    __syncthreads();
}

namespace pg8 {
constexpr int BM = 256, BK = 64, HALF = 128, HTB = HALF * BK * 2, STAGE_BYTES = 8 * HTB, NXCD = 8, WGM = 8;
__host__ __device__ __forceinline__ int lds_byte(int r, int c) { const int st = (r >> 4) * 2 + (c >> 5), rr = r & 15, cc = c & 31, ob = rr * 64 + cc * 2; return st * 1024 + (ob ^ (((ob >> 9) & 1) << 5)); }
__host__ __device__ __forceinline__ void stage_rc(int b, int& R, int& C) { const int st = b / 1024, sb = b % 1024, swz = sb ^ (((sb >> 9) & 1) << 5); R = (st >> 1) * 16 + swz / 64; C = (st & 1) * 32 + (swz % 64) / 2; }
__host__ __device__ __forceinline__ int perm32(int rho) { const int n = rho >> 4, i = rho & 15; return 8 * (i >> 2) + 4 * n + (i & 3); }

struct Unit { int pm, pn, e, n, r0, x; };

struct DenseOrder {
    static constexpr bool GATHER = false;
    int nM, nN, nwg, G, c; const char* Bt; size_t tstepB;
    __device__ void init(int M, int N, int K, int G_, int c_, const void* Bt_) { nM = M / BM; nN = N / BM; nwg = nM * nN; G = G_; c = c_; Bt = (const char*)Bt_; tstepB = (size_t)BM * K * 2; }
    __device__ __forceinline__ bool next(int i, Unit& u) const {
        const long L = (long)i * G + c; if (L >= nwg) return false;
        int wgid = (int)L; { const int q = nwg / NXCD, r = nwg % NXCD, xcd = wgid % NXCD, off = wgid / NXCD; wgid = (xcd < r ? xcd * (q + 1) : r * (q + 1) + (xcd - r) * q) + off; }
        const int nig = WGM * nN, gid = wgid / nig, fm = gid * WGM, gsz = (nM - fm) < WGM ? (nM - fm) : WGM;
        u.pm = fm + ((wgid % nig) % gsz); u.pn = (wgid % nig) / gsz; u.e = -1; u.n = 256; u.r0 = u.pm * BM; u.x = u.pm * BM; return true;
    }
    __device__ __forceinline__ int a_row(const Unit& u, int R) const { return u.r0 + R; }
    __device__ __forceinline__ void a_row_issue(const Unit& u, int R, int& out) const { out = u.r0 + R; }
    __device__ __forceinline__ int a_row_fix(const Unit& u, int R, int loaded) const { return loaded; }
    __device__ __forceinline__ const char* b_tile(const Unit& u) const { return Bt + (size_t)u.pn * tstepB; }
};
template <int NPN, bool GATHER_> struct MoeOrder {
    static constexpr bool GATHER = GATHER_;
    const LAS int* utab; const char* Wbase; size_t wstepE, tstepB; const int* ltok;
    __device__ __forceinline__ bool next(int i, Unit& u) const {
        if (i >= 64) return false;
        const LAS int* p = utab + i * 8;
        const int pm = __builtin_amdgcn_readfirstlane(p[0]); if (pm < 0) return false;
        u.pm = pm; u.pn = __builtin_amdgcn_readfirstlane(p[1]); u.e = __builtin_amdgcn_readfirstlane(p[2]); u.n = __builtin_amdgcn_readfirstlane(p[3]);
        u.r0 = __builtin_amdgcn_readfirstlane(p[4]); u.x = __builtin_amdgcn_readfirstlane(p[5]); return true;
    }
    __device__ __forceinline__ int a_row(const Unit& u, int R) const {
        if (!GATHER) return u.r0 + R;
        if (u.e == 64) return u.r0 + R;
        const int rr = R < u.n ? R : u.n - 1; return ((const GAS int*)ltok)[u.r0 + rr];
    }
    __device__ __forceinline__ void a_row_issue(const Unit& u, int R, int& out) const {
        const int rr = R < u.n ? R : u.n - 1; const GAS int* p = (const GAS int*)ltok + (u.e == 64 ? 0 : u.r0 + rr);
        asm volatile("global_load_dword %0, %1, off" : "=v"(out) : "v"(p) : "memory");
    }
    __device__ __forceinline__ int a_row_fix(const Unit& u, int R, int loaded) const { return u.e == 64 ? u.r0 + R : loaded; }
    __device__ __forceinline__ const char* b_tile(const Unit& u) const { return Wbase + (size_t)u.e * wstepE + (size_t)u.pn * tstepB; }
};
template <int NPN, bool GATHER> __device__ __forceinline__ void moe_build(LAS int* tpre, LAS int* ebase, LAS int* ecnt, LAS int* utab, const unsigned* counts, int G, int c, int tid) {
    if (tid < 64) ecnt[tid] = (int)__hip_atomic_load(counts + tid, __ATOMIC_RELAXED, __HIP_MEMORY_SCOPE_AGENT);
    __syncthreads();
    if (tid == 0) { int tp = 0, eb = 0; for (int e = 0; e < 64; ++e) { tpre[e] = tp; ebase[e] = eb; tp += (ecnt[e] + 255) >> 8; eb += ecnt[e]; } tpre[64] = tp; ebase[64] = eb; }
    __syncthreads();
#if MOE_XCD
    if (tid < 64) {
        int pm = -1, pn = 0, e = 64, n = 256;
        const int xc = c & 7; int idx = (c >> 3) + (G >> 3) * tid;
        if (idx < 4 * NPN) { pm = xc + 8 * (idx / NPN); pn = idx % NPN; }
        else { idx -= 4 * NPN;
#pragma unroll 1
            for (int j = 0; j < 8; ++j) { const int ee = xc + 8 * j, nu = ((ecnt[ee] + 255) >> 8) * NPN;
                if (pm < 0) { if (idx < nu) { e = ee; pm = idx / NPN; pn = idx % NPN; } else idx -= nu; } }
            if (pm >= 0) { const int rem = ecnt[e] - pm * BM; n = rem < BM ? rem : BM; } }
        const int hb = (e == 64 ? 65536 : ebase[e]) + pm * BM;
        const int r0 = GATHER ? (e == 64 ? pm * BM : e * 8192 + pm * BM) : hb, x = hb;
#else
    if (tid < 64) {
        int pm = -1, pn = 0, e = 64, n = 256;
        const int vc = ((G & 7) == 0) ? (c & 7) * (G >> 3) + (c >> 3) : c;
        int L = tid * G + vc; const int shared_units = 32 * NPN, tot = shared_units + NPN * tpre[64];
        if (L < tot) {
            if (L < shared_units) { pm = L / NPN; pn = L % NPN; }
            else { L -= shared_units; const int tile = L / NPN; pn = L % NPN; e = 0;
#pragma unroll 1
                for (int j = 1; j <= 64; ++j) e += (tpre[j] <= tile) ? 1 : 0;
                pm = tile - tpre[e]; const int rem = ecnt[e] - pm * BM; n = rem < BM ? rem : BM; } }
        const int hb = (e == 64 ? 65536 : ebase[e]) + pm * BM;
        const int r0 = GATHER ? (e == 64 ? pm * BM : e * 8192 + pm * BM) : hb, x = hb;
#endif
        LAS int* p = utab + tid * 8; p[0] = pm; p[1] = pn; p[2] = e; p[3] = n; p[4] = r0; p[5] = x;
    }
    __syncthreads();
}

template <class Epi, class Sched, bool ALIGN_EPI = false, bool SP2 = GEMM_SP2, bool F8 = false>
__device__ __forceinline__ void gemm_phase(LAS unsigned char* lds, const char* Abase, const int K, const Sched& S, const Epi& E, const int wave_s) {
    int tid = lane_now() + 64 * wave_s; asm volatile("" : "+v"(tid));
    const int wid = wave_s, lane = tid & 63, wr = wid >> 2, wc = wid & 3, fr = lane & 15, fq = lane >> 4;
    const int nt = K / BK;
    constexpr bool GA = Sched::GATHER;
    unsigned voffA[2], voffB[2];
#pragma unroll
    for (int i = 0; i < 2; ++i) { int R, C; stage_rc(tid * 16 + i * 8192, R, C); const int Rb = Epi::PERM ? ((R & ~31) + perm32(R & 31)) : R; voffA[i] = (unsigned)(R * K + C) * 2u; voffB[i] = (unsigned)(Rb * K + C) * 2u; }
    const size_t kstep = (size_t)(BK * 2);
    const size_t hstep = (size_t)HALF * K * 2;
    const unsigned ldsw = (unsigned)wid * 1024u;
    const int aoff = lds_byte(wr * 64 + fr, fq * 8), boff = lds_byte(wc * 32 + fr, fq * 8);
#define PG8_SA(b, h) (((b) * 2 + (h)) * HTB)
#define PG8_SB(b, h) ((4 + (b) * 2 + (h)) * HTB)
#define PG8_STB(bufoff, gbase) do { const char* _sb = (const char*)(gbase); asm volatile("" : "+s"(_sb)); _Pragma("unroll") for (int _i = 0; _i < 2; ++_i) \
        { unsigned _vo = voffB[_i]; asm volatile("" : "+v"(_vo)); __builtin_amdgcn_global_load_lds((const unsigned*)(_sb + _vo), (LAS unsigned*)(lds + (bufoff) + ldsw + _i * 8192), 16, 0, 0); } } while (0)
#define PG8_STA(bufoff, h, kb) do { const char* _sa = GA ? (Abase + (kb)) : (cA + (kb) + (h) * hstep); asm volatile("" : "+s"(_sa)); _Pragma("unroll") for (int _i = 0; _i < 2; ++_i) \
        { unsigned _vo = GA ? offC[h][_i] : voffA[_i]; asm volatile("" : "+v"(_vo)); __builtin_amdgcn_global_load_lds((const unsigned*)(_sa + _vo), (LAS unsigned*)(lds + (bufoff) + ldsw + _i * 8192), 16, 0, 0); } } while (0)
#define PG8_LDA(dst, b, h) do { _Pragma("unroll") for (int m = 0; m < 4; ++m) _Pragma("unroll") for (int k = 0; k < 2; ++k) dst[m][k] = *(const LAS bf16x8*)(lds + PG8_SA(b, h) + aoff + m * 2048 + k * 1024); } while (0)
#define PG8_LDB(dst, b, h) do { _Pragma("unroll") for (int n = 0; n < 2; ++n) _Pragma("unroll") for (int k = 0; k < 2; ++k) dst[n][k] = *(const LAS bf16x8*)(lds + PG8_SB(b, h) + boff + n * 2048 + k * 1024); } while (0)
#define PG8_CAT8(x, y) __builtin_shufflevector(__builtin_bit_cast(i32x4, x), __builtin_bit_cast(i32x4, y), 0, 1, 2, 3, 4, 5, 6, 7)
#define PG8_MMA(ai, bj, At, Bt) do { __builtin_amdgcn_s_setprio(1); _Pragma("unroll") for (int m = 0; m < 4; ++m) _Pragma("unroll") for (int n = 0; n < 2; ++n) { \
        if constexpr (F8) acc[ai][bj][m][n] = __builtin_amdgcn_mfma_scale_f32_16x16x128_f8f6f4(PG8_CAT8(Bt[n][0], Bt[n][1]), PG8_CAT8(At[m][0], At[m][1]), acc[ai][bj][m][n], 0, 0, 0, 0, 0, 0); \
        else { _Pragma("unroll") for (int k = 0; k < 2; ++k) acc[ai][bj][m][n] = __builtin_amdgcn_mfma_f32_16x16x32_bf16(Bt[n][k], At[m][k], acc[ai][bj][m][n], 0, 0, 0); } } \
        __builtin_amdgcn_s_setprio(0); } while (0)
#define PG8_WAIT_V(n) asm volatile("s_waitcnt vmcnt(" #n ")" ::: "memory")
#define PG8_WAIT_L(n) asm volatile("s_waitcnt lgkmcnt(" #n ")" ::: "memory")
#define PG8_BAR __builtin_amdgcn_s_barrier()
#define PG8_SCHED __builtin_amdgcn_sched_barrier(0)
#define PG8_AOFF(dst, u) do { if constexpr (GA) { _Pragma("unroll") for (int _h = 0; _h < 2; ++_h) _Pragma("unroll") for (int _i = 0; _i < 2; ++_i) { int _R, _C; stage_rc(tid * 16 + _i * 8192, _R, _C); \
        dst[_h][_i] = (unsigned)(S.a_row(u, _h * HALF + _R) * K + _C) * 2u; } } } while (0)
    Unit cur, nxt; int ui = 0;
    if (!S.next(0, cur)) return;
    f32x4 acc[2][2][4][2];
#pragma unroll
    for (int a = 0; a < 2; ++a)
#pragma unroll
        for (int b = 0; b < 2; ++b)
#pragma unroll
            for (int m = 0; m < 4; ++m)
#pragma unroll
                for (int n = 0; n < 2; ++n) { acc[a][b][m][n] = (f32x4){0.f, 0.f, 0.f, 0.f}; if constexpr (F8) F8_PIN_ASM(acc[a][b][m][n]); }
    bf16x8 At[4][2], B0[2][2], B1[2][2];
    unsigned offC[2][2];
    PG8_AOFF(offC, cur);
    const char* cB = S.b_tile(cur);
    const char* cA = GA ? Abase : Abase + (size_t)S.a_row(cur, 0) * K * 2;
    if constexpr (SP2) {
        PG8_STB(PG8_SB(0, 0), cB); PG8_STB(PG8_SB(0, 1), cB + hstep); PG8_STA(PG8_SA(0, 0), 0, 0); PG8_STA(PG8_SA(0, 1), 1, 0);
        if (wr == 1) PG8_BAR;
        PG8_WAIT_V(2); PG8_BAR;
        PG8_STB(PG8_SB(1, 0), cB + kstep); PG8_STA(PG8_SA(1, 0), 0, kstep); PG8_STB(PG8_SB(1, 1), cB + hstep + kstep);
        PG8_WAIT_V(6); PG8_BAR;
    } else {
    PG8_STB(PG8_SB(0, 0), cB); PG8_STA(PG8_SA(0, 0), 0, 0); PG8_STB(PG8_SB(0, 1), cB + hstep); PG8_STA(PG8_SA(0, 1), 1, 0);
    if (wr == 1) PG8_BAR;
    PG8_WAIT_V(4); PG8_BAR;
    PG8_STB(PG8_SB(1, 0), cB + kstep); PG8_STA(PG8_SA(1, 0), 0, kstep); PG8_STB(PG8_SB(1, 1), cB + hstep + kstep);
    PG8_WAIT_V(6); PG8_BAR;
    }
    for (;;) {
        int pre_v0, pre_v1; if constexpr (Epi::PRE) E.pre_issue(cur, wr, opaque(lane_now()), pre_v0, pre_v1);
        const bool has_next = S.next(ui + 1, nxt);
        const char* nB = has_next ? S.b_tile(nxt) : cB;
        const char* nA = (!GA && has_next) ? Abase + (size_t)S.a_row(nxt, 0) * K * 2 : cA;
        int rowN[2][2];
        if constexpr (GA) { const Unit un = has_next ? nxt : cur;
#pragma unroll
            for (int h = 0; h < 2; ++h)
#pragma unroll
                for (int i = 0; i < 2; ++i) { int R_, C_; stage_rc(tid * 16 + i * 8192, R_, C_); S.a_row_issue(un, h * HALF + R_, rowN[h][i]); } }
#pragma unroll 1
        for (int t = 0; t < nt; t += 2) {
            const bool last = (t == nt - 2);
            const size_t kb1 = (size_t)(t + 1) * kstep;
            const size_t kb2 = last ? 0 : (size_t)(t + 2) * kstep, kb3 = kb2 + kstep;
            const char* b2 = last ? nB : cB + (size_t)(t + 2) * kstep; const char* b3 = b2 + kstep;
            if constexpr (SP2) {
            PG8_LDB(B0, 0, 0); PG8_LDB(B1, 0, 1); PG8_SCHED; PG8_LDA(At, 0, 0); PG8_STA(PG8_SA(1, 1), 1, kb1);
            if (last) { if constexpr (GA) { if (has_next) {
#pragma unroll
                for (int h = 0; h < 2; ++h)
#pragma unroll
                    for (int i = 0; i < 2; ++i) { int R_, C_; stage_rc(tid * 16 + i * 8192, R_, C_); int rl = rowN[h][i]; asm volatile("" : "+v"(rl));
                        offC[h][i] = (unsigned)(S.a_row_fix(nxt, h * HALF + R_, rl) * K + C_) * 2u; } } } else cA = nA; }
            PG8_WAIT_V(8); PG8_WAIT_L(0); PG8_BAR; PG8_MMA(0, 0, At, B0); PG8_MMA(0, 1, At, B1); PG8_BAR; PG8_SCHED;
            PG8_LDA(At, 0, 1); PG8_STB(PG8_SB(0, 0), b2); PG8_STB(PG8_SB(0, 1), b2 + hstep); PG8_STA(PG8_SA(0, 0), 0, kb2);
            PG8_WAIT_V(8); PG8_WAIT_L(0); PG8_BAR; PG8_MMA(1, 0, At, B0); PG8_MMA(1, 1, At, B1); PG8_BAR; PG8_SCHED;
            PG8_LDB(B0, 1, 0); PG8_LDB(B1, 1, 1); PG8_SCHED; PG8_LDA(At, 1, 0); PG8_STA(PG8_SA(0, 1), 1, kb2);
            PG8_WAIT_V(8); PG8_WAIT_L(0); PG8_BAR; PG8_MMA(0, 0, At, B0); PG8_MMA(0, 1, At, B1); PG8_BAR; PG8_SCHED;
            PG8_LDA(At, 1, 1); PG8_STB(PG8_SB(1, 0), b3); PG8_STB(PG8_SB(1, 1), b3 + hstep); PG8_STA(PG8_SA(1, 0), 0, kb3);
            PG8_WAIT_V(8); PG8_WAIT_L(0); PG8_BAR; PG8_MMA(1, 0, At, B0); PG8_MMA(1, 1, At, B1); PG8_BAR; PG8_SCHED;
            } else {
            PG8_LDB(B0, 0, 0); PG8_SCHED; PG8_LDA(At, 0, 0); PG8_STA(PG8_SA(1, 1), 1, kb1);
            if (last) { if constexpr (GA) { if (has_next) {
#pragma unroll
                for (int h = 0; h < 2; ++h)
#pragma unroll
                    for (int i = 0; i < 2; ++i) { int R_, C_; stage_rc(tid * 16 + i * 8192, R_, C_); int rl = rowN[h][i]; asm volatile("" : "+v"(rl));
                        offC[h][i] = (unsigned)(S.a_row_fix(nxt, h * HALF + R_, rl) * K + C_) * 2u; } } } else cA = nA; }
            PG8_WAIT_L(8); PG8_BAR; PG8_WAIT_L(0); PG8_MMA(0, 0, At, B0); PG8_BAR; PG8_SCHED;
            PG8_LDB(B1, 0, 1); PG8_STB(PG8_SB(0, 0), b2);
            PG8_BAR; PG8_WAIT_L(0); PG8_MMA(0, 1, At, B1); PG8_BAR;
            PG8_LDA(At, 0, 1); PG8_STA(PG8_SA(0, 0), 0, kb2);
            PG8_BAR; PG8_WAIT_L(0); PG8_MMA(1, 0, At, B0); PG8_BAR; PG8_SCHED;
            PG8_STB(PG8_SB(0, 1), b2 + hstep);
            PG8_WAIT_V(6); PG8_BAR; PG8_MMA(1, 1, At, B1); PG8_BAR;
            PG8_LDB(B0, 1, 0); PG8_SCHED; PG8_LDA(At, 1, 0); PG8_STA(PG8_SA(0, 1), 1, kb2);
            PG8_WAIT_L(8); PG8_BAR; PG8_WAIT_L(0); PG8_MMA(0, 0, At, B0); PG8_BAR; PG8_SCHED;
            PG8_LDB(B1, 1, 1); PG8_STB(PG8_SB(1, 0), b3);
            PG8_BAR; PG8_WAIT_L(0); PG8_MMA(0, 1, At, B1); PG8_BAR;
            PG8_LDA(At, 1, 1); PG8_STA(PG8_SA(1, 0), 0, kb3);
            PG8_BAR; PG8_WAIT_L(0); PG8_MMA(1, 0, At, B0); PG8_BAR; PG8_SCHED;
            PG8_STB(PG8_SB(1, 1), b3 + hstep);
            PG8_WAIT_V(6); PG8_BAR; PG8_MMA(1, 1, At, B1); PG8_BAR;
            }
        }
        if constexpr (ALIGN_EPI) { if (wr == 0) PG8_BAR; }
        const int tq = opaque(lane_now() + 64 * wid);
        if constexpr (Epi::PRE) { asm volatile("" : "+v"(pre_v0), "+v"(pre_v1)); E.pre_commit(pre_v0, pre_v1, wid, tq & 63); }
        E(acc, cur, wr, wc, tq & 15, (tq >> 4) & 3);
        if (!has_next) break;
#pragma unroll
        for (int a = 0; a < 2; ++a)
#pragma unroll
            for (int b = 0; b < 2; ++b)
#pragma unroll
                for (int m = 0; m < 4; ++m)
#pragma unroll
                    for (int n = 0; n < 2; ++n) { acc[a][b][m][n] = (f32x4){0.f, 0.f, 0.f, 0.f}; if constexpr (F8) F8_PIN_ASM(acc[a][b][m][n]); }
        cur = nxt; cB = nB; ++ui;
        if constexpr (ALIGN_EPI) { if (wr == 1) PG8_BAR; }
    }
    PG8_WAIT_V(0);
    if constexpr (!ALIGN_EPI) { if (wr == 0) PG8_BAR; }
    PG8_BAR;
#undef PG8_SA
#undef PG8_SB
#undef PG8_STB
#undef PG8_STA
#undef PG8_LDA
#undef PG8_LDB
#undef PG8_MMA
#undef PG8_CAT8
#undef PG8_WAIT_V
#undef PG8_WAIT_L
#undef PG8_BAR
#undef PG8_SCHED
#undef PG8_AOFF
}

typedef const f32x4 (&AccRef)[2][2][4][2];
__device__ __forceinline__ u32x4 pack8(const f32x4& a, const f32x4& b) { u32x4 w; w.x = cvt_pk_bf16(a[0], a[1]); w.y = cvt_pk_bf16(a[2], a[3]); w.z = cvt_pk_bf16(b[0], b[1]); w.w = cvt_pk_bf16(b[2], b[3]); return w; }
__device__ __forceinline__ void unpack8(const u32x4 w, f32x4& a, f32x4& b) { a = (f32x4){bf_lo(w.x), bf_hi(w.x), bf_lo(w.y), bf_hi(w.y)}; b = (f32x4){bf_lo(w.z), bf_hi(w.z), bf_lo(w.w), bf_hi(w.w)}; }

constexpr float WGU_SCALE = 64.0f, WD_SCALE = 32.0f;
__device__ __forceinline__ unsigned pk_fp8x4(const f32x4& a) {
    int w = 0; w = __builtin_amdgcn_cvt_pk_fp8_f32(a[0], a[1], w, false); w = __builtin_amdgcn_cvt_pk_fp8_f32(a[2], a[3], w, true); return (unsigned)w; }
struct EpiInProj {
    static constexpr bool PERM = true; static constexpr bool PRE = false;
    bf16_t* O; const float* bias; float qscale; int nostore;
    __device__ __forceinline__ void operator()(AccRef acc, const Unit& u, int wr, int wc, int fr, int fq) const {
        if (nostore) return;
        const int row0 = u.pm * BM + wr * 64 + fr, colb = u.pn * BM + wc * 32 + 8 * fq;
        const int mode = u.pn < 4 ? 1 : (u.pn >= 8 ? 2 : 0);
        float dq = INP_F8 ? 1.0f / WGU_SCALE : 1.0f; asm volatile("" : "+s"(dq));
        f32x4 bv[2][2];
#pragma unroll
        for (int bj = 0; bj < 2; ++bj)
#pragma unroll
            for (int n = 0; n < 2; ++n) bv[bj][n] = *(const GAS f32x4*)(bias + colb + bj * HALF + 4 * n);
#pragma unroll
        for (int ai = 0; ai < 2; ++ai)
#pragma unroll
            for (int m = 0; m < 4; ++m) { bf16_t* rowp = O + (size_t)(row0 + ai * HALF + m * 16) * INW + colb;
#pragma unroll
                for (int bj = 0; bj < 2; ++bj) { f32x4 v0 = acc[ai][bj][m][0] * dq + bv[bj][0], v1 = acc[ai][bj][m][1] * dq + bv[bj][1];
                    if (mode == 1) { v0 = v0 * qscale; v1 = v1 * qscale; }
                    if (mode == 2) {
#pragma unroll
                        for (int j = 0; j < 4; ++j) { v0[j] = fast_sigmoid(v0[j]); v1[j] = fast_sigmoid(v1[j]); } }
                    *(GAS u32x4*)(rowp + bj * HALF) = pack8(v0, v1); } }
    }
};
struct EpiAttnProj {
    static constexpr bool PERM = true; static constexpr bool PRE = false;
    const bf16_t* proj; bf16_t* mixed;
    __device__ __forceinline__ void operator()(AccRef acc, const Unit& u, int wr, int wc, int fr, int fq) const {
        const int row0 = u.pm * BM + wr * 64 + fr, colb = u.pn * BM + wc * 32 + 8 * fq;
#pragma unroll
        for (int ai = 0; ai < 2; ++ai) {
            u32x4 gw[4][2];
#pragma unroll
            for (int m = 0; m < 4; ++m)
#pragma unroll
                for (int bj = 0; bj < 2; ++bj) gw[m][bj] = *(const GAS u32x4*)(proj + (size_t)(row0 + ai * HALF + m * 16) * INW + O_GA + colb + bj * HALF);
#pragma unroll
            for (int m = 0; m < 4; ++m) { const size_t row = (size_t)(row0 + ai * HALF + m * 16);
#pragma unroll
                for (int bj = 0; bj < 2; ++bj) { f32x4 g0, g1; unpack8(gw[m][bj], g0, g1);
                    *(GAS u32x4*)(mixed + row * D + colb + bj * HALF) = pack8(g0 * acc[ai][bj][m][0], g1 * acc[ai][bj][m][1]); } } }
    }
};
struct EpiGlu {
    static constexpr bool PERM = true; static constexpr bool PRE = false;
    const bf16_t* proj; const bf16_t* mixed; bf16_t* mixed2;
    __device__ __forceinline__ void operator()(AccRef acc, const Unit& u, int wr, int wc, int fr, int fq) const {
        const int row0 = u.pm * BM + wr * 64 + fr, col = u.pn * HALF + wc * 32 + 8 * fq;
#pragma unroll
        for (int ai = 0; ai < 2; ++ai) {
            u32x4 gw[4], pw[4];
#pragma unroll
            for (int m = 0; m < 4; ++m) { const size_t row = (size_t)(row0 + ai * HALF + m * 16);
                gw[m] = *(const GAS u32x4*)(proj + row * INW + O_GS + col); pw[m] = *(const GAS u32x4*)(mixed + row * D + col); }
#pragma unroll
            for (int m = 0; m < 4; ++m) { const size_t row = (size_t)(row0 + ai * HALF + m * 16);
                f32x4 g0, g1, p0, p1; unpack8(gw[m], g0, g1); unpack8(pw[m], p0, p1);
                const f32x4 za0 = acc[ai][0][m][0], za1 = acc[ai][0][m][1], zb0 = acc[ai][1][m][0], zb1 = acc[ai][1][m][1];
#pragma unroll
                for (int j = 0; j < 4; ++j) { p0[j] += g0[j] * za0[j] * fast_sigmoid(zb0[j]); p1[j] += g1[j] * za1[j] * fast_sigmoid(zb1[j]); }
                if constexpr (MIX_F8 != 0) *(GAS u32x2*)((unsigned char*)mixed2 + row * D + col) = (u32x2){pk_fp8x4(p0), pk_fp8x4(p1)};
                else *(GAS u32x4*)(mixed2 + row * D + col) = pack8(p0, p1); } }
    }
};
struct EpiMixOut {
    static constexpr bool PERM = true; static constexpr bool PRE = false;
    const float* xin; const bf16_t* xsrc; bf16_t* xdst; const float* gt;
    __device__ __forceinline__ void operator()(AccRef acc, const Unit& u, int wr, int wc, int fr, int fq) const {
        const int row0 = u.pm * BM + wr * 64 + fr, colb = u.pn * BM + wc * 32 + 8 * fq;
        const float* g = gt + (u.pm >= 16 ? 12288 : 0);
        f32x4 gv[2][2];
#pragma unroll
        for (int bj = 0; bj < 2; ++bj)
#pragma unroll
            for (int n = 0; n < 2; ++n) gv[bj][n] = *(const GAS f32x4*)(g + colb + bj * HALF + 4 * n) * (MIX_F8 ? 1.0f / WGU_SCALE : 1.0f);
        if (xin) {
#pragma unroll
            for (int ai = 0; ai < 2; ++ai)
#pragma unroll
                for (int mp = 0; mp < 2; ++mp) { f32x4 xv[2][2][2];
#pragma unroll
                    for (int mm = 0; mm < 2; ++mm)
#pragma unroll
                        for (int bj = 0; bj < 2; ++bj) { const size_t off = (size_t)(row0 + ai * HALF + (2 * mp + mm) * 16) * D + colb + bj * HALF;
                            xv[mm][bj][0] = *(const GAS f32x4*)(xin + off); xv[mm][bj][1] = *(const GAS f32x4*)(xin + off + 4); }
#pragma unroll
                    for (int mm = 0; mm < 2; ++mm)
#pragma unroll
                        for (int bj = 0; bj < 2; ++bj) { const int m = 2 * mp + mm; const size_t off = (size_t)(row0 + ai * HALF + m * 16) * D + colb + bj * HALF;
                            *(GAS u32x4*)(xdst + off) = pack8(xv[mm][bj][0] + gv[bj][0] * acc[ai][bj][m][0], xv[mm][bj][1] + gv[bj][1] * acc[ai][bj][m][1]); } }
        } else {
#pragma unroll
            for (int ai = 0; ai < 2; ++ai) { u32x4 xw[4][2];
#pragma unroll
                for (int m = 0; m < 4; ++m)
#pragma unroll
                    for (int bj = 0; bj < 2; ++bj) xw[m][bj] = *(const GAS u32x4*)(xsrc + (size_t)(row0 + ai * HALF + m * 16) * D + colb + bj * HALF);
#pragma unroll
                for (int m = 0; m < 4; ++m)
#pragma unroll
                    for (int bj = 0; bj < 2; ++bj) { f32x4 x0, x1; unpack8(xw[m][bj], x0, x1);
                        *(GAS u32x4*)(xdst + (size_t)(row0 + ai * HALF + m * 16) * D + colb + bj * HALF) = pack8(x0 + gv[bj][0] * acc[ai][bj][m][0], x1 + gv[bj][1] * acc[ai][bj][m][1]); } }
        }
    }
};
struct EpiGateUp {
    static constexpr bool PERM = true; static constexpr bool PRE = false;
    unsigned char* hid;
    __device__ __forceinline__ void operator()(AccRef acc, const Unit& u, int wr, int wc, int fr, int fq) const {
        const int r0 = wr * 64 + fr, col = u.pn * HALF + wc * 32 + 8 * fq;
        float dq = 1.0f / WGU_SCALE; asm volatile("" : "+s"(dq));
#pragma unroll
        for (int ai = 0; ai < 2; ++ai)
#pragma unroll
            for (int m = 0; m < 4; ++m) { const int r = r0 + ai * HALF + m * 16;
                f32x4 g0 = acc[ai][0][m][0] * dq, g1 = acc[ai][0][m][1] * dq, u0 = acc[ai][1][m][0] * dq, u1 = acc[ai][1][m][1] * dq;
#pragma unroll
                for (int j = 0; j < 4; ++j) { g0[j] = g0[j] * fast_sigmoid(g0[j]) * u0[j]; g1[j] = g1[j] * fast_sigmoid(g1[j]) * u1[j]; }
                if (r < u.n) { if constexpr (DOWN_F8 != 0) *(GAS u32x2*)(hid + (size_t)(u.x + r) * 512 + col) = (u32x2){pk_fp8x4(g0), pk_fp8x4(g1)};
                               else *(GAS u32x4*)(hid + ((size_t)(u.x + r) * 512 + col) * 2) = pack8(g0, g1); } }
    }
};
constexpr float YS_SCALE = 8.0f, YS_INV = 1.0f / 8.0f, YS_ACC = DOWN_F8 ? YS_SCALE / WD_SCALE : YS_SCALE;
struct EpiDown {
    static constexpr bool PERM = true; static constexpr bool PRE = (DOWN_PRE != 0);
    unsigned char* ys; const int* ldst; LAS int* dstl; int nostore;
    __device__ __forceinline__ void pre_issue(const Unit& u, int wr, int lane, int& v0, int& v1) const {
        const int ra = 64 * wr + lane, rb = ra + 128; const GAS int* p = (const GAS int*)ldst + (u.e == 64 ? 0 : u.e * 8192 + u.pm * BM);
        const GAS int* pa = p + ((u.e != 64 && ra < u.n) ? ra : 0); const GAS int* pb = p + ((u.e != 64 && rb < u.n) ? rb : 0);
        asm volatile("global_load_dword %0, %1, off" : "=v"(v0) : "v"(pa) : "memory");
        asm volatile("global_load_dword %0, %1, off" : "=v"(v1) : "v"(pb) : "memory");
    }
    __device__ __forceinline__ void pre_commit(int v0, int v1, int wid, int lane_) const { const int lane = opaque(lane_); dstl[wid * 128 + lane] = v0; dstl[wid * 128 + 64 + lane] = v1; }
    __device__ __forceinline__ void operator()(AccRef acc, const Unit& u, int wr, int wc, int fr_, int fq_) const {
        const int fr = opaque(fr_), fq = opaque(fq_);
        const int r0 = wr * 64 + fr, colb = u.pn * BM + 16 * (4 * wc + fq);
#pragma unroll
        for (int ai = 0; ai < 2; ++ai)
#pragma unroll
            for (int m = 0; m < 4; ++m) { const int r = r0 + ai * HALF + m * 16;
                int dst;
                if constexpr (PRE) dst = (u.e == 64) ? (u.pm * BM + r) * NSLOT + 8 : dstl[(wr * 4 + wc) * 128 + ai * 64 + m * 16 + fr];
                else dst = (u.e == 64) ? (u.pm * BM + r) * NSLOT + 8 : ((const GAS int*)ldst)[u.e * 8192 + u.pm * BM + (r < u.n ? r : 0)];
                if (r < u.n && !nostore)
                    *(GAS u32x4*)(ys + (size_t)dst * D + colb) = (u32x4){pk_fp8x4(acc[ai][0][m][0] * YS_ACC), pk_fp8x4(acc[ai][0][m][1] * YS_ACC), pk_fp8x4(acc[ai][1][m][0] * YS_ACC), pk_fp8x4(acc[ai][1][m][1] * YS_ACC)}; }
    }
};
}

struct Args { const float* in[29]; float* out; unsigned char* ws; int ph_lo, ph_hi; };
typedef const __attribute__((address_space(4))) Args KArgs;
__device__ __forceinline__ const float* arg_in(int which) {
#if defined(__HIP_DEVICE_COMPILE__)
    KArgs* p = (KArgs*)__builtin_amdgcn_kernarg_segment_ptr(); return p->in[which];
#else
    (void)which; return nullptr;
#endif
}
enum { I_X = 0, I_C, I_WADA, I_BADA, I_NMIX, I_WIN, I_BIN, I_SINK, I_WO, I_ARE, I_AIM, I_LDT, I_BRE, I_BIM, I_CRE, I_CIM, I_SD, I_WGLU, I_WMIX, I_NFFN, I_WR, I_BR, I_WEG, I_WEU, I_WED, I_WSG, I_WSU, I_WSD, I_NFIN };

struct TDesc { const float* src; bf16_t* dst; int N, K, cc0; float f8s; };
__device__ __forceinline__ void tr_load(const TDesc& d, int lane, f32x4 (&v)[16]) {
    const int kr = lane >> 4, nq = lane & 15;
    const GAS float* p = (const GAS float*)d.src + (size_t)kr * d.N + 4 * nq; const size_t step = (size_t)4 * d.N;
#pragma unroll
    for (int i = 0; i < 16; ++i) { v[i] = __builtin_nontemporal_load((const GAS f32x4*)p); p += step; }
}
__device__ __forceinline__ void tr_finish(const TDesc& d, int lane_, LAS float* scr, const f32x4 (&v)[16]) {
    const int lane = opaque(lane_);
    const int kr = lane >> 4, nq = lane & 15;
#pragma unroll
    for (int i = 0; i < 16; ++i) { const int k = 4 * i + kr;
#pragma unroll
        for (int e = 0; e < 4; ++e) scr[k * 64 + ((4 * nq + e) ^ k)] = v[i][e]; }
    LDS_WAIT();
    const int c = lane & 7;
#pragma unroll
    for (int j = 0; j < 8; ++j) { const int n = (lane >> 3) + 8 * j; float s[8];
#pragma unroll
        for (int i = 0; i < 8; ++i) { const int k = 8 * c + i; s[i] = scr[k * 64 + (n ^ k)]; }
        u32x4 o; o.x = cvt_pk_bf16(s[0], s[1]); o.y = cvt_pk_bf16(s[2], s[3]); o.z = cvt_pk_bf16(s[4], s[5]); o.w = cvt_pk_bf16(s[6], s[7]);
        const int cc = d.cc0 + n, drow = d.cc0 >= 0 ? (128 * ((cc & 15) >> 3) + 8 * (cc >> 4) + (cc & 7)) : n;
        if (d.f8s != 0.f) { const f32x4 sa = (f32x4){s[0], s[1], s[2], s[3]} * d.f8s, sb = (f32x4){s[4], s[5], s[6], s[7]} * d.f8s;
            __builtin_nontemporal_store((u32x2){pg8::pk_fp8x4(sa), pg8::pk_fp8x4(sb)}, (GAS u32x2*)((unsigned char*)d.dst + (size_t)drow * d.K + 8 * c)); }
        else __builtin_nontemporal_store(o, (GAS u32x4*)(d.dst + (size_t)drow * d.K + 8 * c)); }
    LDS_WAIT();
}
__device__ __forceinline__ void tr_half8(const TDesc& d, int lane_, LAS float* scr, const f32x4 (&v)[16], u32x2 (&o)[8]) {
    const int lane = opaque(lane_);
    const int kr = lane >> 4, nq = lane & 15;
#pragma unroll
    for (int i = 0; i < 16; ++i) { const int k = 4 * i + kr;
#pragma unroll
        for (int e = 0; e < 4; ++e) scr[k * 64 + ((4 * nq + e) ^ k)] = v[i][e]; }
    LDS_WAIT();
    const int c = lane & 7;
#pragma unroll
    for (int j = 0; j < 8; ++j) { const int n = (lane >> 3) + 8 * j; float s[8];
#pragma unroll
        for (int i = 0; i < 8; ++i) { const int k = 8 * c + i; s[i] = scr[k * 64 + (n ^ k)]; }
        const f32x4 sa = (f32x4){s[0], s[1], s[2], s[3]} * d.f8s, sb = (f32x4){s[4], s[5], s[6], s[7]} * d.f8s;
        o[j] = (u32x2){pg8::pk_fp8x4(sa), pg8::pk_fp8x4(sb)}; }
    LDS_WAIT();
}
__device__ __forceinline__ void tr_store8(const TDesc& d, int lane, const u32x2 (&o0)[8], const u32x2 (&o1)[8]) {
    const int c = lane & 7;
#pragma unroll
    for (int j = 0; j < 8; ++j) { const int n = (lane >> 3) + 8 * j; const int cc = d.cc0 + n, drow = d.cc0 >= 0 ? (128 * ((cc & 15) >> 3) + 8 * (cc >> 4) + (cc & 7)) : n;
        unsigned char* p = (unsigned char*)d.dst + (size_t)drow * d.K + 8 * c;
        __builtin_nontemporal_store(o0[j], (GAS u32x2*)p); __builtin_nontemporal_store(o1[j], (GAS u32x2*)(p + 64)); }
}
constexpr int IT_WIN = INP_F8 ? 1536 : 3072, IT_WO = 512, IT_WGLU = 512, IT_WMIX = MIX_F8 ? 512 : 1024, IT_EXP = 64 * 128, IT_SH = 128, IT_EXPD = DOWN_F8 ? 64 * 128 : 64 * 256, IT_SHD = DOWN_F8 ? 128 : 256;
constexpr int IT_LAYER = IT_WIN + IT_WO + IT_WGLU + IT_WMIX + 2 * IT_EXP + IT_EXPD + 2 * IT_SH + IT_SHD;
constexpr int IT_MOD = 768;
constexpr int IT_TR = 2 * IT_LAYER;

__device__ __forceinline__ TDesc tr_desc(const float* W, int K, int N, bf16_t* WT, int kb, int nb, int drow0) {
    TDesc d; d.src = W + (size_t)(64 * kb) * N + 64 * nb; d.dst = WT + (size_t)drow0 * K + 64 * kb; d.N = N; d.K = K; d.cc0 = -1; d.f8s = 0.f; return d;
}
__device__ __forceinline__ TDesc tr_desc8(const float* W, int K, int N, unsigned char* WT, int kb, int nb, int drow0, float scale) {
    TDesc d; d.src = W + (size_t)(64 * kb) * N + 64 * nb; d.dst = (bf16_t*)(WT + (size_t)drow0 * K + 64 * kb); d.N = N; d.K = K; d.cc0 = -1; d.f8s = scale; return d;
}
__device__ __forceinline__ TDesc tr_decode(unsigned char* ws, int it) {
    const int l = 1 - it / IT_LAYER; int r = it % IT_LAYER;
    int which, K, N, kb, nb, drow0, cc0 = -1, es = 2; size_t soff, dbyte; float f8s = 0.f;
    if (r < IT_WIN) { which = I_WIN; soff = (size_t)l * 2048 * 6144; K = 2048; N = 6144; dbyte = WS_WIN + (size_t)l * 6144 * 2048 * (INP_F8 ? 1 : 2); kb = r / 96; nb = r % 96; drow0 = 64 * nb;
        if (INP_F8) { es = 1; f8s = pg8::WGU_SCALE; } }
    else if ((r -= IT_WIN) < IT_WO) { which = I_WO; soff = (size_t)l * 1024 * 2048; K = 1024; N = 2048; dbyte = WS_WO + (size_t)l * 2048 * 1024 * 2; kb = r / 32; nb = r % 32; drow0 = 64 * nb; }
    else if ((r -= IT_WO) < IT_WGLU) { which = I_WGLU; soff = (size_t)l * 512 * 4096; K = 512; N = 4096; dbyte = WS_WGLU + (size_t)l * 4096 * 512 * 2; kb = r / 64; nb = r % 64; const int n0 = 64 * nb;
        drow0 = n0 < 2048 ? 256 * (n0 / 128) + (n0 % 128) : 256 * ((n0 - 2048) / 128) + 128 + (n0 % 128); }
    else if ((r -= IT_WGLU) < IT_WMIX) { which = I_WMIX; soff = (size_t)l * 2048 * 2048; K = 2048; N = 2048; dbyte = WS_WMIX + (size_t)l * 2048 * 2048 * (MIX_F8 ? 1 : 2); kb = r / 32; nb = r % 32; drow0 = 64 * nb;
        if (MIX_F8) { es = 1; f8s = pg8::WGU_SCALE; } }
    else { r -= IT_WMIX;
        const size_t wgu = WS_WGU + (size_t)l * 65 * 1024 * 2048;
        constexpr int DES = DOWN_F8 ? 1 : 2; const size_t wd = WS_WD + (size_t)l * 65 * 2048 * 512 * DES;
        if (r < 2 * IT_EXP) { const int up = r >= IT_EXP; r -= up * IT_EXP; const int e = r / 128, q = r % 128; kb = q / 8; nb = q % 8; const int n0 = 64 * nb;
            which = up ? I_WEU : I_WEG; soff = ((size_t)l * 64 + e) * 2048 * 512; K = 2048; N = 512; dbyte = wgu + (size_t)e * 1024 * 2048; es = 1; f8s = pg8::WGU_SCALE; drow0 = 256 * (n0 / 128) + (n0 % 128) + 128 * up; }
        else if ((r -= 2 * IT_EXP) < IT_EXPD) { constexpr int QD = DOWN_F8 ? 128 : 256; const int e = r / QD, q = r % QD; kb = q / 32; nb = q % 32;
            which = I_WED; soff = ((size_t)l * 64 + e) * 512 * 2048; K = 512; N = 2048; dbyte = wd + (size_t)e * 2048 * 512 * DES; es = DES; f8s = DOWN_F8 ? pg8::WD_SCALE : 0.f; drow0 = 256 * (nb / 4); cc0 = 64 * (nb % 4); }
        else if ((r -= IT_EXPD) < 2 * IT_SH) { const int up = r >= IT_SH; r -= up * IT_SH; kb = r / 8; nb = r % 8; const int n0 = 64 * nb;
            which = up ? I_WSU : I_WSG; soff = (size_t)l * 2048 * 512; K = 2048; N = 512; dbyte = wgu + (size_t)64 * 1024 * 2048; es = 1; f8s = pg8::WGU_SCALE; drow0 = 256 * (n0 / 128) + (n0 % 128) + 128 * up; }
        else { r -= 2 * IT_SH; kb = r / 32; nb = r % 32;
            which = I_WSD; soff = (size_t)l * 512 * 2048; K = 512; N = 2048; dbyte = wd + (size_t)64 * 2048 * 512 * DES; es = DES; f8s = DOWN_F8 ? pg8::WD_SCALE : 0.f; drow0 = 256 * (nb / 4); cc0 = 64 * (nb % 4); } }
    const int kr = f8s != 0.f ? 128 : 64;
    TDesc d; d.src = arg_in(which) + soff + (size_t)(kr * kb) * N + 64 * nb; d.dst = (bf16_t*)(ws + dbyte + ((size_t)drow0 * K + kr * kb) * es); d.N = N; d.K = K; d.cc0 = cc0; d.f8s = f8s; return d;
}
__device__ __forceinline__ void mod_item(const Args& a, int it, int tid, LAS unsigned char* lds) {
    const int lane = tid & 63, wave = tid >> 6;
    const int l = it / 384, r = it % 384, ks = r / 48, cc = r % 48;
    const float* W = a.in[I_WADA] + (size_t)l * 2048 * 12288 + (size_t)(256 * ks + 32 * wave) * 12288 + 256 * cc + 4 * lane;
    const float* c0 = a.in[I_C] + 256 * ks + 32 * wave, *c1 = c0 + 2048;
    f32x4 a0 = {0.f, 0.f, 0.f, 0.f}, a1 = {0.f, 0.f, 0.f, 0.f};
#pragma unroll 1
    for (int h = 0; h < 2; ++h) { f32x4 w[16]; const GAS float* wp = (const GAS float*)W + (size_t)(16 * h) * 12288;
#pragma unroll
        for (int i = 0; i < 16; ++i) { w[i] = __builtin_nontemporal_load((const GAS f32x4*)wp); wp += 12288; }
#pragma unroll
        for (int i = 0; i < 16; ++i) { const float x0 = c0[16 * h + i], x1 = c1[16 * h + i]; const float s0 = x0 * fast_sigmoid(x0), s1 = x1 * fast_sigmoid(x1); a0 += w[i] * s0; a1 += w[i] * s1; } }
    LAS f32x4* red = (LAS f32x4*)lds;
    red[(wave * 2 + 0) * 64 + lane] = a0; red[(wave * 2 + 1) * 64 + lane] = a1;
    __syncthreads();
    { const int b = tid >> 8, col = tid & 255; LAS float* rf = (LAS float*)lds; float s = 0.f;
#pragma unroll
        for (int w8 = 0; w8 < 8; ++w8) s += rf[((w8 * 2 + b) * 64) * 4 + col];
        ((float*)(a.ws + WS_MODP))[((size_t)(ks * 2 + l) * 2 + b) * 12288 + 256 * cc + col] = s; }
    __syncthreads();
}
__device__ __forceinline__ void p0_items(const Args& a, int gw, int ngw, LAS float* scr, int lane) {
#pragma unroll 1
    for (int it = gw; it < IT_TR; it += ngw) { f32x4 v[16]; const TDesc d = tr_decode(a.ws, it);
        if (d.f8s != 0.f) { u32x2 o0[8], o1[8]; f32x4 w[16]; TDesc d2 = d; d2.src += (size_t)64 * d.N; tr_load(d, lane, v); tr_load(d2, lane, w);
            tr_half8(d, lane, scr, v, o0); tr_half8(d, lane, scr, w, o1); tr_store8(d, lane, o0, o1); }
        else { tr_load(d, lane, v); tr_finish(d, lane, scr, v); } }
}

__device__ __forceinline__ void cpow(float are, float aim, float dt, int n, float& pr, float& pi) {
    const float mag = __builtin_amdgcn_exp2f((float)n * dt * are * LOG2E);
    const double turns = (double)n * ((double)dt * (double)aim * 0.15915494309189535);
    const float fr = (float)(turns - __builtin_rint(turns));
    pr = mag * __builtin_amdgcn_cosf(fr); pi = mag * __builtin_amdgcn_sinf(fr);
}
__device__ __forceinline__ void ssm_tables(const Args& a, int l, int g, LAS unsigned char* lds, int tid) {
    LAS f32x2* Apow = (LAS f32x2*)lds;
    LAS f32x2* Bb = (LAS f32x2*)(lds + 65 * 64 * 8);
    LAS f32x2* Cc = (LAS f32x2*)(lds + 65 * 64 * 8 + 64 * 16 * 8);
    const int lg = l * 32 + g;
    const float* are_p = a.in[I_ARE] + lg * 64; const float* aim_p = a.in[I_AIM] + lg * 64;
    const float dt = __expf(a.in[I_LDT][lg]);
    unsigned char* tb = a.ws + WS_SSM + (size_t)lg * SSM_STRIDE;
    bf16_t* Et = (bf16_t*)(tb + SSM_E); bf16_t* Ft = (bf16_t*)(tb + SSM_F); bf16_t* Kt = (bf16_t*)(tb + SSM_KT); GAS f32x2* Pt = (GAS f32x2*)(tb + SSM_P);
    for (int idx = tid; idx < 65 * 64; idx += 512) { const int n = idx >> 6, p = idx & 63; float pr, pi; cpow(are_p[p], aim_p[p], dt, n, pr, pi); Apow[idx] = (f32x2){pr, pi}; }
    for (int idx = tid; idx < 64 * 64; idx += 512) { const int m = idx >> 6, p = idx & 63; float pr, pi; cpow(are_p[p], aim_p[p], dt, 64 * m, pr, pi); Pt[idx] = (f32x2){pr, pi}; }
    for (int idx = tid; idx < 64 * 16; idx += 512) { const int p = idx >> 4, c = idx & 15;
        const float ar = are_p[p], ai = aim_p[p]; float br, bi; cpow(ar, ai, dt, 1, br, bi);
        const float nr = br - 1.0f, ni = bi, den = ar * ar + ai * ai; const float fr = (nr * ar + ni * ai) / den, fi = (ni * ar - nr * ai) / den;
        const float b_r = a.in[I_BRE][(size_t)lg * 1024 + idx], b_i = a.in[I_BIM][(size_t)lg * 1024 + idx];
        Bb[idx] = (f32x2){fr * b_r - fi * b_i, fr * b_i + fi * b_r}; }
    for (int idx = tid; idx < 16 * 64; idx += 512) Cc[idx] = (f32x2){a.in[I_CRE][(size_t)lg * 1024 + idx], a.in[I_CIM][(size_t)lg * 1024 + idx]};
    __syncthreads();
    for (int idx = tid; idx < 128 * 128; idx += 512) { const int n = idx >> 7, k8 = idx & 127, ri = n >> 6, p = n & 63, s = k8 >> 1, c0 = (k8 & 1) * 8;
        const f32x2 ap = Apow[(63 - s) * 64 + p]; float v[8];
#pragma unroll
        for (int j = 0; j < 8; ++j) { const f32x2 b = Bb[p * 16 + c0 + j]; v[j] = ri ? (ap.x * b.y + ap.y * b.x) : (ap.x * b.x - ap.y * b.y); }
        u32x4 o; o.x = cvt_pk_bf16(v[0], v[1]); o.y = cvt_pk_bf16(v[2], v[3]); o.z = cvt_pk_bf16(v[4], v[5]); o.w = cvt_pk_bf16(v[6], v[7]);
        *(GAS u32x4*)(Et + (size_t)n * 1024 + k8 * 8) = o; }
    for (int idx = tid; idx < 1024 * 16; idx += 512) { const int n = idx >> 4, k8 = idx & 15, t = n >> 4, c = n & 15, ri = k8 >> 3, p0 = (k8 & 7) * 8; float v[8];
#pragma unroll
        for (int j = 0; j < 8; ++j) { const f32x2 ap = Apow[(t + 1) * 64 + p0 + j], cc = Cc[c * 64 + p0 + j]; v[j] = ri ? -(cc.x * ap.y + cc.y * ap.x) : (cc.x * ap.x - cc.y * ap.y); }
        u32x4 o; o.x = cvt_pk_bf16(v[0], v[1]); o.y = cvt_pk_bf16(v[2], v[3]); o.z = cvt_pk_bf16(v[4], v[5]); o.w = cvt_pk_bf16(v[6], v[7]);
        *(GAS u32x4*)(Ft + (size_t)n * 128 + k8 * 8) = o; }
    for (int idx = tid; idx < 65 * 16 * 2; idx += 512) { const int t1 = idx >> 5, c = (idx >> 1) & 15, c0 = (idx & 1) * 8; float v[8];
#pragma unroll
        for (int j = 0; j < 8; ++j) v[j] = 0.f;
        if (t1 > 0) for (int p = 0; p < 64; ++p) { const f32x2 ap = Apow[(t1 - 1) * 64 + p], cc = Cc[c * 64 + p]; const float cr = cc.x * ap.x - cc.y * ap.y, ci = cc.x * ap.y + cc.y * ap.x;
#pragma unroll
            for (int j = 0; j < 8; ++j) { const f32x2 b = Bb[p * 16 + c0 + j]; v[j] += cr * b.x - ci * b.y; } }
        u32x4 o; o.x = cvt_pk_bf16(v[0], v[1]); o.y = cvt_pk_bf16(v[2], v[3]); o.z = cvt_pk_bf16(v[4], v[5]); o.w = cvt_pk_bf16(v[6], v[7]);
        *(GAS u32x4*)(Kt + (size_t)(t1 * 16 + c) * 16 + c0) = o; }
    __syncthreads();
}

__device__ __forceinline__ void attn_unit(const bf16_t* __restrict__ proj, bf16_t* __restrict__ attn, const float* sinks, int unit, LAS unsigned char* lds, int tid_) {
    const int tid = opaque(tid_);
    const int b = unit >> 7, hk = (unit >> 5) & 3, nb = unit & 31;
    const int wave = __builtin_amdgcn_readfirstlane(tid >> 6), lane = tid & 63, r16 = lane & 15, q4 = lane >> 4;
    LAS unsigned char* Kl = lds;
    LAS unsigned char* Vt = lds + 36864;
    const int gh0 = wave >> 1, half0 = wave & 1, qh0 = hk * 4 + gh0;
    bf16x8 qfa[4][2];
#pragma unroll
    for (int pass = 0; pass < 4; ++pass)
#pragma unroll
        for (int s = 0; s < 2; ++s) qfa[pass][s] = *(const GAS bf16x8*)(proj + (size_t)(b * SEQ + nb * 128 + 16 * (half0 * 4 + pass) + r16) * INW + O_Q + qh0 * 64 + 32 * s + 8 * q4);
#pragma unroll
    for (int i = 0; i < 4; ++i) { const int id = tid + 512 * i, key = id >> 3, ch = id & 7; const int tp = nb * 128 - 128 + key;
        u32x4 kv = {0u, 0u, 0u, 0u}, vv = {0u, 0u, 0u, 0u};
        if (tp >= 0) { const bf16_t* src = proj + (size_t)(b * SEQ + tp) * INW + hk * 64 + ch * 8; kv = *(const GAS u32x4*)(src + O_K); vv = *(const GAS u32x4*)(src + O_V); }
        *(LAS u32x4*)(Kl + key * 144 + ch * 16) = kv;
        LAS bf16_t* vd = (LAS bf16_t*)(Vt + (ch * 8) * 528 + key * 2);
        vd[0 * 264] = (bf16_t)(vv.x & 0xffff); vd[1 * 264] = (bf16_t)(vv.x >> 16); vd[2 * 264] = (bf16_t)(vv.y & 0xffff); vd[3 * 264] = (bf16_t)(vv.y >> 16);
        vd[4 * 264] = (bf16_t)(vv.z & 0xffff); vd[5 * 264] = (bf16_t)(vv.z >> 16); vd[6 * 264] = (bf16_t)(vv.w & 0xffff); vd[7 * 264] = (bf16_t)(vv.w >> 16); }
    __syncthreads();
    const int gh = wave >> 1, half = wave & 1, qh = hk * 4 + gh;
    const float sink = sinks[qh] * LOG2E;
#pragma unroll
    for (int pass = 0; pass < 4; ++pass) {
        const int kt0 = half * 4 + pass, i0 = 16 * kt0, iabs = i0 + r16; const size_t qtok = (size_t)(b * SEQ + nb * 128 + iabs);
        bf16x8 qf[2];
#pragma unroll
        for (int s = 0; s < 2; ++s) qf[s] = qfa[pass][s];
        __builtin_amdgcn_sched_barrier(0);
        f32x4 st[10];
        const LAS unsigned char* kbase = Kl + (16 * kt0 + r16) * 144 + (8 * q4) * 2;
#pragma unroll
        for (int i = 0; i < 9; ++i) { st[i] = (f32x4){0.f, 0.f, 0.f, 0.f};
#pragma unroll
            for (int s = 0; s < 2; ++s) { const bf16x8 kf = *(const LAS bf16x8*)(kbase + i * 16 * 144 + s * 64);
                st[i] = __builtin_amdgcn_mfma_f32_16x16x32_bf16(kf, qf[s], st[i], 0, 0, 0); } }
        st[9] = (f32x4){0.f, 0.f, 0.f, 0.f};
        float mx = sink;
#pragma unroll
        for (int i = 0; i < 9; ++i)
#pragma unroll
            for (int r = 0; r < 4; ++r) { const int jj = 16 * i + 4 * q4 + r; const bool ok = (jj > r16) && (jj <= r16 + 128) && (nb > 0 || jj + i0 >= 128);
                st[i][r] = ok ? st[i][r] : -1e30f; mx = fmaxf(mx, st[i][r]); }
        mx = fmaxf(mx, __shfl_xor(mx, 16)); mx = fmaxf(mx, __shfl_xor(mx, 32));
        float sum = 0.f;
#pragma unroll
        for (int i = 0; i < 9; ++i)
#pragma unroll
            for (int r = 0; r < 4; ++r) { const float p = __builtin_amdgcn_exp2f(st[i][r] - mx); st[i][r] = p; sum += p; }
        sum += __shfl_xor(sum, 16); sum += __shfl_xor(sum, 32);
        const float inv = __builtin_amdgcn_rcpf(sum + __builtin_amdgcn_exp2f(sink - mx));
        f32x4 ot[4];
#pragma unroll
        for (int dt = 0; dt < 4; ++dt) ot[dt] = (f32x4){0.f, 0.f, 0.f, 0.f};
#pragma unroll
        for (int kk = 0; kk < 5; ++kk) {
            u32x4 pw; pw.x = cvt_pk_bf16(st[2 * kk][0], st[2 * kk][1]); pw.y = cvt_pk_bf16(st[2 * kk][2], st[2 * kk][3]); pw.z = cvt_pk_bf16(st[2 * kk + 1][0], st[2 * kk + 1][1]); pw.w = cvt_pk_bf16(st[2 * kk + 1][2], st[2 * kk + 1][3]);
            const bf16x8 pf = __builtin_bit_cast(bf16x8, pw);
            const int t0 = kt0 + 2 * kk, t1 = (t0 + 1) < 15 ? (t0 + 1) : 15;
#pragma unroll
            for (int dt = 0; dt < 4; ++dt) { const LAS unsigned char* vp = Vt + (16 * dt + r16) * 528 + (4 * q4) * 2;
                const u32x2 lo = *(const LAS u32x2*)(vp + t0 * 32), hi = *(const LAS u32x2*)(vp + t1 * 32);
                const u32x4 vw = {lo.x, lo.y, hi.x, hi.y};
                ot[dt] = __builtin_amdgcn_mfma_f32_16x16x32_bf16(__builtin_bit_cast(bf16x8, vw), pf, ot[dt], 0, 0, 0); } }
#pragma unroll
        for (int dt = 0; dt < 4; ++dt) { u32x2 o; o.x = cvt_pk_bf16(ot[dt][0] * inv, ot[dt][1] * inv); o.y = cvt_pk_bf16(ot[dt][2] * inv, ot[dt][3] * inv);
            *(GAS u32x2*)(attn + qtok * 1024 + qh * 64 + 16 * dt + 4 * q4) = o; }
    }
    __syncthreads();
}

constexpr int UPITCH = 2064;
__device__ __forceinline__ void stage_u_issue(const bf16_t* __restrict__ proj, int g, int b, int q, int tid, u32x4 (&uu)[4]) {
#pragma unroll
    for (int i = 0; i < 4; ++i) { const int id = tid + 512 * i, tl = id >> 1, half = id & 1, chunk = tl >> 6, s = tl & 63;
        uu[i] = *(const GAS u32x4*)(proj + (size_t)(b * SEQ + (16 * q + chunk) * 64 + s) * INW + O_U + g * 16 + 8 * half); }
}
__device__ __forceinline__ void stage_u_commit(LAS unsigned char* Al, int tid, u32x4 (&uu)[4]) {
    asm volatile("" : "+v"(uu[0]), "+v"(uu[1]), "+v"(uu[2]), "+v"(uu[3]) :: "memory");
#pragma unroll
    for (int i = 0; i < 4; ++i) { const int id = tid + 512 * i, tl = id >> 1, half = id & 1, chunk = tl >> 6, s = tl & 63;
        *(LAS u32x4*)(Al + chunk * UPITCH + (s * 16 + 8 * half) * 2) = uu[i]; }
}
__device__ __forceinline__ void ssm_s1_unit(const bf16_t* __restrict__ proj, const bf16_t* __restrict__ Et, float* __restrict__ sloc, int g, int b, int q, LAS unsigned char* lds, int tid_) {
    const int tid = opaque(tid_);
    const int wave = __builtin_amdgcn_readfirstlane(tid >> 6), lane = tid & 63, r16 = lane & 15, q4 = lane >> 4;
    const bf16_t* eb = Et + (size_t)(16 * wave + r16) * 1024 + 8 * q4;
    u32x4 uu[4]; stage_u_issue(proj, g, b, q, tid, uu);
    bf16x8 bf[32];
#pragma unroll
    for (int ks = 0; ks < 32; ++ks) bf[ks] = *(const GAS bf16x8*)(eb + 32 * ks);
    stage_u_commit(lds, tid, uu);
    __syncthreads();
    f32x4 acc = {0.f, 0.f, 0.f, 0.f};
#pragma unroll
    for (int ks = 0; ks < 32; ++ks) { const bf16x8 af = *(const LAS bf16x8*)(lds + r16 * UPITCH + (32 * ks + 8 * q4) * 2);
        acc = __builtin_amdgcn_mfma_f32_16x16x32_bf16(af, bf[ks], acc, 0, 0, 0); }
#pragma unroll
    for (int r = 0; r < 4; ++r) sloc[((size_t)(b * 64 + 16 * q + 4 * q4 + r) * 32 + g) * 128 + 16 * wave + r16] = acc[r];
    __syncthreads();
}

__device__ __forceinline__ void ssm_s2_unit(const bf16_t* __restrict__ proj, const unsigned char* __restrict__ tb, const float* __restrict__ sloc, const float* __restrict__ dskip, bf16_t* __restrict__ ybuf,
                                            int g, int b, int q, LAS unsigned char* lds, int tid_, int nostore = 0) {
    const int tid = opaque(tid_);
    const int wave = __builtin_amdgcn_readfirstlane(tid >> 6), lane = tid & 63, r16 = lane & 15, q4 = lane >> 4;
    LAS unsigned char* Ktl = lds;
    LAS bf16_t* x0l = (LAS bf16_t*)(lds + 33280);
    LAS unsigned char* Al = lds + 49152;
    const bf16_t* Ft = (const bf16_t*)(tb + SSM_F); const GAS f32x2* Pt = (const GAS f32x2*)(tb + SSM_P);
    const int p = tid & 63, part = tid >> 6, j0 = 16 * q;
    f32x2 Pp[6]; float srp[6], sip[6];
#pragma unroll
    for (int ii = 0; ii < 6; ++ii) { const int i = part + 8 * ii; const bool ok = i < j0; const int ic = ok ? i : 0, pc = ok ? (j0 - 1 - i) : 0;
        Pp[ii] = Pt[pc * 64 + p]; const GAS float* sp = (const GAS float*)(sloc + ((size_t)(b * 64 + ic) * 32 + g) * 128); srp[ii] = sp[p]; sip[ii] = sp[64 + p]; }
    u32x4 kt[5];
    { const GAS u32x4* src = (const GAS u32x4*)(tb + SSM_KT);
#pragma unroll
      for (int j = 0; j < 5; ++j) { const int i = tid + 512 * j; kt[j] = src[i < 33280 / 16 ? i : 33280 / 16 - 1]; } }
    u32x4 uu[4]; stage_u_issue(proj, g, b, q, tid, uu);
    const f32x2 A64 = Pt[64 + p];
    float sr[15], si[15];
#pragma unroll
    for (int jq = 0; jq < 15; ++jq) { const GAS float* sp = (const GAS float*)(sloc + ((size_t)(b * 64 + j0 + jq) * 32 + g) * 128); sr[jq] = sp[p]; si[jq] = sp[64 + p]; }
    bf16x8 ff[4][8];
#pragma unroll
    for (int k2 = 0; k2 < 4; ++k2)
#pragma unroll
        for (int tt = 0; tt < 8; ++tt) ff[k2][tt] = *(const GAS bf16x8*)(Ft + (size_t)((wave + 8 * tt) * 16 + r16) * 128 + 32 * k2 + 8 * q4);
    {
        LAS f32x2* red = (LAS f32x2*)(lds + 40960);
        asm volatile("" : "+v"(Pp[0]), "+v"(Pp[1]), "+v"(Pp[2]), "+v"(Pp[3]), "+v"(Pp[4]), "+v"(Pp[5]) :: "memory");
        asm volatile("" : "+v"(srp[0]), "+v"(srp[1]), "+v"(srp[2]), "+v"(srp[3]), "+v"(srp[4]), "+v"(srp[5]), "+v"(sip[0]), "+v"(sip[1]), "+v"(sip[2]), "+v"(sip[3]), "+v"(sip[4]), "+v"(sip[5]) :: "memory");
        float xr = 0.f, xi = 0.f;
#pragma unroll
        for (int ii = 0; ii < 6; ++ii) { const bool ok = part + 8 * ii < j0; const float pr = ok ? Pp[ii].x : 0.f, pi = ok ? Pp[ii].y : 0.f;
            xr += pr * srp[ii] - pi * sip[ii]; xi += pr * sip[ii] + pi * srp[ii]; }
        red[part * 64 + p] = (f32x2){xr, xi};
        asm volatile("" : "+v"(kt[0]), "+v"(kt[1]), "+v"(kt[2]), "+v"(kt[3]), "+v"(kt[4]) :: "memory");
#pragma unroll
        for (int j = 0; j < 5; ++j) { const int i = tid + 512 * j; if (i < 33280 / 16) *(LAS u32x4*)(Ktl + i * 16) = kt[j]; }
        stage_u_commit(Al, tid, uu);
        __syncthreads();
        if (part == 0) {
            float ar = 0.f, ai = 0.f;
#pragma unroll
            for (int w8 = 0; w8 < 8; ++w8) { const f32x2 t = red[w8 * 64 + p]; ar += t.x; ai += t.y; }
#pragma unroll
            for (int jq = 0; jq < 16; ++jq) {
                x0l[jq * 136 + p] = (bf16_t)(cvt_pk_bf16(ar, 0.f) & 0xffff); x0l[jq * 136 + 64 + p] = (bf16_t)(cvt_pk_bf16(ai, 0.f) & 0xffff);
                if (jq < 15) { const float nr = A64.x * ar - A64.y * ai + sr[jq], ni = A64.x * ai + A64.y * ar + si[jq]; ar = nr; ai = ni; } }
        }
    }
    __syncthreads();
    f32x4 acc[8];
#pragma unroll
    for (int tt = 0; tt < 8; ++tt) acc[tt] = (f32x4){0.f, 0.f, 0.f, 0.f};
#pragma unroll 2
    for (int ks = 0; ks < 32; ++ks) { const int s = 2 * ks + (q4 >> 1);
        const bf16x8 af = *(const LAS bf16x8*)(Al + r16 * UPITCH + (32 * ks + 8 * q4) * 2);
#pragma unroll
        for (int tt = 0; tt < 8; ++tt) { const int t = wave + 8 * tt;
            const int tau1 = t - s + 1, tc = tau1 > 0 ? tau1 : 0;
            const bf16x8 bf = *(const LAS bf16x8*)(Ktl + ((tc * 16 + r16) * 16 + 8 * (q4 & 1)) * 2);
            acc[tt] = __builtin_amdgcn_mfma_f32_16x16x32_bf16(af, bf, acc[tt], 0, 0, 0); }
        __builtin_amdgcn_sched_barrier(0); }
#pragma unroll
    for (int k2 = 0; k2 < 4; ++k2) { const bf16x8 ax = *(const LAS bf16x8*)(x0l + r16 * 136 + 32 * k2 + 8 * q4);
#pragma unroll
        for (int tt = 0; tt < 8; ++tt) acc[tt] = __builtin_amdgcn_mfma_f32_16x16x32_bf16(ax, ff[k2][tt], acc[tt], 0, 0, 0); }
    const float dsk = dskip[g * 16 + r16];
#pragma unroll
    for (int tt = 0; tt < 8; ++tt) { const int t = wave + 8 * tt;
#pragma unroll
        for (int r = 0; r < 4; ++r) { const int jq = 4 * q4 + r; const size_t tok = (size_t)(b * SEQ + (16 * q + jq) * 64 + t);
            const float uv = bf1(*(const LAS bf16_t*)(Al + jq * UPITCH + (t * 16 + r16) * 2)); const float y = acc[tt][r] + dsk * uv;
            const float z = 0.7978845608028654f * (y + 0.044715f * y * y * y); const float gl = y * fast_sigmoid(2.0f * z);
            if (!nostore) ybuf[tok * 512 + g * 16 + r16] = (bf16_t)(cvt_pk_bf16(gl, 0.f) & 0xffff); } }
    __syncthreads();
}

__device__ __forceinline__ unsigned char* opaque_p(unsigned char* p) { asm volatile("" : "+s"(p)); return p; }
__device__ __forceinline__ int opaque_si(int v) { asm volatile("" : "+s"(v)); return v; }
__device__ __forceinline__ Args load_args() {
#if defined(__HIP_DEVICE_COMPILE__)
    KArgs* p = (KArgs*)__builtin_amdgcn_kernarg_segment_ptr(); asm volatile("" : "+s"(p)); Args a;
#pragma unroll
    for (int i = 0; i < 29; ++i) a.in[i] = p->in[i];
    a.out = p->out; a.ws = p->ws; a.ph_lo = p->ph_lo; a.ph_hi = p->ph_hi; return a;
#else
    return Args{};
#endif
}
#define PH_BEGIN const unsigned long long ph_t0 = (TIME_MASK) ? __builtin_amdgcn_s_memtime() : 0ull; (void)ph_t0; const Args args = load_args(); const int G = opaque_si(G_k), blk = opaque_si(blk_k); const int wave = opaque_si(wave_k); const int tid = opaque(lane_now() + 64 * wave), lane = tid & 63; unsigned char* const ws = opaque_p(args.ws); (void)lane; (void)wave; \
    bf16_t* const hbuf = (bf16_t*)(ws + WS_H); bf16_t* const proj = (bf16_t*)(ws + WS_PROJ); float* const mod = (float*)(ws + WS_MOD); float* const xbuf = args.out; unsigned* const ctl = (unsigned*)(ws + WS_CTL); \
    (void)hbuf; (void)proj; (void)mod; (void)xbuf; (void)ctl;

__global__ void __launch_bounds__(NWAVES * 64, 2) mega_fwd(Args args) {
    extern __shared__ __attribute__((aligned(16))) unsigned char lds_raw[];
    LAS unsigned char* lds = (LAS unsigned char*)lds_raw;
    const int wave_k = __builtin_amdgcn_readfirstlane((int)threadIdx.x >> 6);
    const int G_k = gridDim.x, blk_k = blockIdx.x;
    XcdBarrier bar;
    {
        volatile LAS unsigned* MISC = (volatile LAS unsigned*)(lds + MISC_OFF);
        unsigned* ctl0 = (unsigned*)(args.ws + WS_CTL);
        for (int u = threadIdx.x; u < (LDS_BYTES - LDSCTL_OFF) / 4; u += NWAVES * 64) ((LAS unsigned*)(lds + LDSCTL_OFF))[u] = 0u;
        __syncthreads();
        bar.bar = ctl0 + CW_BAR; bar.x = 0; bar.st = nullptr; bar.wv = wave_k;
        if (N_LAUNCHES == 1) bar = xcd_barrier_post(ctl0 + CW_BAR, MISC + 8);
    }
#define GRID_BAR() do { if (N_LAUNCHES == 1) xcd_barrier(bar); } while (0)
    const int lo = args.ph_lo, hi = args.ph_hi;
#ifndef PH_MASK
#define PH_MASK 0x7ff
#endif
#ifndef REP_MASK
#define REP_MASK 0
#endif
#ifndef REP_VARIANT
#define REP_VARIANT 0
#endif
#define REPS(bit) (((REP_MASK) >> (bit)) & 1 ? 2 : 1)
#ifndef TIME_MASK
#define TIME_MASK 0
#endif
#define PH_END(bit) if ((TIME_MASK >> (bit)) & 1) { asm volatile("s_waitcnt vmcnt(0) lgkmcnt(0)" ::: "memory"); const unsigned long long t1_ = __builtin_amdgcn_s_memtime(); \
    while (__builtin_amdgcn_s_memtime() - t1_ < t1_ - ph_t0) __builtin_amdgcn_s_sleep(8); }
#define IN(k) (lo <= (k) && (k) < hi)
#define BOTH(k) (IN(k) && IN((k) + 1))

    if ((PH_MASK & 1) && IN(0)) {
        PH_BEGIN
            _Pragma("unroll 1") for (int rep = 0; rep < REPS(9); ++rep) {
        if (blk < 64) ssm_tables(args, blk >> 5, blk & 31, lds, tid);
        LAS float* scr = (LAS float*)(lds + wave * 16384);
        for (int idx = blk * 512 + tid; idx < 2 * 64 * 256; idx += G * 512) {
            const int e = idx & 63, kc = (idx >> 6) & 255, l = idx >> 14; const float* wsrc = args.in[I_WR] + (size_t)l * D * NE + (size_t)(8 * kc) * NE + e;
            float w[8], lo[8]; unsigned hi[4];
#pragma unroll
            for (int i = 0; i < 8; ++i) w[i] = wsrc[i * NE];
#pragma unroll
            for (int i = 0; i < 4; ++i) { hi[i] = cvt_pk_bf16(w[2 * i], w[2 * i + 1]); lo[2 * i] = w[2 * i] - bf_lo(hi[i]); lo[2 * i + 1] = w[2 * i + 1] - bf_hi(hi[i]); }
            bf16_t* dsth = (bf16_t*)(ws + WS_WRT) + ((size_t)(l * 2) * 64 + e) * 2048 + 8 * kc;
            *(GAS u32x4*)dsth = (u32x4){hi[0], hi[1], hi[2], hi[3]};
            *(GAS u32x4*)(dsth + 64 * 2048) = (u32x4){cvt_pk_bf16(lo[0], lo[1]), cvt_pk_bf16(lo[2], lo[3]), cvt_pk_bf16(lo[4], lo[5]), cvt_pk_bf16(lo[6], lo[7])}; }
        for (int it = blk; it < IT_MOD; it += G) mod_item(args, it, tid, lds);
        p0_items(args, blk * NWAVES + wave, G * NWAVES, scr, lane);
            if (rep + 1 < REPS(9)) GRID_BAR(); }
        PH_END(9) if (BOTH(0)) GRID_BAR();
    }
    if ((PH_MASK & 2) && IN(1)) {
        PH_BEGIN
        const float* modp = (const float*)(ws + WS_MODP);
        for (int idx = blk * 512 + tid; idx < 2 * 2 * 12288; idx += G * 512) { const int l = idx / 24576, c = idx % 12288; float s = args.in[I_BADA][l * 12288 + c];
#pragma unroll
            for (int ks = 0; ks < 8; ++ks) s += modp[(size_t)ks * 49152 + idx];
            mod[idx] = s; }
        for (int rb = blk; rb < T / 32; rb += G) {
            const int bb = (rb * 32) / SEQ;
            LAS float* shl = (LAS float*)lds; LAS float* scl = shl + 2048;
            for (int c = tid; c < 4096; c += 512) { float s = args.in[I_BADA][c];
#pragma unroll
                for (int ks = 0; ks < 8; ++ks) s += modp[(size_t)ks * 49152 + bb * 12288 + c];
                shl[c] = s; }
            __syncthreads();
#pragma unroll 1
            for (int pr = 0; pr < 2; ++pr) {
                f32x4 v[2][4][2]; float ss[2] = {0.f, 0.f};
#pragma unroll
                for (int rr = 0; rr < 2; ++rr) { const float* xr = args.in[I_X] + (size_t)(rb * 32 + wave * 4 + pr * 2 + rr) * D;
#pragma unroll
                    for (int j = 0; j < 4; ++j)
#pragma unroll
                        for (int h = 0; h < 2; ++h) v[rr][j][h] = *(const GAS f32x4*)(xr + 8 * (lane + 64 * j) + 4 * h); }
#pragma unroll
                for (int rr = 0; rr < 2; ++rr)
#pragma unroll
                    for (int j = 0; j < 4; ++j)
#pragma unroll
                        for (int h = 0; h < 2; ++h) ss[rr] += v[rr][j][h][0] * v[rr][j][h][0] + v[rr][j][h][1] * v[rr][j][h][1] + v[rr][j][h][2] * v[rr][j][h][2] + v[rr][j][h][3] * v[rr][j][h][3];
#pragma unroll
                for (int rr = 0; rr < 2; ++rr) { const int row = rb * 32 + wave * 4 + pr * 2 + rr;
                    const float rstd = 1.0f / sqrtf(wave_sum(ss[rr]) * (1.0f / D) + NORM_EPS);
                    bf16_t* hrow = hbuf + (size_t)row * D;
#pragma unroll
                    for (int j = 0; j < 4; ++j) { const int c = 8 * (lane + 64 * j); f32x4 o[2];
#pragma unroll
                        for (int h = 0; h < 2; ++h) { const f32x4 g = *(const GAS f32x4*)(args.in[I_NMIX] + c + 4 * h); const f32x4 s1 = *(const LAS f32x4*)(scl + c + 4 * h), s0 = *(const LAS f32x4*)(shl + c + 4 * h);
                            o[h] = v[rr][j][h] * rstd * g * (s1 + 1.0f) + s0; }
                        if (INP_F8) *(GAS u32x2*)((unsigned char*)hbuf + (size_t)row * D + c) = (u32x2){pg8::pk_fp8x4(o[0]), pg8::pk_fp8x4(o[1])};
                        else *(GAS u32x4*)(hrow + c) = pg8::pack8(o[0], o[1]); } } }
            __syncthreads();
        }
        PH_END(10) if (BOTH(1)) GRID_BAR();
    }

#pragma unroll 1
    for (int l = 0; l < DEPTH; ++l) {
        const int pb = 2 + 9 * l;
        if ((PH_MASK & 4) && IN(pb + 0)) {
            PH_BEGIN
            _Pragma("unroll 1") for (int rep = 0; rep < REPS(0); ++rep) {
            pg8::DenseOrder S; S.init(T, INW, INP_F8 ? D / 2 : D, G, blk, ws + WS_WIN + (size_t)l * INW * D * (INP_F8 ? 1 : 2));
            pg8::EpiInProj E{proj, args.in[I_BIN] + l * INW, 0.125f * LOG2E, (REP_VARIANT && rep == 1) ? 1 : 0};
            pg8::gemm_phase<pg8::EpiInProj, pg8::DenseOrder, GEMM_ALIGN, GEMM_SP2, INP_F8 != 0>(lds, (const char*)hbuf, INP_F8 ? D / 2 : D, S, E, wave);
            if (rep + 1 < REPS(0)) GRID_BAR(); }
            PH_END(0) if (BOTH(pb + 0)) GRID_BAR();
        }
        if ((PH_MASK & 8) && IN(pb + 1)) {
            PH_BEGIN
            _Pragma("unroll 1") for (int rep = 0; rep < REPS(1); ++rep) {
            for (int u = blk; u < 256; u += G) attn_unit(proj, (bf16_t*)(ws + WS_ATTN), args.in[I_SINK] + l * 16, u, lds, tid);
            if (!(REP_VARIANT == 1 && rep == 1)) for (int u = blk; u < 256; u += G) { const int g = u >> 3, b = (u >> 2) & 1, q = u & 3;
                ssm_s1_unit(proj, (const bf16_t*)(ws + WS_SSM + (size_t)(l * 32 + g) * SSM_STRIDE + SSM_E), (float*)(ws + WS_SLOC), g, b, q, lds, tid); }
            if (rep + 1 < REPS(1)) GRID_BAR(); }
            PH_END(1) if (BOTH(pb + 1)) GRID_BAR();
        }
        if ((PH_MASK & 16) && IN(pb + 2)) {
            PH_BEGIN
            _Pragma("unroll 1") for (int rep = 0; rep < REPS(2); ++rep) {
            if (!(REP_VARIANT == 1 && rep == 1)) for (int u = blk; u < 256; u += G) { const int g = u >> 3, b = (u >> 2) & 1, q = u & 3;
                ssm_s2_unit(proj, ws + WS_SSM + (size_t)(l * 32 + g) * SSM_STRIDE, (const float*)(ws + WS_SLOC), args.in[I_SD] + l * 512, (bf16_t*)(ws + WS_Y), g, b, q, lds, tid, (REP_VARIANT == 2 && rep == 1) ? 1 : 0); }
            pg8::DenseOrder S; S.init(T, D, 1024, G, blk, (bf16_t*)(ws + WS_WO) + (size_t)l * D * 1024);
            pg8::EpiAttnProj E{proj, (bf16_t*)(ws + WS_MIXED)};
            pg8::gemm_phase<pg8::EpiAttnProj, pg8::DenseOrder>(lds, (const char*)(ws + WS_ATTN), 1024, S, E, wave);
            if (rep + 1 < REPS(2)) GRID_BAR(); }
            PH_END(2) if (BOTH(pb + 2)) GRID_BAR();
        }
        if ((PH_MASK & 32) && IN(pb + 3)) {
            PH_BEGIN
            const int nrep = REPS(3);
            _Pragma("unroll 1") for (int rep = 0; rep < nrep; ++rep) {
            pg8::DenseOrder S; S.init(T, 4096, 512, G, blk, (bf16_t*)(ws + WS_WGLU) + (size_t)l * 4096 * 512);
            pg8::EpiGlu E{proj, (const bf16_t*)(ws + WS_MIXED), (bf16_t*)(ws + WS_MIXED2)};
            pg8::gemm_phase<pg8::EpiGlu, pg8::DenseOrder, GEMM_ALIGN>(lds, (const char*)(ws + WS_Y), 512, S, E, wave);
            if (rep + 1 < nrep) GRID_BAR(); }
            PH_END(3) if (BOTH(pb + 3)) GRID_BAR();
        }
        if ((PH_MASK & 64) && IN(pb + 4)) {
            PH_BEGIN
            const int nrep = (l == 0 ? REPS(4) : 1);
            _Pragma("unroll 1") for (int rep = 0; rep < nrep; ++rep) {
            pg8::DenseOrder S; S.init(T, D, MIX_F8 ? D / 2 : D, G, blk, ws + WS_WMIX + (size_t)l * D * D * (MIX_F8 ? 1 : 2));
            pg8::EpiMixOut E{l == 0 ? args.in[I_X] : (const float*)nullptr, (const bf16_t*)(ws + WS_XB), (bf16_t*)(ws + WS_XB), mod + (size_t)l * 2 * 12288 + 2 * 2048};
            pg8::gemm_phase<pg8::EpiMixOut, pg8::DenseOrder, false, GEMM_SP2, MIX_F8 != 0>(lds, (const char*)(ws + WS_MIXED2), MIX_F8 ? D / 2 : D, S, E, wave);
            if (rep + 1 < nrep) GRID_BAR(); }
            PH_END(4) if (BOTH(pb + 4)) GRID_BAR();
        }
        if ((PH_MASK & 128) && IN(pb + 5)) {
            PH_BEGIN
            const int nrep = REPS(5);
            _Pragma("unroll 1") for (int rep = 0; rep < nrep; ++rep) {
            const float* modl = mod + (size_t)l * 2 * 12288;
            int* ltok = (int*)(ws + WS_LTOK); int* ldst = (int*)(ws + WS_LDST); float* lw = (float*)(ws + WS_LW);
            LAS unsigned long long* selmask = (LAS unsigned long long*)(lds + SEL_OFF);
            LAS float* selw = (LAS float*)(lds + SEL_OFF + 256);
            const float* wrt = args.in[I_WR] + (size_t)l * D * NE; const float brt = args.in[I_BR][l * NE + lane];
            for (int rb = blk; rb < T / 32; rb += G) {
                const int bb = (rb * 32) / SEQ; const float* sh2 = modl + bb * 12288 + 3 * 2048; const float* sc2 = sh2 + 2048;
#pragma unroll 1
                for (int it = 0; it < 2; ++it) {
                    {
                        f32x4 v[2][4][2]; float ss[2] = {0.f, 0.f};
                        u32x4 xw[2][4]; f32x4 gsc[4][2], gsh[4][2], sc1[4][2];
#pragma unroll
                        for (int rr = 0; rr < 2; ++rr) { const bf16_t* xr = (const bf16_t*)(ws + WS_XB) + (size_t)(rb * 32 + it * 16 + 2 * wave + rr) * D;
#pragma unroll
                            for (int j = 0; j < 4; ++j) xw[rr][j] = *(const GAS u32x4*)(xr + 8 * (lane + 64 * j)); }
#pragma unroll
                        for (int j = 0; j < 4; ++j)
#pragma unroll
                            for (int h = 0; h < 2; ++h) { const int c = 8 * (lane + 64 * j) + 4 * h;
                                gsc[j][h] = *(const GAS f32x4*)(args.in[I_NFFN] + l * D + c); sc1[j][h] = *(const GAS f32x4*)(sc2 + c); gsh[j][h] = *(const GAS f32x4*)(sh2 + c); }
#pragma unroll
                        for (int rr = 0; rr < 2; ++rr) asm volatile("" : "+v"(xw[rr][0]), "+v"(xw[rr][1]), "+v"(xw[rr][2]), "+v"(xw[rr][3]) :: "memory");
#pragma unroll
                        for (int j = 0; j < 4; ++j) asm volatile("" : "+v"(gsc[j][0]), "+v"(gsc[j][1]), "+v"(sc1[j][0]), "+v"(sc1[j][1]), "+v"(gsh[j][0]), "+v"(gsh[j][1]) :: "memory");
#pragma unroll
                        for (int rr = 0; rr < 2; ++rr)
#pragma unroll
                            for (int j = 0; j < 4; ++j) pg8::unpack8(xw[rr][j], v[rr][j][0], v[rr][j][1]);
#pragma unroll
                        for (int j = 0; j < 4; ++j)
#pragma unroll
                            for (int h = 0; h < 2; ++h) gsc[j][h] = gsc[j][h] * (sc1[j][h] + 1.0f);
#pragma unroll
                        for (int rr = 0; rr < 2; ++rr)
#pragma unroll
                            for (int j = 0; j < 4; ++j)
#pragma unroll
                                for (int h = 0; h < 2; ++h) ss[rr] += v[rr][j][h][0] * v[rr][j][h][0] + v[rr][j][h][1] * v[rr][j][h][1] + v[rr][j][h][2] * v[rr][j][h][2] + v[rr][j][h][3] * v[rr][j][h][3];
#pragma unroll
                        for (int rr = 0; rr < 2; ++rr) { const int lr = 2 * wave + rr, row = rb * 32 + it * 16 + lr;
                            const float rstd = 1.0f / sqrtf(wave_sum(ss[rr]) * (1.0f / D) + NORM_EPS);
                            unsigned char* hrow8 = (unsigned char*)hbuf + (size_t)row * D;
#pragma unroll
                            for (int j = 0; j < 4; ++j) { const int c = 8 * (lane + 64 * j); f32x4 o[2];
#pragma unroll
                                for (int h = 0; h < 2; ++h) o[h] = v[rr][j][h] * rstd * gsc[j][h] + gsh[j][h];
                                const u32x4 hiw = pg8::pack8(o[0], o[1]); *(GAS u32x2*)(hrow8 + c) = (u32x2){pg8::pk_fp8x4(o[0]), pg8::pk_fp8x4(o[1])};
                                f32x4 h0, h1; pg8::unpack8(hiw, h0, h1); const u32x4 low = pg8::pack8(o[0] - h0, o[1] - h1);
                                const int so = lr * 4096 + (((lane + 64 * j) ^ lr) << 4);
                                *(LAS u32x4*)(lds + so) = hiw; *(LAS u32x4*)(lds + 65536 + so) = low; } }
                    }
                    f32x4 racc[4];
                    {
                        const GAS bf16_t* whi = (const GAS bf16_t*)(ws + WS_WRT) + (size_t)(l * 2) * 64 * 2048 + 256 * wave; const GAS bf16_t* wlo = whi + 64 * 2048;
                        const int lop = opaque(lane), r16 = lop & 15, q4 = lop >> 4;
#pragma unroll
                        for (int nt = 0; nt < 4; ++nt) racc[nt] = (f32x4){0.f, 0.f, 0.f, 0.f};
                        auto ldB = [&](int kp, bf16x8 (&bh)[2][4], bf16x8 (&bl)[2][4]) {
#pragma unroll
                            for (int k2 = 0; k2 < 2; ++k2)
#pragma unroll
                                for (int nt = 0; nt < 4; ++nt) { const size_t wo = (size_t)(16 * nt + r16) * 2048 + 32 * (2 * kp + k2) + 8 * q4; bh[k2][nt] = *(const GAS bf16x8*)(whi + wo); bl[k2][nt] = *(const GAS bf16x8*)(wlo + wo); } };
                        auto mm = [&](int kp, const bf16x8 (&bh)[2][4], const bf16x8 (&bl)[2][4]) {
#pragma unroll
                            for (int k2 = 0; k2 < 2; ++k2) { const int chunk = 32 * wave + 4 * (2 * kp + k2) + q4, so = r16 * 4096 + ((chunk ^ r16) << 4);
                                const bf16x8 ah = *(const LAS bf16x8*)(lds + so), al = *(const LAS bf16x8*)(lds + 65536 + so);
#pragma unroll
                                for (int nt = 0; nt < 4; ++nt) {
                                    racc[nt] = __builtin_amdgcn_mfma_f32_16x16x32_bf16(ah, bh[k2][nt], racc[nt], 0, 0, 0);
                                    racc[nt] = __builtin_amdgcn_mfma_f32_16x16x32_bf16(al, bh[k2][nt], racc[nt], 0, 0, 0);
                                    racc[nt] = __builtin_amdgcn_mfma_f32_16x16x32_bf16(ah, bl[k2][nt], racc[nt], 0, 0, 0); } } };
#define RT_FENCE() asm volatile("" ::: "memory")
#define RT_PIN() asm volatile("" : "+v"(racc[0]), "+v"(racc[1]), "+v"(racc[2]), "+v"(racc[3]) :: "memory")
                        bf16x8 bhA[2][4], blA[2][4], bhB[2][4], blB[2][4];
                        RT_FENCE(); ldB(0, bhA, blA); ldB(1, bhB, blB); RT_FENCE();
                        __syncthreads();
                        mm(0, bhA, blA); RT_PIN(); ldB(2, bhA, blA); RT_FENCE();
                        mm(1, bhB, blB); RT_PIN(); ldB(3, bhB, blB); RT_FENCE();
                        mm(2, bhA, blA); mm(3, bhB, blB);
#undef RT_FENCE
#undef RT_PIN
                    }
                    __syncthreads();
                    LAS float* part = (LAS float*)lds;
#pragma unroll
                    for (int nt = 0; nt < 4; ++nt)
#pragma unroll
                        for (int r = 0; r < 4; ++r) part[(wave * 16 + 4 * (lane >> 4) + r) * 64 + 16 * nt + (lane & 15)] = racc[nt][r];
                    __syncthreads();
#pragma unroll 1
                    for (int rr = 0; rr < 2; ++rr) { const int lr = 2 * wave + rr; float logit = 0.f;
#pragma unroll
                        for (int w8 = 0; w8 < 8; ++w8) logit += part[(w8 * 16 + lr) * 64 + lane];
                        const float score = 1.0f / (1.0f + __expf(-logit)); const float sel = score + brt;
                        float m1 = sel; m1 = fmaxf(m1, __shfl_xor(m1, 1)); m1 = fmaxf(m1, __shfl_xor(m1, 2)); m1 = fmaxf(m1, __shfl_xor(m1, 4));
                        const unsigned long long bm = __ballot(sel == m1); const unsigned gb = (unsigned)(bm >> (lane & 56)) & 0xffu; const int first = __builtin_ctz(gb);
                        float v2 = ((lane & 7) == first) ? -3.0e38f : sel; v2 = fmaxf(v2, __shfl_xor(v2, 1)); v2 = fmaxf(v2, __shfl_xor(v2, 2)); v2 = fmaxf(v2, __shfl_xor(v2, 4));
                        const float gs = m1 + v2; int grank = 0; const int mygrp = lane >> 3;
#pragma unroll
                        for (int gg = 0; gg < 8; ++gg) { const float o = __shfl(gs, gg * 8); grank += (o > gs || (o == gs && gg < mygrp)) ? 1 : 0; }
                        float val = grank < 4 ? sel : -3.0e38f; unsigned long long cm = 0ull;
#pragma unroll
                        for (int pick = 0; pick < 8; ++pick) {
                            float mxv = val;
#pragma unroll
                            for (int o = 1; o < 64; o <<= 1) mxv = fmaxf(mxv, __shfl_xor(mxv, o));
                            const unsigned long long bmx = __ballot(val == mxv); const int sl = __builtin_ctzll(bmx);
                            cm |= 1ull << sl; if (lane == sl) val = -3.4e38f; }
                        const bool chosen = (cm >> lane) & 1ull; const float sw = wave_sum(chosen ? score : 0.f);
                        const int gr = it * 16 + lr;
                        selw[gr * 64 + lane] = chosen ? score / sw * 2.5f : 0.f;
                        if (lane == 0) selmask[gr] = cm; }
                    __syncthreads();
                }
                if (wave == 0 && rep + 1 == nrep) {
                    int cntl = 0;
                    for (int r = 0; r < 32; ++r) cntl += (int)((selmask[r] >> lane) & 1ull);
                    int pos = cntl ? (int)atomicAdd(ctl + CW_CNT + l * 64 + opaque(lane), (unsigned)cntl) : 0;
                    for (int r = 0; r < 32; ++r) { const unsigned long long m = selmask[r];
                        if ((m >> lane) & 1ull) { const int k = __builtin_popcountll(m & ((1ull << lane) - 1ull)); const int tok = rb * 32 + r; const int li = lane * 8192 + pos;
                            ltok[li] = tok; ldst[li] = tok * NSLOT + k; ((float*)(ws + WS_TOKW))[tok * 8 + k] = selw[r * 64 + lane]; ++pos; } }
                }
                __syncthreads();
            }
            if (rep + 1 < nrep) GRID_BAR(); }
            PH_END(5) if (BOTH(pb + 5)) GRID_BAR();
        }
        if ((PH_MASK & 256) && IN(pb + 6)) {
            PH_BEGIN
            _Pragma("unroll 1") for (int rep = 0; rep < REPS(6); ++rep) {
            LAS int* tpre = (LAS int*)(lds + MOE_OFF); LAS int* ebase = tpre + 65; LAS int* ecnt = ebase + 65; LAS int* utab = (LAS int*)(lds + MOE_OFF + 1024);
            pg8::moe_build<4, true>(tpre, ebase, ecnt, utab, ctl + CW_CNT + l * 64, G, blk, tid);
            pg8::MoeOrder<4, true> S{utab, (const char*)(ws + WS_WGU + (size_t)l * 65 * 1024 * 2048), (size_t)1024 * 2048, (size_t)256 * 2048, (const int*)(ws + WS_LTOK)};
            pg8::EpiGateUp E{(unsigned char*)(ws + WS_HID)};
            pg8::gemm_phase<pg8::EpiGateUp, pg8::MoeOrder<4, true>, GEMM_ALIGN, GEMM_SP2, true>(lds, (const char*)hbuf, D / 2, S, E, wave);
            if (rep + 1 < REPS(6)) GRID_BAR(); }
            PH_END(6) if (BOTH(pb + 6)) GRID_BAR();
        }
        if ((PH_MASK & 512) && IN(pb + 7)) {
            PH_BEGIN
            _Pragma("unroll 1") for (int rep = 0; rep < REPS(7); ++rep) {
            LAS int* tpre = (LAS int*)(lds + MOE_OFF); LAS int* ebase = tpre + 65; LAS int* ecnt = ebase + 65; LAS int* utab = (LAS int*)(lds + MOE_OFF + 1024);
            pg8::moe_build<8, false>(tpre, ebase, ecnt, utab, ctl + CW_CNT + l * 64, G, blk, tid);
            constexpr size_t DB = DOWN_F8 ? 1 : 2;
            pg8::MoeOrder<8, false> S{utab, (const char*)(ws + WS_WD + (size_t)l * 65 * 2048 * 512 * DB), (size_t)2048 * 512 * DB, (size_t)256 * 512 * DB, (const int*)(ws + WS_LTOK)};
            pg8::EpiDown E{(unsigned char*)(ws + WS_YSLOT), (const int*)(ws + WS_LDST), (LAS int*)(lds + SEL_OFF), (REP_VARIANT && rep == 1) ? 1 : 0};
            pg8::gemm_phase<pg8::EpiDown, pg8::MoeOrder<8, false>, GEMM_ALIGN, GEMM_SP2, DOWN_F8 != 0>(lds, (const char*)(ws + WS_HID), DOWN_F8 ? 256 : 512, S, E, wave);
            if (rep + 1 < REPS(7)) GRID_BAR(); }
            PH_END(7) if (BOTH(pb + 7)) GRID_BAR();
        }
        if ((PH_MASK & 1024) && IN(pb + 8)) {
            PH_BEGIN
            const int nrep = REPS(8);
            _Pragma("unroll 1") for (int rep = 0; rep < nrep; ++rep) {
            const float* modl = mod + (size_t)l * 2 * 12288;
            const unsigned char* yslot = (const unsigned char*)(ws + WS_YSLOT);
            for (int run = blk * NWAVES + wave; run < T / 4; run += G * NWAVES) {
                const int bb = (run * 4) / SEQ; const float* gt2 = modl + bb * 12288 + 5 * 2048;
                const float* m1 = mod + (size_t)2 * 12288 + bb * 12288;
                f32x4 gtv[2][4];
#pragma unroll
                for (int jj = 0; jj < 2; ++jj)
#pragma unroll
                    for (int q = 0; q < 4; ++q) { const int c = 16 * (lane + 64 * jj) + 4 * q; gtv[jj][q] = *(const GAS f32x4*)(gt2 + c) * pg8::YS_INV; }
#pragma unroll 1
                for (int pr = 0; pr < 2; ++pr) {
                    f32x4 v[2][2][4]; float ss[2] = {0.f, 0.f};
                    const int rowb = run * 4 + pr * 2;
                    f32x4 tw[2][2];
#pragma unroll
                    for (int rr = 0; rr < 2; ++rr) { tw[rr][0] = *(const GAS f32x4*)((const float*)(ws + WS_TOKW) + (rowb + rr) * 8); tw[rr][1] = *(const GAS f32x4*)((const float*)(ws + WS_TOKW) + (rowb + rr) * 8 + 4); }
                    auto issue = [&](int rr, int jj, u32x4 (&w)[NSLOT], u32x4 (&xq)[2]) {
                        const int c = 16 * (lane + 64 * jj); const unsigned char* ys = yslot + (size_t)(rowb + rr) * NSLOT * D + c;
#pragma unroll
                        for (int k = 0; k < NSLOT; ++k) w[k] = *(const GAS u32x4*)(ys + (size_t)k * D);
                        const bf16_t* xr = (const bf16_t*)(ws + WS_XB) + (size_t)(rowb + rr) * D + c; xq[0] = *(const GAS u32x4*)xr; xq[1] = *(const GAS u32x4*)(xr + 8); };
                    auto consume = [&](int rr, int jj, const u32x4 (&w)[NSLOT], const u32x4 (&xq)[2]) {
                        f32x4 a[4];
#pragma unroll
                        for (int q = 0; q < 4; ++q) a[q] = (f32x4){0.f, 0.f, 0.f, 0.f};
#pragma unroll
                        for (int k = 0; k < NSLOT; ++k) { const float wk = k < 8 ? tw[rr][k >> 2][k & 3] : 1.0f;
#pragma unroll
                            for (int q = 0; q < 4; ++q) { const f32x2 lo = __builtin_amdgcn_cvt_pk_f32_fp8((int)w[k][q], false), hi = __builtin_amdgcn_cvt_pk_f32_fp8((int)w[k][q], true); a[q] += (f32x4){lo.x, lo.y, hi.x, hi.y} * wk; } }
                        f32x4 xv[4]; pg8::unpack8(xq[0], xv[0], xv[1]); pg8::unpack8(xq[1], xv[2], xv[3]);
#pragma unroll
                        for (int q = 0; q < 4; ++q) { v[rr][jj][q] = xv[q] + gtv[jj][q] * a[q];
                            ss[rr] += v[rr][jj][q][0] * v[rr][jj][q][0] + v[rr][jj][q][1] * v[rr][jj][q][1] + v[rr][jj][q][2] * v[rr][jj][q][2] + v[rr][jj][q][3] * v[rr][jj][q][3]; } };
                    {
                        u32x4 wA[NSLOT], xA[2], wB[NSLOT], xB[2];
#define CMB_FENCE() asm volatile("" ::: "memory")
#define CMB_PIN(x) asm volatile("" : "+v"(x) :: "memory")
                        issue(0, 0, wA, xA); issue(0, 1, wB, xB); CMB_FENCE();
                        consume(0, 0, wA, xA); CMB_PIN(ss[0]); issue(1, 0, wA, xA); CMB_FENCE();
                        consume(0, 1, wB, xB); CMB_PIN(ss[0]); issue(1, 1, wB, xB); CMB_FENCE();
                        consume(1, 0, wA, xA); consume(1, 1, wB, xB); CMB_PIN(ss[1]);
#undef CMB_FENCE
#undef CMB_PIN
                    }
                    f32x4 gs[2][4], gh[2][4];
                    if (l == 0) {
#pragma unroll
                        for (int jj = 0; jj < 2; ++jj)
#pragma unroll
                            for (int q = 0; q < 4; ++q) { const int c = 16 * (lane + 64 * jj) + 4 * q;
                                gs[jj][q] = *(const GAS f32x4*)(args.in[I_NMIX] + D + c) * (*(const GAS f32x4*)(m1 + 2048 + c) + 1.0f); gh[jj][q] = *(const GAS f32x4*)(m1 + c); }
                    } else {
#pragma unroll
                        for (int jj = 0; jj < 2; ++jj)
#pragma unroll
                            for (int q = 0; q < 4; ++q) { const int c = 16 * (lane + 64 * jj) + 4 * q; gs[jj][q] = *(const GAS f32x4*)(args.in[I_NFIN] + c); gh[jj][q] = (f32x4){0.f, 0.f, 0.f, 0.f}; }
                    }
#pragma unroll
                    for (int rr = 0; rr < 2; ++rr) { const int row = rowb + rr;
                        const float rstd = 1.0f / sqrtf(wave_sum(ss[rr]) * (1.0f / D) + NORM_EPS);
                        float* xw = (rep + 1 == nrep) ? xbuf + (size_t)row * D : (float*)(ws + WS_HID) + (size_t)row * D; bf16_t* hw = (rep + 1 == nrep) ? hbuf + (size_t)row * D : (bf16_t*)(ws + WS_MIXED2) + (size_t)row * D;
                        unsigned char* hw8 = (rep + 1 == nrep) ? (unsigned char*)hbuf + (size_t)row * D : (unsigned char*)(ws + WS_MIXED2) + (size_t)row * D; (void)hw8; (void)hw;
                        bf16_t* xbw = (rep + 1 == nrep) ? (bf16_t*)(ws + WS_XB) + (size_t)row * D : (bf16_t*)(ws + WS_MIXED) + (size_t)row * D;
                        if (l == 0) {
#pragma unroll
                            for (int jj = 0; jj < 2; ++jj) { const int c = 16 * (lane + 64 * jj); f32x4 o[4];
                                *(GAS u32x4*)(xbw + c) = pg8::pack8(v[rr][jj][0], v[rr][jj][1]); *(GAS u32x4*)(xbw + c + 8) = pg8::pack8(v[rr][jj][2], v[rr][jj][3]);
#pragma unroll
                                for (int q = 0; q < 4; ++q) o[q] = v[rr][jj][q] * rstd * gs[jj][q] + gh[jj][q];
                                if (INP_F8) *(GAS u32x4*)((unsigned char*)hw8 + c) = (u32x4){pg8::pk_fp8x4(o[0]), pg8::pk_fp8x4(o[1]), pg8::pk_fp8x4(o[2]), pg8::pk_fp8x4(o[3])};
                                else { *(GAS u32x4*)(hw + c) = pg8::pack8(o[0], o[1]); *(GAS u32x4*)(hw + c + 8) = pg8::pack8(o[2], o[3]); } }
                        } else {
#pragma unroll
                            for (int jj = 0; jj < 2; ++jj) { const int c = 16 * (lane + 64 * jj);
#pragma unroll
                                for (int q = 0; q < 4; ++q) *(GAS f32x4*)(xw + c + 4 * q) = v[rr][jj][q] * rstd * gs[jj][q]; }
                        } }
                }
            }
            if (rep + 1 < nrep) GRID_BAR(); }
            PH_END(8) if (BOTH(pb + 8)) GRID_BAR();
        }
    }
#undef IN
#undef BOTH
#undef GRID_BAR
}

extern "C" void kernel_launch(void* const* d_in, const int* in_sizes, int n_in, void* d_out, int out_size, void* d_ws, size_t ws_size, hipStream_t stream) {
    static int grid = 0;
    if (grid == 0) {
        if (n_in != 29 || out_size != T * D || ws_size < WS_END) { fprintf(stderr, "kernel_launch: unexpected shapes (n_in %d out %d ws %zu)\n", n_in, out_size, ws_size); grid = -1; return; }
        int dev = 0, cus = 0, per_cu = 0;
        if (hipGetDevice(&dev) != hipSuccess || hipDeviceGetAttribute(&cus, hipDeviceAttributeMultiprocessorCount, dev) != hipSuccess) { grid = -1; return; }
        if (hipFuncSetAttribute((const void*)mega_fwd, hipFuncAttributeMaxDynamicSharedMemorySize, LDS_BYTES) != hipSuccess) { fprintf(stderr, "kernel_launch: hipFuncSetAttribute failed\n"); grid = -1; return; }
        if (hipOccupancyMaxActiveBlocksPerMultiprocessor(&per_cu, (const void*)mega_fwd, NWAVES * 64, LDS_BYTES) != hipSuccess || per_cu < 1) { fprintf(stderr, "kernel_launch: occupancy query says %d\n", per_cu); }
        (void)hipGetLastError();
        grid = cus & ~7;
    }
    if (grid < 0) return;
    (void)hipMemsetAsync((char*)d_ws + WS_CTL, 0, CTL_ZERO_BYTES, stream);
    Args a{};
    for (int i = 0; i < 29; ++i) a.in[i] = (const float*)d_in[i];
    a.out = (float*)d_out; a.ws = (unsigned char*)d_ws;
    if (N_LAUNCHES == 1) { a.ph_lo = 0; a.ph_hi = 20; hipLaunchKernelGGL(mega_fwd, dim3(grid), dim3(NWAVES * 64), LDS_BYTES, stream, a); }
    else { for (int p = 0; p < 20; ++p) { a.ph_lo = p; a.ph_hi = p + 1; hipLaunchKernelGGL(mega_fwd, dim3(grid), dim3(NWAVES * 64), LDS_BYTES, stream, a); } }
}
```

```cpp
#include <hip/hip_runtime.h>
#include <cstdio>
#include <cstdint>

#ifndef N_LAUNCHES
#define N_LAUNCHES 1
#endif
#ifndef GEMM_ALIGN
#define GEMM_ALIGN true
#endif
#ifndef GEMM_SP2
#define GEMM_SP2 true
#endif
#ifndef MOE_XCD
#define MOE_XCD 0
#endif
#ifndef F8_PIN
#define F8_PIN 1
#endif
#if F8_PIN == 1
#define F8_PIN_ASM(x) asm volatile("" : "+v"(x))
#elif F8_PIN == 2
#define F8_PIN_ASM(x) asm volatile("" : "+a"(x))
#else
#define F8_PIN_ASM(x) do {} while (0)
#endif
#ifndef DOWN_PRE
#define DOWN_PRE 1
#endif
#ifndef DOWN_F8
#define DOWN_F8 1
#endif
#ifndef MIX_F8
#define MIX_F8 1
#endif
#ifndef INP_F8
#define INP_F8 1
#endif
#ifndef AO_F8
#define AO_F8 1
#endif
#ifndef GLU_F8
#define GLU_F8 1
#endif

#define LAS __attribute__((address_space(3)))
#define GAS __attribute__((address_space(1)))
typedef unsigned short bf16_t;
typedef short bf16x8 __attribute__((ext_vector_type(8)));
typedef float f32x4 __attribute__((ext_vector_type(4)));
typedef float f32x2 __attribute__((ext_vector_type(2)));
typedef unsigned u32x4 __attribute__((ext_vector_type(4)));
typedef unsigned u32x2 __attribute__((ext_vector_type(2)));
typedef int i32x4 __attribute__((ext_vector_type(4)));
typedef int i32x8 __attribute__((ext_vector_type(8)));

constexpr int T = 8192, D = 2048, SEQ = 4096, DEPTH = 2;
constexpr int INW = 6144, O_Q = 0, O_K = 1024, O_V = 1280, O_U = 1536, O_GA = 2048, O_GS = 4096;
constexpr int NE = 64, NSLOT = 9;
constexpr float NORM_EPS = 1e-6f;
constexpr float LOG2E = 1.4426950408889634f;

constexpr size_t MiB = 1u << 20;
constexpr size_t WS_CTL = 0, CTL_ZERO_BYTES = 1 * MiB;
constexpr size_t WS_MODP = 1 * MiB;
constexpr size_t WS_MOD = 3 * MiB;
constexpr size_t WS_SSM = 4 * MiB;
constexpr size_t SSM_STRIDE = 640 * 1024, SSM_E = 0, SSM_F = 256 * 1024, SSM_KT = 512 * 1024, SSM_P = 560 * 1024;
constexpr size_t WS_WIN = 44 * MiB;
constexpr size_t WS_WO = 92 * MiB;
constexpr size_t WS_WGLU = 100 * MiB;
constexpr size_t WS_WMIX = 108 * MiB;
constexpr size_t WS_WGU = 124 * MiB;
constexpr size_t WS_WD = 644 * MiB;
constexpr size_t WS_H = 904 * MiB;
constexpr size_t WS_PROJ = 936 * MiB;
constexpr size_t WS_ATTN = 1032 * MiB;
constexpr size_t WS_SLOC = 1048 * MiB;
constexpr size_t WS_Y = 1050 * MiB;
constexpr size_t WS_MIXED = 1058 * MiB;
constexpr size_t WS_HID = 1090 * MiB;
constexpr size_t WS_YSLOT = 1163 * MiB;
constexpr size_t WS_LTOK = 1451 * MiB, WS_LDST = 1453 * MiB, WS_LW = 1455 * MiB;
constexpr size_t WS_MIXED2 = 1457 * MiB;
constexpr size_t WS_WRT = 1489 * MiB;
constexpr size_t WS_XB = 1490 * MiB;
constexpr size_t WS_TOKW = 1522 * MiB;
constexpr size_t WS_END = 1523 * MiB;
constexpr int CW_TMO = 0, CW_BAR = 4096, CW_CNT = 8192;

constexpr int RING_BYTES = 131072, LDSCTL_OFF = RING_BYTES, MISC_OFF = LDSCTL_OFF + 320;
constexpr int SEL_OFF = LDSCTL_OFF + 1024;
constexpr int MOE_OFF = LDSCTL_OFF + 10240;
constexpr int LDS_BYTES = 147456;
constexpr int NWAVES = 8;

__device__ __forceinline__ unsigned cvt_pk_bf16(float lo, float hi) { unsigned r; asm("v_cvt_pk_bf16_f32 %0, %1, %2" : "=v"(r) : "v"(lo), "v"(hi)); return r; }
__device__ __forceinline__ float bf_lo(unsigned w) { return __uint_as_float(w << 16); }
__device__ __forceinline__ float bf_hi(unsigned w) { return __uint_as_float(w & 0xffff0000u); }
__device__ __forceinline__ float bf1(bf16_t h) { return __uint_as_float(((unsigned)h) << 16); }
__device__ __forceinline__ float fast_sigmoid(float x) { return __builtin_amdgcn_rcpf(1.0f + __builtin_amdgcn_exp2f(-x * LOG2E)); }
__device__ __forceinline__ int opaque(int v) { asm volatile("" : "+v"(v)); return v; }
__device__ __forceinline__ int lane_now() { int l; asm volatile("v_mbcnt_lo_u32_b32 %0, -1, 0\n\tv_mbcnt_hi_u32_b32 %0, -1, %0" : "=v"(l)); return l; }
__device__ __forceinline__ float shx(float v, int mask, int l) { return __builtin_bit_cast(float, __builtin_amdgcn_ds_bpermute((l ^ mask) << 2, __builtin_bit_cast(int, v))); }
__device__ __forceinline__ float wave_sum(float v) {
    const int l = lane_now();
#pragma unroll
    for (int o = 1; o < 64; o <<= 1) v += shx(v, o, l);
    return v;
}
__device__ __forceinline__ float shl_from(float v, int srclane) { return __builtin_bit_cast(float, __builtin_amdgcn_ds_bpermute(srclane << 2, __builtin_bit_cast(int, v))); }
#define LDS_WAIT() asm volatile("s_waitcnt lgkmcnt(0)" ::: "memory")
#define VM_WAIT() asm volatile("s_waitcnt vmcnt(0)" ::: "memory")

#define XB_TMO      128
#define XB_XCNT(j)  (256  + 64 * (j))
#define XB_XSUB(j)  (1280 + 64 * (j))
#define XB_XGEN(j)  (2304 + 64 * (j))
#define XB_TOP      3328
#define XB_TOPGEN   3392
#define XCD_BAR_WORDS 3456
#define XB_SPIN_CAP (1u << 18)
__device__ __forceinline__ unsigned xb_ld(unsigned* p)              { return __hip_atomic_load(p, __ATOMIC_RELAXED, __HIP_MEMORY_SCOPE_AGENT); }
__device__ __forceinline__ unsigned xb_add(unsigned* p, unsigned v) { return __hip_atomic_fetch_add(p, v, __ATOMIC_RELAXED, __HIP_MEMORY_SCOPE_AGENT); }
__device__ __forceinline__ unsigned xb_xcc_id() { return (unsigned)__builtin_amdgcn_s_getreg((3 << 11) | 20) & 0xFu; }
#define XB_SPIN(cond, bar) do { unsigned _sp = 0; while (cond) { __builtin_amdgcn_s_sleep(1); \
    if ((++_sp & 255u) == 0u) { if (xb_ld(&(bar)[XB_TMO])) break; if (_sp > XB_SPIN_CAP) { atomicAdd(&(bar)[XB_TMO], 1u); break; } } } } while (0)
struct XcdBarrier { unsigned* bar; unsigned x; volatile LAS unsigned* st; int wv; };
__device__ __forceinline__ XcdBarrier xcd_barrier_post(unsigned* bar, volatile LAS unsigned* st) {
    XcdBarrier b; b.bar = bar; b.x = xb_xcc_id(); b.st = st; b.wv = __builtin_amdgcn_readfirstlane((int)threadIdx.x >> 6);
    if (threadIdx.x == 0) (void)xb_add(&bar[XB_XCNT(b.x)], 1u);
    return b;
}
__device__ __forceinline__ void xcd_barrier_complete(unsigned* bar, unsigned x, unsigned& nloc, unsigned& nx) {
    const unsigned G = gridDim.x * gridDim.y * gridDim.z;
    unsigned sum, cnt, mine, sp = 0u;
    for (;;) {
        sum = 0u; cnt = 0u; mine = 0u;
#pragma unroll
        for (unsigned j = 0; j < 16; ++j) { const unsigned c = xb_ld(&bar[XB_XCNT(j)]); sum += c; cnt += (c > 0u) ? 1u : 0u; mine = (j == x) ? c : mine; }
        if (sum == G) break;
        __builtin_amdgcn_s_sleep(1);
        if ((++sp & 255u) == 0u) { if (xb_ld(&bar[XB_TMO])) break; if (sp > XB_SPIN_CAP) { atomicAdd(&bar[XB_TMO], 1u); break; } }
    }
    nloc = mine > 0u ? mine : 1u; nx = cnt > 0u ? cnt : 1u;
}
__device__ __forceinline__ void xcd_barrier(const XcdBarrier& b) {
    asm volatile("s_waitcnt vmcnt(0)" ::: "memory");
    __syncthreads();
    if (lane_now() + 64 * b.wv == 0) {
        unsigned* bar = b.bar; asm volatile("" : "+s"(bar));
        __builtin_amdgcn_s_waitcnt(0);
        unsigned nloc = b.st[0], nx = b.st[1];
        if (nloc == 0u) { xcd_barrier_complete(bar, b.x, nloc, nx); b.st[0] = nloc; b.st[1] = nx; }
        const unsigned old = xb_add(&bar[XB_XSUB(b.x)], 1u);
        const unsigned gen = old / nloc;
        if (old + 1u == (gen + 1u) * nloc) {
            __builtin_amdgcn_fence(__ATOMIC_RELEASE, "agent");
            asm volatile("s_waitcnt vmcnt(0)" ::: "memory");
            const unsigned og = xb_add(&bar[XB_TOP], 1u);
            const unsigned tg = og / nx;
            if (og + 1u == (tg + 1u) * nx) xb_add(&bar[XB_TOPGEN], 1u);
            else XB_SPIN(xb_ld(&bar[XB_TOPGEN]) == tg, bar);
            __builtin_amdgcn_fence(__ATOMIC_ACQUIRE, "agent");
            xb_add(&bar[XB_XGEN(b.x)], 1u);
            asm volatile("s_waitcnt vmcnt(0)" ::: "memory");
        } else {
            XB_SPIN(xb_ld(&bar[XB_XGEN(b.x)]) == gen, bar);
            __builtin_amdgcn_fence(__ATOMIC_ACQUIRE, "agent");
            asm volatile("s_waitcnt vmcnt(0)" ::: "memory");
        }
    }
    __syncthreads();
}

namespace pg8 {
constexpr int BM = 256, BK = 64, HALF = 128, HTB = HALF * BK * 2, STAGE_BYTES = 8 * HTB, NXCD = 8, WGM = 8;
__host__ __device__ __forceinline__ int lds_byte(int r, int c) { const int st = (r >> 4) * 2 + (c >> 5), rr = r & 15, cc = c & 31, ob = rr * 64 + cc * 2; return st * 1024 + (ob ^ (((ob >> 9) & 1) << 5)); }
__host__ __device__ __forceinline__ void stage_rc(int b, int& R, int& C) { const int st = b / 1024, sb = b % 1024, swz = sb ^ (((sb >> 9) & 1) << 5); R = (st >> 1) * 16 + swz / 64; C = (st & 1) * 32 + (swz % 64) / 2; }
__host__ __device__ __forceinline__ int perm32(int rho) { const int n = rho >> 4, i = rho & 15; return 8 * (i >> 2) + 4 * n + (i & 3); }

struct Unit { int pm, pn, e, n, r0, x; };

struct DenseOrder {
    static constexpr bool GATHER = false;
    int nM, nN, nwg, G, c; const char* Bt; size_t tstepB;
    __device__ void init(int M, int N, int K, int G_, int c_, const void* Bt_) { nM = M / BM; nN = N / BM; nwg = nM * nN; G = G_; c = c_; Bt = (const char*)Bt_; tstepB = (size_t)BM * K * 2; }
    __device__ __forceinline__ bool next(int i, Unit& u) const {
        const long L = (long)i * G + c; if (L >= nwg) return false;
        int wgid = (int)L; { const int q = nwg / NXCD, r = nwg % NXCD, xcd = wgid % NXCD, off = wgid / NXCD; wgid = (xcd < r ? xcd * (q + 1) : r * (q + 1) + (xcd - r) * q) + off; }
        const int nig = WGM * nN, gid = wgid / nig, fm = gid * WGM, gsz = (nM - fm) < WGM ? (nM - fm) : WGM;
        u.pm = fm + ((wgid % nig) % gsz); u.pn = (wgid % nig) / gsz; u.e = -1; u.n = 256; u.r0 = u.pm * BM; u.x = u.pm * BM; return true;
    }
    __device__ __forceinline__ int a_row(const Unit& u, int R) const { return u.r0 + R; }
    __device__ __forceinline__ void a_row_issue(const Unit& u, int R, int& out) const { out = u.r0 + R; }
    __device__ __forceinline__ int a_row_fix(const Unit& u, int R, int loaded) const { return loaded; }
    __device__ __forceinline__ const char* b_tile(const Unit& u) const { return Bt + (size_t)u.pn * tstepB; }
};
template <int NPN, bool GATHER_> struct MoeOrder {
    static constexpr bool GATHER = GATHER_;
    const LAS int* utab; const char* Wbase; size_t wstepE, tstepB; const int* ltok;
    __device__ __forceinline__ bool next(int i, Unit& u) const {
        if (i >= 64) return false;
        const LAS int* p = utab + i * 8;
        const int pm = __builtin_amdgcn_readfirstlane(p[0]); if (pm < 0) return false;
        u.pm = pm; u.pn = __builtin_amdgcn_readfirstlane(p[1]); u.e = __builtin_amdgcn_readfirstlane(p[2]); u.n = __builtin_amdgcn_readfirstlane(p[3]);
        u.r0 = __builtin_amdgcn_readfirstlane(p[4]); u.x = __builtin_amdgcn_readfirstlane(p[5]); return true;
    }
    __device__ __forceinline__ int a_row(const Unit& u, int R) const {
        if (!GATHER) return u.r0 + R;
        if (u.e == 64) return u.r0 + R;
        const int rr = R < u.n ? R : u.n - 1; return ((const GAS int*)ltok)[u.r0 + rr];
    }
    __device__ __forceinline__ void a_row_issue(const Unit& u, int R, int& out) const {
        const int rr = R < u.n ? R : u.n - 1; const GAS int* p = (const GAS int*)ltok + (u.e == 64 ? 0 : u.r0 + rr);
        asm volatile("global_load_dword %0, %1, off" : "=v"(out) : "v"(p) : "memory");
    }
    __device__ __forceinline__ int a_row_fix(const Unit& u, int R, int loaded) const { return u.e == 64 ? u.r0 + R : loaded; }
    __device__ __forceinline__ const char* b_tile(const Unit& u) const { return Wbase + (size_t)u.e * wstepE + (size_t)u.pn * tstepB; }
};
template <int NPN, bool GATHER> __device__ __forceinline__ void moe_build(LAS int* tpre, LAS int* ebase, LAS int* ecnt, LAS int* utab, const unsigned* counts, int G, int c, int tid) {
    if (tid < 64) ecnt[tid] = (int)__hip_atomic_load(counts + tid, __ATOMIC_RELAXED, __HIP_MEMORY_SCOPE_AGENT);
    __syncthreads();
    if (tid == 0) { int tp = 0, eb = 0; for (int e = 0; e < 64; ++e) { tpre[e] = tp; ebase[e] = eb; tp += (ecnt[e] + 255) >> 8; eb += ecnt[e]; } tpre[64] = tp; ebase[64] = eb; }
    __syncthreads();
#if MOE_XCD
    if (tid < 64) {
        int pm = -1, pn = 0, e = 64, n = 256;
        const int xc = c & 7; int idx = (c >> 3) + (G >> 3) * tid;
        if (idx < 4 * NPN) { pm = xc + 8 * (idx / NPN); pn = idx % NPN; }
        else { idx -= 4 * NPN;
#pragma unroll 1
            for (int j = 0; j < 8; ++j) { const int ee = xc + 8 * j, nu = ((ecnt[ee] + 255) >> 8) * NPN;
                if (pm < 0) { if (idx < nu) { e = ee; pm = idx / NPN; pn = idx % NPN; } else idx -= nu; } }
            if (pm >= 0) { const int rem = ecnt[e] - pm * BM; n = rem < BM ? rem : BM; } }
        const int hb = (e == 64 ? 65536 : ebase[e]) + pm * BM;
        const int r0 = GATHER ? (e == 64 ? pm * BM : e * 8192 + pm * BM) : hb, x = hb;
#else
    if (tid < 64) {
        int pm = -1, pn = 0, e = 64, n = 256;
        const int vc = ((G & 7) == 0) ? (c & 7) * (G >> 3) + (c >> 3) : c;
        int L = tid * G + vc; const int shared_units = 32 * NPN, tot = shared_units + NPN * tpre[64];
        if (L < tot) {
            if (L < shared_units) { pm = L / NPN; pn = L % NPN; }
            else { L -= shared_units; const int tile = L / NPN; pn = L % NPN; e = 0;
#pragma unroll 1
                for (int j = 1; j <= 64; ++j) e += (tpre[j] <= tile) ? 1 : 0;
                pm = tile - tpre[e]; const int rem = ecnt[e] - pm * BM; n = rem < BM ? rem : BM; } }
        const int hb = (e == 64 ? 65536 : ebase[e]) + pm * BM;
        const int r0 = GATHER ? (e == 64 ? pm * BM : e * 8192 + pm * BM) : hb, x = hb;
#endif
        LAS int* p = utab + tid * 8; p[0] = pm; p[1] = pn; p[2] = e; p[3] = n; p[4] = r0; p[5] = x;
    }
    __syncthreads();
}

template <class Epi, class Sched, bool ALIGN_EPI = false, bool SP2 = GEMM_SP2, bool F8 = false>
__device__ __forceinline__ void gemm_phase(LAS unsigned char* lds, const char* Abase, const int K, const Sched& S, const Epi& E, const int wave_s) {
    int tid = lane_now() + 64 * wave_s; asm volatile("" : "+v"(tid));
    const int wid = wave_s, lane = tid & 63, wr = wid >> 2, wc = wid & 3, fr = lane & 15, fq = lane >> 4;
    const int nt = K / BK;
    constexpr bool GA = Sched::GATHER;
    unsigned voffA[2], voffB[2];
#pragma unroll
    for (int i = 0; i < 2; ++i) { int R, C; stage_rc(tid * 16 + i * 8192, R, C); const int Rb = Epi::PERM ? ((R & ~31) + perm32(R & 31)) : R; voffA[i] = (unsigned)(R * K + C) * 2u; voffB[i] = (unsigned)(Rb * K + C) * 2u; }
    const size_t kstep = (size_t)(BK * 2);
    const size_t hstep = (size_t)HALF * K * 2;
    const unsigned ldsw = (unsigned)wid * 1024u;
    const int aoff = lds_byte(wr * 64 + fr, fq * 8), boff = lds_byte(wc * 32 + fr, fq * 8);
#define PG8_SA(b, h) (((b) * 2 + (h)) * HTB)
#define PG8_SB(b, h) ((4 + (b) * 2 + (h)) * HTB)
#define PG8_STB(bufoff, gbase) do { const char* _sb = (const char*)(gbase); asm volatile("" : "+s"(_sb)); _Pragma("unroll") for (int _i = 0; _i < 2; ++_i) \
        { unsigned _vo = voffB[_i]; asm volatile("" : "+v"(_vo)); __builtin_amdgcn_global_load_lds((const unsigned*)(_sb + _vo), (LAS unsigned*)(lds + (bufoff) + ldsw + _i * 8192), 16, 0, 0); } } while (0)
#define PG8_STA(bufoff, h, kb) do { const char* _sa = GA ? (Abase + (kb)) : (cA + (kb) + (h) * hstep); asm volatile("" : "+s"(_sa)); _Pragma("unroll") for (int _i = 0; _i < 2; ++_i) \
        { unsigned _vo = GA ? offC[h][_i] : voffA[_i]; asm volatile("" : "+v"(_vo)); __builtin_amdgcn_global_load_lds((const unsigned*)(_sa + _vo), (LAS unsigned*)(lds + (bufoff) + ldsw + _i * 8192), 16, 0, 0); } } while (0)
#define PG8_LDA(dst, b, h) do { _Pragma("unroll") for (int m = 0; m < 4; ++m) _Pragma("unroll") for (int k = 0; k < 2; ++k) dst[m][k] = *(const LAS bf16x8*)(lds + PG8_SA(b, h) + aoff + m * 2048 + k * 1024); } while (0)
#define PG8_LDB(dst, b, h) do { _Pragma("unroll") for (int n = 0; n < 2; ++n) _Pragma("unroll") for (int k = 0; k < 2; ++k) dst[n][k] = *(const LAS bf16x8*)(lds + PG8_SB(b, h) + boff + n * 2048 + k * 1024); } while (0)
#define PG8_CAT8(x, y) __builtin_shufflevector(__builtin_bit_cast(i32x4, x), __builtin_bit_cast(i32x4, y), 0, 1, 2, 3, 4, 5, 6, 7)
#define PG8_MMA(ai, bj, At, Bt) do { __builtin_amdgcn_s_setprio(1); _Pragma("unroll") for (int m = 0; m < 4; ++m) _Pragma("unroll") for (int n = 0; n < 2; ++n) { \
        if constexpr (F8) acc[ai][bj][m][n] = __builtin_amdgcn_mfma_scale_f32_16x16x128_f8f6f4(PG8_CAT8(Bt[n][0], Bt[n][1]), PG8_CAT8(At[m][0], At[m][1]), acc[ai][bj][m][n], 0, 0, 0, 0, 0, 0); \
        else { _Pragma("unroll") for (int k = 0; k < 2; ++k) acc[ai][bj][m][n] = __builtin_amdgcn_mfma_f32_16x16x32_bf16(Bt[n][k], At[m][k], acc[ai][bj][m][n], 0, 0, 0); } } \
        __builtin_amdgcn_s_setprio(0); } while (0)
#define PG8_WAIT_V(n) asm volatile("s_waitcnt vmcnt(" #n ")" ::: "memory")
#define PG8_WAIT_L(n) asm volatile("s_waitcnt lgkmcnt(" #n ")" ::: "memory")
#define PG8_BAR __builtin_amdgcn_s_barrier()
#define PG8_SCHED __builtin_amdgcn_sched_barrier(0)
#define PG8_AOFF(dst, u) do { if constexpr (GA) { _Pragma("unroll") for (int _h = 0; _h < 2; ++_h) _Pragma("unroll") for (int _i = 0; _i < 2; ++_i) { int _R, _C; stage_rc(tid * 16 + _i * 8192, _R, _C); \
        dst[_h][_i] = (unsigned)(S.a_row(u, _h * HALF + _R) * K + _C) * 2u; } } } while (0)
    Unit cur, nxt; int ui = 0;
    if (!S.next(0, cur)) return;
    f32x4 acc[2][2][4][2];
#pragma unroll
    for (int a = 0; a < 2; ++a)
#pragma unroll
        for (int b = 0; b < 2; ++b)
#pragma unroll
            for (int m = 0; m < 4; ++m)
#pragma unroll
                for (int n = 0; n < 2; ++n) { acc[a][b][m][n] = (f32x4){0.f, 0.f, 0.f, 0.f}; if constexpr (F8) F8_PIN_ASM(acc[a][b][m][n]); }
    bf16x8 At[4][2], B0[2][2], B1[2][2];
    unsigned offC[2][2];
    PG8_AOFF(offC, cur);
    const char* cB = S.b_tile(cur);
    const char* cA = GA ? Abase : Abase + (size_t)S.a_row(cur, 0) * K * 2;
    if constexpr (SP2) {
        PG8_STB(PG8_SB(0, 0), cB); PG8_STB(PG8_SB(0, 1), cB + hstep); PG8_STA(PG8_SA(0, 0), 0, 0); PG8_STA(PG8_SA(0, 1), 1, 0);
        if (wr == 1) PG8_BAR;
        PG8_WAIT_V(2); PG8_BAR;
        PG8_STB(PG8_SB(1, 0), cB + kstep); PG8_STA(PG8_SA(1, 0), 0, kstep); PG8_STB(PG8_SB(1, 1), cB + hstep + kstep);
        PG8_WAIT_V(6); PG8_BAR;
    } else {
    PG8_STB(PG8_SB(0, 0), cB); PG8_STA(PG8_SA(0, 0), 0, 0); PG8_STB(PG8_SB(0, 1), cB + hstep); PG8_STA(PG8_SA(0, 1), 1, 0);
    if (wr == 1) PG8_BAR;
    PG8_WAIT_V(4); PG8_BAR;
    PG8_STB(PG8_SB(1, 0), cB + kstep); PG8_STA(PG8_SA(1, 0), 0, kstep); PG8_STB(PG8_SB(1, 1), cB + hstep + kstep);
    PG8_WAIT_V(6); PG8_BAR;
    }
    for (;;) {
        int pre_v0, pre_v1; if constexpr (Epi::PRE) E.pre_issue(cur, wr, opaque(lane_now()), pre_v0, pre_v1);
        const bool has_next = S.next(ui + 1, nxt);
        const char* nB = has_next ? S.b_tile(nxt) : cB;
        const char* nA = (!GA && has_next) ? Abase + (size_t)S.a_row(nxt, 0) * K * 2 : cA;
        int rowN[2][2];
        if constexpr (GA) { const Unit un = has_next ? nxt : cur;
#pragma unroll
            for (int h = 0; h < 2; ++h)
#pragma unroll
                for (int i = 0; i < 2; ++i) { int R_, C_; stage_rc(tid * 16 + i * 8192, R_, C_); S.a_row_issue(un, h * HALF + R_, rowN[h][i]); } }
#pragma unroll 1
        for (int t = 0; t < nt; t += 2) {
            const bool last = (t == nt - 2);
            const size_t kb1 = (size_t)(t + 1) * kstep;
            const size_t kb2 = last ? 0 : (size_t)(t + 2) * kstep, kb3 = kb2 + kstep;
            const char* b2 = last ? nB : cB + (size_t)(t + 2) * kstep; const char* b3 = b2 + kstep;
            if constexpr (SP2) {
            PG8_LDB(B0, 0, 0); PG8_LDB(B1, 0, 1); PG8_SCHED; PG8_LDA(At, 0, 0); PG8_STA(PG8_SA(1, 1), 1, kb1);
            if (last) { if constexpr (GA) { if (has_next) {
#pragma unroll
                for (int h = 0; h < 2; ++h)
#pragma unroll
                    for (int i = 0; i < 2; ++i) { int R_, C_; stage_rc(tid * 16 + i * 8192, R_, C_); int rl = rowN[h][i]; asm volatile("" : "+v"(rl));
                        offC[h][i] = (unsigned)(S.a_row_fix(nxt, h * HALF + R_, rl) * K + C_) * 2u; } } } else cA = nA; }
            PG8_WAIT_V(8); PG8_WAIT_L(0); PG8_BAR; PG8_MMA(0, 0, At, B0); PG8_MMA(0, 1, At, B1); PG8_BAR; PG8_SCHED;
            PG8_LDA(At, 0, 1); PG8_STB(PG8_SB(0, 0), b2); PG8_STB(PG8_SB(0, 1), b2 + hstep); PG8_STA(PG8_SA(0, 0), 0, kb2);
            PG8_WAIT_V(8); PG8_WAIT_L(0); PG8_BAR; PG8_MMA(1, 0, At, B0); PG8_MMA(1, 1, At, B1); PG8_BAR; PG8_SCHED;
            PG8_LDB(B0, 1, 0); PG8_LDB(B1, 1, 1); PG8_SCHED; PG8_LDA(At, 1, 0); PG8_STA(PG8_SA(0, 1), 1, kb2);
            PG8_WAIT_V(8); PG8_WAIT_L(0); PG8_BAR; PG8_MMA(0, 0, At, B0); PG8_MMA(0, 1, At, B1); PG8_BAR; PG8_SCHED;
            PG8_LDA(At, 1, 1); PG8_STB(PG8_SB(1, 0), b3); PG8_STB(PG8_SB(1, 1), b3 + hstep); PG8_STA(PG8_SA(1, 0), 0, kb3);
            PG8_WAIT_V(8); PG8_WAIT_L(0); PG8_BAR; PG8_MMA(1, 0, At, B0); PG8_MMA(1, 1, At, B1); PG8_BAR; PG8_SCHED;
            } else {
            PG8_LDB(B0, 0, 0); PG8_SCHED; PG8_LDA(At, 0, 0); PG8_STA(PG8_SA(1, 1), 1, kb1);
            if (last) { if constexpr (GA) { if (has_next) {
#pragma unroll
                for (int h = 0; h < 2; ++h)
#pragma unroll
                    for (int i = 0; i < 2; ++i) { int R_, C_; stage_rc(tid * 16 + i * 8192, R_, C_); int rl = rowN[h][i]; asm volatile("" : "+v"(rl));
                        offC[h][i] = (unsigned)(S.a_row_fix(nxt, h * HALF + R_, rl) * K + C_) * 2u; } } } else cA = nA; }
            PG8_WAIT_L(8); PG8_BAR; PG8_WAIT_L(0); PG8_MMA(0, 0, At, B0); PG8_BAR; PG8_SCHED;
            PG8_LDB(B1, 0, 1); PG8_STB(PG8_SB(0, 0), b2);
            PG8_BAR; PG8_WAIT_L(0); PG8_MMA(0, 1, At, B1); PG8_BAR;
            PG8_LDA(At, 0, 1); PG8_STA(PG8_SA(0, 0), 0, kb2);
            PG8_BAR; PG8_WAIT_L(0); PG8_MMA(1, 0, At, B0); PG8_BAR; PG8_SCHED;
            PG8_STB(PG8_SB(0, 1), b2 + hstep);
            PG8_WAIT_V(6); PG8_BAR; PG8_MMA(1, 1, At, B1); PG8_BAR;
            PG8_LDB(B0, 1, 0); PG8_SCHED; PG8_LDA(At, 1, 0); PG8_STA(PG8_SA(0, 1), 1, kb2);
            PG8_WAIT_L(8); PG8_BAR; PG8_WAIT_L(0); PG8_MMA(0, 0, At, B0); PG8_BAR; PG8_SCHED;
            PG8_LDB(B1, 1, 1); PG8_STB(PG8_SB(1, 0), b3);
            PG8_BAR; PG8_WAIT_L(0); PG8_MMA(0, 1, At, B1); PG8_BAR;
            PG8_LDA(At, 1, 1); PG8_STA(PG8_SA(1, 0), 0, kb3);
            PG8_BAR; PG8_WAIT_L(0); PG8_MMA(1, 0, At, B0); PG8_BAR; PG8_SCHED;
            PG8_STB(PG8_SB(1, 1), b3 + hstep);
            PG8_WAIT_V(6); PG8_BAR; PG8_MMA(1, 1, At, B1); PG8_BAR;
            }
        }
        if constexpr (ALIGN_EPI) { if (wr == 0) PG8_BAR; }
        const int tq = opaque(lane_now() + 64 * wid);
        if constexpr (Epi::PRE) { asm volatile("" : "+v"(pre_v0), "+v"(pre_v1)); E.pre_commit(pre_v0, pre_v1, wid, tq & 63); }
        E(acc, cur, wr, wc, tq & 15, (tq >> 4) & 3);
        if (!has_next) break;
#pragma unroll
        for (int a = 0; a < 2; ++a)
#pragma unroll
            for (int b = 0; b < 2; ++b)
#pragma unroll
                for (int m = 0; m < 4; ++m)
#pragma unroll
                    for (int n = 0; n < 2; ++n) { acc[a][b][m][n] = (f32x4){0.f, 0.f, 0.f, 0.f}; if constexpr (F8) F8_PIN_ASM(acc[a][b][m][n]); }
        cur = nxt; cB = nB; ++ui;
        if constexpr (ALIGN_EPI) { if (wr == 1) PG8_BAR; }
    }
    PG8_WAIT_V(0);
    if constexpr (!ALIGN_EPI) { if (wr == 0) PG8_BAR; }
    PG8_BAR;
#undef PG8_SA
#undef PG8_SB
#undef PG8_STB
#undef PG8_STA
#undef PG8_LDA
#undef PG8_LDB
#undef PG8_MMA
#undef PG8_CAT8
#undef PG8_WAIT_V
#undef PG8_WAIT_L
#undef PG8_BAR
#undef PG8_SCHED
#undef PG8_AOFF
}

typedef const f32x4 (&AccRef)[2][2][4][2];
__device__ __forceinline__ u32x4 pack8(const f32x4& a, const f32x4& b) { u32x4 w; w.x = cvt_pk_bf16(a[0], a[1]); w.y = cvt_pk_bf16(a[2], a[3]); w.z = cvt_pk_bf16(b[0], b[1]); w.w = cvt_pk_bf16(b[2], b[3]); return w; }
__device__ __forceinline__ void unpack8(const u32x4 w, f32x4& a, f32x4& b) { a = (f32x4){bf_lo(w.x), bf_hi(w.x), bf_lo(w.y), bf_hi(w.y)}; b = (f32x4){bf_lo(w.z), bf_hi(w.z), bf_lo(w.w), bf_hi(w.w)}; }

constexpr float WGU_SCALE = 64.0f, WD_SCALE = 32.0f;
__device__ __forceinline__ unsigned pk_fp8x4(const f32x4& a) {
    int w = 0; w = __builtin_amdgcn_cvt_pk_fp8_f32(a[0], a[1], w, false); w = __builtin_amdgcn_cvt_pk_fp8_f32(a[2], a[3], w, true); return (unsigned)w; }
struct EpiInProj {
    static constexpr bool PERM = true; static constexpr bool PRE = false;
    bf16_t* O; const float* bias; float qscale; int nostore;
    __device__ __forceinline__ void operator()(AccRef acc, const Unit& u, int wr, int wc, int fr, int fq) const {
        if (nostore) return;
        const int row0 = u.pm * BM + wr * 64 + fr, colb = u.pn * BM + wc * 32 + 8 * fq;
        const int mode = u.pn < 4 ? 1 : (u.pn >= 8 ? 2 : 0);
        float dq = INP_F8 ? 1.0f / WGU_SCALE : 1.0f; asm volatile("" : "+s"(dq));
        f32x4 bv[2][2];
#pragma unroll
        for (int bj = 0; bj < 2; ++bj)
#pragma unroll
            for (int n = 0; n < 2; ++n) bv[bj][n] = *(const GAS f32x4*)(bias + colb + bj * HALF + 4 * n);
#pragma unroll
        for (int ai = 0; ai < 2; ++ai)
#pragma unroll
            for (int m = 0; m < 4; ++m) { bf16_t* rowp = O + (size_t)(row0 + ai * HALF + m * 16) * INW + colb;
#pragma unroll
                for (int bj = 0; bj < 2; ++bj) { f32x4 v0 = acc[ai][bj][m][0] * dq + bv[bj][0], v1 = acc[ai][bj][m][1] * dq + bv[bj][1];
                    if (mode == 1) { v0 = v0 * qscale; v1 = v1 * qscale; }
                    if (mode == 2) {
#pragma unroll
                        for (int j = 0; j < 4; ++j) { v0[j] = fast_sigmoid(v0[j]); v1[j] = fast_sigmoid(v1[j]); } }
                    *(GAS u32x4*)(rowp + bj * HALF) = pack8(v0, v1); } }
    }
};
struct EpiAttnProj {
    static constexpr bool PERM = true; static constexpr bool PRE = false;
    const bf16_t* proj; bf16_t* mixed;
    __device__ __forceinline__ void operator()(AccRef acc, const Unit& u, int wr, int wc, int fr, int fq) const {
        const int row0 = u.pm * BM + wr * 64 + fr, colb = u.pn * BM + wc * 32 + 8 * fq;
#pragma unroll
        for (int ai = 0; ai < 2; ++ai) {
            u32x4 gw[4][2];
#pragma unroll
            for (int m = 0; m < 4; ++m)
#pragma unroll
                for (int bj = 0; bj < 2; ++bj) gw[m][bj] = *(const GAS u32x4*)(proj + (size_t)(row0 + ai * HALF + m * 16) * INW + O_GA + colb + bj * HALF);
#pragma unroll
            for (int m = 0; m < 4; ++m) { const size_t row = (size_t)(row0 + ai * HALF + m * 16);
#pragma unroll
                for (int bj = 0; bj < 2; ++bj) { f32x4 g0, g1; unpack8(gw[m][bj], g0, g1);
                    if (AO_F8) { g0 = g0 * (1.0f / WGU_SCALE); g1 = g1 * (1.0f / WGU_SCALE); }
                    *(GAS u32x4*)(mixed + row * D + colb + bj * HALF) = pack8(g0 * acc[ai][bj][m][0], g1 * acc[ai][bj][m][1]); } } }
    }
};
struct EpiGlu {
    static constexpr bool PERM = true; static constexpr bool PRE = false;
    const bf16_t* proj; const bf16_t* mixed; bf16_t* mixed2;
    __device__ __forceinline__ void operator()(AccRef acc, const Unit& u, int wr, int wc, int fr, int fq) const {
        const int row0 = u.pm * BM + wr * 64 + fr, col = u.pn * HALF + wc * 32 + 8 * fq;
#pragma unroll
        for (int ai = 0; ai < 2; ++ai) {
            u32x4 gw[4], pw[4];
#pragma unroll
            for (int m = 0; m < 4; ++m) { const size_t row = (size_t)(row0 + ai * HALF + m * 16);
                gw[m] = *(const GAS u32x4*)(proj + row * INW + O_GS + col); pw[m] = *(const GAS u32x4*)(mixed + row * D + col); }
#pragma unroll
            for (int m = 0; m < 4; ++m) { const size_t row = (size_t)(row0 + ai * HALF + m * 16);
                f32x4 g0, g1, p0, p1; unpack8(gw[m], g0, g1); unpack8(pw[m], p0, p1);
                const float dq = GLU_F8 ? 1.0f / WGU_SCALE : 1.0f;
                const f32x4 za0 = acc[ai][0][m][0] * dq, za1 = acc[ai][0][m][1] * dq, zb0 = acc[ai][1][m][0] * dq, zb1 = acc[ai][1][m][1] * dq;
#pragma unroll
                for (int j = 0; j < 4; ++j) { p0[j] += g0[j] * za0[j] * fast_sigmoid(zb0[j]); p1[j] += g1[j] * za1[j] * fast_sigmoid(zb1[j]); }
                if constexpr (MIX_F8 != 0) *(GAS u32x2*)((unsigned char*)mixed2 + row * D + col) = (u32x2){pk_fp8x4(p0), pk_fp8x4(p1)};
                else *(GAS u32x4*)(mixed2 + row * D + col) = pack8(p0, p1); } }
    }
};
struct EpiMixOut {
    static constexpr bool PERM = true; static constexpr bool PRE = false;
    const float* xin; const bf16_t* xsrc; bf16_t* xdst; const float* gt;
    __device__ __forceinline__ void operator()(AccRef acc, const Unit& u, int wr, int wc, int fr, int fq) const {
        const int row0 = u.pm * BM + wr * 64 + fr, colb = u.pn * BM + wc * 32 + 8 * fq;
        const float* g = gt + (u.pm >= 16 ? 12288 : 0);
        f32x4 gv[2][2];
#pragma unroll
        for (int bj = 0; bj < 2; ++bj)
#pragma unroll
            for (int n = 0; n < 2; ++n) gv[bj][n] = *(const GAS f32x4*)(g + colb + bj * HALF + 4 * n) * (MIX_F8 ? 1.0f / WGU_SCALE : 1.0f);
        if (xin) {
#pragma unroll
            for (int ai = 0; ai < 2; ++ai)
#pragma unroll
                for (int mp = 0; mp < 2; ++mp) { f32x4 xv[2][2][2];
#pragma unroll
                    for (int mm = 0; mm < 2; ++mm)
#pragma unroll
                        for (int bj = 0; bj < 2; ++bj) { const size_t off = (size_t)(row0 + ai * HALF + (2 * mp + mm) * 16) * D + colb + bj * HALF;
                            xv[mm][bj][0] = *(const GAS f32x4*)(xin + off); xv[mm][bj][1] = *(const GAS f32x4*)(xin + off + 4); }
#pragma unroll
                    for (int mm = 0; mm < 2; ++mm)
#pragma unroll
                        for (int bj = 0; bj < 2; ++bj) { const int m = 2 * mp + mm; const size_t off = (size_t)(row0 + ai * HALF + m * 16) * D + colb + bj * HALF;
                            *(GAS u32x4*)(xdst + off) = pack8(xv[mm][bj][0] + gv[bj][0] * acc[ai][bj][m][0], xv[mm][bj][1] + gv[bj][1] * acc[ai][bj][m][1]); } }
        } else {
#pragma unroll
            for (int ai = 0; ai < 2; ++ai) { u32x4 xw[4][2];
#pragma unroll
                for (int m = 0; m < 4; ++m)
#pragma unroll
                    for (int bj = 0; bj < 2; ++bj) xw[m][bj] = *(const GAS u32x4*)(xsrc + (size_t)(row0 + ai * HALF + m * 16) * D + colb + bj * HALF);
#pragma unroll
                for (int m = 0; m < 4; ++m)
#pragma unroll
                    for (int bj = 0; bj < 2; ++bj) { f32x4 x0, x1; unpack8(xw[m][bj], x0, x1);
                        *(GAS u32x4*)(xdst + (size_t)(row0 + ai * HALF + m * 16) * D + colb + bj * HALF) = pack8(x0 + gv[bj][0] * acc[ai][bj][m][0], x1 + gv[bj][1] * acc[ai][bj][m][1]); } }
        }
    }
};
struct EpiGateUp {
    static constexpr bool PERM = true; static constexpr bool PRE = false;
    unsigned char* hid;
    __device__ __forceinline__ void operator()(AccRef acc, const Unit& u, int wr, int wc, int fr, int fq) const {
        const int r0 = wr * 64 + fr, col = u.pn * HALF + wc * 32 + 8 * fq;
        float dq = 1.0f / WGU_SCALE; asm volatile("" : "+s"(dq));
#pragma unroll
        for (int ai = 0; ai < 2; ++ai)
#pragma unroll
            for (int m = 0; m < 4; ++m) { const int r = r0 + ai * HALF + m * 16;
                f32x4 g0 = acc[ai][0][m][0] * dq, g1 = acc[ai][0][m][1] * dq, u0 = acc[ai][1][m][0] * dq, u1 = acc[ai][1][m][1] * dq;
#pragma unroll
                for (int j = 0; j < 4; ++j) { g0[j] = g0[j] * fast_sigmoid(g0[j]) * u0[j]; g1[j] = g1[j] * fast_sigmoid(g1[j]) * u1[j]; }
                if (r < u.n) { if constexpr (DOWN_F8 != 0) *(GAS u32x2*)(hid + (size_t)(u.x + r) * 512 + col) = (u32x2){pk_fp8x4(g0), pk_fp8x4(g1)};
                               else *(GAS u32x4*)(hid + ((size_t)(u.x + r) * 512 + col) * 2) = pack8(g0, g1); } }
    }
};
constexpr float YS_SCALE = 8.0f, YS_INV = 1.0f / 8.0f, YS_ACC = DOWN_F8 ? YS_SCALE / WD_SCALE : YS_SCALE;
struct EpiDown {
    static constexpr bool PERM = true; static constexpr bool PRE = (DOWN_PRE != 0);
    unsigned char* ys; const int* ldst; LAS int* dstl; int nostore;
    __device__ __forceinline__ void pre_issue(const Unit& u, int wr, int lane, int& v0, int& v1) const {
        const int ra = 64 * wr + lane, rb = ra + 128; const GAS int* p = (const GAS int*)ldst + (u.e == 64 ? 0 : u.e * 8192 + u.pm * BM);
        const GAS int* pa = p + ((u.e != 64 && ra < u.n) ? ra : 0); const GAS int* pb = p + ((u.e != 64 && rb < u.n) ? rb : 0);
        asm volatile("global_load_dword %0, %1, off" : "=v"(v0) : "v"(pa) : "memory");
        asm volatile("global_load_dword %0, %1, off" : "=v"(v1) : "v"(pb) : "memory");
    }
    __device__ __forceinline__ void pre_commit(int v0, int v1, int wid, int lane_) const { const int lane = opaque(lane_); dstl[wid * 128 + lane] = v0; dstl[wid * 128 + 64 + lane] = v1; }
    __device__ __forceinline__ void operator()(AccRef acc, const Unit& u, int wr, int wc, int fr_, int fq_) const {
        const int fr = opaque(fr_), fq = opaque(fq_);
        const int r0 = wr * 64 + fr, colb = u.pn * BM + 16 * (4 * wc + fq);
#pragma unroll
        for (int ai = 0; ai < 2; ++ai)
#pragma unroll
            for (int m = 0; m < 4; ++m) { const int r = r0 + ai * HALF + m * 16;
                int dst;
                if constexpr (PRE) dst = (u.e == 64) ? (u.pm * BM + r) * NSLOT + 8 : dstl[(wr * 4 + wc) * 128 + ai * 64 + m * 16 + fr];
                else dst = (u.e == 64) ? (u.pm * BM + r) * NSLOT + 8 : ((const GAS int*)ldst)[u.e * 8192 + u.pm * BM + (r < u.n ? r : 0)];
                if (r < u.n && !nostore)
                    *(GAS u32x4*)(ys + (size_t)dst * D + colb) = (u32x4){pk_fp8x4(acc[ai][0][m][0] * YS_ACC), pk_fp8x4(acc[ai][0][m][1] * YS_ACC), pk_fp8x4(acc[ai][1][m][0] * YS_ACC), pk_fp8x4(acc[ai][1][m][1] * YS_ACC)}; }
    }
};
}

struct Args { const float* in[29]; float* out; unsigned char* ws; int ph_lo, ph_hi; };
typedef const __attribute__((address_space(4))) Args KArgs;
__device__ __forceinline__ const float* arg_in(int which) {
#if defined(__HIP_DEVICE_COMPILE__)
    KArgs* p = (KArgs*)__builtin_amdgcn_kernarg_segment_ptr(); return p->in[which];
#else
    (void)which; return nullptr;
#endif
}
enum { I_X = 0, I_C, I_WADA, I_BADA, I_NMIX, I_WIN, I_BIN, I_SINK, I_WO, I_ARE, I_AIM, I_LDT, I_BRE, I_BIM, I_CRE, I_CIM, I_SD, I_WGLU, I_WMIX, I_NFFN, I_WR, I_BR, I_WEG, I_WEU, I_WED, I_WSG, I_WSU, I_WSD, I_NFIN };

struct TDesc { const float* src; bf16_t* dst; int N, K, cc0; float f8s; };
__device__ __forceinline__ void tr_load(const TDesc& d, int lane, f32x4 (&v)[16]) {
    const int kr = lane >> 4, nq = lane & 15;
    const GAS float* p = (const GAS float*)d.src + (size_t)kr * d.N + 4 * nq; const size_t step = (size_t)4 * d.N;
#pragma unroll
    for (int i = 0; i < 16; ++i) { v[i] = __builtin_nontemporal_load((const GAS f32x4*)p); p += step; }
}
__device__ __forceinline__ void tr_finish(const TDesc& d, int lane_, LAS float* scr, const f32x4 (&v)[16]) {
    const int lane = opaque(lane_);
    const int kr = lane >> 4, nq = lane & 15;
#pragma unroll
    for (int i = 0; i < 16; ++i) { const int k = 4 * i + kr;
#pragma unroll
        for (int e = 0; e < 4; ++e) scr[k * 64 + ((4 * nq + e) ^ k)] = v[i][e]; }
    LDS_WAIT();
    const int c = lane & 7;
#pragma unroll
    for (int j = 0; j < 8; ++j) { const int n = (lane >> 3) + 8 * j; float s[8];
#pragma unroll
        for (int i = 0; i < 8; ++i) { const int k = 8 * c + i; s[i] = scr[k * 64 + (n ^ k)]; }
        u32x4 o; o.x = cvt_pk_bf16(s[0], s[1]); o.y = cvt_pk_bf16(s[2], s[3]); o.z = cvt_pk_bf16(s[4], s[5]); o.w = cvt_pk_bf16(s[6], s[7]);
        const int cc = d.cc0 + n, drow = d.cc0 >= 0 ? (128 * ((cc & 15) >> 3) + 8 * (cc >> 4) + (cc & 7)) : n;
        if (d.f8s != 0.f) { const f32x4 sa = (f32x4){s[0], s[1], s[2], s[3]} * d.f8s, sb = (f32x4){s[4], s[5], s[6], s[7]} * d.f8s;
            __builtin_nontemporal_store((u32x2){pg8::pk_fp8x4(sa), pg8::pk_fp8x4(sb)}, (GAS u32x2*)((unsigned char*)d.dst + (size_t)drow * d.K + 8 * c)); }
        else __builtin_nontemporal_store(o, (GAS u32x4*)(d.dst + (size_t)drow * d.K + 8 * c)); }
    LDS_WAIT();
}
__device__ __forceinline__ void tr_half8(const TDesc& d, int lane_, LAS float* scr, const f32x4 (&v)[16], u32x2 (&o)[8]) {
    const int lane = opaque(lane_);
    const int kr = lane >> 4, nq = lane & 15;
#pragma unroll
    for (int i = 0; i < 16; ++i) { const int k = 4 * i + kr;
#pragma unroll
        for (int e = 0; e < 4; ++e) scr[k * 64 + ((4 * nq + e) ^ k)] = v[i][e]; }
    LDS_WAIT();
    const int c = lane & 7;
#pragma unroll
    for (int j = 0; j < 8; ++j) { const int n = (lane >> 3) + 8 * j; float s[8];
#pragma unroll
        for (int i = 0; i < 8; ++i) { const int k = 8 * c + i; s[i] = scr[k * 64 + (n ^ k)]; }
        const f32x4 sa = (f32x4){s[0], s[1], s[2], s[3]} * d.f8s, sb = (f32x4){s[4], s[5], s[6], s[7]} * d.f8s;
        o[j] = (u32x2){pg8::pk_fp8x4(sa), pg8::pk_fp8x4(sb)}; }
    LDS_WAIT();
}
__device__ __forceinline__ void tr_store8(const TDesc& d, int lane, const u32x2 (&o0)[8], const u32x2 (&o1)[8]) {
    const int c = lane & 7;
#pragma unroll
    for (int j = 0; j < 8; ++j) { const int n = (lane >> 3) + 8 * j; const int cc = d.cc0 + n, drow = d.cc0 >= 0 ? (128 * ((cc & 15) >> 3) + 8 * (cc >> 4) + (cc & 7)) : n;
        unsigned char* p = (unsigned char*)d.dst + (size_t)drow * d.K + 8 * c;
        __builtin_nontemporal_store(o0[j], (GAS u32x2*)p); __builtin_nontemporal_store(o1[j], (GAS u32x2*)(p + 64)); }
}
constexpr int IT_WIN = INP_F8 ? 1536 : 3072, IT_WO = AO_F8 ? 256 : 512, IT_WGLU = GLU_F8 ? 256 : 512, IT_WMIX = MIX_F8 ? 512 : 1024, IT_EXP = 64 * 128, IT_SH = 128, IT_EXPD = DOWN_F8 ? 64 * 128 : 64 * 256, IT_SHD = DOWN_F8 ? 128 : 256;
constexpr int IT_LAYER = IT_WIN + IT_WO + IT_WGLU + IT_WMIX + 2 * IT_EXP + IT_EXPD + 2 * IT_SH + IT_SHD;
constexpr int IT_MOD = 768;
constexpr int IT_TR = 2 * IT_LAYER;

__device__ __forceinline__ TDesc tr_desc(const float* W, int K, int N, bf16_t* WT, int kb, int nb, int drow0) {
    TDesc d; d.src = W + (size_t)(64 * kb) * N + 64 * nb; d.dst = WT + (size_t)drow0 * K + 64 * kb; d.N = N; d.K = K; d.cc0 = -1; d.f8s = 0.f; return d;
}
__device__ __forceinline__ TDesc tr_desc8(const float* W, int K, int N, unsigned char* WT, int kb, int nb, int drow0, float scale) {
    TDesc d; d.src = W + (size_t)(64 * kb) * N + 64 * nb; d.dst = (bf16_t*)(WT + (size_t)drow0 * K + 64 * kb); d.N = N; d.K = K; d.cc0 = -1; d.f8s = scale; return d;
}
__device__ __forceinline__ TDesc tr_decode(unsigned char* ws, int it) {
    const int l = 1 - it / IT_LAYER; int r = it % IT_LAYER;
    int which, K, N, kb, nb, drow0, cc0 = -1, es = 2; size_t soff, dbyte; float f8s = 0.f;
    if (r < IT_WIN) { which = I_WIN; soff = (size_t)l * 2048 * 6144; K = 2048; N = 6144; dbyte = WS_WIN + (size_t)l * 6144 * 2048 * (INP_F8 ? 1 : 2); kb = r / 96; nb = r % 96; drow0 = 64 * nb;
        if (INP_F8) { es = 1; f8s = pg8::WGU_SCALE; } }
    else if ((r -= IT_WIN) < IT_WO) { which = I_WO; soff = (size_t)l * 1024 * 2048; K = 1024; N = 2048; dbyte = WS_WO + (size_t)l * 2048 * 1024 * (AO_F8 ? 1 : 2); kb = r / 32; nb = r % 32; drow0 = 64 * nb; if (AO_F8) { es = 1; f8s = pg8::WGU_SCALE; } }
    else if ((r -= IT_WO) < IT_WGLU) { which = I_WGLU; soff = (size_t)l * 512 * 4096; K = 512; N = 4096; dbyte = WS_WGLU + (size_t)l * 4096 * 512 * (GLU_F8 ? 1 : 2); kb = r / 64; nb = r % 64; const int n0 = 64 * nb; if (GLU_F8) { es = 1; f8s = pg8::WGU_SCALE; }
        drow0 = n0 < 2048 ? 256 * (n0 / 128) + (n0 % 128) : 256 * ((n0 - 2048) / 128) + 128 + (n0 % 128); }
    else if ((r -= IT_WGLU) < IT_WMIX) { which = I_WMIX; soff = (size_t)l * 2048 * 2048; K = 2048; N = 2048; dbyte = WS_WMIX + (size_t)l * 2048 * 2048 * (MIX_F8 ? 1 : 2); kb = r / 32; nb = r % 32; drow0 = 64 * nb;
        if (MIX_F8) { es = 1; f8s = pg8::WGU_SCALE; } }
    else { r -= IT_WMIX;
        const size_t wgu = WS_WGU + (size_t)l * 65 * 1024 * 2048;
        constexpr int DES = DOWN_F8 ? 1 : 2; const size_t wd = WS_WD + (size_t)l * 65 * 2048 * 512 * DES;
        if (r < 2 * IT_EXP) { const int up = r >= IT_EXP; r -= up * IT_EXP; const int e = r / 128, q = r % 128; kb = q / 8; nb = q % 8; const int n0 = 64 * nb;
            which = up ? I_WEU : I_WEG; soff = ((size_t)l * 64 + e) * 2048 * 512; K = 2048; N = 512; dbyte = wgu + (size_t)e * 1024 * 2048; es = 1; f8s = pg8::WGU_SCALE; drow0 = 256 * (n0 / 128) + (n0 % 128) + 128 * up; }
        else if ((r -= 2 * IT_EXP) < IT_EXPD) { constexpr int QD = DOWN_F8 ? 128 : 256; const int e = r / QD, q = r % QD; kb = q / 32; nb = q % 32;
            which = I_WED; soff = ((size_t)l * 64 + e) * 512 * 2048; K = 512; N = 2048; dbyte = wd + (size_t)e * 2048 * 512 * DES; es = DES; f8s = DOWN_F8 ? pg8::WD_SCALE : 0.f; drow0 = 256 * (nb / 4); cc0 = 64 * (nb % 4); }
        else if ((r -= IT_EXPD) < 2 * IT_SH) { const int up = r >= IT_SH; r -= up * IT_SH; kb = r / 8; nb = r % 8; const int n0 = 64 * nb;
            which = up ? I_WSU : I_WSG; soff = (size_t)l * 2048 * 512; K = 2048; N = 512; dbyte = wgu + (size_t)64 * 1024 * 2048; es = 1; f8s = pg8::WGU_SCALE; drow0 = 256 * (n0 / 128) + (n0 % 128) + 128 * up; }
        else { r -= 2 * IT_SH; kb = r / 32; nb = r % 32;
            which = I_WSD; soff = (size_t)l * 512 * 2048; K = 512; N = 2048; dbyte = wd + (size_t)64 * 2048 * 512 * DES; es = DES; f8s = DOWN_F8 ? pg8::WD_SCALE : 0.f; drow0 = 256 * (nb / 4); cc0 = 64 * (nb % 4); } }
    const int kr = f8s != 0.f ? 128 : 64;
    TDesc d; d.src = arg_in(which) + soff + (size_t)(kr * kb) * N + 64 * nb; d.dst = (bf16_t*)(ws + dbyte + ((size_t)drow0 * K + kr * kb) * es); d.N = N; d.K = K; d.cc0 = cc0; d.f8s = f8s; return d;
}
__device__ __forceinline__ void mod_item(const Args& a, int it, int tid, LAS unsigned char* lds) {
    const int lane = tid & 63, wave = tid >> 6;
    const int l = it / 384, r = it % 384, ks = r / 48, cc = r % 48;
    const float* W = a.in[I_WADA] + (size_t)l * 2048 * 12288 + (size_t)(256 * ks + 32 * wave) * 12288 + 256 * cc + 4 * lane;
    const float* c0 = a.in[I_C] + 256 * ks + 32 * wave, *c1 = c0 + 2048;
    f32x4 a0 = {0.f, 0.f, 0.f, 0.f}, a1 = {0.f, 0.f, 0.f, 0.f};
#pragma unroll 1
    for (int h = 0; h < 2; ++h) { f32x4 w[16]; const GAS float* wp = (const GAS float*)W + (size_t)(16 * h) * 12288;
#pragma unroll
        for (int i = 0; i < 16; ++i) { w[i] = __builtin_nontemporal_load((const GAS f32x4*)wp); wp += 12288; }
#pragma unroll
        for (int i = 0; i < 16; ++i) { const float x0 = c0[16 * h + i], x1 = c1[16 * h + i]; const float s0 = x0 * fast_sigmoid(x0), s1 = x1 * fast_sigmoid(x1); a0 += w[i] * s0; a1 += w[i] * s1; } }
    LAS f32x4* red = (LAS f32x4*)lds;
    red[(wave * 2 + 0) * 64 + lane] = a0; red[(wave * 2 + 1) * 64 + lane] = a1;
    __syncthreads();
    { const int b = tid >> 8, col = tid & 255; LAS float* rf = (LAS float*)lds; float s = 0.f;
#pragma unroll
        for (int w8 = 0; w8 < 8; ++w8) s += rf[((w8 * 2 + b) * 64) * 4 + col];
        ((float*)(a.ws + WS_MODP))[((size_t)(ks * 2 + l) * 2 + b) * 12288 + 256 * cc + col] = s; }
    __syncthreads();
}
__device__ __forceinline__ void p0_items(const Args& a, int gw, int ngw, LAS float* scr, int lane) {
#pragma unroll 1
    for (int it = gw; it < IT_TR; it += ngw) { f32x4 v[16]; const TDesc d = tr_decode(a.ws, it);
        if (d.f8s != 0.f) { u32x2 o0[8], o1[8]; f32x4 w[16]; TDesc d2 = d; d2.src += (size_t)64 * d.N; tr_load(d, lane, v); tr_load(d2, lane, w);
            tr_half8(d, lane, scr, v, o0); tr_half8(d, lane, scr, w, o1); tr_store8(d, lane, o0, o1); }
        else { tr_load(d, lane, v); tr_finish(d, lane, scr, v); } }
}

__device__ __forceinline__ void cpow(float are, float aim, float dt, int n, float& pr, float& pi) {
    const float mag = __builtin_amdgcn_exp2f((float)n * dt * are * LOG2E);
    const double turns = (double)n * ((double)dt * (double)aim * 0.15915494309189535);
    const float fr = (float)(turns - __builtin_rint(turns));
    pr = mag * __builtin_amdgcn_cosf(fr); pi = mag * __builtin_amdgcn_sinf(fr);
}
__device__ __forceinline__ void ssm_tables(const Args& a, int l, int g, LAS unsigned char* lds, int tid) {
    LAS f32x2* Apow = (LAS f32x2*)lds;
    LAS f32x2* Bb = (LAS f32x2*)(lds + 65 * 64 * 8);
    LAS f32x2* Cc = (LAS f32x2*)(lds + 65 * 64 * 8 + 64 * 16 * 8);
    const int lg = l * 32 + g;
    const float* are_p = a.in[I_ARE] + lg * 64; const float* aim_p = a.in[I_AIM] + lg * 64;
    const float dt = __expf(a.in[I_LDT][lg]);
    unsigned char* tb = a.ws + WS_SSM + (size_t)lg * SSM_STRIDE;
    bf16_t* Et = (bf16_t*)(tb + SSM_E); bf16_t* Ft = (bf16_t*)(tb + SSM_F); bf16_t* Kt = (bf16_t*)(tb + SSM_KT); GAS f32x2* Pt = (GAS f32x2*)(tb + SSM_P);
    for (int idx = tid; idx < 65 * 64; idx += 512) { const int n = idx >> 6, p = idx & 63; float pr, pi; cpow(are_p[p], aim_p[p], dt, n, pr, pi); Apow[idx] = (f32x2){pr, pi}; }
    for (int idx = tid; idx < 64 * 64; idx += 512) { const int m = idx >> 6, p = idx & 63; float pr, pi; cpow(are_p[p], aim_p[p], dt, 64 * m, pr, pi); Pt[idx] = (f32x2){pr, pi}; }
    for (int idx = tid; idx < 64 * 16; idx += 512) { const int p = idx >> 4, c = idx & 15;
        const float ar = are_p[p], ai = aim_p[p]; float br, bi; cpow(ar, ai, dt, 1, br, bi);
        const float nr = br - 1.0f, ni = bi, den = ar * ar + ai * ai; const float fr = (nr * ar + ni * ai) / den, fi = (ni * ar - nr * ai) / den;
        const float b_r = a.in[I_BRE][(size_t)lg * 1024 + idx], b_i = a.in[I_BIM][(size_t)lg * 1024 + idx];
        Bb[idx] = (f32x2){fr * b_r - fi * b_i, fr * b_i + fi * b_r}; }
    for (int idx = tid; idx < 16 * 64; idx += 512) Cc[idx] = (f32x2){a.in[I_CRE][(size_t)lg * 1024 + idx], a.in[I_CIM][(size_t)lg * 1024 + idx]};
    __syncthreads();
    for (int idx = tid; idx < 128 * 128; idx += 512) { const int n = idx >> 7, k8 = idx & 127, ri = n >> 6, p = n & 63, s = k8 >> 1, c0 = (k8 & 1) * 8;
        const f32x2 ap = Apow[(63 - s) * 64 + p]; float v[8];
#pragma unroll
        for (int j = 0; j < 8; ++j) { const f32x2 b = Bb[p * 16 + c0 + j]; v[j] = ri ? (ap.x * b.y + ap.y * b.x) : (ap.x * b.x - ap.y * b.y); }
        u32x4 o; o.x = cvt_pk_bf16(v[0], v[1]); o.y = cvt_pk_bf16(v[2], v[3]); o.z = cvt_pk_bf16(v[4], v[5]); o.w = cvt_pk_bf16(v[6], v[7]);
        *(GAS u32x4*)(Et + (size_t)n * 1024 + k8 * 8) = o; }
    for (int idx = tid; idx < 1024 * 16; idx += 512) { const int n = idx >> 4, k8 = idx & 15, t = n >> 4, c = n & 15, ri = k8 >> 3, p0 = (k8 & 7) * 8; float v[8];
#pragma unroll
        for (int j = 0; j < 8; ++j) { const f32x2 ap = Apow[(t + 1) * 64 + p0 + j], cc = Cc[c * 64 + p0 + j]; v[j] = ri ? -(cc.x * ap.y + cc.y * ap.x) : (cc.x * ap.x - cc.y * ap.y); }
        u32x4 o; o.x = cvt_pk_bf16(v[0], v[1]); o.y = cvt_pk_bf16(v[2], v[3]); o.z = cvt_pk_bf16(v[4], v[5]); o.w = cvt_pk_bf16(v[6], v[7]);
        *(GAS u32x4*)(Ft + (size_t)n * 128 + k8 * 8) = o; }
    for (int idx = tid; idx < 65 * 16 * 2; idx += 512) { const int t1 = idx >> 5, c = (idx >> 1) & 15, c0 = (idx & 1) * 8; float v[8];
#pragma unroll
        for (int j = 0; j < 8; ++j) v[j] = 0.f;
        if (t1 > 0) for (int p = 0; p < 64; ++p) { const f32x2 ap = Apow[(t1 - 1) * 64 + p], cc = Cc[c * 64 + p]; const float cr = cc.x * ap.x - cc.y * ap.y, ci = cc.x * ap.y + cc.y * ap.x;
#pragma unroll
            for (int j = 0; j < 8; ++j) { const f32x2 b = Bb[p * 16 + c0 + j]; v[j] += cr * b.x - ci * b.y; } }
        u32x4 o; o.x = cvt_pk_bf16(v[0], v[1]); o.y = cvt_pk_bf16(v[2], v[3]); o.z = cvt_pk_bf16(v[4], v[5]); o.w = cvt_pk_bf16(v[6], v[7]);
        *(GAS u32x4*)(Kt + (size_t)(t1 * 16 + c) * 16 + c0) = o; }
    __syncthreads();
}

__device__ __forceinline__ void attn_unit(const bf16_t* __restrict__ proj, bf16_t* __restrict__ attn, const float* sinks, int unit, LAS unsigned char* lds, int tid_) {
    const int tid = opaque(tid_);
    const int b = unit >> 7, hk = (unit >> 5) & 3, nb = unit & 31;
    const int wave = __builtin_amdgcn_readfirstlane(tid >> 6), lane = tid & 63, r16 = lane & 15, q4 = lane >> 4;
    LAS unsigned char* Kl = lds;
    LAS unsigned char* Vt = lds + 36864;
    const int gh0 = wave >> 1, half0 = wave & 1, qh0 = hk * 4 + gh0;
    bf16x8 qfa[4][2];
#pragma unroll
    for (int pass = 0; pass < 4; ++pass)
#pragma unroll
        for (int s = 0; s < 2; ++s) qfa[pass][s] = *(const GAS bf16x8*)(proj + (size_t)(b * SEQ + nb * 128 + 16 * (half0 * 4 + pass) + r16) * INW + O_Q + qh0 * 64 + 32 * s + 8 * q4);
#pragma unroll
    for (int i = 0; i < 4; ++i) { const int id = tid + 512 * i, key = id >> 3, ch = id & 7; const int tp = nb * 128 - 128 + key;
        u32x4 kv = {0u, 0u, 0u, 0u}, vv = {0u, 0u, 0u, 0u};
        if (tp >= 0) { const bf16_t* src = proj + (size_t)(b * SEQ + tp) * INW + hk * 64 + ch * 8; kv = *(const GAS u32x4*)(src + O_K); vv = *(const GAS u32x4*)(src + O_V); }
        *(LAS u32x4*)(Kl + key * 144 + ch * 16) = kv;
        LAS bf16_t* vd = (LAS bf16_t*)(Vt + (ch * 8) * 528 + key * 2);
        vd[0 * 264] = (bf16_t)(vv.x & 0xffff); vd[1 * 264] = (bf16_t)(vv.x >> 16); vd[2 * 264] = (bf16_t)(vv.y & 0xffff); vd[3 * 264] = (bf16_t)(vv.y >> 16);
        vd[4 * 264] = (bf16_t)(vv.z & 0xffff); vd[5 * 264] = (bf16_t)(vv.z >> 16); vd[6 * 264] = (bf16_t)(vv.w & 0xffff); vd[7 * 264] = (bf16_t)(vv.w >> 16); }
    __syncthreads();
    const int gh = wave >> 1, half = wave & 1, qh = hk * 4 + gh;
    const float sink = sinks[qh] * LOG2E;
#pragma unroll
    for (int pass = 0; pass < 4; ++pass) {
        const int kt0 = half * 4 + pass, i0 = 16 * kt0, iabs = i0 + r16; const size_t qtok = (size_t)(b * SEQ + nb * 128 + iabs);
        bf16x8 qf[2];
#pragma unroll
        for (int s = 0; s < 2; ++s) qf[s] = qfa[pass][s];
        __builtin_amdgcn_sched_barrier(0);
        f32x4 st[10];
        const LAS unsigned char* kbase = Kl + (16 * kt0 + r16) * 144 + (8 * q4) * 2;
#pragma unroll
        for (int i = 0; i < 9; ++i) { st[i] = (f32x4){0.f, 0.f, 0.f, 0.f};
#pragma unroll
            for (int s = 0; s < 2; ++s) { const bf16x8 kf = *(const LAS bf16x8*)(kbase + i * 16 * 144 + s * 64);
                st[i] = __builtin_amdgcn_mfma_f32_16x16x32_bf16(kf, qf[s], st[i], 0, 0, 0); } }
        st[9] = (f32x4){0.f, 0.f, 0.f, 0.f};
        float mx = sink;
#pragma unroll
        for (int i = 0; i < 9; ++i)
#pragma unroll
            for (int r = 0; r < 4; ++r) { const int jj = 16 * i + 4 * q4 + r; const bool ok = (jj > r16) && (jj <= r16 + 128) && (nb > 0 || jj + i0 >= 128);
                st[i][r] = ok ? st[i][r] : -1e30f; mx = fmaxf(mx, st[i][r]); }
        const int ll = lane_now();
        mx = fmaxf(mx, shx(mx, 16, ll)); mx = fmaxf(mx, shx(mx, 32, ll));
        float sum = 0.f;
#pragma unroll
        for (int i = 0; i < 9; ++i)
#pragma unroll
            for (int r = 0; r < 4; ++r) { const float p = __builtin_amdgcn_exp2f(st[i][r] - mx); st[i][r] = p; sum += p; }
        sum += shx(sum, 16, ll); sum += shx(sum, 32, ll);
        const float inv = __builtin_amdgcn_rcpf(sum + __builtin_amdgcn_exp2f(sink - mx));
        f32x4 ot[4];
#pragma unroll
        for (int dt = 0; dt < 4; ++dt) ot[dt] = (f32x4){0.f, 0.f, 0.f, 0.f};
#pragma unroll
        for (int kk = 0; kk < 5; ++kk) {
            u32x4 pw; pw.x = cvt_pk_bf16(st[2 * kk][0], st[2 * kk][1]); pw.y = cvt_pk_bf16(st[2 * kk][2], st[2 * kk][3]); pw.z = cvt_pk_bf16(st[2 * kk + 1][0], st[2 * kk + 1][1]); pw.w = cvt_pk_bf16(st[2 * kk + 1][2], st[2 * kk + 1][3]);
            const bf16x8 pf = __builtin_bit_cast(bf16x8, pw);
            const int t0 = kt0 + 2 * kk, t1 = (t0 + 1) < 15 ? (t0 + 1) : 15;
#pragma unroll
            for (int dt = 0; dt < 4; ++dt) { const LAS unsigned char* vp = Vt + (16 * dt + r16) * 528 + (4 * q4) * 2;
                const u32x2 lo = *(const LAS u32x2*)(vp + t0 * 32), hi = *(const LAS u32x2*)(vp + t1 * 32);
                const u32x4 vw = {lo.x, lo.y, hi.x, hi.y};
                ot[dt] = __builtin_amdgcn_mfma_f32_16x16x32_bf16(__builtin_bit_cast(bf16x8, vw), pf, ot[dt], 0, 0, 0); } }
#pragma unroll
        for (int dt = 0; dt < 4; ++dt) {
            if (AO_F8) *(GAS unsigned*)((unsigned char*)attn + qtok * 1024 + qh * 64 + 16 * dt + 4 * q4) = pg8::pk_fp8x4(ot[dt] * inv);
            else { u32x2 o; o.x = cvt_pk_bf16(ot[dt][0] * inv, ot[dt][1] * inv); o.y = cvt_pk_bf16(ot[dt][2] * inv, ot[dt][3] * inv);
                *(GAS u32x2*)(attn + qtok * 1024 + qh * 64 + 16 * dt + 4 * q4) = o; } }
    }
    __syncthreads();
}

constexpr int UPITCH = 2064;
__device__ __forceinline__ void stage_u_issue(const bf16_t* __restrict__ proj, int g, int b, int q, int tid, u32x4 (&uu)[4]) {
#pragma unroll
    for (int i = 0; i < 4; ++i) { const int id = tid + 512 * i, tl = id >> 1, half = id & 1, chunk = tl >> 6, s = tl & 63;
        uu[i] = *(const GAS u32x4*)(proj + (size_t)(b * SEQ + (16 * q + chunk) * 64 + s) * INW + O_U + g * 16 + 8 * half); }
}
__device__ __forceinline__ void stage_u_commit(LAS unsigned char* Al, int tid, u32x4 (&uu)[4]) {
    asm volatile("" : "+v"(uu[0]), "+v"(uu[1]), "+v"(uu[2]), "+v"(uu[3]) :: "memory");
#pragma unroll
    for (int i = 0; i < 4; ++i) { const int id = tid + 512 * i, tl = id >> 1, half = id & 1, chunk = tl >> 6, s = tl & 63;
        *(LAS u32x4*)(Al + chunk * UPITCH + (s * 16 + 8 * half) * 2) = uu[i]; }
}
__device__ __forceinline__ void ssm_s1_unit(const bf16_t* __restrict__ proj, const bf16_t* __restrict__ Et, float* __restrict__ sloc, int g, int b, int q, LAS unsigned char* lds, int tid_) {
    const int tid = opaque(tid_);
    const int wave = __builtin_amdgcn_readfirstlane(tid >> 6), lane = tid & 63, r16 = lane & 15, q4 = lane >> 4;
    const bf16_t* eb = Et + (size_t)(16 * wave + r16) * 1024 + 8 * q4;
    u32x4 uu[4]; stage_u_issue(proj, g, b, q, tid, uu);
    bf16x8 bf[32];
#pragma unroll
    for (int ks = 0; ks < 32; ++ks) bf[ks] = *(const GAS bf16x8*)(eb + 32 * ks);
    stage_u_commit(lds, tid, uu);
    __syncthreads();
    f32x4 acc = {0.f, 0.f, 0.f, 0.f};
#pragma unroll
    for (int ks = 0; ks < 32; ++ks) { const bf16x8 af = *(const LAS bf16x8*)(lds + r16 * UPITCH + (32 * ks + 8 * q4) * 2);
        acc = __builtin_amdgcn_mfma_f32_16x16x32_bf16(af, bf[ks], acc, 0, 0, 0); }
#pragma unroll
    for (int r = 0; r < 4; ++r) sloc[((size_t)(b * 64 + 16 * q + 4 * q4 + r) * 32 + g) * 128 + 16 * wave + r16] = acc[r];
    __syncthreads();
}

__device__ __forceinline__ void ssm_s2_unit(const bf16_t* __restrict__ proj, const unsigned char* __restrict__ tb, const float* __restrict__ sloc, const float* __restrict__ dskip, bf16_t* __restrict__ ybuf,
                                            int g, int b, int q, LAS unsigned char* lds, int tid_, int nostore = 0) {
    const int tid = opaque(tid_);
    const int wave = __builtin_amdgcn_readfirstlane(tid >> 6), lane = tid & 63, r16 = lane & 15, q4 = lane >> 4;
    LAS unsigned char* Ktl = lds;
    LAS bf16_t* x0l = (LAS bf16_t*)(lds + 33280);
    LAS unsigned char* Al = lds + 49152;
    const bf16_t* Ft = (const bf16_t*)(tb + SSM_F); const GAS f32x2* Pt = (const GAS f32x2*)(tb + SSM_P);
    const int p = tid & 63, part = tid >> 6, j0 = 16 * q;
    f32x2 Pp[6]; float srp[6], sip[6];
#pragma unroll
    for (int ii = 0; ii < 6; ++ii) { const int i = part + 8 * ii; const bool ok = i < j0; const int ic = ok ? i : 0, pc = ok ? (j0 - 1 - i) : 0;
        Pp[ii] = Pt[pc * 64 + p]; const GAS float* sp = (const GAS float*)(sloc + ((size_t)(b * 64 + ic) * 32 + g) * 128); srp[ii] = sp[p]; sip[ii] = sp[64 + p]; }
    u32x4 kt[5];
    { const GAS u32x4* src = (const GAS u32x4*)(tb + SSM_KT);
#pragma unroll
      for (int j = 0; j < 5; ++j) { const int i = tid + 512 * j; kt[j] = src[i < 33280 / 16 ? i : 33280 / 16 - 1]; } }
    u32x4 uu[4]; stage_u_issue(proj, g, b, q, tid, uu);
    const f32x2 A64 = Pt[64 + p];
    float sr[15], si[15];
#pragma unroll
    for (int jq = 0; jq < 15; ++jq) { const GAS float* sp = (const GAS float*)(sloc + ((size_t)(b * 64 + j0 + jq) * 32 + g) * 128); sr[jq] = sp[p]; si[jq] = sp[64 + p]; }
    bf16x8 ff[4][8];
#pragma unroll
    for (int k2 = 0; k2 < 4; ++k2)
#pragma unroll
        for (int tt = 0; tt < 8; ++tt) ff[k2][tt] = *(const GAS bf16x8*)(Ft + (size_t)((wave + 8 * tt) * 16 + r16) * 128 + 32 * k2 + 8 * q4);
    {
        LAS f32x2* red = (LAS f32x2*)(lds + 40960);
        asm volatile("" : "+v"(Pp[0]), "+v"(Pp[1]), "+v"(Pp[2]), "+v"(Pp[3]), "+v"(Pp[4]), "+v"(Pp[5]) :: "memory");
        asm volatile("" : "+v"(srp[0]), "+v"(srp[1]), "+v"(srp[2]), "+v"(srp[3]), "+v"(srp[4]), "+v"(srp[5]), "+v"(sip[0]), "+v"(sip[1]), "+v"(sip[2]), "+v"(sip[3]), "+v"(sip[4]), "+v"(sip[5]) :: "memory");
        float xr = 0.f, xi = 0.f;
#pragma unroll
        for (int ii = 0; ii < 6; ++ii) { const bool ok = part + 8 * ii < j0; const float pr = ok ? Pp[ii].x : 0.f, pi = ok ? Pp[ii].y : 0.f;
            xr += pr * srp[ii] - pi * sip[ii]; xi += pr * sip[ii] + pi * srp[ii]; }
        red[part * 64 + p] = (f32x2){xr, xi};
        asm volatile("" : "+v"(kt[0]), "+v"(kt[1]), "+v"(kt[2]), "+v"(kt[3]), "+v"(kt[4]) :: "memory");
#pragma unroll
        for (int j = 0; j < 5; ++j) { const int i = tid + 512 * j; if (i < 33280 / 16) *(LAS u32x4*)(Ktl + i * 16) = kt[j]; }
        stage_u_commit(Al, tid, uu);
        __syncthreads();
        if (part == 0) {
            float ar = 0.f, ai = 0.f;
#pragma unroll
            for (int w8 = 0; w8 < 8; ++w8) { const f32x2 t = red[w8 * 64 + p]; ar += t.x; ai += t.y; }
#pragma unroll
            for (int jq = 0; jq < 16; ++jq) {
                x0l[jq * 136 + p] = (bf16_t)(cvt_pk_bf16(ar, 0.f) & 0xffff); x0l[jq * 136 + 64 + p] = (bf16_t)(cvt_pk_bf16(ai, 0.f) & 0xffff);
                if (jq < 15) { const float nr = A64.x * ar - A64.y * ai + sr[jq], ni = A64.x * ai + A64.y * ar + si[jq]; ar = nr; ai = ni; } }
        }
    }
    __syncthreads();
    f32x4 acc[8];
#pragma unroll
    for (int tt = 0; tt < 8; ++tt) acc[tt] = (f32x4){0.f, 0.f, 0.f, 0.f};
#pragma unroll 2
    for (int ks = 0; ks < 32; ++ks) { const int s = 2 * ks + (q4 >> 1);
        const bf16x8 af = *(const LAS bf16x8*)(Al + r16 * UPITCH + (32 * ks + 8 * q4) * 2);
#pragma unroll
        for (int tt = 0; tt < 8; ++tt) { const int t = wave + 8 * tt;
            const int tau1 = t - s + 1, tc = tau1 > 0 ? tau1 : 0;
            const bf16x8 bf = *(const LAS bf16x8*)(Ktl + ((tc * 16 + r16) * 16 + 8 * (q4 & 1)) * 2);
            acc[tt] = __builtin_amdgcn_mfma_f32_16x16x32_bf16(af, bf, acc[tt], 0, 0, 0); }
        __builtin_amdgcn_sched_barrier(0); }
#pragma unroll
    for (int k2 = 0; k2 < 4; ++k2) { const bf16x8 ax = *(const LAS bf16x8*)(x0l + r16 * 136 + 32 * k2 + 8 * q4);
#pragma unroll
        for (int tt = 0; tt < 8; ++tt) acc[tt] = __builtin_amdgcn_mfma_f32_16x16x32_bf16(ax, ff[k2][tt], acc[tt], 0, 0, 0); }
    const float dsk = dskip[g * 16 + r16];
#pragma unroll
    for (int tt = 0; tt < 8; ++tt) { const int t = wave + 8 * tt;
#pragma unroll
        for (int r = 0; r < 4; ++r) { const int jq = 4 * q4 + r; const size_t tok = (size_t)(b * SEQ + (16 * q + jq) * 64 + t);
            const float uv = bf1(*(const LAS bf16_t*)(Al + jq * UPITCH + (t * 16 + r16) * 2)); const float y = acc[tt][r] + dsk * uv;
            const float z = 0.7978845608028654f * (y + 0.044715f * y * y * y); const float gl = y * fast_sigmoid(2.0f * z);
            if (!nostore) { if (GLU_F8) ((unsigned char*)ybuf)[tok * 512 + g * 16 + r16] = (unsigned char)(__builtin_amdgcn_cvt_pk_fp8_f32(gl, 0.f, 0, false) & 0xff);
                            else ybuf[tok * 512 + g * 16 + r16] = (bf16_t)(cvt_pk_bf16(gl, 0.f) & 0xffff); } } }
    __syncthreads();
}

__device__ __forceinline__ unsigned char* opaque_p(unsigned char* p) { asm volatile("" : "+s"(p)); return p; }
__device__ __forceinline__ int opaque_si(int v) { asm volatile("" : "+s"(v)); return v; }
__device__ __forceinline__ Args load_args() {
#if defined(__HIP_DEVICE_COMPILE__)
    KArgs* p = (KArgs*)__builtin_amdgcn_kernarg_segment_ptr(); asm volatile("" : "+s"(p)); Args a;
#pragma unroll
    for (int i = 0; i < 29; ++i) a.in[i] = p->in[i];
    a.out = p->out; a.ws = p->ws; a.ph_lo = p->ph_lo; a.ph_hi = p->ph_hi; return a;
#else
    return Args{};
#endif
}
#define PH_BEGIN const unsigned long long ph_t0 = (TIME_MASK) ? __builtin_amdgcn_s_memtime() : 0ull; (void)ph_t0; const Args args = load_args(); const int G = opaque_si(G_k), blk = opaque_si(blk_k); const int wave = opaque_si(wave_k); const int tid = opaque(lane_now() + 64 * wave), lane = tid & 63; unsigned char* const ws = opaque_p(args.ws); (void)lane; (void)wave; \
    bf16_t* const hbuf = (bf16_t*)(ws + WS_H); bf16_t* const proj = (bf16_t*)(ws + WS_PROJ); float* const mod = (float*)(ws + WS_MOD); float* const xbuf = args.out; unsigned* const ctl = (unsigned*)(ws + WS_CTL); \
    (void)hbuf; (void)proj; (void)mod; (void)xbuf; (void)ctl;

__global__ void __launch_bounds__(NWAVES * 64, 2) mega_fwd(Args args) {
    extern __shared__ __attribute__((aligned(16))) unsigned char lds_raw[];
    LAS unsigned char* lds = (LAS unsigned char*)lds_raw;
    const int wave_k = __builtin_amdgcn_readfirstlane((int)threadIdx.x >> 6);
    const int G_k = gridDim.x, blk_k = blockIdx.x;
    XcdBarrier bar;
    {
        volatile LAS unsigned* MISC = (volatile LAS unsigned*)(lds + MISC_OFF);
        unsigned* ctl0 = (unsigned*)(args.ws + WS_CTL);
        for (int u = threadIdx.x; u < (LDS_BYTES - LDSCTL_OFF) / 4; u += NWAVES * 64) ((LAS unsigned*)(lds + LDSCTL_OFF))[u] = 0u;
        __syncthreads();
        bar.bar = ctl0 + CW_BAR; bar.x = 0; bar.st = nullptr; bar.wv = wave_k;
        if (N_LAUNCHES == 1) bar = xcd_barrier_post(ctl0 + CW_BAR, MISC + 8);
    }
#define GRID_BAR() do { if (N_LAUNCHES == 1) xcd_barrier(bar); } while (0)
    const int lo = args.ph_lo, hi = args.ph_hi;
#ifndef PH_MASK
#define PH_MASK 0x7ff
#endif
#ifndef REP_MASK
#define REP_MASK 0
#endif
#ifndef REP_VARIANT
#define REP_VARIANT 0
#endif
#define REPS(bit) (((REP_MASK) >> (bit)) & 1 ? 2 : 1)
#ifndef TIME_MASK
#define TIME_MASK 0
#endif
#define PH_END(bit) if ((TIME_MASK >> (bit)) & 1) { asm volatile("s_waitcnt vmcnt(0) lgkmcnt(0)" ::: "memory"); const unsigned long long t1_ = __builtin_amdgcn_s_memtime(); \
    while (__builtin_amdgcn_s_memtime() - t1_ < t1_ - ph_t0) __builtin_amdgcn_s_sleep(8); }
#define IN(k) (lo <= (k) && (k) < hi)
#define BOTH(k) (IN(k) && IN((k) + 1))

    if ((PH_MASK & 1) && IN(0)) {
        PH_BEGIN
            _Pragma("unroll 1") for (int rep = 0; rep < REPS(9); ++rep) {
        if (blk < 64) ssm_tables(args, blk >> 5, blk & 31, lds, tid);
        LAS float* scr = (LAS float*)(lds + wave * 16384);
        for (int idx = blk * 512 + tid; idx < 2 * 64 * 256; idx += G * 512) {
            const int e = idx & 63, kc = (idx >> 6) & 255, l = idx >> 14; const float* wsrc = args.in[I_WR] + (size_t)l * D * NE + (size_t)(8 * kc) * NE + e;
            float w[8], lo[8]; unsigned hi[4];
#pragma unroll
            for (int i = 0; i < 8; ++i) w[i] = wsrc[i * NE];
#pragma unroll
            for (int i = 0; i < 4; ++i) { hi[i] = cvt_pk_bf16(w[2 * i], w[2 * i + 1]); lo[2 * i] = w[2 * i] - bf_lo(hi[i]); lo[2 * i + 1] = w[2 * i + 1] - bf_hi(hi[i]); }
            bf16_t* dsth = (bf16_t*)(ws + WS_WRT) + ((size_t)(l * 2) * 64 + e) * 2048 + 8 * kc;
            *(GAS u32x4*)dsth = (u32x4){hi[0], hi[1], hi[2], hi[3]};
            *(GAS u32x4*)(dsth + 64 * 2048) = (u32x4){cvt_pk_bf16(lo[0], lo[1]), cvt_pk_bf16(lo[2], lo[3]), cvt_pk_bf16(lo[4], lo[5]), cvt_pk_bf16(lo[6], lo[7])}; }
        for (int it = blk; it < IT_MOD; it += G) mod_item(args, it, tid, lds);
        p0_items(args, blk * NWAVES + wave, G * NWAVES, scr, lane);
            if (rep + 1 < REPS(9)) GRID_BAR(); }
        PH_END(9) if (BOTH(0)) GRID_BAR();
    }
    if ((PH_MASK & 2) && IN(1)) {
        PH_BEGIN
        const float* modp = (const float*)(ws + WS_MODP);
        for (int idx = blk * 512 + tid; idx < 2 * 2 * 12288; idx += G * 512) { const int l = idx / 24576, c = idx % 12288; float s = args.in[I_BADA][l * 12288 + c];
#pragma unroll
            for (int ks = 0; ks < 8; ++ks) s += modp[(size_t)ks * 49152 + idx];
            mod[idx] = s; }
        for (int rb = blk; rb < T / 32; rb += G) {
            const int bb = (rb * 32) / SEQ;
            LAS float* shl = (LAS float*)lds; LAS float* scl = shl + 2048;
            for (int c = tid; c < 4096; c += 512) { float s = args.in[I_BADA][c];
#pragma unroll
                for (int ks = 0; ks < 8; ++ks) s += modp[(size_t)ks * 49152 + bb * 12288 + c];
                shl[c] = s; }
            __syncthreads();
#pragma unroll 1
            for (int pr = 0; pr < 2; ++pr) {
                f32x4 v[2][4][2]; float ss[2] = {0.f, 0.f};
#pragma unroll
                for (int rr = 0; rr < 2; ++rr) { const float* xr = args.in[I_X] + (size_t)(rb * 32 + wave * 4 + pr * 2 + rr) * D;
#pragma unroll
                    for (int j = 0; j < 4; ++j)
#pragma unroll
                        for (int h = 0; h < 2; ++h) v[rr][j][h] = *(const GAS f32x4*)(xr + 8 * (lane + 64 * j) + 4 * h); }
#pragma unroll
                for (int rr = 0; rr < 2; ++rr)
#pragma unroll
                    for (int j = 0; j < 4; ++j)
#pragma unroll
                        for (int h = 0; h < 2; ++h) ss[rr] += v[rr][j][h][0] * v[rr][j][h][0] + v[rr][j][h][1] * v[rr][j][h][1] + v[rr][j][h][2] * v[rr][j][h][2] + v[rr][j][h][3] * v[rr][j][h][3];
#pragma unroll
                for (int rr = 0; rr < 2; ++rr) { const int row = rb * 32 + wave * 4 + pr * 2 + rr;
                    const float rstd = 1.0f / sqrtf(wave_sum(ss[rr]) * (1.0f / D) + NORM_EPS);
                    bf16_t* hrow = hbuf + (size_t)row * D;
#pragma unroll
                    for (int j = 0; j < 4; ++j) { const int c = 8 * (lane + 64 * j); f32x4 o[2];
#pragma unroll
                        for (int h = 0; h < 2; ++h) { const f32x4 g = *(const GAS f32x4*)(args.in[I_NMIX] + c + 4 * h); const f32x4 s1 = *(const LAS f32x4*)(scl + c + 4 * h), s0 = *(const LAS f32x4*)(shl + c + 4 * h);
                            o[h] = v[rr][j][h] * rstd * g * (s1 + 1.0f) + s0; }
                        if (INP_F8) *(GAS u32x2*)((unsigned char*)hbuf + (size_t)row * D + c) = (u32x2){pg8::pk_fp8x4(o[0]), pg8::pk_fp8x4(o[1])};
                        else *(GAS u32x4*)(hrow + c) = pg8::pack8(o[0], o[1]); } } }
            __syncthreads();
        }
        PH_END(10) if (BOTH(1)) GRID_BAR();
    }

#pragma unroll 1
    for (int l = 0; l < DEPTH; ++l) {
        const int pb = 2 + 9 * l;
        if ((PH_MASK & 4) && IN(pb + 0)) {
            PH_BEGIN
            _Pragma("unroll 1") for (int rep = 0; rep < REPS(0); ++rep) {
            pg8::DenseOrder S; S.init(T, INW, INP_F8 ? D / 2 : D, G, blk, ws + WS_WIN + (size_t)l * INW * D * (INP_F8 ? 1 : 2));
            pg8::EpiInProj E{proj, args.in[I_BIN] + l * INW, 0.125f * LOG2E, (REP_VARIANT && rep == 1) ? 1 : 0};
            pg8::gemm_phase<pg8::EpiInProj, pg8::DenseOrder, GEMM_ALIGN, GEMM_SP2, INP_F8 != 0>(lds, (const char*)hbuf, INP_F8 ? D / 2 : D, S, E, wave);
            if (rep + 1 < REPS(0)) GRID_BAR(); }
            PH_END(0) if (BOTH(pb + 0)) GRID_BAR();
        }
        if ((PH_MASK & 8) && IN(pb + 1)) {
            PH_BEGIN
            _Pragma("unroll 1") for (int rep = 0; rep < REPS(1); ++rep) {
            for (int u = blk; u < 256; u += G) attn_unit(proj, (bf16_t*)(ws + WS_ATTN), args.in[I_SINK] + l * 16, u, lds, tid);
            if (!(REP_VARIANT == 1 && rep == 1)) for (int u = blk; u < 256; u += G) { const int g = u >> 3, b = (u >> 2) & 1, q = u & 3;
                ssm_s1_unit(proj, (const bf16_t*)(ws + WS_SSM + (size_t)(l * 32 + g) * SSM_STRIDE + SSM_E), (float*)(ws + WS_SLOC), g, b, q, lds, tid); }
            if (rep + 1 < REPS(1)) GRID_BAR(); }
            PH_END(1) if (BOTH(pb + 1)) GRID_BAR();
        }
        if ((PH_MASK & 16) && IN(pb + 2)) {
            PH_BEGIN
            _Pragma("unroll 1") for (int rep = 0; rep < REPS(2); ++rep) {
            if (!(REP_VARIANT == 1 && rep == 1)) for (int u = blk; u < 256; u += G) { const int g = u >> 3, b = (u >> 2) & 1, q = u & 3;
                ssm_s2_unit(proj, ws + WS_SSM + (size_t)(l * 32 + g) * SSM_STRIDE, (const float*)(ws + WS_SLOC), args.in[I_SD] + l * 512, (bf16_t*)(ws + WS_Y), g, b, q, lds, tid, (REP_VARIANT == 2 && rep == 1) ? 1 : 0); }
            pg8::DenseOrder S; S.init(T, D, AO_F8 ? 512 : 1024, G, blk, ws + WS_WO + (size_t)l * D * 1024 * (AO_F8 ? 1 : 2));
            pg8::EpiAttnProj E{proj, (bf16_t*)(ws + WS_MIXED)};
            pg8::gemm_phase<pg8::EpiAttnProj, pg8::DenseOrder, false, GEMM_SP2, AO_F8 != 0>(lds, (const char*)(ws + WS_ATTN), AO_F8 ? 512 : 1024, S, E, wave);
            if (rep + 1 < REPS(2)) GRID_BAR(); }
            PH_END(2) if (BOTH(pb + 2)) GRID_BAR();
        }
        if ((PH_MASK & 32) && IN(pb + 3)) {
            PH_BEGIN
            const int nrep = REPS(3);
            _Pragma("unroll 1") for (int rep = 0; rep < nrep; ++rep) {
            pg8::DenseOrder S; S.init(T, 4096, GLU_F8 ? 256 : 512, G, blk, ws + WS_WGLU + (size_t)l * 4096 * 512 * (GLU_F8 ? 1 : 2));
            pg8::EpiGlu E{proj, (const bf16_t*)(ws + WS_MIXED), (bf16_t*)(ws + WS_MIXED2)};
            pg8::gemm_phase<pg8::EpiGlu, pg8::DenseOrder, GEMM_ALIGN, GEMM_SP2, GLU_F8 != 0>(lds, (const char*)(ws + WS_Y), GLU_F8 ? 256 : 512, S, E, wave);
            if (rep + 1 < nrep) GRID_BAR(); }
            PH_END(3) if (BOTH(pb + 3)) GRID_BAR();
        }
        if ((PH_MASK & 64) && IN(pb + 4)) {
            PH_BEGIN
            const int nrep = (l == 0 ? REPS(4) : 1);
            _Pragma("unroll 1") for (int rep = 0; rep < nrep; ++rep) {
            pg8::DenseOrder S; S.init(T, D, MIX_F8 ? D / 2 : D, G, blk, ws + WS_WMIX + (size_t)l * D * D * (MIX_F8 ? 1 : 2));
            pg8::EpiMixOut E{l == 0 ? args.in[I_X] : (const float*)nullptr, (const bf16_t*)(ws + WS_XB), (bf16_t*)(ws + WS_XB), mod + (size_t)l * 2 * 12288 + 2 * 2048};
            pg8::gemm_phase<pg8::EpiMixOut, pg8::DenseOrder, false, GEMM_SP2, MIX_F8 != 0>(lds, (const char*)(ws + WS_MIXED2), MIX_F8 ? D / 2 : D, S, E, wave);
            if (rep + 1 < nrep) GRID_BAR(); }
            PH_END(4) if (BOTH(pb + 4)) GRID_BAR();
        }
        if ((PH_MASK & 128) && IN(pb + 5)) {
            PH_BEGIN
            const int nrep = REPS(5);
            _Pragma("unroll 1") for (int rep = 0; rep < nrep; ++rep) {
            const float* modl = mod + (size_t)l * 2 * 12288;
            int* ltok = (int*)(ws + WS_LTOK); int* ldst = (int*)(ws + WS_LDST); float* lw = (float*)(ws + WS_LW);
            LAS unsigned long long* selmask = (LAS unsigned long long*)(lds + SEL_OFF);
            LAS float* selw = (LAS float*)(lds + SEL_OFF + 256);
            const float* wrt = args.in[I_WR] + (size_t)l * D * NE; const float brt = args.in[I_BR][l * NE + lane];
            for (int rb = blk; rb < T / 32; rb += G) {
                const int bb = (rb * 32) / SEQ; const float* sh2 = modl + bb * 12288 + 3 * 2048; const float* sc2 = sh2 + 2048;
#pragma unroll 1
                for (int it = 0; it < 2; ++it) {
                    {
                        f32x4 v[2][4][2]; float ss[2] = {0.f, 0.f};
                        u32x4 xw[2][4]; f32x4 gsc[4][2], gsh[4][2], sc1[4][2];
#pragma unroll
                        for (int rr = 0; rr < 2; ++rr) { const bf16_t* xr = (const bf16_t*)(ws + WS_XB) + (size_t)(rb * 32 + it * 16 + 2 * wave + rr) * D;
#pragma unroll
                            for (int j = 0; j < 4; ++j) xw[rr][j] = *(const GAS u32x4*)(xr + 8 * (lane + 64 * j)); }
#pragma unroll
                        for (int j = 0; j < 4; ++j)
#pragma unroll
                            for (int h = 0; h < 2; ++h) { const int c = 8 * (lane + 64 * j) + 4 * h;
                                gsc[j][h] = *(const GAS f32x4*)(args.in[I_NFFN] + l * D + c); sc1[j][h] = *(const GAS f32x4*)(sc2 + c); gsh[j][h] = *(const GAS f32x4*)(sh2 + c); }
#pragma unroll
                        for (int rr = 0; rr < 2; ++rr) asm volatile("" : "+v"(xw[rr][0]), "+v"(xw[rr][1]), "+v"(xw[rr][2]), "+v"(xw[rr][3]) :: "memory");
#pragma unroll
                        for (int j = 0; j < 4; ++j) asm volatile("" : "+v"(gsc[j][0]), "+v"(gsc[j][1]), "+v"(sc1[j][0]), "+v"(sc1[j][1]), "+v"(gsh[j][0]), "+v"(gsh[j][1]) :: "memory");
#pragma unroll
                        for (int rr = 0; rr < 2; ++rr)
#pragma unroll
                            for (int j = 0; j < 4; ++j) pg8::unpack8(xw[rr][j], v[rr][j][0], v[rr][j][1]);
#pragma unroll
                        for (int j = 0; j < 4; ++j)
#pragma unroll
                            for (int h = 0; h < 2; ++h) gsc[j][h] = gsc[j][h] * (sc1[j][h] + 1.0f);
#pragma unroll
                        for (int rr = 0; rr < 2; ++rr)
#pragma unroll
                            for (int j = 0; j < 4; ++j)
#pragma unroll
                                for (int h = 0; h < 2; ++h) ss[rr] += v[rr][j][h][0] * v[rr][j][h][0] + v[rr][j][h][1] * v[rr][j][h][1] + v[rr][j][h][2] * v[rr][j][h][2] + v[rr][j][h][3] * v[rr][j][h][3];
#pragma unroll
                        for (int rr = 0; rr < 2; ++rr) { const int lr = 2 * wave + rr, row = rb * 32 + it * 16 + lr;
                            const float rstd = 1.0f / sqrtf(wave_sum(ss[rr]) * (1.0f / D) + NORM_EPS);
                            unsigned char* hrow8 = (unsigned char*)hbuf + (size_t)row * D;
#pragma unroll
                            for (int j = 0; j < 4; ++j) { const int c = 8 * (lane + 64 * j); f32x4 o[2];
#pragma unroll
                                for (int h = 0; h < 2; ++h) o[h] = v[rr][j][h] * rstd * gsc[j][h] + gsh[j][h];
                                const u32x4 hiw = pg8::pack8(o[0], o[1]); *(GAS u32x2*)(hrow8 + c) = (u32x2){pg8::pk_fp8x4(o[0]), pg8::pk_fp8x4(o[1])};
                                f32x4 h0, h1; pg8::unpack8(hiw, h0, h1); const u32x4 low = pg8::pack8(o[0] - h0, o[1] - h1);
                                const int so = lr * 4096 + (((lane + 64 * j) ^ lr) << 4);
                                *(LAS u32x4*)(lds + so) = hiw; *(LAS u32x4*)(lds + 65536 + so) = low; } }
                    }
                    f32x4 racc[4];
                    {
                        const GAS bf16_t* whi = (const GAS bf16_t*)(ws + WS_WRT) + (size_t)(l * 2) * 64 * 2048 + 256 * wave; const GAS bf16_t* wlo = whi + 64 * 2048;
                        const int lop = opaque(lane), r16 = lop & 15, q4 = lop >> 4;
#pragma unroll
                        for (int nt = 0; nt < 4; ++nt) racc[nt] = (f32x4){0.f, 0.f, 0.f, 0.f};
                        auto ldB = [&](int kp, bf16x8 (&bh)[2][4], bf16x8 (&bl)[2][4]) {
#pragma unroll
                            for (int k2 = 0; k2 < 2; ++k2)
#pragma unroll
                                for (int nt = 0; nt < 4; ++nt) { const size_t wo = (size_t)(16 * nt + r16) * 2048 + 32 * (2 * kp + k2) + 8 * q4; bh[k2][nt] = *(const GAS bf16x8*)(whi + wo); bl[k2][nt] = *(const GAS bf16x8*)(wlo + wo); } };
                        auto mm = [&](int kp, const bf16x8 (&bh)[2][4], const bf16x8 (&bl)[2][4]) {
#pragma unroll
                            for (int k2 = 0; k2 < 2; ++k2) { const int chunk = 32 * wave + 4 * (2 * kp + k2) + q4, so = r16 * 4096 + ((chunk ^ r16) << 4);
                                const bf16x8 ah = *(const LAS bf16x8*)(lds + so), al = *(const LAS bf16x8*)(lds + 65536 + so);
#pragma unroll
                                for (int nt = 0; nt < 4; ++nt) {
                                    racc[nt] = __builtin_amdgcn_mfma_f32_16x16x32_bf16(ah, bh[k2][nt], racc[nt], 0, 0, 0);
                                    racc[nt] = __builtin_amdgcn_mfma_f32_16x16x32_bf16(al, bh[k2][nt], racc[nt], 0, 0, 0);
                                    racc[nt] = __builtin_amdgcn_mfma_f32_16x16x32_bf16(ah, bl[k2][nt], racc[nt], 0, 0, 0); } } };
#define RT_FENCE() asm volatile("" ::: "memory")
#define RT_PIN() asm volatile("" : "+v"(racc[0]), "+v"(racc[1]), "+v"(racc[2]), "+v"(racc[3]) :: "memory")
                        bf16x8 bhA[2][4], blA[2][4], bhB[2][4], blB[2][4];
                        RT_FENCE(); ldB(0, bhA, blA); ldB(1, bhB, blB); RT_FENCE();
                        __syncthreads();
                        mm(0, bhA, blA); RT_PIN(); ldB(2, bhA, blA); RT_FENCE();
                        mm(1, bhB, blB); RT_PIN(); ldB(3, bhB, blB); RT_FENCE();
                        mm(2, bhA, blA); mm(3, bhB, blB);
#undef RT_FENCE
#undef RT_PIN
                    }
                    __syncthreads();
                    LAS float* part = (LAS float*)lds;
#pragma unroll
                    for (int nt = 0; nt < 4; ++nt)
#pragma unroll
                        for (int r = 0; r < 4; ++r) part[(wave * 16 + 4 * (lane >> 4) + r) * 64 + 16 * nt + (lane & 15)] = racc[nt][r];
                    __syncthreads();
#pragma unroll 1
                    for (int rr = 0; rr < 2; ++rr) { const int lr = 2 * wave + rr; float logit = 0.f;
#pragma unroll
                        for (int w8 = 0; w8 < 8; ++w8) logit += part[(w8 * 16 + lr) * 64 + lane];
                        const float score = 1.0f / (1.0f + __expf(-logit)); const float sel = score + brt;
                        const int ll = lane_now(); float m1 = sel; m1 = fmaxf(m1, shx(m1, 1, ll)); m1 = fmaxf(m1, shx(m1, 2, ll)); m1 = fmaxf(m1, shx(m1, 4, ll));
                        const unsigned long long bm = __ballot(sel == m1); const unsigned gb = (unsigned)(bm >> (lane & 56)) & 0xffu; const int first = __builtin_ctz(gb);
                        float v2 = ((lane & 7) == first) ? -3.0e38f : sel; v2 = fmaxf(v2, shx(v2, 1, ll)); v2 = fmaxf(v2, shx(v2, 2, ll)); v2 = fmaxf(v2, shx(v2, 4, ll));
                        const float gs = m1 + v2; int grank = 0; const int mygrp = lane >> 3;
#pragma unroll
                        for (int gg = 0; gg < 8; ++gg) { const float o = shl_from(gs, gg * 8); grank += (o > gs || (o == gs && gg < mygrp)) ? 1 : 0; }
                        float val = grank < 4 ? sel : -3.0e38f; unsigned long long cm = 0ull;
#pragma unroll
                        for (int pick = 0; pick < 8; ++pick) {
                            float mxv = val;
#pragma unroll
                            for (int o = 1; o < 64; o <<= 1) mxv = fmaxf(mxv, shx(mxv, o, ll));
                            const unsigned long long bmx = __ballot(val == mxv); const int sl = __builtin_ctzll(bmx);
                            cm |= 1ull << sl; if (lane == sl) val = -3.4e38f; }
                        const bool chosen = (cm >> lane) & 1ull; const float sw = wave_sum(chosen ? score : 0.f);
                        const int gr = it * 16 + lr;
                        selw[gr * 64 + lane] = chosen ? score / sw * 2.5f : 0.f;
                        if (lane == 0) selmask[gr] = cm; }
                    __syncthreads();
                }
                if (wave == 0 && rep + 1 == nrep) {
                    int cntl = 0;
                    for (int r = 0; r < 32; ++r) cntl += (int)((selmask[r] >> lane) & 1ull);
                    int pos = cntl ? (int)atomicAdd(ctl + CW_CNT + l * 64 + opaque(lane), (unsigned)cntl) : 0;
                    for (int r = 0; r < 32; ++r) { const unsigned long long m = selmask[r];
                        if ((m >> lane) & 1ull) { const int k = __builtin_popcountll(m & ((1ull << lane) - 1ull)); const int tok = rb * 32 + r; const int li = lane * 8192 + pos;
                            ltok[li] = tok; ldst[li] = tok * NSLOT + k; ((float*)(ws + WS_TOKW))[tok * 8 + k] = selw[r * 64 + lane]; ++pos; } }
                }
                __syncthreads();
            }
            if (rep + 1 < nrep) GRID_BAR(); }
            PH_END(5) if (BOTH(pb + 5)) GRID_BAR();
        }
        if ((PH_MASK & 256) && IN(pb + 6)) {
            PH_BEGIN
            _Pragma("unroll 1") for (int rep = 0; rep < REPS(6); ++rep) {
            LAS int* tpre = (LAS int*)(lds + MOE_OFF); LAS int* ebase = tpre + 65; LAS int* ecnt = ebase + 65; LAS int* utab = (LAS int*)(lds + MOE_OFF + 1024);
            pg8::moe_build<4, true>(tpre, ebase, ecnt, utab, ctl + CW_CNT + l * 64, G, blk, tid);
            pg8::MoeOrder<4, true> S{utab, (const char*)(ws + WS_WGU + (size_t)l * 65 * 1024 * 2048), (size_t)1024 * 2048, (size_t)256 * 2048, (const int*)(ws + WS_LTOK)};
            pg8::EpiGateUp E{(unsigned char*)(ws + WS_HID)};
            pg8::gemm_phase<pg8::EpiGateUp, pg8::MoeOrder<4, true>, GEMM_ALIGN, GEMM_SP2, true>(lds, (const char*)hbuf, D / 2, S, E, wave);
            if (rep + 1 < REPS(6)) GRID_BAR(); }
            PH_END(6) if (BOTH(pb + 6)) GRID_BAR();
        }
        if ((PH_MASK & 512) && IN(pb + 7)) {
            PH_BEGIN
            _Pragma("unroll 1") for (int rep = 0; rep < REPS(7); ++rep) {
            LAS int* tpre = (LAS int*)(lds + MOE_OFF); LAS int* ebase = tpre + 65; LAS int* ecnt = ebase + 65; LAS int* utab = (LAS int*)(lds + MOE_OFF + 1024);
            pg8::moe_build<8, false>(tpre, ebase, ecnt, utab, ctl + CW_CNT + l * 64, G, blk, tid);
            constexpr size_t DB = DOWN_F8 ? 1 : 2;
            pg8::MoeOrder<8, false> S{utab, (const char*)(ws + WS_WD + (size_t)l * 65 * 2048 * 512 * DB), (size_t)2048 * 512 * DB, (size_t)256 * 512 * DB, (const int*)(ws + WS_LTOK)};
            pg8::EpiDown E{(unsigned char*)(ws + WS_YSLOT), (const int*)(ws + WS_LDST), (LAS int*)(lds + SEL_OFF), (REP_VARIANT && rep == 1) ? 1 : 0};
            pg8::gemm_phase<pg8::EpiDown, pg8::MoeOrder<8, false>, GEMM_ALIGN, GEMM_SP2, DOWN_F8 != 0>(lds, (const char*)(ws + WS_HID), DOWN_F8 ? 256 : 512, S, E, wave);
            if (rep + 1 < REPS(7)) GRID_BAR(); }
            PH_END(7) if (BOTH(pb + 7)) GRID_BAR();
        }
        if ((PH_MASK & 1024) && IN(pb + 8)) {
            PH_BEGIN
            const int nrep = REPS(8);
            _Pragma("unroll 1") for (int rep = 0; rep < nrep; ++rep) {
            const float* modl = mod + (size_t)l * 2 * 12288;
            const unsigned char* yslot = (const unsigned char*)(ws + WS_YSLOT);
            for (int run = blk * NWAVES + wave; run < T / 4; run += G * NWAVES) {
                const int bb = (run * 4) / SEQ; const float* gt2 = modl + bb * 12288 + 5 * 2048;
                const float* m1 = mod + (size_t)2 * 12288 + bb * 12288;
                f32x4 gtv[2][4];
#pragma unroll
                for (int jj = 0; jj < 2; ++jj)
#pragma unroll
                    for (int q = 0; q < 4; ++q) { const int c = 16 * (lane + 64 * jj) + 4 * q; gtv[jj][q] = *(const GAS f32x4*)(gt2 + c) * pg8::YS_INV; }
#pragma unroll 1
                for (int pr = 0; pr < 2; ++pr) {
                    f32x4 v[2][2][4]; float ss[2] = {0.f, 0.f};
                    const int rowb = run * 4 + pr * 2;
                    f32x4 tw[2][2];
#pragma unroll
                    for (int rr = 0; rr < 2; ++rr) { tw[rr][0] = *(const GAS f32x4*)((const float*)(ws + WS_TOKW) + (rowb + rr) * 8); tw[rr][1] = *(const GAS f32x4*)((const float*)(ws + WS_TOKW) + (rowb + rr) * 8 + 4); }
                    auto issue = [&](int rr, int jj, u32x4 (&w)[NSLOT], u32x4 (&xq)[2]) {
                        const int c = 16 * (lane + 64 * jj); const unsigned char* ys = yslot + (size_t)(rowb + rr) * NSLOT * D + c;
#pragma unroll
                        for (int k = 0; k < NSLOT; ++k) w[k] = *(const GAS u32x4*)(ys + (size_t)k * D);
                        const bf16_t* xr = (const bf16_t*)(ws + WS_XB) + (size_t)(rowb + rr) * D + c; xq[0] = *(const GAS u32x4*)xr; xq[1] = *(const GAS u32x4*)(xr + 8); };
                    auto consume = [&](int rr, int jj, const u32x4 (&w)[NSLOT], const u32x4 (&xq)[2]) {
                        f32x4 a[4];
#pragma unroll
                        for (int q = 0; q < 4; ++q) a[q] = (f32x4){0.f, 0.f, 0.f, 0.f};
#pragma unroll
                        for (int k = 0; k < NSLOT; ++k) { const float wk = k < 8 ? tw[rr][k >> 2][k & 3] : 1.0f;
#pragma unroll
                            for (int q = 0; q < 4; ++q) { const f32x2 lo = __builtin_amdgcn_cvt_pk_f32_fp8((int)w[k][q], false), hi = __builtin_amdgcn_cvt_pk_f32_fp8((int)w[k][q], true); a[q] += (f32x4){lo.x, lo.y, hi.x, hi.y} * wk; } }
                        f32x4 xv[4]; pg8::unpack8(xq[0], xv[0], xv[1]); pg8::unpack8(xq[1], xv[2], xv[3]);
#pragma unroll
                        for (int q = 0; q < 4; ++q) { v[rr][jj][q] = xv[q] + gtv[jj][q] * a[q];
                            ss[rr] += v[rr][jj][q][0] * v[rr][jj][q][0] + v[rr][jj][q][1] * v[rr][jj][q][1] + v[rr][jj][q][2] * v[rr][jj][q][2] + v[rr][jj][q][3] * v[rr][jj][q][3]; } };
                    {
                        u32x4 wA[NSLOT], xA[2], wB[NSLOT], xB[2];
#define CMB_FENCE() asm volatile("" ::: "memory")
#define CMB_PIN(x) asm volatile("" : "+v"(x) :: "memory")
                        issue(0, 0, wA, xA); issue(0, 1, wB, xB); CMB_FENCE();
                        consume(0, 0, wA, xA); CMB_PIN(ss[0]); issue(1, 0, wA, xA); CMB_FENCE();
                        consume(0, 1, wB, xB); CMB_PIN(ss[0]); issue(1, 1, wB, xB); CMB_FENCE();
                        consume(1, 0, wA, xA); consume(1, 1, wB, xB); CMB_PIN(ss[1]);
#undef CMB_FENCE
#undef CMB_PIN
                    }
                    f32x4 gs[2][4], gh[2][4];
                    if (l == 0) {
#pragma unroll
                        for (int jj = 0; jj < 2; ++jj)
#pragma unroll
                            for (int q = 0; q < 4; ++q) { const int c = 16 * (lane + 64 * jj) + 4 * q;
                                gs[jj][q] = *(const GAS f32x4*)(args.in[I_NMIX] + D + c) * (*(const GAS f32x4*)(m1 + 2048 + c) + 1.0f); gh[jj][q] = *(const GAS f32x4*)(m1 + c); }
                    } else {
#pragma unroll
                        for (int jj = 0; jj < 2; ++jj)
#pragma unroll
                            for (int q = 0; q < 4; ++q) { const int c = 16 * (lane + 64 * jj) + 4 * q; gs[jj][q] = *(const GAS f32x4*)(args.in[I_NFIN] + c); gh[jj][q] = (f32x4){0.f, 0.f, 0.f, 0.f}; }
                    }
#pragma unroll
                    for (int rr = 0; rr < 2; ++rr) { const int row = rowb + rr;
                        const float rstd = 1.0f / sqrtf(wave_sum(ss[rr]) * (1.0f / D) + NORM_EPS);
                        float* xw = (rep + 1 == nrep) ? xbuf + (size_t)row * D : (float*)(ws + WS_HID) + (size_t)row * D; bf16_t* hw = (rep + 1 == nrep) ? hbuf + (size_t)row * D : (bf16_t*)(ws + WS_MIXED2) + (size_t)row * D;
                        unsigned char* hw8 = (rep + 1 == nrep) ? (unsigned char*)hbuf + (size_t)row * D : (unsigned char*)(ws + WS_MIXED2) + (size_t)row * D; (void)hw8; (void)hw;
                        bf16_t* xbw = (rep + 1 == nrep) ? (bf16_t*)(ws + WS_XB) + (size_t)row * D : (bf16_t*)(ws + WS_MIXED) + (size_t)row * D;
                        if (l == 0) {
#pragma unroll
                            for (int jj = 0; jj < 2; ++jj) { const int c = 16 * (lane + 64 * jj); f32x4 o[4];
                                *(GAS u32x4*)(xbw + c) = pg8::pack8(v[rr][jj][0], v[rr][jj][1]); *(GAS u32x4*)(xbw + c + 8) = pg8::pack8(v[rr][jj][2], v[rr][jj][3]);
#pragma unroll
                                for (int q = 0; q < 4; ++q) o[q] = v[rr][jj][q] * rstd * gs[jj][q] + gh[jj][q];
                                if (INP_F8) *(GAS u32x4*)((unsigned char*)hw8 + c) = (u32x4){pg8::pk_fp8x4(o[0]), pg8::pk_fp8x4(o[1]), pg8::pk_fp8x4(o[2]), pg8::pk_fp8x4(o[3])};
                                else { *(GAS u32x4*)(hw + c) = pg8::pack8(o[0], o[1]); *(GAS u32x4*)(hw + c + 8) = pg8::pack8(o[2], o[3]); } }
                        } else {
#pragma unroll
                            for (int jj = 0; jj < 2; ++jj) { const int c = 16 * (lane + 64 * jj);
#pragma unroll
                                for (int q = 0; q < 4; ++q) *(GAS f32x4*)(xw + c + 4 * q) = v[rr][jj][q] * rstd * gs[jj][q]; }
                        } }
                }
            }
            if (rep + 1 < nrep) GRID_BAR(); }
            PH_END(8) if (BOTH(pb + 8)) GRID_BAR();
        }
    }
#undef IN
#undef BOTH
#undef GRID_BAR
}

extern "C" void kernel_launch(void* const* d_in, const int* in_sizes, int n_in, void* d_out, int out_size, void* d_ws, size_t ws_size, hipStream_t stream) {
    static int grid = 0;
    if (grid == 0) {
        if (n_in != 29 || out_size != T * D || ws_size < WS_END) { fprintf(stderr, "kernel_launch: unexpected shapes (n_in %d out %d ws %zu)\n", n_in, out_size, ws_size); grid = -1; return; }
        int dev = 0, cus = 0, per_cu = 0;
        if (hipGetDevice(&dev) != hipSuccess || hipDeviceGetAttribute(&cus, hipDeviceAttributeMultiprocessorCount, dev) != hipSuccess) { grid = -1; return; }
        if (hipFuncSetAttribute((const void*)mega_fwd, hipFuncAttributeMaxDynamicSharedMemorySize, LDS_BYTES) != hipSuccess) { fprintf(stderr, "kernel_launch: hipFuncSetAttribute failed\n"); grid = -1; return; }
        if (hipOccupancyMaxActiveBlocksPerMultiprocessor(&per_cu, (const void*)mega_fwd, NWAVES * 64, LDS_BYTES) != hipSuccess || per_cu < 1) { fprintf(stderr, "kernel_launch: occupancy query says %d\n", per_cu); }
        (void)hipGetLastError();
        grid = cus & ~7;
    }
    if (grid < 0) return;
    (void)hipMemsetAsync((char*)d_ws + WS_CTL, 0, CTL_ZERO_BYTES, stream);
    Args a{};
    for (int i = 0; i < 29; ++i) a.in[i] = (const float*)d_in[i];
    a.out = (float*)d_out; a.ws = (unsigned char*)d_ws;
    if (N_LAUNCHES == 1) { a.ph_lo = 0; a.ph_hi = 20; hipLaunchKernelGGL(mega_fwd, dim3(grid), dim3(NWAVES * 64), LDS_BYTES, stream, a); }
    else { for (int p = 0; p < 20; ++p) { a.ph_lo = p; a.ph_hi = p + 1; hipLaunchKernelGGL(mega_fwd, dim3(grid), dim3(NWAVES * 64), LDS_BYTES, stream, a); } }
}
```

```cpp
#include <hip/hip_runtime.h>
#include <cstdio>
#include <cstdint>

#ifndef N_LAUNCHES
#define N_LAUNCHES 1
#endif
#ifndef GEMM_ALIGN
#define GEMM_ALIGN true
#endif
#ifndef GEMM_SP2
#define GEMM_SP2 true
#endif
#ifndef MOE_XCD
#define MOE_XCD 0
#endif
#ifndef F8_PIN
#define F8_PIN 1
#endif
#if F8_PIN == 1
#define F8_PIN_ASM(x) asm volatile("" : "+v"(x))
#elif F8_PIN == 2
#define F8_PIN_ASM(x) asm volatile("" : "+a"(x))
#else
#define F8_PIN_ASM(x) do {} while (0)
#endif
#ifndef DOWN_PRE
#define DOWN_PRE 1
#endif
#ifndef DOWN_F8
#define DOWN_F8 1
#endif
#ifndef MIX_F8
#define MIX_F8 1
#endif
#ifndef INP_F8
#define INP_F8 1
#endif
#ifndef AO_F8
#define AO_F8 1
#endif
#ifndef GLU_F8
#define GLU_F8 1
#endif

#define LAS __attribute__((address_space(3)))
#define GAS __attribute__((address_space(1)))
typedef unsigned short bf16_t;
typedef short bf16x8 __attribute__((ext_vector_type(8)));
typedef float f32x4 __attribute__((ext_vector_type(4)));
typedef float f32x2 __attribute__((ext_vector_type(2)));
typedef unsigned u32x4 __attribute__((ext_vector_type(4)));
typedef unsigned u32x2 __attribute__((ext_vector_type(2)));
typedef int i32x4 __attribute__((ext_vector_type(4)));
typedef int i32x8 __attribute__((ext_vector_type(8)));

constexpr int T = 8192, D = 2048, SEQ = 4096, DEPTH = 2;
constexpr int INW = 6144, O_Q = 0, O_K = 1024, O_V = 1280, O_U = 1536, O_GA = 2048, O_GS = 4096;
constexpr int NE = 64, NSLOT = 9;
constexpr float NORM_EPS = 1e-6f;
constexpr float LOG2E = 1.4426950408889634f;

constexpr size_t MiB = 1u << 20;
constexpr size_t WS_CTL = 0, CTL_ZERO_BYTES = 1 * MiB;
constexpr size_t WS_MODP = 1 * MiB;
constexpr size_t WS_MOD = 3 * MiB;
constexpr size_t WS_SSM = 4 * MiB;
constexpr size_t SSM_STRIDE = 640 * 1024, SSM_E = 0, SSM_F = 256 * 1024, SSM_KT = 512 * 1024, SSM_P = 560 * 1024;
constexpr size_t WS_WIN = 44 * MiB;
constexpr size_t WS_WO = 92 * MiB;
constexpr size_t WS_WGLU = 100 * MiB;
constexpr size_t WS_WMIX = 108 * MiB;
constexpr size_t WS_WGU = 124 * MiB;
constexpr size_t WS_WD = 644 * MiB;
constexpr size_t WS_H = 904 * MiB;
constexpr size_t WS_PROJ = 936 * MiB;
constexpr size_t WS_ATTN = 1032 * MiB;
constexpr size_t WS_SLOC = 1048 * MiB;
constexpr size_t WS_Y = 1050 * MiB;
constexpr size_t WS_MIXED = 1058 * MiB;
constexpr size_t WS_HID = 1090 * MiB;
constexpr size_t WS_YSLOT = 1163 * MiB;
constexpr size_t WS_LTOK = 1451 * MiB, WS_LDST = 1453 * MiB, WS_LW = 1455 * MiB;
constexpr size_t WS_MIXED2 = 1457 * MiB;
constexpr size_t WS_WRT = 1489 * MiB;
constexpr size_t WS_XB = 1490 * MiB;
constexpr size_t WS_TOKW = 1522 * MiB;
constexpr size_t WS_END = 1523 * MiB;
constexpr int CW_TMO = 0, CW_BAR = 4096, CW_CNT = 8192;

constexpr int RING_BYTES = 131072, LDSCTL_OFF = RING_BYTES, MISC_OFF = LDSCTL_OFF + 320;
constexpr int SEL_OFF = LDSCTL_OFF + 1024;
constexpr int MOE_OFF = LDSCTL_OFF + 10240;
constexpr int LDS_BYTES = 147456;
constexpr int NWAVES = 8;

__device__ __forceinline__ unsigned cvt_pk_bf16(float lo, float hi) { unsigned r; asm("v_cvt_pk_bf16_f32 %0, %1, %2" : "=v"(r) : "v"(lo), "v"(hi)); return r; }
__device__ __forceinline__ float bf_lo(unsigned w) { return __uint_as_float(w << 16); }
__device__ __forceinline__ float bf_hi(unsigned w) { return __uint_as_float(w & 0xffff0000u); }
__device__ __forceinline__ float bf1(bf16_t h) { return __uint_as_float(((unsigned)h) << 16); }
__device__ __forceinline__ float fast_sigmoid(float x) { return __builtin_amdgcn_rcpf(1.0f + __builtin_amdgcn_exp2f(-x * LOG2E)); }
__device__ __forceinline__ int opaque(int v) { asm volatile("" : "+v"(v)); return v; }
__device__ __forceinline__ int lane_now() { int l; asm volatile("v_mbcnt_lo_u32_b32 %0, -1, 0\n\tv_mbcnt_hi_u32_b32 %0, -1, %0" : "=v"(l)); return l; }
__device__ __forceinline__ float shx(float v, int mask, int l) { return __builtin_bit_cast(float, __builtin_amdgcn_ds_bpermute((l ^ mask) << 2, __builtin_bit_cast(int, v))); }
__device__ __forceinline__ float wave_sum(float v) {
    const int l = lane_now();
#pragma unroll
    for (int o = 1; o < 64; o <<= 1) v += shx(v, o, l);
    return v;
}
__device__ __forceinline__ float shl_from(float v, int srclane) { return __builtin_bit_cast(float, __builtin_amdgcn_ds_bpermute(srclane << 2, __builtin_bit_cast(int, v))); }
#define LDS_WAIT() asm volatile("s_waitcnt lgkmcnt(0)" ::: "memory")
#define VM_WAIT() asm volatile("s_waitcnt vmcnt(0)" ::: "memory")

#define XB_TMO      128
#define XB_XCNT(j)  (256  + 64 * (j))
#define XB_XSUB(j)  (1280 + 64 * (j))
#define XB_XGEN(j)  (2304 + 64 * (j))
#define XB_TOP      3328
#define XB_TOPGEN   3392
#define XCD_BAR_WORDS 3456
#define XB_SPIN_CAP (1u << 18)
__device__ __forceinline__ unsigned xb_ld(unsigned* p)              { return __hip_atomic_load(p, __ATOMIC_RELAXED, __HIP_MEMORY_SCOPE_AGENT); }
__device__ __forceinline__ unsigned xb_add(unsigned* p, unsigned v) { return __hip_atomic_fetch_add(p, v, __ATOMIC_RELAXED, __HIP_MEMORY_SCOPE_AGENT); }
__device__ __forceinline__ unsigned xb_xcc_id() { return (unsigned)__builtin_amdgcn_s_getreg((3 << 11) | 20) & 0xFu; }
#define XB_SPIN(cond, bar) do { unsigned _sp = 0; while (cond) { __builtin_amdgcn_s_sleep(1); \
    if ((++_sp & 255u) == 0u) { if (xb_ld(&(bar)[XB_TMO])) break; if (_sp > XB_SPIN_CAP) { atomicAdd(&(bar)[XB_TMO], 1u); break; } } } } while (0)
struct XcdBarrier { unsigned* bar; unsigned x; volatile LAS unsigned* st; int wv; };
__device__ __forceinline__ XcdBarrier xcd_barrier_post(unsigned* bar, volatile LAS unsigned* st) {
    XcdBarrier b; b.bar = bar; b.x = xb_xcc_id(); b.st = st; b.wv = __builtin_amdgcn_readfirstlane((int)threadIdx.x >> 6);
    if (threadIdx.x == 0) (void)xb_add(&bar[XB_XCNT(b.x)], 1u);
    return b;
}
__device__ __forceinline__ void xcd_barrier_complete(unsigned* bar, unsigned x, unsigned& nloc, unsigned& nx) {
    const unsigned G = gridDim.x * gridDim.y * gridDim.z;
    unsigned sum, cnt, mine, sp = 0u;
    for (;;) {
        sum = 0u; cnt = 0u; mine = 0u;
#pragma unroll
        for (unsigned j = 0; j < 16; ++j) { const unsigned c = xb_ld(&bar[XB_XCNT(j)]); sum += c; cnt += (c > 0u) ? 1u : 0u; mine = (j == x) ? c : mine; }
        if (sum == G) break;
        __builtin_amdgcn_s_sleep(1);
        if ((++sp & 255u) == 0u) { if (xb_ld(&bar[XB_TMO])) break; if (sp > XB_SPIN_CAP) { atomicAdd(&bar[XB_TMO], 1u); break; } }
    }
    nloc = mine > 0u ? mine : 1u; nx = cnt > 0u ? cnt : 1u;
}
__device__ __forceinline__ void xcd_barrier(const XcdBarrier& b) {
    asm volatile("s_waitcnt vmcnt(0)" ::: "memory");
    __syncthreads();
    if (lane_now() + 64 * b.wv == 0) {
        unsigned* bar = b.bar; asm volatile("" : "+s"(bar));
        __builtin_amdgcn_s_waitcnt(0);
        unsigned nloc = b.st[0], nx = b.st[1];
        if (nloc == 0u) { xcd_barrier_complete(bar, b.x, nloc, nx); b.st[0] = nloc; b.st[1] = nx; }
        const unsigned old = xb_add(&bar[XB_XSUB(b.x)], 1u);
        const unsigned gen = old / nloc;
        if (old + 1u == (gen + 1u) * nloc) {
            __builtin_amdgcn_fence(__ATOMIC_RELEASE, "agent");
            asm volatile("s_waitcnt vmcnt(0)" ::: "memory");
            const unsigned og = xb_add(&bar[XB_TOP], 1u);
            const unsigned tg = og / nx;
            if (og + 1u == (tg + 1u) * nx) xb_add(&bar[XB_TOPGEN], 1u);
            else XB_SPIN(xb_ld(&bar[XB_TOPGEN]) == tg, bar);
            __builtin_amdgcn_fence(__ATOMIC_ACQUIRE, "agent");
            xb_add(&bar[XB_XGEN(b.x)], 1u);
            asm volatile("s_waitcnt vmcnt(0)" ::: "memory");
        } else {
            XB_SPIN(xb_ld(&bar[XB_XGEN(b.x)]) == gen, bar);
            __builtin_amdgcn_fence(__ATOMIC_ACQUIRE, "agent");
            asm volatile("s_waitcnt vmcnt(0)" ::: "memory");
        }
    }
    __syncthreads();
}

namespace pg8 {
constexpr int BM = 256, BK = 64, HALF = 128, HTB = HALF * BK * 2, STAGE_BYTES = 8 * HTB, NXCD = 8, WGM = 8;
__host__ __device__ __forceinline__ int lds_byte(int r, int c) { const int st = (r >> 4) * 2 + (c >> 5), rr = r & 15, cc = c & 31, ob = rr * 64 + cc * 2; return st * 1024 + (ob ^ (((ob >> 9) & 1) << 5)); }
__host__ __device__ __forceinline__ void stage_rc(int b, int& R, int& C) { const int st = b / 1024, sb = b % 1024, swz = sb ^ (((sb >> 9) & 1) << 5); R = (st >> 1) * 16 + swz / 64; C = (st & 1) * 32 + (swz % 64) / 2; }
__host__ __device__ __forceinline__ int perm32(int rho) { const int n = rho >> 4, i = rho & 15; return 8 * (i >> 2) + 4 * n + (i & 3); }

struct Unit { int pm, pn, e, n, r0, x; };

struct DenseOrder {
    static constexpr bool GATHER = false;
    int nM, nN, nwg, G, c; const char* Bt; size_t tstepB;
    __device__ void init(int M, int N, int K, int G_, int c_, const void* Bt_) { nM = M / BM; nN = N / BM; nwg = nM * nN; G = G_; c = c_; Bt = (const char*)Bt_; tstepB = (size_t)BM * K * 2; }
    __device__ __forceinline__ bool next(int i, Unit& u) const {
        const long L = (long)i * G + c; if (L >= nwg) return false;
        int wgid = (int)L; { const int q = nwg / NXCD, r = nwg % NXCD, xcd = wgid % NXCD, off = wgid / NXCD; wgid = (xcd < r ? xcd * (q + 1) : r * (q + 1) + (xcd - r) * q) + off; }
        const int nig = WGM * nN, gid = wgid / nig, fm = gid * WGM, gsz = (nM - fm) < WGM ? (nM - fm) : WGM;
        u.pm = fm + ((wgid % nig) % gsz); u.pn = (wgid % nig) / gsz; u.e = -1; u.n = 256; u.r0 = u.pm * BM; u.x = u.pm * BM; return true;
    }
    __device__ __forceinline__ int a_row(const Unit& u, int R) const { return u.r0 + R; }
    __device__ __forceinline__ void a_row_issue(const Unit& u, int R, int& out) const { out = u.r0 + R; }
    __device__ __forceinline__ int a_row_fix(const Unit& u, int R, int loaded) const { return loaded; }
    __device__ __forceinline__ const char* b_tile(const Unit& u) const { return Bt + (size_t)u.pn * tstepB; }
};
template <int NPN, bool GATHER_> struct MoeOrder {
    static constexpr bool GATHER = GATHER_;
    const LAS int* utab; const char* Wbase; size_t wstepE, tstepB; const int* ltok;
    __device__ __forceinline__ bool next(int i, Unit& u) const {
        if (i >= 64) return false;
        const LAS int* p = utab + i * 8;
        const int pm = __builtin_amdgcn_readfirstlane(p[0]); if (pm < 0) return false;
        u.pm = pm; u.pn = __builtin_amdgcn_readfirstlane(p[1]); u.e = __builtin_amdgcn_readfirstlane(p[2]); u.n = __builtin_amdgcn_readfirstlane(p[3]);
        u.r0 = __builtin_amdgcn_readfirstlane(p[4]); u.x = __builtin_amdgcn_readfirstlane(p[5]); return true;
    }
    __device__ __forceinline__ int a_row(const Unit& u, int R) const {
        if (!GATHER) return u.r0 + R;
        if (u.e == 64) return u.r0 + R;
        const int rr = R < u.n ? R : u.n - 1; return ((const GAS int*)ltok)[u.r0 + rr];
    }
    __device__ __forceinline__ void a_row_issue(const Unit& u, int R, int& out) const {
        const int rr = R < u.n ? R : u.n - 1; const GAS int* p = (const GAS int*)ltok + (u.e == 64 ? 0 : u.r0 + rr);
        asm volatile("global_load_dword %0, %1, off" : "=v"(out) : "v"(p) : "memory");
    }
    __device__ __forceinline__ int a_row_fix(const Unit& u, int R, int loaded) const { return u.e == 64 ? u.r0 + R : loaded; }
    __device__ __forceinline__ const char* b_tile(const Unit& u) const { return Wbase + (size_t)u.e * wstepE + (size_t)u.pn * tstepB; }
};
template <int NPN, bool GATHER> __device__ __forceinline__ void moe_build(LAS int* tpre, LAS int* ebase, LAS int* ecnt, LAS int* utab, const unsigned* counts, int G, int c, int tid) {
    if (tid < 64) ecnt[tid] = (int)__hip_atomic_load(counts + tid, __ATOMIC_RELAXED, __HIP_MEMORY_SCOPE_AGENT);
    __syncthreads();
    if (tid == 0) { int tp = 0, eb = 0; for (int e = 0; e < 64; ++e) { tpre[e] = tp; ebase[e] = eb; tp += (ecnt[e] + 255) >> 8; eb += ecnt[e]; } tpre[64] = tp; ebase[64] = eb; }
    __syncthreads();
#if MOE_XCD
    if (tid < 64) {
        int pm = -1, pn = 0, e = 64, n = 256;
        const int xc = c & 7; int idx = (c >> 3) + (G >> 3) * tid;
        if (idx < 4 * NPN) { pm = xc + 8 * (idx / NPN); pn = idx % NPN; }
        else { idx -= 4 * NPN;
#pragma unroll 1
            for (int j = 0; j < 8; ++j) { const int ee = xc + 8 * j, nu = ((ecnt[ee] + 255) >> 8) * NPN;
                if (pm < 0) { if (idx < nu) { e = ee; pm = idx / NPN; pn = idx % NPN; } else idx -= nu; } }
            if (pm >= 0) { const int rem = ecnt[e] - pm * BM; n = rem < BM ? rem : BM; } }
        const int hb = (e == 64 ? 65536 : ebase[e]) + pm * BM;
        const int r0 = GATHER ? (e == 64 ? pm * BM : e * 8192 + pm * BM) : hb, x = hb;
#else
    if (tid < 64) {
        int pm = -1, pn = 0, e = 64, n = 256;
        const int vc = ((G & 7) == 0) ? (c & 7) * (G >> 3) + (c >> 3) : c;
        int L = tid * G + vc; const int shared_units = 32 * NPN, tot = shared_units + NPN * tpre[64];
        if (L < tot) {
            if (L < shared_units) { pm = L / NPN; pn = L % NPN; }
            else { L -= shared_units; const int tile = L / NPN; pn = L % NPN; e = 0;
#pragma unroll 1
                for (int j = 1; j <= 64; ++j) e += (tpre[j] <= tile) ? 1 : 0;
                pm = tile - tpre[e]; const int rem = ecnt[e] - pm * BM; n = rem < BM ? rem : BM; } }
        const int hb = (e == 64 ? 65536 : ebase[e]) + pm * BM;
        const int r0 = GATHER ? (e == 64 ? pm * BM : e * 8192 + pm * BM) : hb, x = hb;
#endif
        LAS int* p = utab + tid * 8; p[0] = pm; p[1] = pn; p[2] = e; p[3] = n; p[4] = r0; p[5] = x;
    }
    __syncthreads();
}

template <class Epi, class Sched, bool ALIGN_EPI = false, bool SP2 = GEMM_SP2, bool F8 = false>
__device__ __forceinline__ void gemm_phase(LAS unsigned char* lds, const char* Abase, const int K, const Sched& S, const Epi& E, const int wave_s) {
    int tid = lane_now() + 64 * wave_s; asm volatile("" : "+v"(tid));
    const int wid = wave_s, lane = tid & 63, wr = wid >> 2, wc = wid & 3, fr = lane & 15, fq = lane >> 4;
    const int nt = K / BK;
    constexpr bool GA = Sched::GATHER;
    unsigned voffA[2], voffB[2];
#pragma unroll
    for (int i = 0; i < 2; ++i) { int R, C; stage_rc(tid * 16 + i * 8192, R, C); const int Rb = Epi::PERM ? ((R & ~31) + perm32(R & 31)) : R; voffA[i] = (unsigned)(R * K + C) * 2u; voffB[i] = (unsigned)(Rb * K + C) * 2u; }
    const size_t kstep = (size_t)(BK * 2);
    const size_t hstep = (size_t)HALF * K * 2;
    const unsigned ldsw = (unsigned)wid * 1024u;
    const int aoff = lds_byte(wr * 64 + fr, fq * 8), boff = lds_byte(wc * 32 + fr, fq * 8);
#define PG8_SA(b, h) (((b) * 2 + (h)) * HTB)
#define PG8_SB(b, h) ((4 + (b) * 2 + (h)) * HTB)
#define PG8_STB(bufoff, gbase) do { const char* _sb = (const char*)(gbase); asm volatile("" : "+s"(_sb)); _Pragma("unroll") for (int _i = 0; _i < 2; ++_i) \
        { unsigned _vo = voffB[_i]; asm volatile("" : "+v"(_vo)); __builtin_amdgcn_global_load_lds((const unsigned*)(_sb + _vo), (LAS unsigned*)(lds + (bufoff) + ldsw + _i * 8192), 16, 0, 0); } } while (0)
#define PG8_STA(bufoff, h, kb) do { const char* _sa = GA ? (Abase + (kb)) : (cA + (kb) + (h) * hstep); asm volatile("" : "+s"(_sa)); _Pragma("unroll") for (int _i = 0; _i < 2; ++_i) \
        { unsigned _vo = GA ? offC[h][_i] : voffA[_i]; asm volatile("" : "+v"(_vo)); __builtin_amdgcn_global_load_lds((const unsigned*)(_sa + _vo), (LAS unsigned*)(lds + (bufoff) + ldsw + _i * 8192), 16, 0, 0); } } while (0)
#define PG8_LDA(dst, b, h) do { _Pragma("unroll") for (int m = 0; m < 4; ++m) _Pragma("unroll") for (int k = 0; k < 2; ++k) dst[m][k] = *(const LAS bf16x8*)(lds + PG8_SA(b, h) + aoff + m * 2048 + k * 1024); } while (0)
#define PG8_LDB(dst, b, h) do { _Pragma("unroll") for (int n = 0; n < 2; ++n) _Pragma("unroll") for (int k = 0; k < 2; ++k) dst[n][k] = *(const LAS bf16x8*)(lds + PG8_SB(b, h) + boff + n * 2048 + k * 1024); } while (0)
#define PG8_CAT8(x, y) __builtin_shufflevector(__builtin_bit_cast(i32x4, x), __builtin_bit_cast(i32x4, y), 0, 1, 2, 3, 4, 5, 6, 7)
#define PG8_MMA(ai, bj, At, Bt) do { __builtin_amdgcn_s_setprio(1); _Pragma("unroll") for (int m = 0; m < 4; ++m) _Pragma("unroll") for (int n = 0; n < 2; ++n) { \
        if constexpr (F8) acc[ai][bj][m][n] = __builtin_amdgcn_mfma_scale_f32_16x16x128_f8f6f4(PG8_CAT8(Bt[n][0], Bt[n][1]), PG8_CAT8(At[m][0], At[m][1]), acc[ai][bj][m][n], 0, 0, 0, 0, 0, 0); \
        else { _Pragma("unroll") for (int k = 0; k < 2; ++k) acc[ai][bj][m][n] = __builtin_amdgcn_mfma_f32_16x16x32_bf16(Bt[n][k], At[m][k], acc[ai][bj][m][n], 0, 0, 0); } } \
        __builtin_amdgcn_s_setprio(0); } while (0)
#define PG8_WAIT_V(n) asm volatile("s_waitcnt vmcnt(" #n ")" ::: "memory")
#define PG8_WAIT_L(n) asm volatile("s_waitcnt lgkmcnt(" #n ")" ::: "memory")
#define PG8_BAR __builtin_amdgcn_s_barrier()
#define PG8_SCHED __builtin_amdgcn_sched_barrier(0)
#define PG8_AOFF(dst, u) do { if constexpr (GA) { _Pragma("unroll") for (int _h = 0; _h < 2; ++_h) _Pragma("unroll") for (int _i = 0; _i < 2; ++_i) { int _R, _C; stage_rc(tid * 16 + _i * 8192, _R, _C); \
        dst[_h][_i] = (unsigned)(S.a_row(u, _h * HALF + _R) * K + _C) * 2u; } } } while (0)
    Unit cur, nxt; int ui = 0;
    if (!S.next(0, cur)) return;
    f32x4 acc[2][2][4][2];
#pragma unroll
    for (int a = 0; a < 2; ++a)
#pragma unroll
        for (int b = 0; b < 2; ++b)
#pragma unroll
            for (int m = 0; m < 4; ++m)
#pragma unroll
                for (int n = 0; n < 2; ++n) { acc[a][b][m][n] = (f32x4){0.f, 0.f, 0.f, 0.f}; if constexpr (F8) F8_PIN_ASM(acc[a][b][m][n]); }
    bf16x8 At[4][2], B0[2][2], B1[2][2];
    unsigned offC[2][2];
    PG8_AOFF(offC, cur);
    const char* cB = S.b_tile(cur);
    const char* cA = GA ? Abase : Abase + (size_t)S.a_row(cur, 0) * K * 2;
    if constexpr (SP2) {
        PG8_STB(PG8_SB(0, 0), cB); PG8_STB(PG8_SB(0, 1), cB + hstep); PG8_STA(PG8_SA(0, 0), 0, 0); PG8_STA(PG8_SA(0, 1), 1, 0);
        if (wr == 1) PG8_BAR;
        PG8_WAIT_V(2); PG8_BAR;
        PG8_STB(PG8_SB(1, 0), cB + kstep); PG8_STA(PG8_SA(1, 0), 0, kstep); PG8_STB(PG8_SB(1, 1), cB + hstep + kstep);
        PG8_WAIT_V(6); PG8_BAR;
    } else {
    PG8_STB(PG8_SB(0, 0), cB); PG8_STA(PG8_SA(0, 0), 0, 0); PG8_STB(PG8_SB(0, 1), cB + hstep); PG8_STA(PG8_SA(0, 1), 1, 0);
    if (wr == 1) PG8_BAR;
    PG8_WAIT_V(4); PG8_BAR;
    PG8_STB(PG8_SB(1, 0), cB + kstep); PG8_STA(PG8_SA(1, 0), 0, kstep); PG8_STB(PG8_SB(1, 1), cB + hstep + kstep);
    PG8_WAIT_V(6); PG8_BAR;
    }
    for (;;) {
        int pre_v0, pre_v1; if constexpr (Epi::PRE) E.pre_issue(cur, wr, opaque(lane_now()), pre_v0, pre_v1);
        const bool has_next = S.next(ui + 1, nxt);
        const char* nB = has_next ? S.b_tile(nxt) : cB;
        const char* nA = (!GA && has_next) ? Abase + (size_t)S.a_row(nxt, 0) * K * 2 : cA;
        int rowN[2][2];
        if constexpr (GA) { const Unit un = has_next ? nxt : cur;
#pragma unroll
            for (int h = 0; h < 2; ++h)
#pragma unroll
                for (int i = 0; i < 2; ++i) { int R_, C_; stage_rc(tid * 16 + i * 8192, R_, C_); S.a_row_issue(un, h * HALF + R_, rowN[h][i]); } }
#pragma unroll 1
        for (int t = 0; t < nt; t += 2) {
            const bool last = (t == nt - 2);
            const size_t kb1 = (size_t)(t + 1) * kstep;
            const size_t kb2 = last ? 0 : (size_t)(t + 2) * kstep, kb3 = kb2 + kstep;
            const char* b2 = last ? nB : cB + (size_t)(t + 2) * kstep; const char* b3 = b2 + kstep;
            if constexpr (SP2) {
            PG8_LDB(B0, 0, 0); PG8_LDB(B1, 0, 1); PG8_SCHED; PG8_LDA(At, 0, 0); PG8_STA(PG8_SA(1, 1), 1, kb1);
            if (last) { if constexpr (GA) { if (has_next) {
#pragma unroll
                for (int h = 0; h < 2; ++h)
#pragma unroll
                    for (int i = 0; i < 2; ++i) { int R_, C_; stage_rc(tid * 16 + i * 8192, R_, C_); int rl = rowN[h][i]; asm volatile("" : "+v"(rl));
                        offC[h][i] = (unsigned)(S.a_row_fix(nxt, h * HALF + R_, rl) * K + C_) * 2u; } } } else cA = nA; }
            PG8_WAIT_V(8); PG8_WAIT_L(0); PG8_BAR; PG8_MMA(0, 0, At, B0); PG8_MMA(0, 1, At, B1); PG8_BAR; PG8_SCHED;
            PG8_LDA(At, 0, 1); PG8_STB(PG8_SB(0, 0), b2); PG8_STB(PG8_SB(0, 1), b2 + hstep); PG8_STA(PG8_SA(0, 0), 0, kb2);
            PG8_WAIT_V(8); PG8_WAIT_L(0); PG8_BAR; PG8_MMA(1, 0, At, B0); PG8_MMA(1, 1, At, B1); PG8_BAR; PG8_SCHED;
            PG8_LDB(B0, 1, 0); PG8_LDB(B1, 1, 1); PG8_SCHED; PG8_LDA(At, 1, 0); PG8_STA(PG8_SA(0, 1), 1, kb2);
            PG8_WAIT_V(8); PG8_WAIT_L(0); PG8_BAR; PG8_MMA(0, 0, At, B0); PG8_MMA(0, 1, At, B1); PG8_BAR; PG8_SCHED;
            PG8_LDA(At, 1, 1); PG8_STB(PG8_SB(1, 0), b3); PG8_STB(PG8_SB(1, 1), b3 + hstep); PG8_STA(PG8_SA(1, 0), 0, kb3);
            PG8_WAIT_V(8); PG8_WAIT_L(0); PG8_BAR; PG8_MMA(1, 0, At, B0); PG8_MMA(1, 1, At, B1); PG8_BAR; PG8_SCHED;
            } else {
            PG8_LDB(B0, 0, 0); PG8_SCHED; PG8_LDA(At, 0, 0); PG8_STA(PG8_SA(1, 1), 1, kb1);
            if (last) { if constexpr (GA) { if (has_next) {
#pragma unroll
                for (int h = 0; h < 2; ++h)
#pragma unroll
                    for (int i = 0; i < 2; ++i) { int R_, C_; stage_rc(tid * 16 + i * 8192, R_, C_); int rl = rowN[h][i]; asm volatile("" : "+v"(rl));
                        offC[h][i] = (unsigned)(S.a_row_fix(nxt, h * HALF + R_, rl) * K + C_) * 2u; } } } else cA = nA; }
            PG8_WAIT_L(8); PG8_BAR; PG8_WAIT_L(0); PG8_MMA(0, 0, At, B0); PG8_BAR; PG8_SCHED;
            PG8_LDB(B1, 0, 1); PG8_STB(PG8_SB(0, 0), b2);
            PG8_BAR; PG8_WAIT_L(0); PG8_MMA(0, 1, At, B1); PG8_BAR;
            PG8_LDA(At, 0, 1); PG8_STA(PG8_SA(0, 0), 0, kb2);
            PG8_BAR; PG8_WAIT_L(0); PG8_MMA(1, 0, At, B0); PG8_BAR; PG8_SCHED;
            PG8_STB(PG8_SB(0, 1), b2 + hstep);
            PG8_WAIT_V(6); PG8_BAR; PG8_MMA(1, 1, At, B1); PG8_BAR;
            PG8_LDB(B0, 1, 0); PG8_SCHED; PG8_LDA(At, 1, 0); PG8_STA(PG8_SA(0, 1), 1, kb2);
            PG8_WAIT_L(8); PG8_BAR; PG8_WAIT_L(0); PG8_MMA(0, 0, At, B0); PG8_BAR; PG8_SCHED;
            PG8_LDB(B1, 1, 1); PG8_STB(PG8_SB(1, 0), b3);
            PG8_BAR; PG8_WAIT_L(0); PG8_MMA(0, 1, At, B1); PG8_BAR;
            PG8_LDA(At, 1, 1); PG8_STA(PG8_SA(1, 0), 0, kb3);
            PG8_BAR; PG8_WAIT_L(0); PG8_MMA(1, 0, At, B0); PG8_BAR; PG8_SCHED;
            PG8_STB(PG8_SB(1, 1), b3 + hstep);
            PG8_WAIT_V(6); PG8_BAR; PG8_MMA(1, 1, At, B1); PG8_BAR;
            }
        }
        if constexpr (ALIGN_EPI) { if (wr == 0) PG8_BAR; }
        const int tq = opaque(lane_now() + 64 * wid);
        if constexpr (Epi::PRE) { asm volatile("" : "+v"(pre_v0), "+v"(pre_v1)); E.pre_commit(pre_v0, pre_v1, wid, tq & 63); }
        E(acc, cur, wr, wc, tq & 15, (tq >> 4) & 3);
        if (!has_next) break;
#pragma unroll
        for (int a = 0; a < 2; ++a)
#pragma unroll
            for (int b = 0; b < 2; ++b)
#pragma unroll
                for (int m = 0; m < 4; ++m)
#pragma unroll
                    for (int n = 0; n < 2; ++n) { acc[a][b][m][n] = (f32x4){0.f, 0.f, 0.f, 0.f}; if constexpr (F8) F8_PIN_ASM(acc[a][b][m][n]); }
        cur = nxt; cB = nB; ++ui;
        if constexpr (ALIGN_EPI) { if (wr == 1) PG8_BAR; }
    }
    PG8_WAIT_V(0);
    if constexpr (!ALIGN_EPI) { if (wr == 0) PG8_BAR; }
    PG8_BAR;
#undef PG8_SA
#undef PG8_SB
#undef PG8_STB
#undef PG8_STA
#undef PG8_LDA
#undef PG8_LDB
#undef PG8_MMA
#undef PG8_CAT8
#undef PG8_WAIT_V
#undef PG8_WAIT_L
#undef PG8_BAR
#undef PG8_SCHED
#undef PG8_AOFF
}

typedef const f32x4 (&AccRef)[2][2][4][2];
__device__ __forceinline__ u32x4 pack8(const f32x4& a, const f32x4& b) { u32x4 w; w.x = cvt_pk_bf16(a[0], a[1]); w.y = cvt_pk_bf16(a[2], a[3]); w.z = cvt_pk_bf16(b[0], b[1]); w.w = cvt_pk_bf16(b[2], b[3]); return w; }
__device__ __forceinline__ void unpack8(const u32x4 w, f32x4& a, f32x4& b) { a = (f32x4){bf_lo(w.x), bf_hi(w.x), bf_lo(w.y), bf_hi(w.y)}; b = (f32x4){bf_lo(w.z), bf_hi(w.z), bf_lo(w.w), bf_hi(w.w)}; }

constexpr float WGU_SCALE = 64.0f, WD_SCALE = 32.0f;
__device__ __forceinline__ unsigned pk_fp8x4(const f32x4& a) {
    int w = 0; w = __builtin_amdgcn_cvt_pk_fp8_f32(a[0], a[1], w, false); w = __builtin_amdgcn_cvt_pk_fp8_f32(a[2], a[3], w, true); return (unsigned)w; }
struct EpiInProj {
    static constexpr bool PERM = true; static constexpr bool PRE = false;
    bf16_t* O; const float* bias; float qscale; int nostore;
    __device__ __forceinline__ void operator()(AccRef acc, const Unit& u, int wr, int wc, int fr, int fq) const {
        if (nostore) return;
        const int row0 = u.pm * BM + wr * 64 + fr, colb = u.pn * BM + wc * 32 + 8 * fq;
        const int mode = u.pn < 4 ? 1 : (u.pn >= 8 ? 2 : 0);
        float dq = INP_F8 ? 1.0f / WGU_SCALE : 1.0f; asm volatile("" : "+s"(dq));
        f32x4 bv[2][2];
#pragma unroll
        for (int bj = 0; bj < 2; ++bj)
#pragma unroll
            for (int n = 0; n < 2; ++n) bv[bj][n] = *(const GAS f32x4*)(bias + colb + bj * HALF + 4 * n);
#pragma unroll
        for (int ai = 0; ai < 2; ++ai)
#pragma unroll
            for (int m = 0; m < 4; ++m) { bf16_t* rowp = O + (size_t)(row0 + ai * HALF + m * 16) * INW + colb;
#pragma unroll
                for (int bj = 0; bj < 2; ++bj) { f32x4 v0 = acc[ai][bj][m][0] * dq + bv[bj][0], v1 = acc[ai][bj][m][1] * dq + bv[bj][1];
                    if (mode == 1) { v0 = v0 * qscale; v1 = v1 * qscale; }
                    if (mode == 2) {
#pragma unroll
                        for (int j = 0; j < 4; ++j) { v0[j] = fast_sigmoid(v0[j]); v1[j] = fast_sigmoid(v1[j]); } }
                    *(GAS u32x4*)(rowp + bj * HALF) = pack8(v0, v1); } }
    }
};
struct EpiAttnProj {
    static constexpr bool PERM = true; static constexpr bool PRE = false;
    const bf16_t* proj; bf16_t* mixed;
    __device__ __forceinline__ void operator()(AccRef acc, const Unit& u, int wr, int wc, int fr, int fq) const {
        const int row0 = u.pm * BM + wr * 64 + fr, colb = u.pn * BM + wc * 32 + 8 * fq;
#pragma unroll
        for (int ai = 0; ai < 2; ++ai) {
            u32x4 gw[4][2];
#pragma unroll
            for (int m = 0; m < 4; ++m)
#pragma unroll
                for (int bj = 0; bj < 2; ++bj) gw[m][bj] = *(const GAS u32x4*)(proj + (size_t)(row0 + ai * HALF + m * 16) * INW + O_GA + colb + bj * HALF);
#pragma unroll
            for (int m = 0; m < 4; ++m) { const size_t row = (size_t)(row0 + ai * HALF + m * 16);
#pragma unroll
                for (int bj = 0; bj < 2; ++bj) { f32x4 g0, g1; unpack8(gw[m][bj], g0, g1);
                    if (AO_F8) { g0 = g0 * (1.0f / WGU_SCALE); g1 = g1 * (1.0f / WGU_SCALE); }
                    *(GAS u32x4*)(mixed + row * D + colb + bj * HALF) = pack8(g0 * acc[ai][bj][m][0], g1 * acc[ai][bj][m][1]); } } }
    }
};
struct EpiGlu {
    static constexpr bool PERM = true; static constexpr bool PRE = false;
    const bf16_t* proj; const bf16_t* mixed; bf16_t* mixed2;
    __device__ __forceinline__ void operator()(AccRef acc, const Unit& u, int wr, int wc, int fr, int fq) const {
        const int row0 = u.pm * BM + wr * 64 + fr, col = u.pn * HALF + wc * 32 + 8 * fq;
#pragma unroll
        for (int ai = 0; ai < 2; ++ai) {
            u32x4 gw[4], pw[4];
#pragma unroll
            for (int m = 0; m < 4; ++m) { const size_t row = (size_t)(row0 + ai * HALF + m * 16);
                gw[m] = *(const GAS u32x4*)(proj + row * INW + O_GS + col); pw[m] = *(const GAS u32x4*)(mixed + row * D + col); }
#pragma unroll
            for (int m = 0; m < 4; ++m) { const size_t row = (size_t)(row0 + ai * HALF + m * 16);
                f32x4 g0, g1, p0, p1; unpack8(gw[m], g0, g1); unpack8(pw[m], p0, p1);
                const float dq = GLU_F8 ? 1.0f / WGU_SCALE : 1.0f;
                const f32x4 za0 = acc[ai][0][m][0] * dq, za1 = acc[ai][0][m][1] * dq, zb0 = acc[ai][1][m][0] * dq, zb1 = acc[ai][1][m][1] * dq;
#pragma unroll
                for (int j = 0; j < 4; ++j) { p0[j] += g0[j] * za0[j] * fast_sigmoid(zb0[j]); p1[j] += g1[j] * za1[j] * fast_sigmoid(zb1[j]); }
                if constexpr (MIX_F8 != 0) *(GAS u32x2*)((unsigned char*)mixed2 + row * D + col) = (u32x2){pk_fp8x4(p0), pk_fp8x4(p1)};
                else *(GAS u32x4*)(mixed2 + row * D + col) = pack8(p0, p1); } }
    }
};
struct EpiMixOut {
    static constexpr bool PERM = true; static constexpr bool PRE = false;
    const float* xin; const bf16_t* xsrc; bf16_t* xdst; const float* gt;
    __device__ __forceinline__ void operator()(AccRef acc, const Unit& u, int wr, int wc, int fr, int fq) const {
        const int row0 = u.pm * BM + wr * 64 + fr, colb = u.pn * BM + wc * 32 + 8 * fq;
        const float* g = gt + (u.pm >= 16 ? 12288 : 0);
        f32x4 gv[2][2];
#pragma unroll
        for (int bj = 0; bj < 2; ++bj)
#pragma unroll
            for (int n = 0; n < 2; ++n) gv[bj][n] = *(const GAS f32x4*)(g + colb + bj * HALF + 4 * n) * (MIX_F8 ? 1.0f / WGU_SCALE : 1.0f);
        if (xin) {
#pragma unroll
            for (int ai = 0; ai < 2; ++ai)
#pragma unroll
                for (int mp = 0; mp < 2; ++mp) { f32x4 xv[2][2][2];
#pragma unroll
                    for (int mm = 0; mm < 2; ++mm)
#pragma unroll
                        for (int bj = 0; bj < 2; ++bj) { const size_t off = (size_t)(row0 + ai * HALF + (2 * mp + mm) * 16) * D + colb + bj * HALF;
                            xv[mm][bj][0] = *(const GAS f32x4*)(xin + off); xv[mm][bj][1] = *(const GAS f32x4*)(xin + off + 4); }
#pragma unroll
                    for (int mm = 0; mm < 2; ++mm)
#pragma unroll
                        for (int bj = 0; bj < 2; ++bj) { const int m = 2 * mp + mm; const size_t off = (size_t)(row0 + ai * HALF + m * 16) * D + colb + bj * HALF;
                            *(GAS u32x4*)(xdst + off) = pack8(xv[mm][bj][0] + gv[bj][0] * acc[ai][bj][m][0], xv[mm][bj][1] + gv[bj][1] * acc[ai][bj][m][1]); } }
        } else {
#pragma unroll
            for (int ai = 0; ai < 2; ++ai) { u32x4 xw[4][2];
#pragma unroll
                for (int m = 0; m < 4; ++m)
#pragma unroll
                    for (int bj = 0; bj < 2; ++bj) xw[m][bj] = *(const GAS u32x4*)(xsrc + (size_t)(row0 + ai * HALF + m * 16) * D + colb + bj * HALF);
#pragma unroll
                for (int m = 0; m < 4; ++m)
#pragma unroll
                    for (int bj = 0; bj < 2; ++bj) { f32x4 x0, x1; unpack8(xw[m][bj], x0, x1);
                        *(GAS u32x4*)(xdst + (size_t)(row0 + ai * HALF + m * 16) * D + colb + bj * HALF) = pack8(x0 + gv[bj][0] * acc[ai][bj][m][0], x1 + gv[bj][1] * acc[ai][bj][m][1]); } }
        }
    }
};
struct EpiGateUp {
    static constexpr bool PERM = true; static constexpr bool PRE = false;
    unsigned char* hid;
    __device__ __forceinline__ void operator()(AccRef acc, const Unit& u, int wr, int wc, int fr, int fq) const {
        const int r0 = wr * 64 + fr, col = u.pn * HALF + wc * 32 + 8 * fq;
        float dq = 1.0f / WGU_SCALE; asm volatile("" : "+s"(dq));
#pragma unroll
        for (int ai = 0; ai < 2; ++ai)
#pragma unroll
            for (int m = 0; m < 4; ++m) { const int r = r0 + ai * HALF + m * 16;
                f32x4 g0 = acc[ai][0][m][0] * dq, g1 = acc[ai][0][m][1] * dq, u0 = acc[ai][1][m][0] * dq, u1 = acc[ai][1][m][1] * dq;
#pragma unroll
                for (int j = 0; j < 4; ++j) { g0[j] = g0[j] * fast_sigmoid(g0[j]) * u0[j]; g1[j] = g1[j] * fast_sigmoid(g1[j]) * u1[j]; }
                if (r < u.n) { if constexpr (DOWN_F8 != 0) *(GAS u32x2*)(hid + (size_t)(u.x + r) * 512 + col) = (u32x2){pk_fp8x4(g0), pk_fp8x4(g1)};
                               else *(GAS u32x4*)(hid + ((size_t)(u.x + r) * 512 + col) * 2) = pack8(g0, g1); } }
    }
};
constexpr float YS_SCALE = 8.0f, YS_INV = 1.0f / 8.0f, YS_ACC = DOWN_F8 ? YS_SCALE / WD_SCALE : YS_SCALE;
struct EpiDown {
    static constexpr bool PERM = true; static constexpr bool PRE = (DOWN_PRE != 0);
    unsigned char* ys; const int* ldst; LAS int* dstl; int nostore;
    __device__ __forceinline__ void pre_issue(const Unit& u, int wr, int lane, int& v0, int& v1) const {
        const int ra = 64 * wr + lane, rb = ra + 128; const GAS int* p = (const GAS int*)ldst + (u.e == 64 ? 0 : u.e * 8192 + u.pm * BM);
        const GAS int* pa = p + ((u.e != 64 && ra < u.n) ? ra : 0); const GAS int* pb = p + ((u.e != 64 && rb < u.n) ? rb : 0);
        asm volatile("global_load_dword %0, %1, off" : "=v"(v0) : "v"(pa) : "memory");
        asm volatile("global_load_dword %0, %1, off" : "=v"(v1) : "v"(pb) : "memory");
    }
    __device__ __forceinline__ void pre_commit(int v0, int v1, int wid, int lane_) const { const int lane = opaque(lane_); dstl[wid * 128 + lane] = v0; dstl[wid * 128 + 64 + lane] = v1; }
    __device__ __forceinline__ void operator()(AccRef acc, const Unit& u, int wr, int wc, int fr_, int fq_) const {
        const int fr = opaque(fr_), fq = opaque(fq_);
        const int r0 = wr * 64 + fr, colb = u.pn * BM + 16 * (4 * wc + fq);
#pragma unroll
        for (int ai = 0; ai < 2; ++ai)
#pragma unroll
            for (int m = 0; m < 4; ++m) { const int r = r0 + ai * HALF + m * 16;
                int dst;
                if constexpr (PRE) dst = (u.e == 64) ? (u.pm * BM + r) * NSLOT + 8 : dstl[(wr * 4 + wc) * 128 + ai * 64 + m * 16 + fr];
                else dst = (u.e == 64) ? (u.pm * BM + r) * NSLOT + 8 : ((const GAS int*)ldst)[u.e * 8192 + u.pm * BM + (r < u.n ? r : 0)];
                if (r < u.n && !nostore)
                    *(GAS u32x4*)(ys + (size_t)dst * D + colb) = (u32x4){pk_fp8x4(acc[ai][0][m][0] * YS_ACC), pk_fp8x4(acc[ai][0][m][1] * YS_ACC), pk_fp8x4(acc[ai][1][m][0] * YS_ACC), pk_fp8x4(acc[ai][1][m][1] * YS_ACC)}; }
    }
};
}

struct Args { const float* in[29]; float* out; unsigned char* ws; int ph_lo, ph_hi; };
typedef const __attribute__((address_space(4))) Args KArgs;
__device__ __forceinline__ const float* arg_in(int which) {
#if defined(__HIP_DEVICE_COMPILE__)
    KArgs* p = (KArgs*)__builtin_amdgcn_kernarg_segment_ptr(); return p->in[which];
#else
    (void)which; return nullptr;
#endif
}
enum { I_X = 0, I_C, I_WADA, I_BADA, I_NMIX, I_WIN, I_BIN, I_SINK, I_WO, I_ARE, I_AIM, I_LDT, I_BRE, I_BIM, I_CRE, I_CIM, I_SD, I_WGLU, I_WMIX, I_NFFN, I_WR, I_BR, I_WEG, I_WEU, I_WED, I_WSG, I_WSU, I_WSD, I_NFIN };

struct TDesc { const float* src; bf16_t* dst; int N, K, cc0; float f8s; };
__device__ __forceinline__ void tr_load(const TDesc& d, int lane, f32x4 (&v)[16]) {
    const int kr = lane >> 4, nq = lane & 15;
    const GAS float* p = (const GAS float*)d.src + (size_t)kr * d.N + 4 * nq; const size_t step = (size_t)4 * d.N;
#pragma unroll
    for (int i = 0; i < 16; ++i) { v[i] = __builtin_nontemporal_load((const GAS f32x4*)p); p += step; }
}
__device__ __forceinline__ void tr_finish(const TDesc& d, int lane_, LAS float* scr, const f32x4 (&v)[16]) {
    const int lane = opaque(lane_);
    const int kr = lane >> 4, nq = lane & 15;
#pragma unroll
    for (int i = 0; i < 16; ++i) { const int k = 4 * i + kr;
#pragma unroll
        for (int e = 0; e < 4; ++e) scr[k * 64 + ((4 * nq + e) ^ k)] = v[i][e]; }
    LDS_WAIT();
    const int c = lane & 7;
#pragma unroll
    for (int j = 0; j < 8; ++j) { const int n = (lane >> 3) + 8 * j; float s[8];
#pragma unroll
        for (int i = 0; i < 8; ++i) { const int k = 8 * c + i; s[i] = scr[k * 64 + (n ^ k)]; }
        u32x4 o; o.x = cvt_pk_bf16(s[0], s[1]); o.y = cvt_pk_bf16(s[2], s[3]); o.z = cvt_pk_bf16(s[4], s[5]); o.w = cvt_pk_bf16(s[6], s[7]);
        const int cc = d.cc0 + n, drow = d.cc0 >= 0 ? (128 * ((cc & 15) >> 3) + 8 * (cc >> 4) + (cc & 7)) : n;
        if (d.f8s != 0.f) { const f32x4 sa = (f32x4){s[0], s[1], s[2], s[3]} * d.f8s, sb = (f32x4){s[4], s[5], s[6], s[7]} * d.f8s;
            __builtin_nontemporal_store((u32x2){pg8::pk_fp8x4(sa), pg8::pk_fp8x4(sb)}, (GAS u32x2*)((unsigned char*)d.dst + (size_t)drow * d.K + 8 * c)); }
        else __builtin_nontemporal_store(o, (GAS u32x4*)(d.dst + (size_t)drow * d.K + 8 * c)); }
    LDS_WAIT();
}
__device__ __forceinline__ void tr_half8(const TDesc& d, int lane_, LAS float* scr, const f32x4 (&v)[16], u32x2 (&o)[8]) {
    const int lane = opaque(lane_);
    const int kr = lane >> 4, nq = lane & 15;
#pragma unroll
    for (int i = 0; i < 16; ++i) { const int k = 4 * i + kr;
#pragma unroll
        for (int e = 0; e < 4; ++e) scr[k * 64 + ((4 * nq + e) ^ k)] = v[i][e]; }
    LDS_WAIT();
    const int c = lane & 7;
#pragma unroll
    for (int j = 0; j < 8; ++j) { const int n = (lane >> 3) + 8 * j; float s[8];
#pragma unroll
        for (int i = 0; i < 8; ++i) { const int k = 8 * c + i; s[i] = scr[k * 64 + (n ^ k)]; }
        const f32x4 sa = (f32x4){s[0], s[1], s[2], s[3]} * d.f8s, sb = (f32x4){s[4], s[5], s[6], s[7]} * d.f8s;
        o[j] = (u32x2){pg8::pk_fp8x4(sa), pg8::pk_fp8x4(sb)}; }
    LDS_WAIT();
}
__device__ __forceinline__ void tr_store8(const TDesc& d, int lane, const u32x2 (&o0)[8], const u32x2 (&o1)[8]) {
    const int c = lane & 7;
#pragma unroll
    for (int j = 0; j < 8; ++j) { const int n = (lane >> 3) + 8 * j; const int cc = d.cc0 + n, drow = d.cc0 >= 0 ? (128 * ((cc & 15) >> 3) + 8 * (cc >> 4) + (cc & 7)) : n;
        unsigned char* p = (unsigned char*)d.dst + (size_t)drow * d.K + 8 * c;
        __builtin_nontemporal_store(o0[j], (GAS u32x2*)p); __builtin_nontemporal_store(o1[j], (GAS u32x2*)(p + 64)); }
}
constexpr int IT_WIN = INP_F8 ? 1536 : 3072, IT_WO = AO_F8 ? 256 : 512, IT_WGLU = GLU_F8 ? 256 : 512, IT_WMIX = MIX_F8 ? 512 : 1024, IT_EXP = 64 * 128, IT_SH = 128, IT_EXPD = DOWN_F8 ? 64 * 128 : 64 * 256, IT_SHD = DOWN_F8 ? 128 : 256;
constexpr int IT_LAYER = IT_WIN + IT_WO + IT_WGLU + IT_WMIX + 2 * IT_EXP + IT_EXPD + 2 * IT_SH + IT_SHD;
constexpr int IT_MOD = 768;
constexpr int IT_TR = 2 * IT_LAYER;

__device__ __forceinline__ TDesc tr_desc(const float* W, int K, int N, bf16_t* WT, int kb, int nb, int drow0) {
    TDesc d; d.src = W + (size_t)(64 * kb) * N + 64 * nb; d.dst = WT + (size_t)drow0 * K + 64 * kb; d.N = N; d.K = K; d.cc0 = -1; d.f8s = 0.f; return d;
}
__device__ __forceinline__ TDesc tr_desc8(const float* W, int K, int N, unsigned char* WT, int kb, int nb, int drow0, float scale) {
    TDesc d; d.src = W + (size_t)(64 * kb) * N + 64 * nb; d.dst = (bf16_t*)(WT + (size_t)drow0 * K + 64 * kb); d.N = N; d.K = K; d.cc0 = -1; d.f8s = scale; return d;
}
__device__ __forceinline__ TDesc tr_decode(unsigned char* ws, int it) {
    const int l = 1 - it / IT_LAYER; int r = it % IT_LAYER;
    int which, K, N, kb, nb, drow0, cc0 = -1, es = 2; size_t soff, dbyte; float f8s = 0.f;
    if (r < IT_WIN) { which = I_WIN; soff = (size_t)l * 2048 * 6144; K = 2048; N = 6144; dbyte = WS_WIN + (size_t)l * 6144 * 2048 * (INP_F8 ? 1 : 2); kb = r / 96; nb = r % 96; drow0 = 64 * nb;
        if (INP_F8) { es = 1; f8s = pg8::WGU_SCALE; } }
    else if ((r -= IT_WIN) < IT_WO) { which = I_WO; soff = (size_t)l * 1024 * 2048; K = 1024; N = 2048; dbyte = WS_WO + (size_t)l * 2048 * 1024 * (AO_F8 ? 1 : 2); kb = r / 32; nb = r % 32; drow0 = 64 * nb; if (AO_F8) { es = 1; f8s = pg8::WGU_SCALE; } }
    else if ((r -= IT_WO) < IT_WGLU) { which = I_WGLU; soff = (size_t)l * 512 * 4096; K = 512; N = 4096; dbyte = WS_WGLU + (size_t)l * 4096 * 512 * (GLU_F8 ? 1 : 2); kb = r / 64; nb = r % 64; const int n0 = 64 * nb; if (GLU_F8) { es = 1; f8s = pg8::WGU_SCALE; }
        drow0 = n0 < 2048 ? 256 * (n0 / 128) + (n0 % 128) : 256 * ((n0 - 2048) / 128) + 128 + (n0 % 128); }
    else if ((r -= IT_WGLU) < IT_WMIX) { which = I_WMIX; soff = (size_t)l * 2048 * 2048; K = 2048; N = 2048; dbyte = WS_WMIX + (size_t)l * 2048 * 2048 * (MIX_F8 ? 1 : 2); kb = r / 32; nb = r % 32; drow0 = 64 * nb;
        if (MIX_F8) { es = 1; f8s = pg8::WGU_SCALE; } }
    else { r -= IT_WMIX;
        const size_t wgu = WS_WGU + (size_t)l * 65 * 1024 * 2048;
        constexpr int DES = DOWN_F8 ? 1 : 2; const size_t wd = WS_WD + (size_t)l * 65 * 2048 * 512 * DES;
        if (r < 2 * IT_EXP) { const int up = r >= IT_EXP; r -= up * IT_EXP; const int e = r / 128, q = r % 128; kb = q / 8; nb = q % 8; const int n0 = 64 * nb;
            which = up ? I_WEU : I_WEG; soff = ((size_t)l * 64 + e) * 2048 * 512; K = 2048; N = 512; dbyte = wgu + (size_t)e * 1024 * 2048; es = 1; f8s = pg8::WGU_SCALE; drow0 = 256 * (n0 / 128) + (n0 % 128) + 128 * up; }
        else if ((r -= 2 * IT_EXP) < IT_EXPD) { constexpr int QD = DOWN_F8 ? 128 : 256; const int e = r / QD, q = r % QD; kb = q / 32; nb = q % 32;
            which = I_WED; soff = ((size_t)l * 64 + e) * 512 * 2048; K = 512; N = 2048; dbyte = wd + (size_t)e * 2048 * 512 * DES; es = DES; f8s = DOWN_F8 ? pg8::WD_SCALE : 0.f; drow0 = 256 * (nb / 4); cc0 = 64 * (nb % 4); }
        else if ((r -= IT_EXPD) < 2 * IT_SH) { const int up = r >= IT_SH; r -= up * IT_SH; kb = r / 8; nb = r % 8; const int n0 = 64 * nb;
            which = up ? I_WSU : I_WSG; soff = (size_t)l * 2048 * 512; K = 2048; N = 512; dbyte = wgu + (size_t)64 * 1024 * 2048; es = 1; f8s = pg8::WGU_SCALE; drow0 = 256 * (n0 / 128) + (n0 % 128) + 128 * up; }
        else { r -= 2 * IT_SH; kb = r / 32; nb = r % 32;
            which = I_WSD; soff = (size_t)l * 512 * 2048; K = 512; N = 2048; dbyte = wd + (size_t)64 * 2048 * 512 * DES; es = DES; f8s = DOWN_F8 ? pg8::WD_SCALE : 0.f; drow0 = 256 * (nb / 4); cc0 = 64 * (nb % 4); } }
    const int kr = f8s != 0.f ? 128 : 64;
    TDesc d; d.src = arg_in(which) + soff + (size_t)(kr * kb) * N + 64 * nb; d.dst = (bf16_t*)(ws + dbyte + ((size_t)drow0 * K + kr * kb) * es); d.N = N; d.K = K; d.cc0 = cc0; d.f8s = f8s; return d;
}
__device__ __forceinline__ void mod_item(const Args& a, int it, int tid, LAS unsigned char* lds) {
    const int lane = tid & 63, wave = tid >> 6;
    const int l = it / 384, r = it % 384, ks = r / 48, cc = r % 48;
    const float* W = a.in[I_WADA] + (size_t)l * 2048 * 12288 + (size_t)(256 * ks + 32 * wave) * 12288 + 256 * cc + 4 * lane;
    const float* c0 = a.in[I_C] + 256 * ks + 32 * wave, *c1 = c0 + 2048;
    f32x4 a0 = {0.f, 0.f, 0.f, 0.f}, a1 = {0.f, 0.f, 0.f, 0.f};
#pragma unroll 1
    for (int h = 0; h < 2; ++h) { f32x4 w[16]; const GAS float* wp = (const GAS float*)W + (size_t)(16 * h) * 12288;
#pragma unroll
        for (int i = 0; i < 16; ++i) { w[i] = __builtin_nontemporal_load((const GAS f32x4*)wp); wp += 12288; }
#pragma unroll
        for (int i = 0; i < 16; ++i) { const float x0 = c0[16 * h + i], x1 = c1[16 * h + i]; const float s0 = x0 * fast_sigmoid(x0), s1 = x1 * fast_sigmoid(x1); a0 += w[i] * s0; a1 += w[i] * s1; } }
    LAS f32x4* red = (LAS f32x4*)lds;
    red[(wave * 2 + 0) * 64 + lane] = a0; red[(wave * 2 + 1) * 64 + lane] = a1;
    __syncthreads();
    { const int b = tid >> 8, col = tid & 255; LAS float* rf = (LAS float*)lds; float s = 0.f;
#pragma unroll
        for (int w8 = 0; w8 < 8; ++w8) s += rf[((w8 * 2 + b) * 64) * 4 + col];
        ((float*)(a.ws + WS_MODP))[((size_t)(ks * 2 + l) * 2 + b) * 12288 + 256 * cc + col] = s; }
    __syncthreads();
}
__device__ __forceinline__ void p0_items(const Args& a, int gw, int ngw, LAS float* scr, int lane) {
#pragma unroll 1
    for (int it = gw; it < IT_TR; it += ngw) { f32x4 v[16]; const TDesc d = tr_decode(a.ws, it);
        if (d.f8s != 0.f) { u32x2 o0[8], o1[8]; f32x4 w[16]; TDesc d2 = d; d2.src += (size_t)64 * d.N; tr_load(d, lane, v); tr_load(d2, lane, w);
            tr_half8(d, lane, scr, v, o0); tr_half8(d, lane, scr, w, o1); tr_store8(d, lane, o0, o1); }
        else { tr_load(d, lane, v); tr_finish(d, lane, scr, v); } }
}

__device__ __forceinline__ void cpow(float are, float aim, float dt, int n, float& pr, float& pi) {
    const float mag = __builtin_amdgcn_exp2f((float)n * dt * are * LOG2E);
    const double turns = (double)n * ((double)dt * (double)aim * 0.15915494309189535);
    const float fr = (float)(turns - __builtin_rint(turns));
    pr = mag * __builtin_amdgcn_cosf(fr); pi = mag * __builtin_amdgcn_sinf(fr);
}
__device__ __forceinline__ void ssm_tables(const Args& a, int l, int g, LAS unsigned char* lds, int tid) {
    LAS f32x2* Apow = (LAS f32x2*)lds;
    LAS f32x2* Bb = (LAS f32x2*)(lds + 65 * 64 * 8);
    LAS f32x2* Cc = (LAS f32x2*)(lds + 65 * 64 * 8 + 64 * 16 * 8);
    const int lg = l * 32 + g;
    const float* are_p = a.in[I_ARE] + lg * 64; const float* aim_p = a.in[I_AIM] + lg * 64;
    const float dt = __expf(a.in[I_LDT][lg]);
    unsigned char* tb = a.ws + WS_SSM + (size_t)lg * SSM_STRIDE;
    bf16_t* Et = (bf16_t*)(tb + SSM_E); bf16_t* Ft = (bf16_t*)(tb + SSM_F); bf16_t* Kt = (bf16_t*)(tb + SSM_KT); GAS f32x2* Pt = (GAS f32x2*)(tb + SSM_P);
    for (int idx = tid; idx < 65 * 64; idx += 512) { const int n = idx >> 6, p = idx & 63; float pr, pi; cpow(are_p[p], aim_p[p], dt, n, pr, pi); Apow[idx] = (f32x2){pr, pi}; }
    for (int idx = tid; idx < 64 * 64; idx += 512) { const int m = idx >> 6, p = idx & 63; float pr, pi; cpow(are_p[p], aim_p[p], dt, 64 * m, pr, pi); Pt[idx] = (f32x2){pr, pi}; }
    for (int idx = tid; idx < 64 * 16; idx += 512) { const int p = idx >> 4, c = idx & 15;
        const float ar = are_p[p], ai = aim_p[p]; float br, bi; cpow(ar, ai, dt, 1, br, bi);
        const float nr = br - 1.0f, ni = bi, den = ar * ar + ai * ai; const float fr = (nr * ar + ni * ai) / den, fi = (ni * ar - nr * ai) / den;
        const float b_r = a.in[I_BRE][(size_t)lg * 1024 + idx], b_i = a.in[I_BIM][(size_t)lg * 1024 + idx];
        Bb[idx] = (f32x2){fr * b_r - fi * b_i, fr * b_i + fi * b_r}; }
    for (int idx = tid; idx < 16 * 64; idx += 512) Cc[idx] = (f32x2){a.in[I_CRE][(size_t)lg * 1024 + idx], a.in[I_CIM][(size_t)lg * 1024 + idx]};
    __syncthreads();
    for (int idx = tid; idx < 128 * 128; idx += 512) { const int n = idx >> 7, k8 = idx & 127, ri = n >> 6, p = n & 63, s = k8 >> 1, c0 = (k8 & 1) * 8;
        const f32x2 ap = Apow[(63 - s) * 64 + p]; float v[8];
#pragma unroll
        for (int j = 0; j < 8; ++j) { const f32x2 b = Bb[p * 16 + c0 + j]; v[j] = ri ? (ap.x * b.y + ap.y * b.x) : (ap.x * b.x - ap.y * b.y); }
        u32x4 o; o.x = cvt_pk_bf16(v[0], v[1]); o.y = cvt_pk_bf16(v[2], v[3]); o.z = cvt_pk_bf16(v[4], v[5]); o.w = cvt_pk_bf16(v[6], v[7]);
        *(GAS u32x4*)(Et + (size_t)n * 1024 + k8 * 8) = o; }
    for (int idx = tid; idx < 1024 * 16; idx += 512) { const int n = idx >> 4, k8 = idx & 15, t = n >> 4, c = n & 15, ri = k8 >> 3, p0 = (k8 & 7) * 8; float v[8];
#pragma unroll
        for (int j = 0; j < 8; ++j) { const f32x2 ap = Apow[(t + 1) * 64 + p0 + j], cc = Cc[c * 64 + p0 + j]; v[j] = ri ? -(cc.x * ap.y + cc.y * ap.x) : (cc.x * ap.x - cc.y * ap.y); }
        u32x4 o; o.x = cvt_pk_bf16(v[0], v[1]); o.y = cvt_pk_bf16(v[2], v[3]); o.z = cvt_pk_bf16(v[4], v[5]); o.w = cvt_pk_bf16(v[6], v[7]);
        *(GAS u32x4*)(Ft + (size_t)n * 128 + k8 * 8) = o; }
    for (int idx = tid; idx < 65 * 16 * 2; idx += 512) { const int t1 = idx >> 5, c = (idx >> 1) & 15, c0 = (idx & 1) * 8; float v[8];
#pragma unroll
        for (int j = 0; j < 8; ++j) v[j] = 0.f;
        if (t1 > 0) for (int p = 0; p < 64; ++p) { const f32x2 ap = Apow[(t1 - 1) * 64 + p], cc = Cc[c * 64 + p]; const float cr = cc.x * ap.x - cc.y * ap.y, ci = cc.x * ap.y + cc.y * ap.x;
#pragma unroll
            for (int j = 0; j < 8; ++j) { const f32x2 b = Bb[p * 16 + c0 + j]; v[j] += cr * b.x - ci * b.y; } }
        u32x4 o; o.x = cvt_pk_bf16(v[0], v[1]); o.y = cvt_pk_bf16(v[2], v[3]); o.z = cvt_pk_bf16(v[4], v[5]); o.w = cvt_pk_bf16(v[6], v[7]);
        *(GAS u32x4*)(Kt + (size_t)(t1 * 16 + c) * 16 + c0) = o; }
    __syncthreads();
}

__device__ __forceinline__ void attn_unit(const bf16_t* __restrict__ proj, bf16_t* __restrict__ attn, const float* sinks, int unit, LAS unsigned char* lds, int tid_) {
    const int tid = opaque(tid_);
    const int b = unit >> 7, hk = (unit >> 5) & 3, nb = unit & 31;
    const int wave = __builtin_amdgcn_readfirstlane(tid >> 6), lane = tid & 63, r16 = lane & 15, q4 = lane >> 4;
    LAS unsigned char* Kl = lds;
    LAS unsigned char* Vt = lds + 36864;
    const int gh0 = wave >> 1, half0 = wave & 1, qh0 = hk * 4 + gh0;
    bf16x8 qfa[4][2];
#pragma unroll
    for (int pass = 0; pass < 4; ++pass)
#pragma unroll
        for (int s = 0; s < 2; ++s) qfa[pass][s] = *(const GAS bf16x8*)(proj + (size_t)(b * SEQ + nb * 128 + 16 * (half0 * 4 + pass) + r16) * INW + O_Q + qh0 * 64 + 32 * s + 8 * q4);
#pragma unroll
    for (int i = 0; i < 4; ++i) { const int id = tid + 512 * i, key = id >> 3, ch = id & 7; const int tp = nb * 128 - 128 + key;
        u32x4 kv = {0u, 0u, 0u, 0u}, vv = {0u, 0u, 0u, 0u};
        if (tp >= 0) { const bf16_t* src = proj + (size_t)(b * SEQ + tp) * INW + hk * 64 + ch * 8; kv = *(const GAS u32x4*)(src + O_K); vv = *(const GAS u32x4*)(src + O_V); }
        *(LAS u32x4*)(Kl + key * 144 + ch * 16) = kv;
        LAS bf16_t* vd = (LAS bf16_t*)(Vt + (ch * 8) * 528 + key * 2);
        vd[0 * 264] = (bf16_t)(vv.x & 0xffff); vd[1 * 264] = (bf16_t)(vv.x >> 16); vd[2 * 264] = (bf16_t)(vv.y & 0xffff); vd[3 * 264] = (bf16_t)(vv.y >> 16);
        vd[4 * 264] = (bf16_t)(vv.z & 0xffff); vd[5 * 264] = (bf16_t)(vv.z >> 16); vd[6 * 264] = (bf16_t)(vv.w & 0xffff); vd[7 * 264] = (bf16_t)(vv.w >> 16); }
    __syncthreads();
    const int gh = wave >> 1, half = wave & 1, qh = hk * 4 + gh;
    const float sink = sinks[qh] * LOG2E;
#pragma unroll
    for (int pass = 0; pass < 4; ++pass) {
        const int kt0 = half * 4 + pass, i0 = 16 * kt0, iabs = i0 + r16; const size_t qtok = (size_t)(b * SEQ + nb * 128 + iabs);
        bf16x8 qf[2];
#pragma unroll
        for (int s = 0; s < 2; ++s) qf[s] = qfa[pass][s];
        __builtin_amdgcn_sched_barrier(0);
        f32x4 st[10];
        const LAS unsigned char* kbase = Kl + (16 * kt0 + r16) * 144 + (8 * q4) * 2;
#pragma unroll
        for (int i = 0; i < 9; ++i) { st[i] = (f32x4){0.f, 0.f, 0.f, 0.f};
#pragma unroll
            for (int s = 0; s < 2; ++s) { const bf16x8 kf = *(const LAS bf16x8*)(kbase + i * 16 * 144 + s * 64);
                st[i] = __builtin_amdgcn_mfma_f32_16x16x32_bf16(kf, qf[s], st[i], 0, 0, 0); } }
        st[9] = (f32x4){0.f, 0.f, 0.f, 0.f};
        float mx = sink;
#pragma unroll
        for (int i = 0; i < 9; ++i)
#pragma unroll
            for (int r = 0; r < 4; ++r) { const int jj = 16 * i + 4 * q4 + r; const bool ok = (jj > r16) && (jj <= r16 + 128) && (nb > 0 || jj + i0 >= 128);
                st[i][r] = ok ? st[i][r] : -1e30f; mx = fmaxf(mx, st[i][r]); }
        const int ll = lane_now();
        mx = fmaxf(mx, shx(mx, 16, ll)); mx = fmaxf(mx, shx(mx, 32, ll));
        float sum = 0.f;
#pragma unroll
        for (int i = 0; i < 9; ++i)
#pragma unroll
            for (int r = 0; r < 4; ++r) { const float p = __builtin_amdgcn_exp2f(st[i][r] - mx); st[i][r] = p; sum += p; }
        sum += shx(sum, 16, ll); sum += shx(sum, 32, ll);
        const float inv = __builtin_amdgcn_rcpf(sum + __builtin_amdgcn_exp2f(sink - mx));
        f32x4 ot[4];
#pragma unroll
        for (int dt = 0; dt < 4; ++dt) ot[dt] = (f32x4){0.f, 0.f, 0.f, 0.f};
#pragma unroll
        for (int kk = 0; kk < 5; ++kk) {
            u32x4 pw; pw.x = cvt_pk_bf16(st[2 * kk][0], st[2 * kk][1]); pw.y = cvt_pk_bf16(st[2 * kk][2], st[2 * kk][3]); pw.z = cvt_pk_bf16(st[2 * kk + 1][0], st[2 * kk + 1][1]); pw.w = cvt_pk_bf16(st[2 * kk + 1][2], st[2 * kk + 1][3]);
            const bf16x8 pf = __builtin_bit_cast(bf16x8, pw);
            const int t0 = kt0 + 2 * kk, t1 = (t0 + 1) < 15 ? (t0 + 1) : 15;
#pragma unroll
            for (int dt = 0; dt < 4; ++dt) { const LAS unsigned char* vp = Vt + (16 * dt + r16) * 528 + (4 * q4) * 2;
                const u32x2 lo = *(const LAS u32x2*)(vp + t0 * 32), hi = *(const LAS u32x2*)(vp + t1 * 32);
                const u32x4 vw = {lo.x, lo.y, hi.x, hi.y};
                ot[dt] = __builtin_amdgcn_mfma_f32_16x16x32_bf16(__builtin_bit_cast(bf16x8, vw), pf, ot[dt], 0, 0, 0); } }
#pragma unroll
        for (int dt = 0; dt < 4; ++dt) {
            if (AO_F8) *(GAS unsigned*)((unsigned char*)attn + qtok * 1024 + qh * 64 + 16 * dt + 4 * q4) = pg8::pk_fp8x4(ot[dt] * inv);
            else { u32x2 o; o.x = cvt_pk_bf16(ot[dt][0] * inv, ot[dt][1] * inv); o.y = cvt_pk_bf16(ot[dt][2] * inv, ot[dt][3] * inv);
                *(GAS u32x2*)(attn + qtok * 1024 + qh * 64 + 16 * dt + 4 * q4) = o; } }
    }
    __syncthreads();
}

constexpr int UPITCH = 2064;
__device__ __forceinline__ void stage_u_issue(const bf16_t* __restrict__ proj, int g, int b, int q, int tid, u32x4 (&uu)[4]) {
#pragma unroll
    for (int i = 0; i < 4; ++i) { const int id = tid + 512 * i, tl = id >> 1, half = id & 1, chunk = tl >> 6, s = tl & 63;
        uu[i] = *(const GAS u32x4*)(proj + (size_t)(b * SEQ + (16 * q + chunk) * 64 + s) * INW + O_U + g * 16 + 8 * half); }
}
__device__ __forceinline__ void stage_u_commit(LAS unsigned char* Al, int tid, u32x4 (&uu)[4]) {
    asm volatile("" : "+v"(uu[0]), "+v"(uu[1]), "+v"(uu[2]), "+v"(uu[3]) :: "memory");
#pragma unroll
    for (int i = 0; i < 4; ++i) { const int id = tid + 512 * i, tl = id >> 1, half = id & 1, chunk = tl >> 6, s = tl & 63;
        *(LAS u32x4*)(Al + chunk * UPITCH + (s * 16 + 8 * half) * 2) = uu[i]; }
}
__device__ __forceinline__ void ssm_s1_unit(const bf16_t* __restrict__ proj, const bf16_t* __restrict__ Et, float* __restrict__ sloc, int g, int b, int q, LAS unsigned char* lds, int tid_) {
    const int tid = opaque(tid_);
    const int wave = __builtin_amdgcn_readfirstlane(tid >> 6), lane = tid & 63, r16 = lane & 15, q4 = lane >> 4;
    const bf16_t* eb = Et + (size_t)(16 * wave + r16) * 1024 + 8 * q4;
    u32x4 uu[4]; stage_u_issue(proj, g, b, q, tid, uu);
    bf16x8 bf[32];
#pragma unroll
    for (int ks = 0; ks < 32; ++ks) bf[ks] = *(const GAS bf16x8*)(eb + 32 * ks);
    stage_u_commit(lds, tid, uu);
    __syncthreads();
    f32x4 acc = {0.f, 0.f, 0.f, 0.f};
#pragma unroll
    for (int ks = 0; ks < 32; ++ks) { const bf16x8 af = *(const LAS bf16x8*)(lds + r16 * UPITCH + (32 * ks + 8 * q4) * 2);
        acc = __builtin_amdgcn_mfma_f32_16x16x32_bf16(af, bf[ks], acc, 0, 0, 0); }
#pragma unroll
    for (int r = 0; r < 4; ++r) sloc[((size_t)(b * 64 + 16 * q + 4 * q4 + r) * 32 + g) * 128 + 16 * wave + r16] = acc[r];
    __syncthreads();
}

__device__ __forceinline__ void ssm_s2_unit(const bf16_t* __restrict__ proj, const unsigned char* __restrict__ tb, const float* __restrict__ sloc, const float* __restrict__ dskip, bf16_t* __restrict__ ybuf,
                                            int g, int b, int q, LAS unsigned char* lds, int tid_, int nostore = 0) {
    const int tid = opaque(tid_);
    const int wave = __builtin_amdgcn_readfirstlane(tid >> 6), lane = tid & 63, r16 = lane & 15, q4 = lane >> 4;
    LAS unsigned char* Ktl = lds;
    LAS bf16_t* x0l = (LAS bf16_t*)(lds + 33280);
    LAS unsigned char* Al = lds + 49152;
    const bf16_t* Ft = (const bf16_t*)(tb + SSM_F); const GAS f32x2* Pt = (const GAS f32x2*)(tb + SSM_P);
    const int p = tid & 63, part = tid >> 6, j0 = 16 * q;
    f32x2 Pp[6]; float srp[6], sip[6];
#pragma unroll
    for (int ii = 0; ii < 6; ++ii) { const int i = part + 8 * ii; const bool ok = i < j0; const int ic = ok ? i : 0, pc = ok ? (j0 - 1 - i) : 0;
        Pp[ii] = Pt[pc * 64 + p]; const GAS float* sp = (const GAS float*)(sloc + ((size_t)(b * 64 + ic) * 32 + g) * 128); srp[ii] = sp[p]; sip[ii] = sp[64 + p]; }
    u32x4 kt[5];
    { const GAS u32x4* src = (const GAS u32x4*)(tb + SSM_KT);
#pragma unroll
      for (int j = 0; j < 5; ++j) { const int i = tid + 512 * j; kt[j] = src[i < 33280 / 16 ? i : 33280 / 16 - 1]; } }
    u32x4 uu[4]; stage_u_issue(proj, g, b, q, tid, uu);
    const f32x2 A64 = Pt[64 + p];
    float sr[15], si[15];
#pragma unroll
    for (int jq = 0; jq < 15; ++jq) { const GAS float* sp = (const GAS float*)(sloc + ((size_t)(b * 64 + j0 + jq) * 32 + g) * 128); sr[jq] = sp[p]; si[jq] = sp[64 + p]; }
    {
        LAS f32x2* red = (LAS f32x2*)(lds + 40960);
        asm volatile("" : "+v"(Pp[0]), "+v"(Pp[1]), "+v"(Pp[2]), "+v"(Pp[3]), "+v"(Pp[4]), "+v"(Pp[5]) :: "memory");
        asm volatile("" : "+v"(srp[0]), "+v"(srp[1]), "+v"(srp[2]), "+v"(srp[3]), "+v"(srp[4]), "+v"(srp[5]), "+v"(sip[0]), "+v"(sip[1]), "+v"(sip[2]), "+v"(sip[3]), "+v"(sip[4]), "+v"(sip[5]) :: "memory");
        float xr = 0.f, xi = 0.f;
#pragma unroll
        for (int ii = 0; ii < 6; ++ii) { const bool ok = part + 8 * ii < j0; const float pr = ok ? Pp[ii].x : 0.f, pi = ok ? Pp[ii].y : 0.f;
            xr += pr * srp[ii] - pi * sip[ii]; xi += pr * sip[ii] + pi * srp[ii]; }
        red[part * 64 + p] = (f32x2){xr, xi};
        asm volatile("" : "+v"(kt[0]), "+v"(kt[1]), "+v"(kt[2]), "+v"(kt[3]), "+v"(kt[4]) :: "memory");
#pragma unroll
        for (int j = 0; j < 5; ++j) { const int i = tid + 512 * j; if (i < 33280 / 16) *(LAS u32x4*)(Ktl + i * 16) = kt[j]; }
        stage_u_commit(Al, tid, uu);
        __syncthreads();
        if (part == 0) {
            float ar = 0.f, ai = 0.f;
#pragma unroll
            for (int w8 = 0; w8 < 8; ++w8) { const f32x2 t = red[w8 * 64 + p]; ar += t.x; ai += t.y; }
#pragma unroll
            for (int jq = 0; jq < 16; ++jq) {
                x0l[jq * 136 + p] = (bf16_t)(cvt_pk_bf16(ar, 0.f) & 0xffff); x0l[jq * 136 + 64 + p] = (bf16_t)(cvt_pk_bf16(ai, 0.f) & 0xffff);
                if (jq < 15) { const float nr = A64.x * ar - A64.y * ai + sr[jq], ni = A64.x * ai + A64.y * ar + si[jq]; ar = nr; ai = ni; } }
        }
    }
    __syncthreads();
    f32x4 acc[8];
#pragma unroll
    for (int tt = 0; tt < 8; ++tt) acc[tt] = (f32x4){0.f, 0.f, 0.f, 0.f};
    auto ldk = [&](int ks, bf16x8& af, bf16x8 (&bf)[8]) {
        const int s = 2 * ks + (q4 >> 1);
        af = *(const LAS bf16x8*)(Al + r16 * UPITCH + (32 * ks + 8 * q4) * 2);
#pragma unroll
        for (int tt = 0; tt < 8; ++tt) { const int t = wave + 8 * tt; const int tau1 = t - s + 1, tc = tau1 > 0 ? tau1 : 0;
            bf[tt] = *(const LAS bf16x8*)(Ktl + ((tc * 16 + r16) * 16 + 8 * (q4 & 1)) * 2); } };
    auto mmk = [&](const bf16x8& af, const bf16x8 (&bf)[8]) {
#pragma unroll
        for (int tt = 0; tt < 8; ++tt) acc[tt] = __builtin_amdgcn_mfma_f32_16x16x32_bf16(af, bf[tt], acc[tt], 0, 0, 0); };
    {
        bf16x8 afA, afB, bfA[8], bfB[8];
        ldk(0, afA, bfA);
#pragma unroll 1
        for (int ks = 0; ks < 24; ks += 2) {
            ldk(ks + 1, afB, bfB); __builtin_amdgcn_sched_barrier(0); mmk(afA, bfA); __builtin_amdgcn_sched_barrier(0);
            ldk(ks + 2, afA, bfA); __builtin_amdgcn_sched_barrier(0); mmk(afB, bfB); __builtin_amdgcn_sched_barrier(0); }
    }
    bf16x8 ff[4][8];
#pragma unroll
    for (int k2 = 0; k2 < 4; ++k2)
#pragma unroll
        for (int tt = 0; tt < 8; ++tt) ff[k2][tt] = *(const GAS bf16x8*)(Ft + (size_t)((wave + 8 * tt) * 16 + r16) * 128 + 32 * k2 + 8 * q4);
#pragma unroll 2
    for (int ks = 24; ks < 32; ++ks) { bf16x8 af, bf[8]; ldk(ks, af, bf); mmk(af, bf); __builtin_amdgcn_sched_barrier(0); }
#pragma unroll
    for (int k2 = 0; k2 < 4; ++k2) { const bf16x8 ax = *(const LAS bf16x8*)(x0l + r16 * 136 + 32 * k2 + 8 * q4);
#pragma unroll
        for (int tt = 0; tt < 8; ++tt) acc[tt] = __builtin_amdgcn_mfma_f32_16x16x32_bf16(ax, ff[k2][tt], acc[tt], 0, 0, 0); }
    const float dsk = dskip[g * 16 + r16];
#pragma unroll
    for (int tt = 0; tt < 8; ++tt) { const int t = wave + 8 * tt;
#pragma unroll
        for (int r = 0; r < 4; ++r) { const int jq = 4 * q4 + r; const size_t tok = (size_t)(b * SEQ + (16 * q + jq) * 64 + t);
            const float uv = bf1(*(const LAS bf16_t*)(Al + jq * UPITCH + (t * 16 + r16) * 2)); const float y = acc[tt][r] + dsk * uv;
            const float z = 0.7978845608028654f * (y + 0.044715f * y * y * y); const float gl = y * fast_sigmoid(2.0f * z);
            if (!nostore) { if (GLU_F8) ((unsigned char*)ybuf)[tok * 512 + g * 16 + r16] = (unsigned char)(__builtin_amdgcn_cvt_pk_fp8_f32(gl, 0.f, 0, false) & 0xff);
                            else ybuf[tok * 512 + g * 16 + r16] = (bf16_t)(cvt_pk_bf16(gl, 0.f) & 0xffff); } } }
    __syncthreads();
}

__device__ __forceinline__ unsigned char* opaque_p(unsigned char* p) { asm volatile("" : "+s"(p)); return p; }
__device__ __forceinline__ int opaque_si(int v) { asm volatile("" : "+s"(v)); return v; }
__device__ __forceinline__ Args load_args() {
#if defined(__HIP_DEVICE_COMPILE__)
    KArgs* p = (KArgs*)__builtin_amdgcn_kernarg_segment_ptr(); asm volatile("" : "+s"(p)); Args a;
#pragma unroll
    for (int i = 0; i < 29; ++i) a.in[i] = p->in[i];
    a.out = p->out; a.ws = p->ws; a.ph_lo = p->ph_lo; a.ph_hi = p->ph_hi; return a;
#else
    return Args{};
#endif
}
#define PH_BEGIN const unsigned long long ph_t0 = (TIME_MASK) ? __builtin_amdgcn_s_memtime() : 0ull; (void)ph_t0; const Args args = load_args(); const int G = opaque_si(G_k), blk = opaque_si(blk_k); const int wave = opaque_si(wave_k); const int tid = opaque(lane_now() + 64 * wave), lane = tid & 63; unsigned char* const ws = opaque_p(args.ws); (void)lane; (void)wave; \
    bf16_t* const hbuf = (bf16_t*)(ws + WS_H); bf16_t* const proj = (bf16_t*)(ws + WS_PROJ); float* const mod = (float*)(ws + WS_MOD); float* const xbuf = args.out; unsigned* const ctl = (unsigned*)(ws + WS_CTL); \
    (void)hbuf; (void)proj; (void)mod; (void)xbuf; (void)ctl;

__global__ void __launch_bounds__(NWAVES * 64, 2) mega_fwd(Args args) {
    extern __shared__ __attribute__((aligned(16))) unsigned char lds_raw[];
    LAS unsigned char* lds = (LAS unsigned char*)lds_raw;
    const int wave_k = __builtin_amdgcn_readfirstlane((int)threadIdx.x >> 6);
    const int G_k = gridDim.x, blk_k = blockIdx.x;
    XcdBarrier bar;
    {
        volatile LAS unsigned* MISC = (volatile LAS unsigned*)(lds + MISC_OFF);
        unsigned* ctl0 = (unsigned*)(args.ws + WS_CTL);
        for (int u = threadIdx.x; u < (LDS_BYTES - LDSCTL_OFF) / 4; u += NWAVES * 64) ((LAS unsigned*)(lds + LDSCTL_OFF))[u] = 0u;
        __syncthreads();
        bar.bar = ctl0 + CW_BAR; bar.x = 0; bar.st = nullptr; bar.wv = wave_k;
        if (N_LAUNCHES == 1) bar = xcd_barrier_post(ctl0 + CW_BAR, MISC + 8);
    }
#define GRID_BAR() do { if (N_LAUNCHES == 1) xcd_barrier(bar); } while (0)
    const int lo = args.ph_lo, hi = args.ph_hi;
#ifndef PH_MASK
#define PH_MASK 0x7ff
#endif
#ifndef REP_MASK
#define REP_MASK 0
#endif
#ifndef REP_VARIANT
#define REP_VARIANT 0
#endif
#define REPS(bit) (((REP_MASK) >> (bit)) & 1 ? 2 : 1)
#ifndef TIME_MASK
#define TIME_MASK 0
#endif
#define PH_END(bit) if ((TIME_MASK >> (bit)) & 1) { asm volatile("s_waitcnt vmcnt(0) lgkmcnt(0)" ::: "memory"); const unsigned long long t1_ = __builtin_amdgcn_s_memtime(); \
    while (__builtin_amdgcn_s_memtime() - t1_ < t1_ - ph_t0) __builtin_amdgcn_s_sleep(8); }
#define IN(k) (lo <= (k) && (k) < hi)
#define BOTH(k) (IN(k) && IN((k) + 1))

    if ((PH_MASK & 1) && IN(0)) {
        PH_BEGIN
            _Pragma("unroll 1") for (int rep = 0; rep < REPS(9); ++rep) {
        if (blk < 64) ssm_tables(args, blk >> 5, blk & 31, lds, tid);
        LAS float* scr = (LAS float*)(lds + wave * 16384);
        for (int idx = blk * 512 + tid; idx < 2 * 64 * 256; idx += G * 512) {
            const int e = idx & 63, kc = (idx >> 6) & 255, l = idx >> 14; const float* wsrc = args.in[I_WR] + (size_t)l * D * NE + (size_t)(8 * kc) * NE + e;
            float w[8], lo[8]; unsigned hi[4];
#pragma unroll
            for (int i = 0; i < 8; ++i) w[i] = wsrc[i * NE];
#pragma unroll
            for (int i = 0; i < 4; ++i) { hi[i] = cvt_pk_bf16(w[2 * i], w[2 * i + 1]); lo[2 * i] = w[2 * i] - bf_lo(hi[i]); lo[2 * i + 1] = w[2 * i + 1] - bf_hi(hi[i]); }
            bf16_t* dsth = (bf16_t*)(ws + WS_WRT) + ((size_t)(l * 2) * 64 + e) * 2048 + 8 * kc;
            *(GAS u32x4*)dsth = (u32x4){hi[0], hi[1], hi[2], hi[3]};
            *(GAS u32x4*)(dsth + 64 * 2048) = (u32x4){cvt_pk_bf16(lo[0], lo[1]), cvt_pk_bf16(lo[2], lo[3]), cvt_pk_bf16(lo[4], lo[5]), cvt_pk_bf16(lo[6], lo[7])}; }
        for (int it = blk; it < IT_MOD; it += G) mod_item(args, it, tid, lds);
        p0_items(args, blk * NWAVES + wave, G * NWAVES, scr, lane);
            if (rep + 1 < REPS(9)) GRID_BAR(); }
        PH_END(9) if (BOTH(0)) GRID_BAR();
    }
    if ((PH_MASK & 2) && IN(1)) {
        PH_BEGIN
        const float* modp = (const float*)(ws + WS_MODP);
        for (int idx = blk * 512 + tid; idx < 2 * 2 * 12288; idx += G * 512) { const int l = idx / 24576, c = idx % 12288; float s = args.in[I_BADA][l * 12288 + c];
#pragma unroll
            for (int ks = 0; ks < 8; ++ks) s += modp[(size_t)ks * 49152 + idx];
            mod[idx] = s; }
        for (int rb = blk; rb < T / 32; rb += G) {
            const int bb = (rb * 32) / SEQ;
            LAS float* shl = (LAS float*)lds; LAS float* scl = shl + 2048;
            {
                float p[8][9], gq[4];
#pragma unroll
                for (int i = 0; i < 8; ++i) { const int c = tid + 512 * i; p[i][0] = ((const GAS float*)args.in[I_BADA])[c];
#pragma unroll
                    for (int ks = 0; ks < 8; ++ks) p[i][1 + ks] = ((const GAS float*)modp)[(size_t)ks * 49152 + bb * 12288 + c]; }
#pragma unroll
                for (int i = 0; i < 4; ++i) gq[i] = ((const GAS float*)args.in[I_NMIX])[tid + 512 * i];
#pragma unroll
                for (int i = 0; i < 8; ++i) asm volatile("" : "+v"(p[i][0]), "+v"(p[i][1]), "+v"(p[i][2]), "+v"(p[i][3]), "+v"(p[i][4]), "+v"(p[i][5]), "+v"(p[i][6]), "+v"(p[i][7]), "+v"(p[i][8]) :: "memory");
                asm volatile("" : "+v"(gq[0]), "+v"(gq[1]), "+v"(gq[2]), "+v"(gq[3]) :: "memory");
#pragma unroll
                for (int i = 0; i < 8; ++i) { float s = p[i][0];
#pragma unroll
                    for (int ks = 0; ks < 8; ++ks) s += p[i][1 + ks];
                    if (i < 4) shl[tid + 512 * i] = s; else scl[tid + 512 * (i - 4)] = gq[i - 4] * (s + 1.0f); }
            }
            __syncthreads();
#pragma unroll 1
            for (int pr = 0; pr < 2; ++pr) {
                f32x4 v[2][4][2]; float ss[2] = {0.f, 0.f};
#pragma unroll
                for (int rr = 0; rr < 2; ++rr) { const float* xr = args.in[I_X] + (size_t)(rb * 32 + wave * 4 + pr * 2 + rr) * D;
#pragma unroll
                    for (int j = 0; j < 4; ++j)
#pragma unroll
                        for (int h = 0; h < 2; ++h) v[rr][j][h] = *(const GAS f32x4*)(xr + 8 * (lane + 64 * j) + 4 * h); }
#pragma unroll
                for (int rr = 0; rr < 2; ++rr)
#pragma unroll
                    for (int j = 0; j < 4; ++j)
#pragma unroll
                        for (int h = 0; h < 2; ++h) ss[rr] += v[rr][j][h][0] * v[rr][j][h][0] + v[rr][j][h][1] * v[rr][j][h][1] + v[rr][j][h][2] * v[rr][j][h][2] + v[rr][j][h][3] * v[rr][j][h][3];
#pragma unroll
                for (int rr = 0; rr < 2; ++rr) { const int row = rb * 32 + wave * 4 + pr * 2 + rr;
                    const float rstd = 1.0f / sqrtf(wave_sum(ss[rr]) * (1.0f / D) + NORM_EPS);
                    bf16_t* hrow = hbuf + (size_t)row * D;
#pragma unroll
                    for (int j = 0; j < 4; ++j) { const int c = 8 * (lane + 64 * j); f32x4 o[2];
#pragma unroll
                        for (int h = 0; h < 2; ++h) { const f32x4 s1 = *(const LAS f32x4*)(scl + c + 4 * h), s0 = *(const LAS f32x4*)(shl + c + 4 * h);
                            o[h] = v[rr][j][h] * rstd * s1 + s0; }
                        if (INP_F8) *(GAS u32x2*)((unsigned char*)hbuf + (size_t)row * D + c) = (u32x2){pg8::pk_fp8x4(o[0]), pg8::pk_fp8x4(o[1])};
                        else *(GAS u32x4*)(hrow + c) = pg8::pack8(o[0], o[1]); } } }
            __syncthreads();
        }
        PH_END(10) if (BOTH(1)) GRID_BAR();
    }

#pragma unroll 1
    for (int l = 0; l < DEPTH; ++l) {
        const int pb = 2 + 9 * l;
        if ((PH_MASK & 4) && IN(pb + 0)) {
            PH_BEGIN
            _Pragma("unroll 1") for (int rep = 0; rep < REPS(0); ++rep) {
            pg8::DenseOrder S; S.init(T, INW, INP_F8 ? D / 2 : D, G, blk, ws + WS_WIN + (size_t)l * INW * D * (INP_F8 ? 1 : 2));
            pg8::EpiInProj E{proj, args.in[I_BIN] + l * INW, 0.125f * LOG2E, (REP_VARIANT && rep == 1) ? 1 : 0};
            pg8::gemm_phase<pg8::EpiInProj, pg8::DenseOrder, GEMM_ALIGN, GEMM_SP2, INP_F8 != 0>(lds, (const char*)hbuf, INP_F8 ? D / 2 : D, S, E, wave);
            if (rep + 1 < REPS(0)) GRID_BAR(); }
            PH_END(0) if (BOTH(pb + 0)) GRID_BAR();
        }
        if ((PH_MASK & 8) && IN(pb + 1)) {
            PH_BEGIN
            _Pragma("unroll 1") for (int rep = 0; rep < REPS(1); ++rep) {
            for (int u = blk; u < 256; u += G) attn_unit(proj, (bf16_t*)(ws + WS_ATTN), args.in[I_SINK] + l * 16, u, lds, tid);
            if (!(REP_VARIANT == 1 && rep == 1)) for (int u = blk; u < 256; u += G) { const int g = u >> 3, b = (u >> 2) & 1, q = u & 3;
                ssm_s1_unit(proj, (const bf16_t*)(ws + WS_SSM + (size_t)(l * 32 + g) * SSM_STRIDE + SSM_E), (float*)(ws + WS_SLOC), g, b, q, lds, tid); }
            if (rep + 1 < REPS(1)) GRID_BAR(); }
            PH_END(1) if (BOTH(pb + 1)) GRID_BAR();
        }
        if ((PH_MASK & 16) && IN(pb + 2)) {
            PH_BEGIN
            _Pragma("unroll 1") for (int rep = 0; rep < REPS(2); ++rep) {
            if (!(REP_VARIANT == 1 && rep == 1)) for (int u = blk; u < 256; u += G) { const int g = u >> 3, b = (u >> 2) & 1, q = u & 3;
                ssm_s2_unit(proj, ws + WS_SSM + (size_t)(l * 32 + g) * SSM_STRIDE, (const float*)(ws + WS_SLOC), args.in[I_SD] + l * 512, (bf16_t*)(ws + WS_Y), g, b, q, lds, tid, (REP_VARIANT == 2 && rep == 1) ? 1 : 0); }
            pg8::DenseOrder S; S.init(T, D, AO_F8 ? 512 : 1024, G, blk, ws + WS_WO + (size_t)l * D * 1024 * (AO_F8 ? 1 : 2));
            pg8::EpiAttnProj E{proj, (bf16_t*)(ws + WS_MIXED)};
            pg8::gemm_phase<pg8::EpiAttnProj, pg8::DenseOrder, false, GEMM_SP2, AO_F8 != 0>(lds, (const char*)(ws + WS_ATTN), AO_F8 ? 512 : 1024, S, E, wave);
            if (rep + 1 < REPS(2)) GRID_BAR(); }
            PH_END(2) if (BOTH(pb + 2)) GRID_BAR();
        }
        if ((PH_MASK & 32) && IN(pb + 3)) {
            PH_BEGIN
            const int nrep = REPS(3);
            _Pragma("unroll 1") for (int rep = 0; rep < nrep; ++rep) {
            pg8::DenseOrder S; S.init(T, 4096, GLU_F8 ? 256 : 512, G, blk, ws + WS_WGLU + (size_t)l * 4096 * 512 * (GLU_F8 ? 1 : 2));
            pg8::EpiGlu E{proj, (const bf16_t*)(ws + WS_MIXED), (bf16_t*)(ws + WS_MIXED2)};
            pg8::gemm_phase<pg8::EpiGlu, pg8::DenseOrder, GEMM_ALIGN, GEMM_SP2, GLU_F8 != 0>(lds, (const char*)(ws + WS_Y), GLU_F8 ? 256 : 512, S, E, wave);
            if (rep + 1 < nrep) GRID_BAR(); }
            PH_END(3) if (BOTH(pb + 3)) GRID_BAR();
        }
        if ((PH_MASK & 64) && IN(pb + 4)) {
            PH_BEGIN
            const int nrep = (l == 0 ? REPS(4) : 1);
            _Pragma("unroll 1") for (int rep = 0; rep < nrep; ++rep) {
            pg8::DenseOrder S; S.init(T, D, MIX_F8 ? D / 2 : D, G, blk, ws + WS_WMIX + (size_t)l * D * D * (MIX_F8 ? 1 : 2));
            pg8::EpiMixOut E{l == 0 ? args.in[I_X] : (const float*)nullptr, (const bf16_t*)(ws + WS_XB), (bf16_t*)(ws + WS_XB), mod + (size_t)l * 2 * 12288 + 2 * 2048};
            pg8::gemm_phase<pg8::EpiMixOut, pg8::DenseOrder, false, GEMM_SP2, MIX_F8 != 0>(lds, (const char*)(ws + WS_MIXED2), MIX_F8 ? D / 2 : D, S, E, wave);
            if (rep + 1 < nrep) GRID_BAR(); }
            PH_END(4) if (BOTH(pb + 4)) GRID_BAR();
        }
        if ((PH_MASK & 128) && IN(pb + 5)) {
            PH_BEGIN
            const int nrep = REPS(5);
            _Pragma("unroll 1") for (int rep = 0; rep < nrep; ++rep) {
            const float* modl = mod + (size_t)l * 2 * 12288;
            int* ltok = (int*)(ws + WS_LTOK); int* ldst = (int*)(ws + WS_LDST); float* lw = (float*)(ws + WS_LW);
            LAS unsigned long long* selmask = (LAS unsigned long long*)(lds + SEL_OFF);
            LAS float* selw = (LAS float*)(lds + SEL_OFF + 256);
            const float* wrt = args.in[I_WR] + (size_t)l * D * NE; const float brt = args.in[I_BR][l * NE + lane];
            for (int rb = blk; rb < T / 32; rb += G) {
                const int bb = (rb * 32) / SEQ; const float* sh2 = modl + bb * 12288 + 3 * 2048; const float* sc2 = sh2 + 2048;
#pragma unroll 1
                for (int it = 0; it < 2; ++it) {
                    {
                        f32x4 v[2][4][2]; float ss[2] = {0.f, 0.f};
                        u32x4 xw[2][4]; f32x4 gsc[4][2], gsh[4][2], sc1[4][2];
#pragma unroll
                        for (int rr = 0; rr < 2; ++rr) { const bf16_t* xr = (const bf16_t*)(ws + WS_XB) + (size_t)(rb * 32 + it * 16 + 2 * wave + rr) * D;
#pragma unroll
                            for (int j = 0; j < 4; ++j) xw[rr][j] = *(const GAS u32x4*)(xr + 8 * (lane + 64 * j)); }
#pragma unroll
                        for (int j = 0; j < 4; ++j)
#pragma unroll
                            for (int h = 0; h < 2; ++h) { const int c = 8 * (lane + 64 * j) + 4 * h;
                                gsc[j][h] = *(const GAS f32x4*)(args.in[I_NFFN] + l * D + c); sc1[j][h] = *(const GAS f32x4*)(sc2 + c); gsh[j][h] = *(const GAS f32x4*)(sh2 + c); }
#pragma unroll
                        for (int rr = 0; rr < 2; ++rr) asm volatile("" : "+v"(xw[rr][0]), "+v"(xw[rr][1]), "+v"(xw[rr][2]), "+v"(xw[rr][3]) :: "memory");
#pragma unroll
                        for (int j = 0; j < 4; ++j) asm volatile("" : "+v"(gsc[j][0]), "+v"(gsc[j][1]), "+v"(sc1[j][0]), "+v"(sc1[j][1]), "+v"(gsh[j][0]), "+v"(gsh[j][1]) :: "memory");
#pragma unroll
                        for (int rr = 0; rr < 2; ++rr)
#pragma unroll
                            for (int j = 0; j < 4; ++j) pg8::unpack8(xw[rr][j], v[rr][j][0], v[rr][j][1]);
#pragma unroll
                        for (int j = 0; j < 4; ++j)
#pragma unroll
                            for (int h = 0; h < 2; ++h) gsc[j][h] = gsc[j][h] * (sc1[j][h] + 1.0f);
#pragma unroll
                        for (int rr = 0; rr < 2; ++rr)
#pragma unroll
                            for (int j = 0; j < 4; ++j)
#pragma unroll
                                for (int h = 0; h < 2; ++h) ss[rr] += v[rr][j][h][0] * v[rr][j][h][0] + v[rr][j][h][1] * v[rr][j][h][1] + v[rr][j][h][2] * v[rr][j][h][2] + v[rr][j][h][3] * v[rr][j][h][3];
#pragma unroll
                        for (int rr = 0; rr < 2; ++rr) { const int lr = 2 * wave + rr, row = rb * 32 + it * 16 + lr;
                            const float rstd = 1.0f / sqrtf(wave_sum(ss[rr]) * (1.0f / D) + NORM_EPS);
                            unsigned char* hrow8 = (unsigned char*)hbuf + (size_t)row * D;
#pragma unroll
                            for (int j = 0; j < 4; ++j) { const int c = 8 * (lane + 64 * j); f32x4 o[2];
#pragma unroll
                                for (int h = 0; h < 2; ++h) o[h] = v[rr][j][h] * rstd * gsc[j][h] + gsh[j][h];
                                const u32x4 hiw = pg8::pack8(o[0], o[1]); *(GAS u32x2*)(hrow8 + c) = (u32x2){pg8::pk_fp8x4(o[0]), pg8::pk_fp8x4(o[1])};
                                f32x4 h0, h1; pg8::unpack8(hiw, h0, h1); const u32x4 low = pg8::pack8(o[0] - h0, o[1] - h1);
                                const int so = lr * 4096 + (((lane + 64 * j) ^ lr) << 4);
                                *(LAS u32x4*)(lds + so) = hiw; *(LAS u32x4*)(lds + 65536 + so) = low; } }
                    }
                    f32x4 racc[4];
                    {
                        const GAS bf16_t* whi = (const GAS bf16_t*)(ws + WS_WRT) + (size_t)(l * 2) * 64 * 2048 + 256 * wave; const GAS bf16_t* wlo = whi + 64 * 2048;
                        const int lop = opaque(lane), r16 = lop & 15, q4 = lop >> 4;
#pragma unroll
                        for (int nt = 0; nt < 4; ++nt) racc[nt] = (f32x4){0.f, 0.f, 0.f, 0.f};
                        auto ldB = [&](int kp, bf16x8 (&bh)[2][4], bf16x8 (&bl)[2][4]) {
#pragma unroll
                            for (int k2 = 0; k2 < 2; ++k2)
#pragma unroll
                                for (int nt = 0; nt < 4; ++nt) { const size_t wo = (size_t)(16 * nt + r16) * 2048 + 32 * (2 * kp + k2) + 8 * q4; bh[k2][nt] = *(const GAS bf16x8*)(whi + wo); bl[k2][nt] = *(const GAS bf16x8*)(wlo + wo); } };
                        auto mm = [&](int kp, const bf16x8 (&bh)[2][4], const bf16x8 (&bl)[2][4]) {
#pragma unroll
                            for (int k2 = 0; k2 < 2; ++k2) { const int chunk = 32 * wave + 4 * (2 * kp + k2) + q4, so = r16 * 4096 + ((chunk ^ r16) << 4);
                                const bf16x8 ah = *(const LAS bf16x8*)(lds + so), al = *(const LAS bf16x8*)(lds + 65536 + so);
#pragma unroll
                                for (int nt = 0; nt < 4; ++nt) {
                                    racc[nt] = __builtin_amdgcn_mfma_f32_16x16x32_bf16(ah, bh[k2][nt], racc[nt], 0, 0, 0);
                                    racc[nt] = __builtin_amdgcn_mfma_f32_16x16x32_bf16(al, bh[k2][nt], racc[nt], 0, 0, 0);
                                    racc[nt] = __builtin_amdgcn_mfma_f32_16x16x32_bf16(ah, bl[k2][nt], racc[nt], 0, 0, 0); } } };
#define RT_FENCE() asm volatile("" ::: "memory")
#define RT_PIN() asm volatile("" : "+v"(racc[0]), "+v"(racc[1]), "+v"(racc[2]), "+v"(racc[3]) :: "memory")
                        bf16x8 bhA[2][4], blA[2][4], bhB[2][4], blB[2][4];
                        RT_FENCE(); ldB(0, bhA, blA); ldB(1, bhB, blB); RT_FENCE();
                        __syncthreads();
                        mm(0, bhA, blA); RT_PIN(); ldB(2, bhA, blA); RT_FENCE();
                        mm(1, bhB, blB); RT_PIN(); ldB(3, bhB, blB); RT_FENCE();
                        mm(2, bhA, blA); mm(3, bhB, blB);
#undef RT_FENCE
#undef RT_PIN
                    }
                    __syncthreads();
                    LAS float* part = (LAS float*)lds;
#pragma unroll
                    for (int nt = 0; nt < 4; ++nt)
#pragma unroll
                        for (int r = 0; r < 4; ++r) part[(wave * 16 + 4 * (lane >> 4) + r) * 64 + 16 * nt + (lane & 15)] = racc[nt][r];
                    __syncthreads();
#pragma unroll 1
                    for (int rr = 0; rr < 2; ++rr) { const int lr = 2 * wave + rr; float logit = 0.f;
#pragma unroll
                        for (int w8 = 0; w8 < 8; ++w8) logit += part[(w8 * 16 + lr) * 64 + lane];
                        const float score = 1.0f / (1.0f + __expf(-logit)); const float sel = score + brt;
                        const int ll = lane_now(); float m1 = sel; m1 = fmaxf(m1, shx(m1, 1, ll)); m1 = fmaxf(m1, shx(m1, 2, ll)); m1 = fmaxf(m1, shx(m1, 4, ll));
                        const unsigned long long bm = __ballot(sel == m1); const unsigned gb = (unsigned)(bm >> (lane & 56)) & 0xffu; const int first = __builtin_ctz(gb);
                        float v2 = ((lane & 7) == first) ? -3.0e38f : sel; v2 = fmaxf(v2, shx(v2, 1, ll)); v2 = fmaxf(v2, shx(v2, 2, ll)); v2 = fmaxf(v2, shx(v2, 4, ll));
                        const float gs = m1 + v2; int grank = 0; const int mygrp = lane >> 3;
#pragma unroll
                        for (int gg = 0; gg < 8; ++gg) { const float o = shl_from(gs, gg * 8); grank += (o > gs || (o == gs && gg < mygrp)) ? 1 : 0; }
                        float val = grank < 4 ? sel : -3.0e38f; unsigned long long cm = 0ull;
#pragma unroll
                        for (int pick = 0; pick < 8; ++pick) {
                            float mxv = val;
#pragma unroll
                            for (int o = 1; o < 64; o <<= 1) mxv = fmaxf(mxv, shx(mxv, o, ll));
                            const unsigned long long bmx = __ballot(val == mxv); const int sl = __builtin_ctzll(bmx);
                            cm |= 1ull << sl; if (lane == sl) val = -3.4e38f; }
                        const bool chosen = (cm >> lane) & 1ull; const float sw = wave_sum(chosen ? score : 0.f);
                        const int gr = it * 16 + lr;
                        selw[gr * 64 + lane] = chosen ? score / sw * 2.5f : 0.f;
                        if (lane == 0) selmask[gr] = cm; }
                    __syncthreads();
                }
                if (wave == 0 && rep + 1 == nrep) {
                    int cntl = 0;
                    for (int r = 0; r < 32; ++r) cntl += (int)((selmask[r] >> lane) & 1ull);
                    int pos = cntl ? (int)atomicAdd(ctl + CW_CNT + l * 64 + opaque(lane), (unsigned)cntl) : 0;
                    for (int r = 0; r < 32; ++r) { const unsigned long long m = selmask[r];
                        if ((m >> lane) & 1ull) { const int k = __builtin_popcountll(m & ((1ull << lane) - 1ull)); const int tok = rb * 32 + r; const int li = lane * 8192 + pos;
                            ltok[li] = tok; ldst[li] = tok * NSLOT + k; ((float*)(ws + WS_TOKW))[tok * 8 + k] = selw[r * 64 + lane]; ++pos; } }
                }
                __syncthreads();
            }
            if (rep + 1 < nrep) GRID_BAR(); }
            PH_END(5) if (BOTH(pb + 5)) GRID_BAR();
        }
        if ((PH_MASK & 256) && IN(pb + 6)) {
            PH_BEGIN
            _Pragma("unroll 1") for (int rep = 0; rep < REPS(6); ++rep) {
            LAS int* tpre = (LAS int*)(lds + MOE_OFF); LAS int* ebase = tpre + 65; LAS int* ecnt = ebase + 65; LAS int* utab = (LAS int*)(lds + MOE_OFF + 1024);
            pg8::moe_build<4, true>(tpre, ebase, ecnt, utab, ctl + CW_CNT + l * 64, G, blk, tid);
            pg8::MoeOrder<4, true> S{utab, (const char*)(ws + WS_WGU + (size_t)l * 65 * 1024 * 2048), (size_t)1024 * 2048, (size_t)256 * 2048, (const int*)(ws + WS_LTOK)};
            pg8::EpiGateUp E{(unsigned char*)(ws + WS_HID)};
            pg8::gemm_phase<pg8::EpiGateUp, pg8::MoeOrder<4, true>, GEMM_ALIGN, GEMM_SP2, true>(lds, (const char*)hbuf, D / 2, S, E, wave);
            if (rep + 1 < REPS(6)) GRID_BAR(); }
            PH_END(6) if (BOTH(pb + 6)) GRID_BAR();
        }
        if ((PH_MASK & 512) && IN(pb + 7)) {
            PH_BEGIN
            _Pragma("unroll 1") for (int rep = 0; rep < REPS(7); ++rep) {
            LAS int* tpre = (LAS int*)(lds + MOE_OFF); LAS int* ebase = tpre + 65; LAS int* ecnt = ebase + 65; LAS int* utab = (LAS int*)(lds + MOE_OFF + 1024);
            pg8::moe_build<8, false>(tpre, ebase, ecnt, utab, ctl + CW_CNT + l * 64, G, blk, tid);
            constexpr size_t DB = DOWN_F8 ? 1 : 2;
            pg8::MoeOrder<8, false> S{utab, (const char*)(ws + WS_WD + (size_t)l * 65 * 2048 * 512 * DB), (size_t)2048 * 512 * DB, (size_t)256 * 512 * DB, (const int*)(ws + WS_LTOK)};
            pg8::EpiDown E{(unsigned char*)(ws + WS_YSLOT), (const int*)(ws + WS_LDST), (LAS int*)(lds + SEL_OFF), (REP_VARIANT && rep == 1) ? 1 : 0};
            pg8::gemm_phase<pg8::EpiDown, pg8::MoeOrder<8, false>, GEMM_ALIGN, GEMM_SP2, DOWN_F8 != 0>(lds, (const char*)(ws + WS_HID), DOWN_F8 ? 256 : 512, S, E, wave);
            if (rep + 1 < REPS(7)) GRID_BAR(); }
            PH_END(7) if (BOTH(pb + 7)) GRID_BAR();
        }
        if ((PH_MASK & 1024) && IN(pb + 8)) {
            PH_BEGIN
            const int nrep = REPS(8);
            _Pragma("unroll 1") for (int rep = 0; rep < nrep; ++rep) {
            const float* modl = mod + (size_t)l * 2 * 12288;
            const unsigned char* yslot = (const unsigned char*)(ws + WS_YSLOT);
            for (int run = blk * NWAVES + wave; run < T / 4; run += G * NWAVES) {
                const int bb = (run * 4) / SEQ; const float* gt2 = modl + bb * 12288 + 5 * 2048;
                const float* m1 = mod + (size_t)2 * 12288 + bb * 12288;
                f32x4 gtv[2][4];
#pragma unroll
                for (int jj = 0; jj < 2; ++jj)
#pragma unroll
                    for (int q = 0; q < 4; ++q) { const int c = 16 * (lane + 64 * jj) + 4 * q; gtv[jj][q] = *(const GAS f32x4*)(gt2 + c) * pg8::YS_INV; }
#pragma unroll 1
                for (int pr = 0; pr < 2; ++pr) {
                    f32x4 v[2][2][4]; float ss[2] = {0.f, 0.f};
                    const int rowb = run * 4 + pr * 2;
                    f32x4 tw[2][2];
#pragma unroll
                    for (int rr = 0; rr < 2; ++rr) { tw[rr][0] = *(const GAS f32x4*)((const float*)(ws + WS_TOKW) + (rowb + rr) * 8); tw[rr][1] = *(const GAS f32x4*)((const float*)(ws + WS_TOKW) + (rowb + rr) * 8 + 4); }
                    auto issue = [&](int rr, int jj, u32x4 (&w)[NSLOT], u32x4 (&xq)[2]) {
                        const int c = 16 * (lane + 64 * jj); const unsigned char* ys = yslot + (size_t)(rowb + rr) * NSLOT * D + c;
#pragma unroll
                        for (int k = 0; k < NSLOT; ++k) w[k] = *(const GAS u32x4*)(ys + (size_t)k * D);
                        const bf16_t* xr = (const bf16_t*)(ws + WS_XB) + (size_t)(rowb + rr) * D + c; xq[0] = *(const GAS u32x4*)xr; xq[1] = *(const GAS u32x4*)(xr + 8); };
                    auto consume = [&](int rr, int jj, const u32x4 (&w)[NSLOT], const u32x4 (&xq)[2]) {
                        f32x4 a[4];
#pragma unroll
                        for (int q = 0; q < 4; ++q) a[q] = (f32x4){0.f, 0.f, 0.f, 0.f};
#pragma unroll
                        for (int k = 0; k < NSLOT; ++k) { const float wk = k < 8 ? tw[rr][k >> 2][k & 3] : 1.0f;
#pragma unroll
                            for (int q = 0; q < 4; ++q) { const f32x2 lo = __builtin_amdgcn_cvt_pk_f32_fp8((int)w[k][q], false), hi = __builtin_amdgcn_cvt_pk_f32_fp8((int)w[k][q], true); a[q] += (f32x4){lo.x, lo.y, hi.x, hi.y} * wk; } }
                        f32x4 xv[4]; pg8::unpack8(xq[0], xv[0], xv[1]); pg8::unpack8(xq[1], xv[2], xv[3]);
#pragma unroll
                        for (int q = 0; q < 4; ++q) { v[rr][jj][q] = xv[q] + gtv[jj][q] * a[q];
                            ss[rr] += v[rr][jj][q][0] * v[rr][jj][q][0] + v[rr][jj][q][1] * v[rr][jj][q][1] + v[rr][jj][q][2] * v[rr][jj][q][2] + v[rr][jj][q][3] * v[rr][jj][q][3]; } };
                    {
                        u32x4 wA[NSLOT], xA[2], wB[NSLOT], xB[2];
#define CMB_FENCE() asm volatile("" ::: "memory")
#define CMB_PIN(x) asm volatile("" : "+v"(x) :: "memory")
                        issue(0, 0, wA, xA); issue(0, 1, wB, xB); CMB_FENCE();
                        consume(0, 0, wA, xA); CMB_PIN(ss[0]); issue(1, 0, wA, xA); CMB_FENCE();
                        consume(0, 1, wB, xB); CMB_PIN(ss[0]); issue(1, 1, wB, xB); CMB_FENCE();
                        consume(1, 0, wA, xA); consume(1, 1, wB, xB); CMB_PIN(ss[1]);
#undef CMB_FENCE
#undef CMB_PIN
                    }
                    f32x4 gs[2][4], gh[2][4];
                    if (l == 0) {
#pragma unroll
                        for (int jj = 0; jj < 2; ++jj)
#pragma unroll
                            for (int q = 0; q < 4; ++q) { const int c = 16 * (lane + 64 * jj) + 4 * q;
                                gs[jj][q] = *(const GAS f32x4*)(args.in[I_NMIX] + D + c) * (*(const GAS f32x4*)(m1 + 2048 + c) + 1.0f); gh[jj][q] = *(const GAS f32x4*)(m1 + c); }
                    } else {
#pragma unroll
                        for (int jj = 0; jj < 2; ++jj)
#pragma unroll
                            for (int q = 0; q < 4; ++q) { const int c = 16 * (lane + 64 * jj) + 4 * q; gs[jj][q] = *(const GAS f32x4*)(args.in[I_NFIN] + c); gh[jj][q] = (f32x4){0.f, 0.f, 0.f, 0.f}; }
                    }
#pragma unroll
                    for (int rr = 0; rr < 2; ++rr) { const int row = rowb + rr;
                        const float rstd = 1.0f / sqrtf(wave_sum(ss[rr]) * (1.0f / D) + NORM_EPS);
                        float* xw = (rep + 1 == nrep) ? xbuf + (size_t)row * D : (float*)(ws + WS_HID) + (size_t)row * D; bf16_t* hw = (rep + 1 == nrep) ? hbuf + (size_t)row * D : (bf16_t*)(ws + WS_MIXED2) + (size_t)row * D;
                        unsigned char* hw8 = (rep + 1 == nrep) ? (unsigned char*)hbuf + (size_t)row * D : (unsigned char*)(ws + WS_MIXED2) + (size_t)row * D; (void)hw8; (void)hw;
                        bf16_t* xbw = (rep + 1 == nrep) ? (bf16_t*)(ws + WS_XB) + (size_t)row * D : (bf16_t*)(ws + WS_MIXED) + (size_t)row * D;
                        if (l == 0) {
#pragma unroll
                            for (int jj = 0; jj < 2; ++jj) { const int c = 16 * (lane + 64 * jj); f32x4 o[4];
                                *(GAS u32x4*)(xbw + c) = pg8::pack8(v[rr][jj][0], v[rr][jj][1]); *(GAS u32x4*)(xbw + c + 8) = pg8::pack8(v[rr][jj][2], v[rr][jj][3]);
#pragma unroll
                                for (int q = 0; q < 4; ++q) o[q] = v[rr][jj][q] * rstd * gs[jj][q] + gh[jj][q];
                                if (INP_F8) *(GAS u32x4*)((unsigned char*)hw8 + c) = (u32x4){pg8::pk_fp8x4(o[0]), pg8::pk_fp8x4(o[1]), pg8::pk_fp8x4(o[2]), pg8::pk_fp8x4(o[3])};
                                else { *(GAS u32x4*)(hw + c) = pg8::pack8(o[0], o[1]); *(GAS u32x4*)(hw + c + 8) = pg8::pack8(o[2], o[3]); } }
                        } else {
#pragma unroll
                            for (int jj = 0; jj < 2; ++jj) { const int c = 16 * (lane + 64 * jj);
#pragma unroll
                                for (int q = 0; q < 4; ++q) *(GAS f32x4*)(xw + c + 4 * q) = v[rr][jj][q] * rstd * gs[jj][q]; }
                        } }
                }
            }
            if (rep + 1 < nrep) GRID_BAR(); }
            PH_END(8) if (BOTH(pb + 8)) GRID_BAR();
        }
    }
#undef IN
#undef BOTH
#undef GRID_BAR
}

extern "C" void kernel_launch(void* const* d_in, const int* in_sizes, int n_in, void* d_out, int out_size, void* d_ws, size_t ws_size, hipStream_t stream) {
    static int grid = 0;
    if (grid == 0) {
        if (n_in != 29 || out_size != T * D || ws_size < WS_END) { fprintf(stderr, "kernel_launch: unexpected shapes (n_in %d out %d ws %zu)\n", n_in, out_size, ws_size); grid = -1; return; }
        int dev = 0, cus = 0, per_cu = 0;
        if (hipGetDevice(&dev) != hipSuccess || hipDeviceGetAttribute(&cus, hipDeviceAttributeMultiprocessorCount, dev) != hipSuccess) { grid = -1; return; }
        if (hipFuncSetAttribute((const void*)mega_fwd, hipFuncAttributeMaxDynamicSharedMemorySize, LDS_BYTES) != hipSuccess) { fprintf(stderr, "kernel_launch: hipFuncSetAttribute failed\n"); grid = -1; return; }
        if (hipOccupancyMaxActiveBlocksPerMultiprocessor(&per_cu, (const void*)mega_fwd, NWAVES * 64, LDS_BYTES) != hipSuccess || per_cu < 1) { fprintf(stderr, "kernel_launch: occupancy query says %d\n", per_cu); }
        (void)hipGetLastError();
        grid = cus & ~7;
    }
    if (grid < 0) return;
    (void)hipMemsetAsync((char*)d_ws + WS_CTL, 0, CTL_ZERO_BYTES, stream);
    Args a{};
    for (int i = 0; i < 29; ++i) a.in[i] = (const float*)d_in[i];
    a.out = (float*)d_out; a.ws = (unsigned char*)d_ws;
    if (N_LAUNCHES == 1) { a.ph_lo = 0; a.ph_hi = 20; hipLaunchKernelGGL(mega_fwd, dim3(grid), dim3(NWAVES * 64), LDS_BYTES, stream, a); }
    else { for (int p = 0; p < 20; ++p) { a.ph_lo = p; a.ph_hi = p + 1; hipLaunchKernelGGL(mega_fwd, dim3(grid), dim3(NWAVES * 64), LDS_BYTES, stream, a); } }
}
```
